# Optimizing an MI355X kernel written in HIP

```python
import math
import jax
import jax.numpy as jnp
from jax import lax
import numpy as np

D_MODEL = 1024
BATCH = 32
SEQ = 256
DEPTH = 2
DEC_BATCH = 4
DEC_SEQ = 2048
PAST_LEN = 256

GRID_W = 64
ROPE_BASE = 10000.0
NORM_EPS = 1e-6
SCAN_CHUNK = 128
Q_BLOCK = 128
CONV_W = 3
N_BRANCH = 4
SSD_HEADS = 8
SSD_HEAD_DIM = 64
SSD_INNER = SSD_HEADS * SSD_HEAD_DIM
SSD_GROUPS = 2
SSD_STATE = 64
SSD_CONV_CH = SSD_INNER + 2 * SSD_GROUPS * SSD_STATE
RET_HEADS = 4
RET_QK = 64
RET_V = 128
ATT_HEADS = 8
ATT_KV_HEADS = 2
ATT_HEAD_DIM = 64
MLA_HEADS = 8
MLA_Q_RANK = 384
MLA_KV_RANK = 256
MLA_NOPE = 64
MLA_ROPE = 32
MLA_V = 64
D_FF = 2816
IN_WIDTHS = (SSD_INNER, SSD_CONV_CH, 2 * SSD_HEADS,
             RET_HEADS * RET_QK, RET_HEADS * RET_QK, RET_HEADS * RET_V, RET_HEADS * RET_V,
             ATT_HEADS * ATT_HEAD_DIM, ATT_KV_HEADS * ATT_HEAD_DIM, ATT_KV_HEADS * ATT_HEAD_DIM,
             MLA_Q_RANK, MLA_KV_RANK + MLA_ROPE)
IN_W = sum(IN_WIDTHS)

kernel_name = 'hybrid_prefix_diffusion_step'


def _rmsnorm(x, w):
    xf = x.astype(jnp.float32)
    y = xf * lax.rsqrt(jnp.mean(xf * xf, axis=-1, keepdims=True) + NORM_EPS)
    return y.astype(x.dtype) * w


def _head_layernorm(x):
    xf = x.astype(jnp.float32)
    xc = xf - jnp.mean(xf, axis=-1, keepdims=True)
    return xc * lax.rsqrt(jnp.mean(xc * xc, axis=-1, keepdims=True) + NORM_EPS)


def _dwconv_centred(x, w, b):
    pad = w.shape[0] // 2
    L = x.shape[1]
    xp = jnp.pad(x, ((0, 0), (pad, pad), (0, 0)))
    y = b
    for j in range(w.shape[0]):
        y = y + xp[:, j:j + L, :] * w[j]
    return y


def _rotate(x, ang):
    x1, x2 = jnp.split(x.astype(jnp.float32), 2, axis=-1)
    cos = jnp.cos(ang)[None, :, None, :]
    sin = jnp.sin(ang)[None, :, None, :]
    return jnp.concatenate([x1 * cos - x2 * sin, x2 * cos + x1 * sin], axis=-1).astype(x.dtype)


def _rope_2d(x):
    L = x.shape[1]
    d_axis = x.shape[-1] // 2
    n_rows = L // GRID_W
    rows = jnp.repeat(jnp.arange(n_rows, dtype=jnp.float32), GRID_W)
    cols = jnp.tile(jnp.arange(GRID_W, dtype=jnp.float32), n_rows)
    inv_freq = ROPE_BASE ** (-jnp.arange(0, d_axis, 2, dtype=jnp.float32) / d_axis)
    xr = _rotate(x[..., :d_axis], rows[:, None] * inv_freq[None, :])
    xc = _rotate(x[..., d_axis:], cols[:, None] * inv_freq[None, :])
    return jnp.concatenate([xr, xc], axis=-1)


def _chunk_scan(q, k, v, log_a, s0):
    bsz, L, nh, dk = q.shape
    dv = v.shape[-1]
    nc = L // SCAN_CHUNK
    T = SCAN_CHUNK
    f32 = jnp.float32
    qc = q.astype(f32).reshape(bsz, nc, T, nh, dk)
    kc = k.astype(f32).reshape(bsz, nc, T, nh, dk)
    vc = v.astype(f32).reshape(bsz, nc, T, nh, dv)
    acum = jnp.cumsum(log_a.astype(f32).reshape(bsz, nc, T, nh), axis=2)
    diff = acum[:, :, :, None, :] - acum[:, :, None, :, :]
    lower = jnp.tril(jnp.ones((T, T), dtype=bool))[None, None, :, :, None]
    decay = jnp.exp(jnp.where(lower, diff, -jnp.inf))
    scores = jnp.einsum('bcihd,bcjhd->bcijh', qc, kc) * decay
    o_intra = jnp.einsum('bcijh,bcjhe->bcihe', scores, vc)
    w_end = jnp.exp(acum[:, :, -1:, :] - acum)
    chunk_states = jnp.einsum('bcjhd,bcjh,bcjhe->bchde', kc, w_end, vc)
    chunk_decay = jnp.exp(acum[:, :, -1, :])

    def step(s, inp):
        cs, cd = inp
        return s * cd[..., None, None] + cs, s

    s_final, s_prev = lax.scan(step, s0.astype(f32),
                               (chunk_states.transpose(1, 0, 2, 3, 4), chunk_decay.transpose(1, 0, 2)))
    s_prev = s_prev.transpose(1, 0, 2, 3, 4)
    o_inter = jnp.einsum('bcihd,bchde->bcihe', qc * jnp.exp(acum)[..., None], s_prev)
    return (o_intra + o_inter).reshape(bsz, L, nh, dv), s_final


def _bidir_scan(q, k_f, k_b, v, la_f, la_b, s0_f, s0_b):
    o_f, s_f = _chunk_scan(q, k_f, v, la_f, s0_f)
    o_b, s_b = _chunk_scan(jnp.flip(q, 1), jnp.flip(k_b, 1), jnp.flip(v, 1), jnp.flip(la_b, 1), s0_b)
    return o_f + jnp.flip(o_b, 1), s_f, s_b


def _attention(q, k, v, scale):
    bsz, lq, n_h, dk = q.shape
    n_g = k.shape[2]
    rep = n_h // n_g
    nb = lq // Q_BLOCK
    qb = q.reshape(bsz, nb, Q_BLOCK, n_g, rep, dk).transpose(1, 0, 2, 3, 4, 5)

    def block(q_blk):
        s = jnp.einsum('bqgrd,bkgd->bgrqk', q_blk, k, preferred_element_type=jnp.float32) * scale
        p = jax.nn.softmax(s, axis=-1).astype(v.dtype)
        return jnp.einsum('bgrqk,bkge->bqgre', p, v)

    o = lax.map(block, qb)
    return o.transpose(1, 0, 2, 3, 4, 5).reshape(bsz, lq, n_h, v.shape[-1])


def _token_mixer(h, lw, ctx):
    bsz, L, _ = h.shape
    latent = ctx is not None
    f32 = jnp.float32
    split_at = np.cumsum(IN_WIDTHS)[:-1].tolist()
    (z, xbc, dt_raw, rq, rk, rv, rg, aq, ak, av, mcq, mckv) = jnp.split(h @ lw['w_in'], split_at, axis=-1)

    xbc = jax.nn.silu(_dwconv_centred(xbc, lw['ssd_conv_w'], lw['ssd_conv_b']))
    xs, bm, cm = jnp.split(xbc, [SSD_INNER, SSD_INNER + SSD_GROUPS * SSD_STATE], axis=-1)
    xs = xs.reshape(bsz, L, SSD_HEADS, SSD_HEAD_DIM)
    rep = SSD_HEADS // SSD_GROUPS
    bh = jnp.repeat(bm.reshape(bsz, L, SSD_GROUPS, SSD_STATE), rep, axis=2)
    ch = jnp.repeat(cm.reshape(bsz, L, SSD_GROUPS, SSD_STATE), rep, axis=2)
    dt = jax.nn.softplus(dt_raw.reshape(bsz, L, 2, SSD_HEADS).astype(f32) + lw['ssd_dt_bias'].astype(f32))
    a = -jnp.exp(lw['ssd_a_log'].astype(f32))
    s0 = ctx['ssd'] if latent else jnp.zeros((bsz, 2, SSD_HEADS, SSD_STATE, SSD_HEAD_DIM), f32)
    y, ssd_f, ssd_b = _bidir_scan(ch, bh * dt[:, :, 0, :, None], bh * dt[:, :, 1, :, None], xs,
                                  dt[:, :, 0] * a[0], dt[:, :, 1] * a[1], s0[:, 0], s0[:, 1])
    y = y.astype(h.dtype) + lw['ssd_d'][:, None] * xs
    o_ssd = _rmsnorm(y.reshape(bsz, L, SSD_INNER) * jax.nn.silu(z), lw['ssd_norm_w'])

    rq = rq.reshape(bsz, L, RET_HEADS, RET_QK)
    rk = rk.reshape(bsz, L, RET_HEADS, RET_QK) * RET_QK ** -0.5
    rv = rv.reshape(bsz, L, RET_HEADS, RET_V)
    if latent:
        rq = _rope_2d(rq)
        rk = _rope_2d(rk)
    la = jax.nn.log_sigmoid(lw['ret_decay_logit'].astype(f32))
    la_f = jnp.broadcast_to(la[0], (bsz, L, RET_HEADS))
    la_b = jnp.broadcast_to(la[1], (bsz, L, RET_HEADS))
    r0 = ctx['ret'] if latent else jnp.zeros((bsz, 2, RET_HEADS, RET_QK, RET_V), f32)
    o, ret_f, ret_b = _bidir_scan(rq, rk, rk, rv, la_f, la_b, r0[:, 0], r0[:, 1])
    o_ret = (_head_layernorm(o).astype(h.dtype).reshape(bsz, L, RET_HEADS * RET_V)
             * lw['ret_gn_w'] * jax.nn.silu(rg))

    aq = _rmsnorm(aq.reshape(bsz, L, ATT_HEADS, ATT_HEAD_DIM), lw['att_q_norm'])
    ak = _rmsnorm(ak.reshape(bsz, L, ATT_KV_HEADS, ATT_HEAD_DIM), lw['att_k_norm'])
    av = av.reshape(bsz, L, ATT_KV_HEADS, ATT_HEAD_DIM)
    if latent:
        keys = jnp.concatenate([ctx['att_k'], _rope_2d(ak)], axis=1)
        vals = jnp.concatenate([ctx['att_v'], av], axis=1)
        q_att = _rope_2d(aq)
    else:
        keys, vals, q_att = ak, av, aq
    o_att = _attention(q_att, keys, vals, ATT_HEAD_DIM ** -0.5).reshape(bsz, L, ATT_HEADS * ATT_HEAD_DIM)

    qm = (_rmsnorm(mcq, lw['mla_q_norm']) @ lw['mla_w_uq']).reshape(bsz, L, MLA_HEADS, MLA_NOPE + MLA_ROPE)
    q_nope, q_rope = jnp.split(qm, [MLA_NOPE], axis=-1)
    ckv = _rmsnorm(mckv[..., :MLA_KV_RANK], lw['mla_kv_norm'])
    krope = mckv[..., MLA_KV_RANK:]
    if latent:
        q_rope = _rope_2d(q_rope)
        ckv_keys = jnp.concatenate([ctx['mla_ckv'], ckv], axis=1)
        kr_keys = jnp.concatenate([ctx['mla_krope'], _rope_2d(krope[:, :, None, :])[:, :, 0, :]], axis=1)
    else:
        ckv_keys, kr_keys = ckv, krope
    lk = ckv_keys.shape[1]
    kv = (ckv_keys @ lw['mla_w_ukv']).reshape(bsz, lk, MLA_HEADS, MLA_NOPE + MLA_V)
    k_nope, v_m = jnp.split(kv, [MLA_NOPE], axis=-1)
    k_m = jnp.concatenate([k_nope, jnp.broadcast_to(kr_keys[:, :, None, :], (bsz, lk, MLA_HEADS, MLA_ROPE))], axis=-1)
    q_m = jnp.concatenate([q_nope, q_rope], axis=-1)
    o_mla = _attention(q_m, k_m, v_m, (MLA_NOPE + MLA_ROPE) ** -0.5).reshape(bsz, L, MLA_HEADS * MLA_V)

    g = jax.nn.sigmoid((h @ lw['w_merge'] + lw['b_merge']).astype(f32)).astype(h.dtype)
    g = g.reshape(bsz, L, N_BRANCH, D_MODEL)
    merged = (g[:, :, 0] * (o_ssd @ lw['w_br_ssd']) + g[:, :, 1] * (o_ret @ lw['w_br_ret'])
              + g[:, :, 2] * (o_att @ lw['w_br_att']) + g[:, :, 3] * (o_mla @ lw['w_br_mla']))
    out = merged @ lw['w_out']
    if latent:
        return out, None
    cache = {
        'ssd': jnp.stack([ssd_f, ssd_b], axis=1).astype(h.dtype),
        'ret': jnp.stack([ret_f, ret_b], axis=1).astype(h.dtype),
        'att_k': ak, 'att_v': av, 'mla_ckv': ckv, 'mla_krope': krope,
    }
    return out, cache


def _conv_ffn(h, lw):
    u = _dwconv_centred(h @ lw['w_ffn_up'], lw['ffn_conv_w'], lw['ffn_conv_b'])
    up, gate = jnp.split(u, 2, axis=-1)
    return (jax.nn.silu(gate) * up) @ lw['w_ffn_down']


def _trunk_layer(x, mod, lw, ctx):
    sh_a, sc_a, g_a, sh_f, sc_f, g_f = jnp.split(mod[:, None, :], 6, axis=-1)
    h = _rmsnorm(x, lw['g_pre_mix']) * (1.0 + sc_a) + sh_a
    m, cache = _token_mixer(h, lw, ctx)
    x = x + g_a * _rmsnorm(m, lw['g_post_mix'])
    h = _rmsnorm(x, lw['g_pre_ffn']) * (1.0 + sc_f) + sh_f
    x = x + g_f * _rmsnorm(_conv_ffn(h, lw), lw['g_post_ffn'])
    return x, cache


def setup_inputs(seed: int = 0) -> dict:
    key = jax.random.key(seed)
    ks = jax.random.split(key, 48)
    f32 = jnp.float32

    def nrm(i, shape, scale=1.0):
        return jax.random.normal(ks[i], shape, f32) * scale

    def gain(i, shape):
        return 1.0 + 0.02 * jax.random.normal(ks[i], shape, f32)

    a_log = jnp.log(jax.random.uniform(ks[10], (DEPTH, 2, SSD_HEADS), f32, 1.0, 16.0))
    dt0 = jnp.exp(jax.random.uniform(ks[11], (DEPTH, 2, SSD_HEADS), f32, math.log(1e-3), math.log(1e-1)))
    dt_bias = dt0 + jnp.log(-jnp.expm1(-dt0))
    gamma = 1.0 - 2.0 ** (-5.0 - jnp.arange(RET_HEADS, dtype=f32))
    ret_logit = (jnp.log(gamma) - jnp.log1p(-gamma))[None, None, :] + nrm(12, (DEPTH, 2, RET_HEADS), 0.1)
    return {
        'x_prompt': nrm(0, (BATCH, SEQ, D_MODEL)),
        'x_sample': nrm(1, (DEC_BATCH, DEC_SEQ, D_MODEL)),
        'state_ssd': nrm(2, (DEC_BATCH, DEPTH, 2, SSD_HEADS, SSD_STATE, SSD_HEAD_DIM), 0.5),
        'state_ret': nrm(3, (DEC_BATCH, DEPTH, 2, RET_HEADS, RET_QK, RET_V), 0.5),
        'cache_att_k': nrm(4, (DEC_BATCH, DEPTH, PAST_LEN, ATT_KV_HEADS, ATT_HEAD_DIM)),
        'cache_att_v': nrm(5, (DEC_BATCH, DEPTH, PAST_LEN, ATT_KV_HEADS, ATT_HEAD_DIM)),
        'cache_mla_ckv': nrm(6, (DEC_BATCH, DEPTH, PAST_LEN, MLA_KV_RANK)),
        'cache_mla_krope': nrm(7, (DEC_BATCH, DEPTH, PAST_LEN, MLA_ROPE)),
        'c': nrm(8, (DEC_BATCH, D_MODEL)),
        'c_ctx': nrm(9, (D_MODEL,)),
        'w_mod': nrm(13, (DEPTH, D_MODEL, 6 * D_MODEL), 0.5 * D_MODEL ** -0.5),
        'b_mod': nrm(14, (DEPTH, 6 * D_MODEL), 0.01),
        'g_pre_mix': gain(15, (DEPTH, D_MODEL)),
        'g_post_mix': gain(16, (DEPTH, D_MODEL)),
        'g_pre_ffn': gain(17, (DEPTH, D_MODEL)),
        'g_post_ffn': gain(18, (DEPTH, D_MODEL)),
        'w_in': nrm(19, (DEPTH, D_MODEL, IN_W), D_MODEL ** -0.5),
        'ssd_conv_w': nrm(20, (DEPTH, CONV_W, SSD_CONV_CH), CONV_W ** -0.5),
        'ssd_conv_b': nrm(21, (DEPTH, SSD_CONV_CH), 0.01),
        'ssd_dt_bias': dt_bias,
        'ssd_a_log': a_log,
        'ssd_d': gain(22, (DEPTH, SSD_HEADS)),
        'ssd_norm_w': gain(23, (DEPTH, SSD_INNER)),
        'ret_decay_logit': ret_logit,
        'ret_gn_w': gain(24, (DEPTH, RET_HEADS * RET_V)),
        'att_q_norm': gain(25, (DEPTH, ATT_HEAD_DIM)),
        'att_k_norm': gain(26, (DEPTH, ATT_HEAD_DIM)),
        'mla_q_norm': gain(27, (DEPTH, MLA_Q_RANK)),
        'mla_w_uq': nrm(28, (DEPTH, MLA_Q_RANK, MLA_HEADS * (MLA_NOPE + MLA_ROPE)), MLA_Q_RANK ** -0.5),
        'mla_kv_norm': gain(29, (DEPTH, MLA_KV_RANK)),
        'mla_w_ukv': nrm(30, (DEPTH, MLA_KV_RANK, MLA_HEADS * (MLA_NOPE + MLA_V)), MLA_KV_RANK ** -0.5),
        'w_br_ssd': nrm(31, (DEPTH, SSD_INNER, D_MODEL), SSD_INNER ** -0.5),
        'w_br_ret': nrm(32, (DEPTH, RET_HEADS * RET_V, D_MODEL), (RET_HEADS * RET_V) ** -0.5),
        'w_br_att': nrm(33, (DEPTH, ATT_HEADS * ATT_HEAD_DIM, D_MODEL), (ATT_HEADS * ATT_HEAD_DIM) ** -0.5),
        'w_br_mla': nrm(34, (DEPTH, MLA_HEADS * MLA_V, D_MODEL), (MLA_HEADS * MLA_V) ** -0.5),
        'w_merge': nrm(35, (DEPTH, D_MODEL, N_BRANCH * D_MODEL), D_MODEL ** -0.5),
        'b_merge': nrm(36, (DEPTH, N_BRANCH * D_MODEL), 0.01),
        'w_out': nrm(37, (DEPTH, D_MODEL, D_MODEL), D_MODEL ** -0.5),
        'w_ffn_up': nrm(38, (DEPTH, D_MODEL, 2 * D_FF), D_MODEL ** -0.5),
        'ffn_conv_w': nrm(39, (DEPTH, CONV_W, 2 * D_FF), CONV_W ** -0.5),
        'ffn_conv_b': nrm(40, (DEPTH, 2 * D_FF), 0.01),
        'w_ffn_down': nrm(41, (DEPTH, D_FF, D_MODEL), D_FF ** -0.5),
    }


def reference(x_prompt, x_sample, state_ssd, state_ret, cache_att_k, cache_att_v, cache_mla_ckv,
              cache_mla_krope, c, c_ctx, w_mod, b_mod, g_pre_mix, g_post_mix, g_pre_ffn, g_post_ffn,
              w_in, ssd_conv_w, ssd_conv_b, ssd_dt_bias, ssd_a_log, ssd_d, ssd_norm_w, ret_decay_logit,
              ret_gn_w, att_q_norm, att_k_norm, mla_q_norm, mla_w_uq, mla_kv_norm, mla_w_ukv, w_br_ssd,
              w_br_ret, w_br_att, w_br_mla, w_merge, b_merge, w_out, w_ffn_up, ffn_conv_w, ffn_conv_b,
              w_ffn_down):
    y_prompt = x_prompt
    y_sample = x_sample
    st_ssd, st_ret, ck_k, ck_v, ck_c, ck_r = [], [], [], [], [], []
    for i in range(DEPTH):
        lw = {
            'g_pre_mix': g_pre_mix[i], 'g_post_mix': g_post_mix[i],
            'g_pre_ffn': g_pre_ffn[i], 'g_post_ffn': g_post_ffn[i],
            'w_in': w_in[i], 'ssd_conv_w': ssd_conv_w[i], 'ssd_conv_b': ssd_conv_b[i],
            'ssd_dt_bias': ssd_dt_bias[i], 'ssd_a_log': ssd_a_log[i], 'ssd_d': ssd_d[i],
            'ssd_norm_w': ssd_norm_w[i], 'ret_decay_logit': ret_decay_logit[i], 'ret_gn_w': ret_gn_w[i],
            'att_q_norm': att_q_norm[i], 'att_k_norm': att_k_norm[i],
            'mla_q_norm': mla_q_norm[i], 'mla_w_uq': mla_w_uq[i],
            'mla_kv_norm': mla_kv_norm[i], 'mla_w_ukv': mla_w_ukv[i],
            'w_br_ssd': w_br_ssd[i], 'w_br_ret': w_br_ret[i], 'w_br_att': w_br_att[i], 'w_br_mla': w_br_mla[i],
            'w_merge': w_merge[i], 'b_merge': b_merge[i], 'w_out': w_out[i],
            'w_ffn_up': w_ffn_up[i], 'ffn_conv_w': ffn_conv_w[i], 'ffn_conv_b': ffn_conv_b[i],
            'w_ffn_down': w_ffn_down[i],
        }
        mod_ctx = (jax.nn.silu(c_ctx) @ w_mod[i] + b_mod[i])[None, :]
        y_prompt, cache = _trunk_layer(y_prompt, mod_ctx, lw, None)
        st_ssd.append(cache['ssd'])
        st_ret.append(cache['ret'])
        ck_k.append(cache['att_k'])
        ck_v.append(cache['att_v'])
        ck_c.append(cache['mla_ckv'])
        ck_r.append(cache['mla_krope'])
        mod_lat = jax.nn.silu(c) @ w_mod[i] + b_mod[i]
        ctx = {
            'ssd': state_ssd[:, i], 'ret': state_ret[:, i],
            'att_k': cache_att_k[:, i], 'att_v': cache_att_v[:, i],
            'mla_ckv': cache_mla_ckv[:, i], 'mla_krope': cache_mla_krope[:, i],
        }
        y_sample, _ = _trunk_layer(y_sample, mod_lat, lw, ctx)
    new_state_ssd = jnp.stack(st_ssd, axis=1)
    new_state_ret = jnp.stack(st_ret, axis=1)
    new_cache_att_k = jnp.stack(ck_k, axis=1)
    new_cache_att_v = jnp.stack(ck_v, axis=1)
    new_cache_mla_ckv = jnp.stack(ck_c, axis=1)
    new_cache_mla_krope = jnp.stack(ck_r, axis=1)
    return (y_prompt, y_sample, new_state_ssd, new_state_ret, new_cache_att_k, new_cache_att_v,
            new_cache_mla_ckv, new_cache_mla_krope)
```

```cpp
#include <hip/hip_runtime.h>
#include <cstdio>
#include <cstdint>
#include <cmath>

typedef unsigned short bf16_t;
typedef short bf16x8 __attribute__((ext_vector_type(8)));
typedef float f32x4 __attribute__((ext_vector_type(4)));
typedef unsigned u32x4 __attribute__((ext_vector_type(4)));
typedef unsigned u32x2 __attribute__((ext_vector_type(2)));
#define DI __device__ __forceinline__
#define LAS __attribute__((address_space(3)))

constexpr int DM = 1024, INW = 4272, INWP = 4352, DFF = 2816;
constexpr int NPT = 8192;
constexpr int KROWS = 8704;
constexpr float EPS = 1e-6f;
constexpr int C_Z = 0, C_XBC = 512, C_DT = 1280, C_RQ = 1296, C_RK = 1552, C_RV = 1808, C_RG = 2320, C_AQ = 2832, C_AK = 3344, C_AV = 3472,
              C_MCQ = 3600, C_MCKV = 3984;
constexpr size_t O_YS = 8388608, O_SSD = 16777216, O_RET = 20971520, O_CK = 25165824, O_CV = 27262976, O_CC = 29360128, O_CR = 33554432;

constexpr size_t al256(size_t x) { return (x + 255) & ~(size_t)255; }
constexpr size_t SZ_WIN = (size_t)INWP * 1024, SZ_WM = (size_t)4096 * 1024, SZ_WUQ = (size_t)768 * 384, SZ_WUKV = (size_t)1024 * 256,
                 SZ_WBR = (size_t)4 * 1024 * 512, SZ_WOUT = (size_t)1024 * 1024, SZ_WUP = (size_t)5632 * 1024, SZ_WDN = (size_t)1024 * 2816;
constexpr size_t OFF_WIN = 0;
constexpr size_t OFF_WM = OFF_WIN + 4 * SZ_WIN;
constexpr size_t OFF_WUQ = OFF_WM + 4 * SZ_WM;
constexpr size_t OFF_WUKV = OFF_WUQ + 4 * SZ_WUQ;
constexpr size_t OFF_WBR = OFF_WUKV + 4 * SZ_WUKV;
constexpr size_t OFF_WOUT = OFF_WBR + 4 * SZ_WBR;
constexpr size_t OFF_WUP = OFF_WOUT + 4 * SZ_WOUT;
constexpr size_t OFF_WDN = OFF_WUP + 4 * SZ_WUP;
constexpr size_t OFF_MOD = al256(OFF_WDN + 4 * SZ_WDN);
constexpr size_t OFF_T16 = al256(OFF_MOD + (size_t)2 * 5 * 6144 * 4);
constexpr size_t OFF_T8 = OFF_T16 + 2 * 64 * 16 * 4;
constexpr size_t OFF_BAR = al256(OFF_T8 + 2 * 64 * 8 * 4);
constexpr size_t BAR_BYTES = 3456 * 4, CTR_BYTES = 128 * 4;
constexpr size_t OFF_CTR = OFF_BAR + BAR_BYTES;
constexpr size_t OFF_DTRAW = al256(OFF_CTR + CTR_BYTES);
constexpr size_t OFF_DT = OFF_DTRAW + (size_t)NPT * 16 * 4;
constexpr size_t OFF_H = al256(OFF_DT + (size_t)NPT * 16 * 4);
constexpr size_t OFF_PROJ = OFF_H + (size_t)NPT * 1024 * 2;
constexpr size_t OFF_XBCA = OFF_PROJ + (size_t)NPT * INWP * 2;
constexpr size_t OFF_KA = OFF_XBCA + (size_t)NPT * 768 * 2;
constexpr size_t OFF_VAT = OFF_KA + (size_t)KROWS * 128 * 2;
constexpr size_t OFF_CKV = OFF_VAT + (size_t)KROWS * 128 * 2;
constexpr size_t OFF_KRP = OFF_CKV + (size_t)KROWS * 256 * 2;
constexpr size_t OFF_QM = OFF_KRP + (size_t)KROWS * 32 * 2;
constexpr size_t OFF_KN = OFF_QM + (size_t)NPT * 768 * 2;
constexpr size_t OFF_VMT = OFF_KN + (size_t)KROWS * 512 * 2;
constexpr size_t OFF_OS = OFF_VMT + (size_t)KROWS * 512 * 2;
constexpr size_t OFF_OR = OFF_OS + (size_t)2 * NPT * 512 * 2;
constexpr size_t OFF_OM = OFF_OR + (size_t)2 * NPT * 512 * 2;
constexpr size_t OFF_OA = OFF_OM + (size_t)NPT * 512 * 2;
constexpr size_t WS_END1 = OFF_OA + (size_t)NPT * 512 * 2;
constexpr size_t OFF_MERGED = OFF_OS;
constexpr size_t OFF_MO = OFF_XBCA;
constexpr size_t OFF_U = OFF_PROJ;
constexpr size_t OFF_ACT = OFF_QM;
constexpr size_t OFF_FO = OFF_PROJ;
static_assert(OFF_MO + (size_t)NPT * 1024 * 4 <= OFF_MERGED, "MO overlaps MERGED");
static_assert(OFF_U + (size_t)NPT * 5632 * 2 <= OFF_ACT, "U overlaps ACT");
static_assert(OFF_ACT + (size_t)NPT * 2816 * 2 <= WS_END1, "ACT beyond end");
constexpr size_t WS_NEED = WS_END1;

struct Params {
    const float* in[42];
    float* out;
    char* ws;
};
struct Ctx {
    volatile LAS unsigned* tbl;
    __device__ __forceinline__ unsigned long long ld(int i) const {
        const unsigned lo = tbl[2 * i], hi = tbl[2 * i + 1];
        return ((unsigned long long)(unsigned)__builtin_amdgcn_readfirstlane((int)hi) << 32) | (unsigned)__builtin_amdgcn_readfirstlane((int)lo);
    }
    __device__ __forceinline__ const float* in(int i) const { return (const float*)ld(i); }
    __device__ __forceinline__ float* out() const { return (float*)ld(42); }
    __device__ __forceinline__ char* ws() const { return (char*)ld(43); }
};

DI float bf2f(unsigned short h) { return __uint_as_float((unsigned)h << 16); }
DI unsigned short f2bf(float f) { unsigned u = __float_as_uint(f); return (unsigned short)((u + 0x7fffu + ((u >> 16) & 1u)) >> 16); }
DI unsigned pk2(float lo, float hi) { return (unsigned)f2bf(lo) | ((unsigned)f2bf(hi) << 16); }
DI void unpack8(const u32x4& w, float* v) {
#pragma unroll
    for (int i = 0; i < 4; ++i) { v[2 * i] = __uint_as_float(w[i] << 16); v[2 * i + 1] = __uint_as_float(w[i] & 0xffff0000u); }
}
DI u32x4 pack8(const float* v) { u32x4 w; w[0] = pk2(v[0], v[1]); w[1] = pk2(v[2], v[3]); w[2] = pk2(v[4], v[5]); w[3] = pk2(v[6], v[7]); return w; }
DI float siluf(float x) { return x / (1.f + __expf(-x)); }
DI float sigmoidf(float x) { return 1.f / (1.f + __expf(-x)); }
DI float wsum(float v) {
#pragma unroll
    for (int o = 32; o >= 1; o >>= 1) v += __shfl_xor(v, o);
    return v;
}
typedef const __attribute__((address_space(1))) u32x4* gp128;
DI u32x4 gld16(const void* p) { return *(gp128)(unsigned long long)p; }
DI int launder(int x) { asm volatile("" : "+v"(x)); return x; }
DI int FQ(int q) { return (4 - q) & 3; }
DI int tile_off(int rows, int ks, int row, int g, int q) { return (ks * rows + row) * 64 + ((g ^ FQ(q)) << 4); }

#define XB_TMO      128
#define XB_XCNT(j)  (256  + 64 * (j))
#define XB_XSUB(j)  (1280 + 64 * (j))
#define XB_XGEN(j)  (2304 + 64 * (j))
#define XB_TOP      3328
#define XB_TOPGEN   3392
#define XB_SPIN_CAP (1u << 22)
DI unsigned xb_ld(unsigned* p) { return __hip_atomic_load(p, __ATOMIC_RELAXED, __HIP_MEMORY_SCOPE_AGENT); }
DI unsigned xb_add(unsigned* p, unsigned v) { return __hip_atomic_fetch_add(p, v, __ATOMIC_RELAXED, __HIP_MEMORY_SCOPE_AGENT); }
DI unsigned xb_xcc_id() { return (unsigned)__builtin_amdgcn_s_getreg((3 << 11) | 20) & 0xFu; }
#define XB_SPIN(cond, bar) do { unsigned _sp = 0; while (cond) { __builtin_amdgcn_s_sleep(1); \
    if ((++_sp & 255u) == 0u) { if (xb_ld(&(bar)[XB_TMO])) break; if (_sp > XB_SPIN_CAP) { atomicAdd(&(bar)[XB_TMO], 1u); break; } } } } while (0)
struct XcdBarrier { unsigned* bar; unsigned x; volatile LAS unsigned* st; };
DI XcdBarrier xcd_barrier_post(unsigned* bar, volatile LAS unsigned* st) {
    XcdBarrier b; b.bar = bar; b.x = xb_xcc_id(); b.st = st;
    if (threadIdx.x == 0) (void)xb_add(&bar[XB_XCNT(b.x)], 1u);
    return b;
}
DI void xcd_barrier_complete(unsigned* bar, unsigned x, unsigned& nloc, unsigned& nx) {
    const unsigned G = gridDim.x * gridDim.y * gridDim.z;
    unsigned sum, cnt, mine, sp = 0u;
    for (;;) {
        sum = 0u; cnt = 0u; mine = 0u;
#pragma unroll
        for (unsigned j = 0; j < 16; ++j) { const unsigned c = xb_ld(&bar[XB_XCNT(j)]); sum += c; cnt += (c > 0u) ? 1u : 0u; mine = (j == x) ? c : mine; }
        if (sum == G) break;
        __builtin_amdgcn_s_sleep(1);
        if ((++sp & 255u) == 0u) { if (xb_ld(&bar[XB_TMO])) break; if (sp > XB_SPIN_CAP) { atomicAdd(&bar[XB_TMO], 1u); break; } }
    }
    nloc = mine > 0u ? mine : 1u; nx = cnt > 0u ? cnt : 1u;
}
DI void xcd_barrier(const XcdBarrier& b) {
    asm volatile("s_waitcnt vmcnt(0)" ::: "memory");
    __syncthreads();
    if (threadIdx.x == 0) {
        unsigned* bar = b.bar;
        __builtin_amdgcn_s_waitcnt(0);
        unsigned nloc = b.st[0], nx = b.st[1];
        if (nloc == 0u) { xcd_barrier_complete(bar, b.x, nloc, nx); b.st[0] = nloc; b.st[1] = nx; }
        const unsigned old = xb_add(&bar[XB_XSUB(b.x)], 1u);
        const unsigned gen = old / nloc;
        if (old + 1u == (gen + 1u) * nloc) {
            __builtin_amdgcn_fence(__ATOMIC_RELEASE, "agent");
            asm volatile("s_waitcnt vmcnt(0)" ::: "memory");
            const unsigned og = xb_add(&bar[XB_TOP], 1u);
            const unsigned tg = og / nx;
            if (og + 1u == (tg + 1u) * nx) xb_add(&bar[XB_TOPGEN], 1u);
            else XB_SPIN(xb_ld(&bar[XB_TOPGEN]) == tg, bar);
            __builtin_amdgcn_fence(__ATOMIC_ACQUIRE, "agent");
            xb_add(&bar[XB_XGEN(b.x)], 1u);
            asm volatile("s_waitcnt vmcnt(0)" ::: "memory");
        } else {
            XB_SPIN(xb_ld(&bar[XB_XGEN(b.x)]) == gen, bar);
            __builtin_amdgcn_fence(__ATOMIC_ACQUIRE, "agent");
            asm volatile("s_waitcnt vmcnt(0)" ::: "memory");
        }
    }
    __syncthreads();
}

struct Tok { int lat, b, t, L, cond, krow, seq0; size_t gx; };
DI Tok tok_info(int m, int ps) {
    Tok k;
    if (m < 4096) { k.lat = 0; k.b = ps * 16 + (m >> 8); k.t = m & 255; k.L = 256; k.cond = 0; k.krow = m; k.seq0 = m & ~255; k.gx = (size_t)ps * 4096 + m; }
    else { const int mm = m - 4096, j = mm >> 11; k.lat = 1; k.b = ps * 2 + j; k.t = mm & 2047; k.L = 2048; k.cond = 1 + k.b; k.krow = 4096 + j * 2304 + 256 + k.t;
           k.seq0 = 4096 + j * 2048; k.gx = (size_t)8192 + (size_t)ps * 4096 + mm; }
    return k;
}

template <int NTA, int NTB>
DI void gemm_kloop(f32x4 (&acc)[NTA][NTB], const bf16_t* __restrict__ W, size_t ldw, const bf16_t* __restrict__ X, size_t ldx, int K, char* smem, int tid) {
    constexpr int BF = 32 * NTA, BT = 32 * NTB;
    constexpr int WB = BF * 128, STG = (BF + BT) * 128;
    constexpr int NPW = BF / 8, NPX = BT / 8, NPIECE = NPW + NPX, PPW = NPIECE / 4;
    static_assert(NPIECE % 4 == 0, "pieces must divide over 4 waves");
    tid = launder(tid);
    const int lane = tid & 63, wv = tid >> 6, wn = wv >> 1, wt = wv & 1, fr = lane & 15, g = lane >> 4;
    const bf16_t* src[PPW]; int dst[PPW];
#pragma unroll
    for (int j = 0; j < PPW; ++j) {
        const int pc = wv * PPW + j;
        const bool isw = pc < NPW;
        const int pp = isw ? pc : pc - NPW;
        const int rows = isw ? BF : BT;
        const int ks = pp / (rows / 16), rb = pp % (rows / 16);
        const int row = rb * 16 + (lane >> 2);
        const int q = isw ? ((row / (4 * NTA)) & 3) : ((row >> 2) & 3);
        const int gl = (lane & 3) ^ FQ(q);
        src[j] = (isw ? W + (size_t)row * ldw : X + (size_t)row * ldx) + (ks * 4 + gl) * 8;
        dst[j] = (isw ? 0 : WB) + (ks * rows + rb * 16) * 64;
    }
    const int aoff = tile_off(BF, 0, wn * 16 * NTA + 4 * NTA * (fr >> 2) + (fr & 3), g, fr >> 2);
    const int boff = WB + tile_off(BT, 0, wt * 16 * NTB + fr, g, (fr >> 2) & 3);
    const int nk = K >> 6;
#pragma unroll
    for (int j = 0; j < PPW; ++j) __builtin_amdgcn_global_load_lds((const unsigned*)src[j], (unsigned*)(smem + dst[j]), 16, 0, 0);
    asm volatile("s_waitcnt vmcnt(0)" ::: "memory");
    __syncthreads();
    for (int kt = 0; kt < nk; ++kt) {
        if (kt + 1 < nk) {
            char* sn = smem + ((kt + 1) & 1) * STG;
#pragma unroll
            for (int j = 0; j < PPW; ++j) __builtin_amdgcn_global_load_lds((const unsigned*)(src[j] + ((kt + 1) << 6)), (unsigned*)(sn + dst[j]), 16, 0, 0);
        }
        const char* sb = smem + (kt & 1) * STG;
#pragma unroll
        for (int kk = 0; kk < 2; ++kk) {
            bf16x8 af[NTA], bfr[NTB];
#pragma unroll
            for (int a = 0; a < NTA; ++a) af[a] = *(const bf16x8*)(sb + aoff + a * 256 + kk * BF * 64);
#pragma unroll
            for (int mt = 0; mt < NTB; ++mt) bfr[mt] = *(const bf16x8*)(sb + boff + mt * 1024 + kk * BT * 64);
#pragma unroll
            for (int a = 0; a < NTA; ++a)
#pragma unroll
                for (int mt = 0; mt < NTB; ++mt) acc[a][mt] = __builtin_amdgcn_mfma_f32_16x16x32_bf16(af[a], bfr[mt], acc[a][mt], 0, 0, 0);
        }
        asm volatile("s_waitcnt vmcnt(0)" ::: "memory");
        __syncthreads();
    }
}

DI void wconv_tile(const float* __restrict__ src, int K, int N, bf16_t* __restrict__ dst, int kt, int nt, char* smem, int tid) {
    float* t = (float*)smem;
    const int k0 = kt * 64, n0 = nt * 64;
    const int r = tid >> 4, c4 = tid & 15;
#pragma unroll
    for (int i = 0; i < 4; ++i) {
        const int row = r + 16 * i;
        f32x4 v = {0.f, 0.f, 0.f, 0.f};
        if (n0 + 4 * c4 < N) v = *(const f32x4*)(src + (size_t)(k0 + row) * N + n0 + 4 * c4);
        t[row * 65 + 4 * c4 + 0] = v[0]; t[row * 65 + 4 * c4 + 1] = v[1]; t[row * 65 + 4 * c4 + 2] = v[2]; t[row * 65 + 4 * c4 + 3] = v[3];
    }
    __syncthreads();
#pragma unroll
    for (int i = 0; i < 2; ++i) {
        const int q = tid + 256 * i, n = q >> 3, c = q & 7;
        float v[8];
#pragma unroll
        for (int j = 0; j < 8; ++j) v[j] = t[(8 * c + j) * 65 + n];
        *(u32x4*)(dst + (size_t)(n0 + n) * K + k0 + 8 * c) = pack8(v);
    }
    __syncthreads();
}

DI void phase_prep_w(const Ctx& p, char* smem, int tid) {
    char* ws = p.ws();
    constexpr int T_IN = 16 * 68, T_M = 16 * 64, T_UQ = 6 * 12, T_UKV = 4 * 16, T_BR = 8 * 16, T_OUT = 16 * 16, T_UP = 16 * 88, T_DN = 44 * 16;
    constexpr int T_LAYER = T_IN + T_M + T_UQ + T_UKV + 4 * T_BR + T_OUT + T_UP + T_DN;
    constexpr int N_MOD = 2 * 96;
    const int total = 2 * T_LAYER + N_MOD + 1;
    for (int it = blockIdx.x; it < total; it += gridDim.x) {
        if (it < 2 * T_LAYER) {
            const int l = it / T_LAYER; int k = it % T_LAYER;
            const float* src; bf16_t* dst; int K, N, ntn;
            if (k < T_IN) { src = p.in(16) + (size_t)l * 1024 * INW; dst = (bf16_t*)(ws + OFF_WIN) + (size_t)l * SZ_WIN; K = 1024; N = INW; ntn = 68; }
            else if ((k -= T_IN) < T_M) { src = p.in(35) + (size_t)l * 1024 * 4096; dst = (bf16_t*)(ws + OFF_WM) + (size_t)l * SZ_WM; K = 1024; N = 4096; ntn = 64; }
            else if ((k -= T_M) < T_UQ) { src = p.in(28) + (size_t)l * 384 * 768; dst = (bf16_t*)(ws + OFF_WUQ) + (size_t)l * SZ_WUQ; K = 384; N = 768; ntn = 12; }
            else if ((k -= T_UQ) < T_UKV) { src = p.in(30) + (size_t)l * 256 * 1024; dst = (bf16_t*)(ws + OFF_WUKV) + (size_t)l * SZ_WUKV; K = 256; N = 1024; ntn = 16; }
            else if ((k -= T_UKV) < 4 * T_BR) { const int j = k / T_BR; k -= j * T_BR; src = p.in(31 + j) + (size_t)l * 512 * 1024;
                                                dst = (bf16_t*)(ws + OFF_WBR) + (size_t)(l * 4 + j) * 1024 * 512; K = 512; N = 1024; ntn = 16; }
            else if ((k -= 4 * T_BR) < T_OUT) { src = p.in(37) + (size_t)l * 1024 * 1024; dst = (bf16_t*)(ws + OFF_WOUT) + (size_t)l * SZ_WOUT; K = 1024; N = 1024; ntn = 16; }
            else if ((k -= T_OUT) < T_UP) { src = p.in(38) + (size_t)l * 1024 * 5632; dst = (bf16_t*)(ws + OFF_WUP) + (size_t)l * SZ_WUP; K = 1024; N = 5632; ntn = 88; }
            else { k -= T_UP; src = p.in(41) + (size_t)l * 2816 * 1024; dst = (bf16_t*)(ws + OFF_WDN) + (size_t)l * SZ_WDN; K = 2816; N = 1024; ntn = 16; }
            wconv_tile(src, K, N, dst, k / ntn, k % ntn, smem, tid);
        } else if (it < 2 * T_LAYER + N_MOD) {
            const int k = it - 2 * T_LAYER, l = k / 96, cb = k % 96;
            float* sc = (float*)smem;
            float* red = sc + 5 * 1024;
            for (int e = tid; e < 5 * 1024; e += 256) {
                const int c = e >> 10, kk = e & 1023;
                const float v = (c == 0) ? p.in(9)[kk] : p.in(8)[(c - 1) * 1024 + kk];
                sc[e] = siluf(v);
            }
            __syncthreads();
            const int col = tid & 63, kg = tid >> 6;
            float a[5] = {0.f, 0.f, 0.f, 0.f, 0.f};
            const float* w = p.in(10) + ((size_t)l * 1024 + kg * 256) * 6144 + cb * 64 + col;
            for (int kk = 0; kk < 256; ++kk) {
                const float wv = w[(size_t)kk * 6144];
#pragma unroll
                for (int c = 0; c < 5; ++c) a[c] += wv * sc[c * 1024 + kg * 256 + kk];
            }
#pragma unroll
            for (int c = 0; c < 5; ++c) red[(kg * 5 + c) * 64 + col] = a[c];
            __syncthreads();
            if (tid < 64) {
                float* mod = (float*)(ws + OFF_MOD);
#pragma unroll
                for (int c = 0; c < 5; ++c) {
                    const float s = red[(0 * 5 + c) * 64 + tid] + red[(1 * 5 + c) * 64 + tid] + red[(2 * 5 + c) * 64 + tid] + red[(3 * 5 + c) * 64 + tid];
                    mod[((size_t)l * 5 + c) * 6144 + cb * 64 + tid] = s + p.in(11)[(size_t)l * 6144 + cb * 64 + tid];
                }
            }
            __syncthreads();
        } else {
            float* t16 = (float*)(ws + OFF_T16); float* t8 = (float*)(ws + OFF_T8);
            for (int e = tid; e < 64 * 16 + 64 * 8; e += 256) {
                const bool small = e >= 1024;
                const int ee = small ? e - 1024 : e;
                const int pos = small ? (ee >> 3) : (ee >> 4), i = small ? (ee & 7) : (ee & 15);
                const double r = small ? 0.31622776601683794 : 0.5623413251903491;
                double th = 1.0;
                for (int j = 0; j < i; ++j) th *= r;
                const double t2 = th * th;
                double c1 = 1.0, s1 = th, term = 1.0;
                double tc = 1.0, tsn = th;
                c1 = 1.0; s1 = th;
                for (int k = 1; k < 14; ++k) {
                    tc = -tc * t2 / (double)((2 * k - 1) * (2 * k));
                    tsn = -tsn * t2 / (double)((2 * k) * (2 * k + 1));
                    c1 += tc; s1 += tsn;
                }
                (void)term;
                double c = 1.0, sn = 0.0;
                for (int j = 0; j < pos; ++j) { const double cn = c * c1 - sn * s1, snn = sn * c1 + c * s1; c = cn; sn = snn; }
                if (small) { t8[ee] = (float)c; t8[512 + ee] = (float)sn; } else { t16[ee] = (float)c; t16[1024 + ee] = (float)sn; }
            }
        }
    }
}

DI void row_load(const float* r, int lane, f32x4 (&v)[4]) {
#pragma unroll
    for (int i = 0; i < 4; ++i) v[i] = *(const f32x4*)(r + 4 * lane + 256 * i);
}
DI float row_ss(const f32x4 (&v)[4]) {
    float s = 0.f;
#pragma unroll
    for (int i = 0; i < 4; ++i) s += v[i][0] * v[i][0] + v[i][1] * v[i][1] + v[i][2] * v[i][2] + v[i][3] * v[i][3];
    return wsum(s);
}
DI void row_modnorm_store(const f32x4 (&x)[4], const float* gw, const float* sh, const float* sc, bf16_t* dst, int lane) {
    const float rstd = rsqrtf(row_ss(x) * (1.f / 1024.f) + EPS);
#pragma unroll
    for (int i = 0; i < 4; ++i) {
        const int c = 4 * lane + 256 * i;
        const f32x4 g = *(const f32x4*)(gw + c), s = *(const f32x4*)(sh + c), q = *(const f32x4*)(sc + c);
        float o[4];
#pragma unroll
        for (int j = 0; j < 4; ++j) o[j] = (x[i][j] * rstd) * g[j] * (1.f + q[j]) + s[j];
        u32x2 w; w[0] = pk2(o[0], o[1]); w[1] = pk2(o[2], o[3]);
        *(u32x2*)(dst + c) = w;
    }
}
DI const float* x_in_row(const Ctx& p, int m, int ps) {
    return (m < 4096) ? p.in(0) + ((size_t)ps * 4096 + m) * 1024 : p.in(1) + ((size_t)ps * 4096 + (m - 4096)) * 1024;
}
DI void phase_h1(const Ctx& p, int ps, int tid) {
    const int lane = tid & 63, wv = tid >> 6;
    const float* mod = (const float*)(p.ws() + OFF_MOD);
    bf16_t* H = (bf16_t*)(p.ws() + OFF_H);
    for (int m = blockIdx.x * 4 + wv; m < NPT; m += gridDim.x * 4) {
        const Tok k = tok_info(m, ps);
        f32x4 x[4]; row_load(x_in_row(p, m, ps), lane, x);
        const float* md = mod + (size_t)(0 * 5 + k.cond) * 6144;
        row_modnorm_store(x, p.in(12), md + 0, md + 1024, H + (size_t)m * 1024, lane);
    }
}
DI void phase_res(const Ctx& p, int ps, int l, int which, int tid) {
    const int lane = tid & 63, wv = tid >> 6;
    const float* mod = (const float*)(p.ws() + OFF_MOD);
    bf16_t* H = (bf16_t*)(p.ws() + OFF_H);
    const float* Y = (const float*)(p.ws() + (which ? OFF_FO : OFF_MO));
    const float* gpost = (which ? p.in(15) : p.in(13)) + (size_t)l * 1024;
    for (int m = blockIdx.x * 4 + wv; m < NPT; m += gridDim.x * 4) {
        const Tok k = tok_info(m, ps);
        const float* md = mod + (size_t)(l * 5 + k.cond) * 6144;
        const float* gate = md + (which ? 5 * 1024 : 2 * 1024);
        f32x4 x[4], y[4];
        if (l == 0 && which == 0) row_load(x_in_row(p, m, ps), lane, x); else row_load(p.out() + k.gx * 1024, lane, x);
        row_load(Y + (size_t)m * 1024, lane, y);
        const float rstd = rsqrtf(row_ss(y) * (1.f / 1024.f) + EPS);
#pragma unroll
        for (int i = 0; i < 4; ++i) {
            const int c = 4 * lane + 256 * i;
            const f32x4 g = *(const f32x4*)(gate + c), w = *(const f32x4*)(gpost + c);
#pragma unroll
            for (int j = 0; j < 4; ++j) x[i][j] = x[i][j] + g[j] * ((y[i][j] * rstd) * w[j]);
            *(f32x4*)(p.out() + k.gx * 1024 + c) = x[i];
        }
        if (which == 0) row_modnorm_store(x, p.in(14) + (size_t)l * 1024, md + 3 * 1024, md + 4 * 1024, H + (size_t)m * 1024, lane);
        else if (l + 1 < 2) { const float* md2 = mod + (size_t)((l + 1) * 5 + k.cond) * 6144;
                              row_modnorm_store(x, p.in(12) + (size_t)(l + 1) * 1024, md2, md2 + 1024, H + (size_t)m * 1024, lane); }
    }
}

DI bool xcd_tile(int it, int Mt, int Nt, int B, int& mt, int& nt) {
    const int x = blockIdx.x & 7, loc = blockIdx.x >> 3, nloc = gridDim.x >> 3;
    const int MP = Mt >> 3;
    const int idx = it * nloc + loc;
    if (idx >= MP * Nt) return false;
    const int ng = idx / (MP * B);
    const int bw = min(B, Nt - ng * B);
    const int r = idx - ng * MP * B;
    mt = x * MP + r / bw; nt = ng * B + r % bw;
    return true;
}
DI void phase_gemm_in(const Ctx& p, int l, char* smem, int tid) {
    const bf16_t* W = (const bf16_t*)(p.ws() + OFF_WIN) + (size_t)l * SZ_WIN;
    const bf16_t* X = (const bf16_t*)(p.ws() + OFF_H);
    bf16_t* PROJ = (bf16_t*)(p.ws() + OFF_PROJ);
    float* DTRAW = (float*)(p.ws() + OFF_DTRAW);
    const int lane = tid & 63, wv = tid >> 6, wn = wv >> 1, wt = wv & 1, fr = lane & 15, g = lane >> 4;
    for (int it = 0;; ++it) {
        int mt0, nt0; if (!xcd_tile(it, 64, 34, 8, mt0, nt0)) break;
        const int m0 = mt0 * 128, n0 = nt0 * 128;
        f32x4 acc[4][4];
#pragma unroll
        for (int a = 0; a < 4; ++a)
#pragma unroll
            for (int b = 0; b < 4; ++b) acc[a][b] = (f32x4){0.f, 0.f, 0.f, 0.f};
        gemm_kloop<4, 4>(acc, W + (size_t)n0 * 1024, 1024, X + (size_t)m0 * 1024, 1024, 1024, smem, tid);
        const int fb = n0 + wn * 64 + 16 * g;
#pragma unroll
        for (int mt = 0; mt < 4; ++mt) {
            const int m = m0 + wt * 64 + 16 * mt + fr;
            float v[16];
#pragma unroll
            for (int a = 0; a < 4; ++a)
#pragma unroll
                for (int r = 0; r < 4; ++r) v[4 * a + r] = acc[a][mt][r];
            bf16_t* d = PROJ + (size_t)m * INWP + fb;
            *(u32x4*)d = pack8(v); *(u32x4*)(d + 8) = pack8(v + 8);
            if (fb == C_DT) {
                float* dd = DTRAW + (size_t)m * 16;
#pragma unroll
                for (int a = 0; a < 4; ++a) *(f32x4*)(dd + 4 * a) = acc[a][mt];
            }
        }
    }
}

template <bool F32OUT>
DI void phase_gemm_plain(const bf16_t* W, int K, const bf16_t* X, size_t ldx, int Mtiles, int Ntiles, void* out, size_t ldo, char* smem, int tid) {
    const int lane = tid & 63, wv = tid >> 6, wn = wv >> 1, wt = wv & 1, fr = lane & 15, g = lane >> 4;
    for (int it = 0;; ++it) {
        int mt0, nt0; if (!xcd_tile(it, Mtiles, Ntiles, 8, mt0, nt0)) break;
        const int m0 = mt0 * 128, n0 = nt0 * 128;
        f32x4 acc[4][4];
#pragma unroll
        for (int a = 0; a < 4; ++a)
#pragma unroll
            for (int b = 0; b < 4; ++b) acc[a][b] = (f32x4){0.f, 0.f, 0.f, 0.f};
        gemm_kloop<4, 4>(acc, W + (size_t)n0 * K, K, X + (size_t)m0 * ldx, ldx, K, smem, tid);
        const int fb = n0 + wn * 64 + 16 * g;
#pragma unroll
        for (int mt = 0; mt < 4; ++mt) {
            const int m = m0 + wt * 64 + 16 * mt + fr;
            if (F32OUT) {
                float* d = (float*)out + (size_t)m * ldo + fb;
#pragma unroll
                for (int a = 0; a < 4; ++a) *(f32x4*)(d + 4 * a) = acc[a][mt];
            } else {
                float v[16];
#pragma unroll
                for (int a = 0; a < 4; ++a)
#pragma unroll
                    for (int r = 0; r < 4; ++r) v[4 * a + r] = acc[a][mt][r];
                bf16_t* d = (bf16_t*)out + (size_t)m * ldo + fb;
                *(u32x4*)d = pack8(v); *(u32x4*)(d + 8) = pack8(v + 8);
            }
        }
    }
}

DI void gemm_uq_tile(const Ctx& p, int l, int ps, int tile, char* smem, int tid) {
    const bf16_t* W = (const bf16_t*)(p.ws() + OFF_WUQ) + (size_t)l * SZ_WUQ;
    const bf16_t* X = (const bf16_t*)(p.ws() + OFF_PROJ) + C_MCQ;
    bf16_t* QM = (bf16_t*)(p.ws() + OFF_QM);
    const float* t8 = (const float*)(p.ws() + OFF_T8);
    const int lane = tid & 63, wv = tid >> 6, wn = wv >> 1, wt = wv & 1, fr = lane & 15, g = lane >> 4;
    const int mt0 = tile / 6, nt0 = tile % 6, m0 = mt0 * 128, n0 = nt0 * 128;
    f32x4 acc[4][4];
#pragma unroll
    for (int a = 0; a < 4; ++a)
#pragma unroll
        for (int b = 0; b < 4; ++b) acc[a][b] = (f32x4){0.f, 0.f, 0.f, 0.f};
    gemm_kloop<4, 4>(acc, W + (size_t)n0 * 384, 384, X + (size_t)m0 * INWP, INWP, 384, smem, tid);
    const int fb = n0 + wn * 64 + 16 * g;
    const int o = fb % 96;
#pragma unroll
    for (int mt = 0; mt < 4; ++mt) {
        const int m = m0 + wt * 64 + 16 * mt + fr;
        float v[16];
#pragma unroll
        for (int a = 0; a < 4; ++a)
#pragma unroll
            for (int r = 0; r < 4; ++r) v[4 * a + r] = acc[a][mt][r];
        if (m >= 4096 && o >= 64) {
            const int t = (m - 4096) & 2047;
            const int pos = (o == 64) ? (t >> 6) : (t & 63);
#pragma unroll
            for (int j = 0; j < 8; ++j) {
                const float c = t8[pos * 8 + j], s = t8[512 + pos * 8 + j];
                const float x1 = v[j], x2 = v[j + 8];
                v[j] = x1 * c - x2 * s; v[j + 8] = x2 * c + x1 * s;
            }
        }
        bf16_t* d = QM + (size_t)m * 768 + fb;
        *(u32x4*)d = pack8(v); *(u32x4*)(d + 8) = pack8(v + 8);
    }
}

DI void gemm_ukv_tile(const Ctx& p, int l, int tile, char* smem, int tid) {
    const bf16_t* W = (const bf16_t*)(p.ws() + OFF_WUKV) + (size_t)l * SZ_WUKV;
    const bf16_t* X = (const bf16_t*)(p.ws() + OFF_CKV);
    bf16_t* KN = (bf16_t*)(p.ws() + OFF_KN);
    bf16_t* VMT = (bf16_t*)(p.ws() + OFF_VMT);
    const int lane = tid & 63, wv = tid >> 6, wn = wv >> 1, wt = wv & 1, fr = lane & 15, g = lane >> 4;
    const int mt0 = tile / 8, nt0 = tile % 8, m0 = mt0 * 128, n0 = nt0 * 128;
    f32x4 acc[4][4];
#pragma unroll
    for (int a = 0; a < 4; ++a)
#pragma unroll
        for (int b = 0; b < 4; ++b) acc[a][b] = (f32x4){0.f, 0.f, 0.f, 0.f};
    gemm_kloop<4, 4>(acc, W + (size_t)n0 * 256, 256, X + (size_t)m0 * 256, 256, 256, smem, tid);
    const int fb = n0 + wn * 64 + 16 * g;
    const int head = fb >> 7, o = fb & 127;
    int key0, Lk;
    if (m0 < 4096) { key0 = m0 & ~255; Lk = 256; } else { const int j = (m0 - 4096) / 2304; key0 = 4096 + j * 2304; Lk = 2304; }
#pragma unroll
    for (int mt = 0; mt < 4; ++mt) {
        const int m = m0 + wt * 64 + 16 * mt + fr;
        float v[16];
#pragma unroll
        for (int a = 0; a < 4; ++a)
#pragma unroll
            for (int r = 0; r < 4; ++r) v[4 * a + r] = acc[a][mt][r];
        if (o < 64) {
            bf16_t* d = KN + (size_t)m * 512 + head * 64 + o;
            *(u32x4*)d = pack8(v); *(u32x4*)(d + 8) = pack8(v + 8);
        } else {
            bf16_t* d = VMT + (size_t)key0 * 512 + (size_t)(head * 64 + (o - 64)) * Lk + (m - key0);
#pragma unroll
            for (int i = 0; i < 16; ++i) d[(size_t)i * Lk] = f2bf(v[i]);
        }
    }
}

DI void phase_merge(const Ctx& p, int l, char* smem, int tid) {
    const bf16_t* WM = (const bf16_t*)(p.ws() + OFF_WM) + (size_t)l * SZ_WM;
    const bf16_t* WBR = (const bf16_t*)(p.ws() + OFF_WBR) + (size_t)l * SZ_WBR;
    const bf16_t* H = (const bf16_t*)(p.ws() + OFF_H);
    const bf16_t* PROJ = (const bf16_t*)(p.ws() + OFF_PROJ);
    const bf16_t* OM = (const bf16_t*)(p.ws() + OFF_OM);
    bf16_t* MG = (bf16_t*)(p.ws() + OFF_MERGED);
    const float* bm = p.in(36) + (size_t)l * 4096;
    const int lane = tid & 63, wv = tid >> 6, wn = wv >> 1, wt = wv & 1, fr = lane & 15, g = lane >> 4;
    for (int it = 0;; ++it) {
        int mt0, nt0; if (!xcd_tile(it, 64, 16, 8, mt0, nt0)) break;
        const int m0 = mt0 * 128, n0 = nt0 * 64;
        const int fb = n0 + wn * 32 + 8 * g;
        f32x4 mg[2][4];
#pragma unroll
        for (int a = 0; a < 2; ++a)
#pragma unroll
            for (int b = 0; b < 4; ++b) mg[a][b] = (f32x4){0.f, 0.f, 0.f, 0.f};
#pragma unroll 1
        for (int br = 0; br < 4; ++br) {
            f32x4 ga[2][4], pa[2][4];
#pragma unroll
            for (int a = 0; a < 2; ++a)
#pragma unroll
                for (int b = 0; b < 4; ++b) { ga[a][b] = (f32x4){0.f, 0.f, 0.f, 0.f}; pa[a][b] = (f32x4){0.f, 0.f, 0.f, 0.f}; }
            gemm_kloop<2, 4>(ga, WM + (size_t)(br * 1024 + n0) * 1024, 1024, H + (size_t)m0 * 1024, 1024, 1024, smem, tid);
            const bf16_t* xb; size_t ldb;
            if (br == 0) { xb = PROJ + (size_t)m0 * INWP + C_Z; ldb = INWP; }
            else if (br == 1) { xb = PROJ + (size_t)m0 * INWP + C_RG; ldb = INWP; }
            else if (br == 2) { xb = (const bf16_t*)(p.ws() + OFF_OA) + (size_t)m0 * 512; ldb = 512; }
            else { xb = OM + (size_t)m0 * 512; ldb = 512; }
            gemm_kloop<2, 4>(pa, WBR + (size_t)br * 1024 * 512 + (size_t)n0 * 512, 512, xb, ldb, 512, smem, tid);
            const f32x4 b0 = *(const f32x4*)(bm + br * 1024 + fb), b1 = *(const f32x4*)(bm + br * 1024 + fb + 4);
#pragma unroll
            for (int mt = 0; mt < 4; ++mt)
#pragma unroll
                for (int r = 0; r < 4; ++r) {
                    mg[0][mt][r] += sigmoidf(ga[0][mt][r] + b0[r]) * pa[0][mt][r];
                    mg[1][mt][r] += sigmoidf(ga[1][mt][r] + b1[r]) * pa[1][mt][r];
                }
        }
#pragma unroll
        for (int mt = 0; mt < 4; ++mt) {
            const int m = m0 + wt * 64 + 16 * mt + fr;
            float v[8];
#pragma unroll
            for (int a = 0; a < 2; ++a)
#pragma unroll
                for (int r = 0; r < 4; ++r) v[4 * a + r] = mg[a][mt][r];
            *(u32x4*)(MG + (size_t)m * 1024 + fb) = pack8(v);
        }
    }
}

DI void prep_token(const Ctx& p, int l, int ps, int m, int lane) {
    char* ws = p.ws();
    bf16_t* PROJ = (bf16_t*)(ws + OFF_PROJ);
    const float* t16 = (const float*)(ws + OFF_T16);
    const float* t8 = (const float*)(ws + OFF_T8);
    const Tok k = tok_info(m, ps);
    bf16_t* pr = PROJ + (size_t)m * INWP;
    if (lane < 16) {
        const float v = ((const float*)(ws + OFF_DTRAW))[(size_t)m * 16 + lane] + p.in(19)[l * 16 + lane];
        const float sp = v > 20.f ? v : log1pf(__expf(v));
        ((float*)(ws + OFF_DT))[(size_t)m * 16 + lane] = sp;
    }
    {
        const int seqkey0 = k.lat ? (k.krow - 256 - k.t) : (k.krow - k.t);
        const int Lk = k.lat ? 2304 : 256;
        const int keyidx = k.krow - seqkey0;
        float v[8];
        if (lane < 32) unpack8(*(const u32x4*)(pr + C_AK + lane * 8), v);
        else {
#pragma unroll
            for (int j = 0; j < 8; ++j) v[j] = 0.f;
        }
        float ss = 0.f;
#pragma unroll
        for (int j = 0; j < 8; ++j) ss += v[j] * v[j];
        ss += __shfl_xor(ss, 1); ss += __shfl_xor(ss, 2); ss += __shfl_xor(ss, 4);
        const float rstd = rsqrtf(ss * (1.f / 64.f) + EPS);
        const int u = lane & 7, axis = u >> 2, pos = axis ? (k.t & 63) : (k.t >> 6);
        float kv[8];
        const float* w = p.in(26) + l * 64 + u * 8;
#pragma unroll
        for (int j = 0; j < 8; ++j) kv[j] = (v[j] * rstd) * w[j];
        float kr[8];
#pragma unroll
        for (int j = 0; j < 8; ++j) {
            const float other = __shfl_xor(kv[j], 2);
            const int fi = (u & 1) * 8 + j;
            const float c = t16[pos * 16 + fi], s = t16[1024 + pos * 16 + fi];
            kr[j] = (u & 2) ? (kv[j] * c + other * s) : (kv[j] * c - other * s);
        }
        if (lane < 16) {
            if (!k.lat) {
                float* o = p.out() + O_CK + ((size_t)(k.b * 2 + l) * 256 + k.t) * 128 + lane * 8;
                *(f32x4*)o = (f32x4){kv[0], kv[1], kv[2], kv[3]}; *(f32x4*)(o + 4) = (f32x4){kv[4], kv[5], kv[6], kv[7]};
            }
            bf16_t* ka = (bf16_t*)(ws + OFF_KA) + (size_t)k.krow * 128 + lane * 8;
            *(u32x4*)ka = k.lat ? pack8(kr) : pack8(kv);
        } else if (lane < 32) {
            const int d0 = (lane - 16) * 8;
            if (!k.lat) {
                float* o = p.out() + O_CV + ((size_t)(k.b * 2 + l) * 256 + k.t) * 128 + d0;
                *(f32x4*)o = (f32x4){v[0], v[1], v[2], v[3]}; *(f32x4*)(o + 4) = (f32x4){v[4], v[5], v[6], v[7]};
            }
            bf16_t* vt = (bf16_t*)(ws + OFF_VAT) + (size_t)seqkey0 * 128 + (size_t)d0 * Lk + keyidx;
#pragma unroll
            for (int j = 0; j < 8; ++j) vt[(size_t)j * Lk] = f2bf(v[j]);
        }
    }
    {
        float v[8];
        if (lane < 48) unpack8(*(const u32x4*)(pr + C_MCQ + lane * 8), v);
        else {
#pragma unroll
            for (int j = 0; j < 8; ++j) v[j] = 0.f;
        }
        float ss = 0.f;
#pragma unroll
        for (int j = 0; j < 8; ++j) ss += v[j] * v[j];
        ss = wsum(ss);
        const float rstd = rsqrtf(ss * (1.f / 384.f) + EPS);
        if (lane < 48) {
            const float* w = p.in(27) + l * 384 + lane * 8;
#pragma unroll
            for (int j = 0; j < 8; ++j) v[j] = (v[j] * rstd) * w[j];
            *(u32x4*)(pr + C_MCQ + lane * 8) = pack8(v);
        }
    }
    {
        float v[8];
        if (lane < 36) unpack8(*(const u32x4*)(pr + C_MCKV + lane * 8), v);
        else {
#pragma unroll
            for (int j = 0; j < 8; ++j) v[j] = 0.f;
        }
        float ss = 0.f;
        if (lane < 32) {
#pragma unroll
            for (int j = 0; j < 8; ++j) ss += v[j] * v[j];
        }
        ss = wsum(ss);
        const float rstd = rsqrtf(ss * (1.f / 256.f) + EPS);
        const int u = (lane - 32) & 3, axis = u >> 1, pos = axis ? (k.t & 63) : (k.t >> 6);
        float kr[8];
#pragma unroll
        for (int j = 0; j < 8; ++j) {
            const float other = __shfl_xor(v[j], 1);
            const float c = t8[pos * 8 + j], s = t8[512 + pos * 8 + j];
            kr[j] = (u & 1) ? (v[j] * c + other * s) : (v[j] * c - other * s);
        }
        if (lane < 32) {
            const float* w = p.in(29) + l * 256 + lane * 8;
            float c[8];
#pragma unroll
            for (int j = 0; j < 8; ++j) c[j] = (v[j] * rstd) * w[j];
            if (!k.lat) {
                float* o = p.out() + O_CC + ((size_t)(k.b * 2 + l) * 256 + k.t) * 256 + lane * 8;
                *(f32x4*)o = (f32x4){c[0], c[1], c[2], c[3]}; *(f32x4*)(o + 4) = (f32x4){c[4], c[5], c[6], c[7]};
            }
            *(u32x4*)((bf16_t*)(ws + OFF_CKV) + (size_t)k.krow * 256 + lane * 8) = pack8(c);
        } else if (lane < 36) {
            const int d0 = (lane - 32) * 8;
            if (!k.lat) {
                float* o = p.out() + O_CR + ((size_t)(k.b * 2 + l) * 256 + k.t) * 32 + d0;
                *(f32x4*)o = (f32x4){v[0], v[1], v[2], v[3]}; *(f32x4*)(o + 4) = (f32x4){v[4], v[5], v[6], v[7]};
            }
            *(u32x4*)((bf16_t*)(ws + OFF_KRP) + (size_t)k.krow * 32 + d0) = k.lat ? pack8(kr) : pack8(v);
        }
    }
}
DI void prep_conv_item(const Ctx& p, int l, int ps, int item, int lane) {
    const int run = item >> 1, cbk = item & 1;
    const int c0 = cbk * 512 + lane * 8;
    if (c0 >= 768) return;
    const int m0 = run * 16;
    const Tok k = tok_info(m0, ps);
    const float* cw = p.in(17) + (size_t)l * 3 * 768; const float* cb = p.in(18) + (size_t)l * 768;
    float w[4][8];
#pragma unroll
    for (int tp = 0; tp < 4; ++tp) {
        const float* src = (tp < 3) ? cw + tp * 768 + c0 : cb + c0;
        const f32x4 a0 = *(const f32x4*)src, a1 = *(const f32x4*)(src + 4);
#pragma unroll
        for (int e = 0; e < 4; ++e) { w[tp][e] = a0[e]; w[tp][4 + e] = a1[e]; }
    }
    const bf16_t* xb = (const bf16_t*)(p.ws() + OFF_PROJ) + (size_t)m0 * INWP + C_XBC + c0;
    bf16_t* xo = (bf16_t*)(p.ws() + OFF_XBCA) + (size_t)m0 * 768 + c0;
    const u32x4 zero = {0u, 0u, 0u, 0u};
    u32x4 pv = zero, cv;
    if (k.t > 0) pv = gld16(xb - INWP);
    cv = gld16(xb);
#pragma unroll 4
    for (int i = 0; i < 16; ++i) {
        u32x4 nv = zero;
        if (k.t + i + 1 < k.L) nv = gld16(xb + (size_t)(i + 1) * INWP);
        float a[8], b[8], c[8], o[8];
        unpack8(pv, a); unpack8(cv, b); unpack8(nv, c);
#pragma unroll
        for (int e = 0; e < 8; ++e) o[e] = siluf(w[3][e] + w[0][e] * a[e] + w[1][e] * b[e] + w[2][e] * c[e]);
        *(u32x4*)(xo + (size_t)i * 768) = pack8(o);
        pv = cv; cv = nv;
    }
}
DI void prep_cache_row(const Ctx& p, int l, int ps, int r, int lane) {
    char* ws = p.ws();
    const int j = r >> 8, c = r & 255, b = ps * 2 + j;
    const int key0 = 4096 + j * 2304, krow = key0 + c, Lk = 2304;
    const size_t src = (size_t)(b * 2 + l) * 256 + c;
    if (lane < 16) {
        const float* s = p.in(4) + src * 128 + lane * 8; float v[8];
#pragma unroll
        for (int i = 0; i < 8; ++i) v[i] = s[i];
        *(u32x4*)((bf16_t*)(ws + OFF_KA) + (size_t)krow * 128 + lane * 8) = pack8(v);
    } else if (lane < 32) {
        const int d0 = (lane - 16) * 8;
        const float* s = p.in(5) + src * 128 + d0;
        bf16_t* vt = (bf16_t*)(ws + OFF_VAT) + (size_t)key0 * 128 + (size_t)d0 * Lk + c;
#pragma unroll
        for (int i = 0; i < 8; ++i) vt[(size_t)i * Lk] = f2bf(s[i]);
    } else if (lane < 36) {
        const int d0 = (lane - 32) * 8;
        const float* s = p.in(7) + src * 32 + d0; float v[8];
#pragma unroll
        for (int i = 0; i < 8; ++i) v[i] = s[i];
        *(u32x4*)((bf16_t*)(ws + OFF_KRP) + (size_t)krow * 32 + d0) = pack8(v);
    }
    if (lane < 32) {
        const float* s = p.in(6) + src * 256 + lane * 8; float v[8];
#pragma unroll
        for (int i = 0; i < 8; ++i) v[i] = s[i];
        *(u32x4*)((bf16_t*)(ws + OFF_CKV) + (size_t)krow * 256 + lane * 8) = pack8(v);
    }
}
DI void phase_prep(const Ctx& p, int l, int ps, int tid) {
    const int lane = tid & 63, wv = tid >> 6;
    for (int m = blockIdx.x * 4 + wv; m < NPT + 512 + 1024; m += gridDim.x * 4) {
        if (m < NPT) prep_token(p, l, ps, m, lane); else if (m < NPT + 512) prep_cache_row(p, l, ps, m - NPT, lane); else prep_conv_item(p, l, ps, m - NPT - 512, lane);
    }
}

template <int KC>
DI void attn_tile(const bf16_t* __restrict__ Q, size_t ldq, const bf16_t* __restrict__ K1, size_t ldk1, const bf16_t* __restrict__ K2, size_t ldk2,
                  const bf16_t* __restrict__ VT, size_t ldvt, int nkt, float c2, bf16_t* __restrict__ O, size_t ldo,
                  const float* __restrict__ qnw  , const float* __restrict__ rope, int t0  , char* smem, int tid) {
    constexpr int KB = KC * 4096, STG = KB + 8192;
    tid = launder(tid);
    const int lane = tid & 63, w = tid >> 6, fr = lane & 15, g = lane >> 4;
    bf16x8 qf[2][KC];
#pragma unroll
    for (int qt = 0; qt < 2; ++qt)
#pragma unroll
        for (int ks = 0; ks < KC; ++ks) { const u32x4 t4 = gld16(Q + (size_t)(32 * w + 16 * qt + fr) * ldq + ks * 32 + 8 * g); qf[qt][ks] = __builtin_bit_cast(bf16x8, t4); }
    if (KC == 2 && qnw) {
#pragma unroll
        for (int qt = 0; qt < 2; ++qt) {
            float v[2][8]; float ss = 0.f;
#pragma unroll
            for (int ks = 0; ks < 2; ++ks) {
                const u32x4 t4 = __builtin_bit_cast(u32x4, qf[qt][ks]); unpack8(t4, v[ks]);
#pragma unroll
                for (int j = 0; j < 8; ++j) ss += v[ks][j] * v[ks][j];
            }
            ss += __shfl_xor(ss, 16); ss += __shfl_xor(ss, 32);
            const float rstd = rsqrtf(ss * (1.f / 64.f) + EPS);
            const int t = t0 + 32 * w + 16 * qt + fr;
#pragma unroll
            for (int ks = 0; ks < 2; ++ks) {
                const int pos = ks ? (t & 63) : (t >> 6);
#pragma unroll
                for (int j = 0; j < 8; ++j) {
                    float x = (v[ks][j] * rstd) * qnw[32 * ks + 8 * g + j];
                    if (rope) {
                        const float other = __shfl_xor(x, 32);
                        const int fi = (g & 1) * 8 + j;
                        const float c = rope[pos * 16 + fi], sn = rope[1024 + pos * 16 + fi];
                        x = (g & 2) ? (x * c + other * sn) : (x * c - other * sn);
                    }
                    v[ks][j] = x;
                }
                const u32x4 t4 = pack8(v[ks]); qf[qt][ks] = __builtin_bit_cast(bf16x8, t4);
            }
        }
    }
    u32x4 rk[KC], rv[2];
    const bf16_t* kp[KC]; size_t kstep[KC]; int ko[KC];
#pragma unroll
    for (int i = 0; i < KC; ++i) {
        const int q = tid + 256 * i, row = q / (KC * 4), cc = q % (KC * 4);
        if (cc < 8) { kp[i] = K1 + (size_t)row * ldk1 + cc * 8; kstep[i] = 64 * ldk1; }
        else { kp[i] = K2 + (size_t)row * ldk2 + (cc - 8) * 8; kstep[i] = 64 * ldk2; }
        ko[i] = tile_off(64, cc >> 2, row, cc & 3, (row >> 3) & 3);
    }
    const bf16_t* vp[2]; int vo[2];
#pragma unroll
    for (int i = 0; i < 2; ++i) {
        const int q = tid + 256 * i, row = q >> 3, cc = q & 7;
        vp[i] = VT + (size_t)row * ldvt + cc * 8;
        vo[i] = KB + tile_off(64, cc >> 2, row, cc & 3, (row >> 2) & 3);
    }
    const int koff = tile_off(64, 0, 8 * (fr >> 2) + (fr & 3), g, fr >> 2);
    const int voff = KB + tile_off(64, 0, fr, g, (fr >> 2) & 3);
    f32x4 o[4][2];
#pragma unroll
    for (int a = 0; a < 4; ++a) { o[a][0] = (f32x4){0.f, 0.f, 0.f, 0.f}; o[a][1] = (f32x4){0.f, 0.f, 0.f, 0.f}; }
    float mrun[2] = {-1e30f, -1e30f}, lrun[2] = {0.f, 0.f};
    __syncthreads();
#pragma unroll
    for (int i = 0; i < KC; ++i) rk[i] = gld16(kp[i]);
#pragma unroll
    for (int i = 0; i < 2; ++i) rv[i] = gld16(vp[i]);
#pragma unroll
    for (int i = 0; i < KC; ++i) *(u32x4*)(smem + ko[i]) = rk[i];
#pragma unroll
    for (int i = 0; i < 2; ++i) *(u32x4*)(smem + vo[i]) = rv[i];
    __syncthreads();
    for (int kt = 0; kt < nkt; ++kt) {
        const bool more = kt + 1 < nkt;
        if (more) {
#pragma unroll
            for (int i = 0; i < KC; ++i) rk[i] = gld16(kp[i] + (size_t)(kt + 1) * kstep[i]);
#pragma unroll
            for (int i = 0; i < 2; ++i) rv[i] = gld16(vp[i] + (size_t)(kt + 1) * 64);
        }
        __builtin_amdgcn_sched_barrier(0);
        const char* sb = smem + (kt & 1) * STG;
        f32x4 s[4][2];
#pragma unroll
        for (int a = 0; a < 4; ++a) { s[a][0] = (f32x4){0.f, 0.f, 0.f, 0.f}; s[a][1] = (f32x4){0.f, 0.f, 0.f, 0.f}; }
#pragma unroll
        for (int ks = 0; ks < KC; ++ks)
#pragma unroll
            for (int a = 0; a < 4; ++a) {
                const bf16x8 af = *(const bf16x8*)(sb + koff + ((a >> 1) * 32 + (a & 1) * 4) * 64 + ks * 4096);
                s[a][0] = __builtin_amdgcn_mfma_f32_16x16x32_bf16(af, qf[0][ks], s[a][0], 0, 0, 0);
                s[a][1] = __builtin_amdgcn_mfma_f32_16x16x32_bf16(af, qf[1][ks], s[a][1], 0, 0, 0);
            }
        bf16x8 pf[2][2];
#pragma unroll
        for (int qt = 0; qt < 2; ++qt) {
            float mx = s[0][qt][0];
#pragma unroll
            for (int a = 0; a < 4; ++a)
#pragma unroll
                for (int r = 0; r < 4; ++r) mx = fmaxf(mx, s[a][qt][r]);
            mx = fmaxf(mx, __shfl_xor(mx, 16)); mx = fmaxf(mx, __shfl_xor(mx, 32));
            const float mnew = fmaxf(mrun[qt], mx);
            const float alpha = exp2f((mrun[qt] - mnew) * c2);
            mrun[qt] = mnew;
            const float mc = mnew * c2;
            float ls = 0.f; float pv[16];
#pragma unroll
            for (int a = 0; a < 4; ++a)
#pragma unroll
                for (int r = 0; r < 4; ++r) { const float e = exp2f(s[a][qt][r] * c2 - mc); pv[4 * a + r] = e; ls += e; }
            lrun[qt] = lrun[qt] * alpha + ls;
#pragma unroll
            for (int a = 0; a < 4; ++a) o[a][qt] = o[a][qt] * alpha;
            u32x4 w0 = pack8(pv), w1 = pack8(pv + 8);
            pf[qt][0] = __builtin_bit_cast(bf16x8, w0); pf[qt][1] = __builtin_bit_cast(bf16x8, w1);
        }
#pragma unroll
        for (int s2 = 0; s2 < 2; ++s2)
#pragma unroll
            for (int dt = 0; dt < 4; ++dt) {
                const bf16x8 vf = *(const bf16x8*)(sb + voff + dt * 1024 + s2 * 4096);
                o[dt][0] = __builtin_amdgcn_mfma_f32_16x16x32_bf16(vf, pf[0][s2], o[dt][0], 0, 0, 0);
                o[dt][1] = __builtin_amdgcn_mfma_f32_16x16x32_bf16(vf, pf[1][s2], o[dt][1], 0, 0, 0);
            }
        __builtin_amdgcn_sched_barrier(0);
        if (more) {
            char* sn = smem + ((kt + 1) & 1) * STG;
#pragma unroll
            for (int i = 0; i < KC; ++i) *(u32x4*)(sn + ko[i]) = rk[i];
#pragma unroll
            for (int i = 0; i < 2; ++i) *(u32x4*)(sn + vo[i]) = rv[i];
        }
        __syncthreads();
    }
#pragma unroll
    for (int qt = 0; qt < 2; ++qt) {
        float l = lrun[qt]; l += __shfl_xor(l, 16); l += __shfl_xor(l, 32);
        const float inv = 1.f / l;
        bf16_t* orow = O + (size_t)(32 * w + 16 * qt + fr) * ldo + 4 * g;
#pragma unroll
        for (int dt = 0; dt < 4; ++dt) {
            u32x2 wv2; wv2[0] = pk2(o[dt][qt][0] * inv, o[dt][qt][1] * inv); wv2[1] = pk2(o[dt][qt][2] * inv, o[dt][qt][3] * inv);
            *(u32x2*)(orow + 16 * dt) = wv2;
        }
    }
}

struct Seq { int lat, tok0, L, key0, Lk, b; };
DI Seq seq_info(int s, int ps) {
    Seq q;
    if (s < 16) { q.lat = 0; q.tok0 = s * 256; q.L = 256; q.key0 = s * 256; q.Lk = 256; q.b = ps * 16 + s; }
    else { const int j = s - 16; q.lat = 1; q.tok0 = 4096 + j * 2048; q.L = 2048; q.key0 = 4096 + j * 2304; q.Lk = 2304; q.b = ps * 2 + j; }
    return q;
}
DI void attn_gqa_item(const Ctx& p, int l, int s, int head, int qb, int ps, char* smem, int tid) {
    const Seq q = seq_info(s, ps);
    bf16_t* PROJ = (bf16_t*)(p.ws() + OFF_PROJ);
    bf16_t* Q = PROJ + (size_t)(q.tok0 + qb * 128) * INWP + C_AQ + head * 64;
    const int kh = head >> 2;
    const bf16_t* K = (const bf16_t*)(p.ws() + OFF_KA) + (size_t)q.key0 * 128 + kh * 64;
    const bf16_t* VT = (const bf16_t*)(p.ws() + OFF_VAT) + (size_t)q.key0 * 128 + (size_t)kh * 64 * q.Lk;
    bf16_t* O = (bf16_t*)(p.ws() + OFF_OA) + (size_t)(q.tok0 + qb * 128) * 512 + head * 64;
    attn_tile<2>(Q, INWP, K, 128, K, 128, VT, q.Lk, q.Lk / 64, 0.125f * 1.4426950408889634f, O, 512,
                 p.in(25) + l * 64, q.lat ? (const float*)(p.ws() + OFF_T16) : nullptr, qb * 128, smem, tid);
}
DI void attn_mla_item(const Ctx& p, int s, int head, int qb, int ps, char* smem, int tid) {
    const Seq q = seq_info(s, ps);
    const bf16_t* Q = (const bf16_t*)(p.ws() + OFF_QM) + (size_t)(q.tok0 + qb * 128) * 768 + head * 96;
    const bf16_t* K1 = (const bf16_t*)(p.ws() + OFF_KN) + (size_t)q.key0 * 512 + head * 64;
    const bf16_t* K2 = (const bf16_t*)(p.ws() + OFF_KRP) + (size_t)q.key0 * 32;
    const bf16_t* VT = (const bf16_t*)(p.ws() + OFF_VMT) + (size_t)q.key0 * 512 + (size_t)head * 64 * q.Lk;
    bf16_t* O = (bf16_t*)(p.ws() + OFF_OM) + (size_t)(q.tok0 + qb * 128) * 512 + head * 64;
    attn_tile<3>(Q, 768, K1, 512, K2, 32, VT, q.Lk, q.Lk / 64, 0.10206207261596577f * 1.4426950408889634f, O, 512, nullptr, nullptr, 0, smem, tid);
}

template <int ET>
DI void scan_item(const bf16_t* __restrict__ Qp, size_t ldq, const bf16_t* __restrict__ Kp, size_t ldk, const bf16_t* __restrict__ Vp, size_t ldv,
                  const float* __restrict__ dtp  , float acoef  ,
                  int L, int dir, const float* __restrict__ s0, float* __restrict__ sout, bf16_t* __restrict__ Op, size_t ldo,
                  const float* __restrict__ rope  , float kmul, char* smem, int tid) {
    constexpr int DV = 16 * ET;
    constexpr int QS = 0, KS = 8192, KT = 16384, VTO = 24576, STO = VTO + DV * 128, ACO = STO + DV * 128;
    constexpr int NV = DV / 32;
    tid = launder(tid);
    const int lane = tid & 63, w = tid >> 6, fr = lane & 15, g = lane >> 4;
    float* acs = (float*)(smem + ACO);
    f32x4 sacc[ET];
#pragma unroll
    for (int et = 0; et < ET; ++et) {
        if (s0) {
#pragma unroll
            for (int r = 0; r < 4; ++r) sacc[et][r] = s0[(size_t)(16 * w + 4 * g + r) * DV + 16 * et + fr];
        } else sacc[et] = (f32x4){0.f, 0.f, 0.f, 0.f};
    }
    const int st_off = STO + ((w >> 1) * DV) * 64 + (g & 1) * 8;
    const int st_gg = (2 * w + (g >> 1)) & 3;
    __syncthreads();
#pragma unroll
    for (int et = 0; et < ET; ++et) {
        const int e = 16 * et + fr;
        u32x2 wv2; wv2[0] = pk2(sacc[et][0], sacc[et][1]); wv2[1] = pk2(sacc[et][2], sacc[et][3]);
        *(u32x2*)(smem + st_off + e * 64 + ((st_gg ^ FQ((e >> 2) & 3)) << 4)) = wv2;
    }
    const int nch = L >> 6;
    const int qoff = QS + tile_off(64, 0, 16 * w + fr, g, (fr >> 2) & 3);
    const int koff = KS + tile_off(64, 0, 8 * (fr >> 2) + (fr & 3), g, fr >> 2);
    const int ktoff = KT + tile_off(64, 0, 16 * w + fr, g, (fr >> 2) & 3);
    const int vtoff = VTO + tile_off(DV, 0, fr, g, (fr >> 2) & 3);
    const int stoff = STO + tile_off(DV, 0, fr, g, (fr >> 2) & 3);
    for (int c = 0; c < nch; ++c) {
        const int n0 = c * 64;
        float dtv = 1.f, la;
        {
            const int tl = dir ? (L - 1 - (n0 + lane)) : (n0 + lane);
            if (dtp) { dtv = dtp[(size_t)tl * 16]; la = dtv * acoef; } else la = acoef;
        }
        float ac = la;
#pragma unroll
        for (int o = 1; o < 64; o <<= 1) { const float t = __shfl_up(ac, o); if (lane >= o) ac += t; }
        const float aend = __shfl(ac, 63);
        if (w == 0) acs[lane] = ac;
#pragma unroll
        for (int i = 0; i < 2; ++i) {
            const int q = tid + 256 * i, row = q >> 3, cc = q & 7;
            const int tl = dir ? (L - 1 - (n0 + row)) : (n0 + row);
            const u32x4 qv = *(const u32x4*)(Qp + (size_t)tl * ldq + cc * 8);
            const u32x4 kv = *(const u32x4*)(Kp + (size_t)tl * ldk + cc * 8);
            float kf[8]; unpack8(kv, kf);
            const float ksc = __shfl(dtv, row) * kmul, wend = __expf(aend - __shfl(ac, row));
            if (rope) {
                float qf8[8]; unpack8(qv, qf8);
                const int pos = (cc >> 2) ? (tl & 63) : (tl >> 6);
                const bool hi = (cc & 2) != 0;
#pragma unroll
                for (int j = 0; j < 8; ++j) {
                    const int fi = (cc & 1) * 8 + j;
                    const float c = rope[pos * 16 + fi], sn = rope[1024 + pos * 16 + fi];
                    const float oq = __shfl_xor(qf8[j], 2), ok = __shfl_xor(kf[j], 2);
                    qf8[j] = hi ? (qf8[j] * c + oq * sn) : (qf8[j] * c - oq * sn);
                    kf[j] = hi ? (kf[j] * c + ok * sn) : (kf[j] * c - ok * sn);
                }
                *(u32x4*)(smem + QS + tile_off(64, cc >> 2, row, cc & 3, (row >> 2) & 3)) = pack8(qf8);
            } else {
                *(u32x4*)(smem + QS + tile_off(64, cc >> 2, row, cc & 3, (row >> 2) & 3)) = qv;
            }
#pragma unroll
            for (int j = 0; j < 8; ++j) kf[j] *= ksc;
            *(u32x4*)(smem + KS + tile_off(64, cc >> 2, row, cc & 3, (row >> 3) & 3)) = pack8(kf);
#pragma unroll
            for (int j = 0; j < 8; ++j) {
                const int d = cc * 8 + j;
                *(bf16_t*)(smem + KT + tile_off(64, row >> 5, d, (row >> 3) & 3, (d >> 2) & 3) + (row & 7) * 2) = f2bf(kf[j] * wend);
            }
        }
#pragma unroll
        for (int i = 0; i < NV; ++i) {
            const int q = tid + 256 * i, row = q / (DV / 8), cc = q % (DV / 8);
            const int tl = dir ? (L - 1 - (n0 + row)) : (n0 + row);
            const u32x4 vv = *(const u32x4*)(Vp + (size_t)tl * ldv + cc * 8);
#pragma unroll
            for (int j = 0; j < 8; ++j) {
                const int e = cc * 8 + j;
                const unsigned short h = (unsigned short)(vv[j >> 1] >> (16 * (j & 1)));
                *(bf16_t*)(smem + VTO + tile_off(DV, row >> 5, e, (row >> 3) & 3, (e >> 2) & 3) + (row & 7) * 2) = h;
            }
        }
        __syncthreads();
        {
            bf16x8 qfr[2];
            qfr[0] = *(const bf16x8*)(smem + qoff); qfr[1] = *(const bf16x8*)(smem + qoff + 4096);
            const int irow = 16 * w + fr;
            const float ai = acs[irow];
            f32x4 o[ET];
#pragma unroll
            for (int et = 0; et < ET; ++et) {
                o[et] = (f32x4){0.f, 0.f, 0.f, 0.f};
#pragma unroll
                for (int ks = 0; ks < 2; ++ks) {
                    const bf16x8 sf = *(const bf16x8*)(smem + stoff + et * 1024 + ks * DV * 64);
                    o[et] = __builtin_amdgcn_mfma_f32_16x16x32_bf16(sf, qfr[ks], o[et], 0, 0, 0);
                }
            }
            const float ei = __expf(ai);
#pragma unroll
            for (int et = 0; et < ET; ++et) o[et] = o[et] * ei;
            const int ns = (w >> 1) + 1;
            for (int s = 0; s < ns; ++s) {
                f32x4 pp[2];
#pragma unroll
                for (int aa = 0; aa < 2; ++aa) {
                    pp[aa] = (f32x4){0.f, 0.f, 0.f, 0.f};
#pragma unroll
                    for (int ks = 0; ks < 2; ++ks) {
                        const bf16x8 kf2 = *(const bf16x8*)(smem + koff + (32 * s + 4 * aa) * 64 + ks * 4096);
                        pp[aa] = __builtin_amdgcn_mfma_f32_16x16x32_bf16(kf2, qfr[ks], pp[aa], 0, 0, 0);
                    }
                }
                float pv[8];
#pragma unroll
                for (int aa = 0; aa < 2; ++aa) {
                    const int j0 = 32 * s + 8 * g + 4 * aa;
                    const f32x4 aj = *(const f32x4*)(acs + j0);
#pragma unroll
                    for (int r = 0; r < 4; ++r) {
                        const float dec = __expf(fminf(ai - aj[r], 0.f));
                        pv[4 * aa + r] = (j0 + r <= irow) ? pp[aa][r] * dec : 0.f;
                    }
                }
                const u32x4 pw = pack8(pv);
                const bf16x8 pf = __builtin_bit_cast(bf16x8, pw);
#pragma unroll
                for (int et = 0; et < ET; ++et) {
                    const bf16x8 vf = *(const bf16x8*)(smem + vtoff + et * 1024 + s * DV * 64);
                    o[et] = __builtin_amdgcn_mfma_f32_16x16x32_bf16(vf, pf, o[et], 0, 0, 0);
                }
            }
            const int tl = dir ? (L - 1 - (n0 + irow)) : (n0 + irow);
            bf16_t* orow = Op + (size_t)tl * ldo + 4 * g;
#pragma unroll
            for (int et = 0; et < ET; ++et) {
                u32x2 wv2; wv2[0] = pk2(o[et][0], o[et][1]); wv2[1] = pk2(o[et][2], o[et][3]);
                *(u32x2*)(orow + 16 * et) = wv2;
            }
            const float cd = __expf(acs[63]);
#pragma unroll
            for (int et = 0; et < ET; ++et) sacc[et] = sacc[et] * cd;
#pragma unroll
            for (int ks = 0; ks < 2; ++ks) {
                const bf16x8 kt2 = *(const bf16x8*)(smem + ktoff + ks * 4096);
#pragma unroll
                for (int et = 0; et < ET; ++et) {
                    const bf16x8 vf = *(const bf16x8*)(smem + vtoff + et * 1024 + ks * DV * 64);
                    sacc[et] = __builtin_amdgcn_mfma_f32_16x16x32_bf16(kt2, vf, sacc[et], 0, 0, 0);
                }
            }
        }
        __syncthreads();
#pragma unroll
        for (int et = 0; et < ET; ++et) {
            const int e = 16 * et + fr;
            u32x2 wv2; wv2[0] = pk2(sacc[et][0], sacc[et][1]); wv2[1] = pk2(sacc[et][2], sacc[et][3]);
            *(u32x2*)(smem + st_off + e * 64 + ((st_gg ^ FQ((e >> 2) & 3)) << 4)) = wv2;
        }
    }
    if (sout) {
#pragma unroll
        for (int et = 0; et < ET; ++et)
#pragma unroll
            for (int r = 0; r < 4; ++r) sout[(size_t)(16 * w + 4 * g + r) * DV + 16 * et + fr] = sacc[et][r];
    }
    __syncthreads();
}

DI void scan_ssd_item(const Ctx& p, int l, int ps, int s, int h, int dir, char* smem, int tid) {
    const Seq q = seq_info(s, ps);
    const bf16_t* XB = (const bf16_t*)(p.ws() + OFF_XBCA) + (size_t)q.tok0 * 768;
    const int grp = h >> 2;
    const float* dtp = (const float*)(p.ws() + OFF_DT) + (size_t)q.tok0 * 16 + dir * 8 + h;
    const float acoef = -__expf(p.in(20)[l * 16 + dir * 8 + h]);
    const float* s0 = q.lat ? p.in(2) + ((size_t)((q.b * 2 + l) * 2 + dir) * 8 + h) * 4096 : nullptr;
    float* so = q.lat ? nullptr : p.out() + O_SSD + ((size_t)((q.b * 2 + l) * 2 + dir) * 8 + h) * 4096;
    bf16_t* O = (bf16_t*)(p.ws() + OFF_OS) + ((size_t)dir * NPT + q.tok0) * 512 + h * 64;
    scan_item<4>(XB + 640 + grp * 64, 768, XB + 512 + grp * 64, 768, XB + h * 64, 768, dtp, acoef, q.L, dir, s0, so, O, 512, nullptr, 1.f, smem, tid);
}
DI void scan_ret_item(const Ctx& p, int l, int ps, int s, int h, int dir, char* smem, int tid) {
    const Seq q = seq_info(s, ps);
    const bf16_t* PR = (const bf16_t*)(p.ws() + OFF_PROJ) + (size_t)q.tok0 * INWP;
    const float x = p.in(23)[l * 8 + dir * 4 + h];
    const float la = fminf(x, 0.f) - log1pf(__expf(-fabsf(x)));
    const float* s0 = q.lat ? p.in(3) + ((size_t)((q.b * 2 + l) * 2 + dir) * 4 + h) * 8192 : nullptr;
    float* so = q.lat ? nullptr : p.out() + O_RET + ((size_t)((q.b * 2 + l) * 2 + dir) * 4 + h) * 8192;
    bf16_t* O = (bf16_t*)(p.ws() + OFF_OR) + ((size_t)dir * NPT + q.tok0) * 512 + h * 128;
    scan_item<8>(PR + C_RQ + h * 64, INWP, PR + C_RK + h * 64, INWP, PR + C_RV + h * 128, INWP, nullptr, la, q.L, dir, s0, so, O, 512,
                 q.lat ? (const float*)(p.ws() + OFF_T16) : nullptr, 0.125f, smem, tid);
}

DI void postscan_token(const Ctx& p, int l, int m, int lane) {
    char* ws = p.ws();
    bf16_t* pr = (bf16_t*)(ws + OFF_PROJ) + (size_t)m * INWP;
    const int c0 = lane * 8;
    {
        const bf16_t* OS = (const bf16_t*)(ws + OFF_OS);
        float a[8], b[8], xs[8], z[8];
        unpack8(*(const u32x4*)(OS + (size_t)m * 512 + c0), a);
        unpack8(*(const u32x4*)(OS + ((size_t)NPT + m) * 512 + c0), b);
        unpack8(*(const u32x4*)((const bf16_t*)(ws + OFF_XBCA) + (size_t)m * 768 + c0), xs);
        unpack8(*(const u32x4*)(pr + C_Z + c0), z);
        const float dsk = p.in(21)[l * 8 + (c0 >> 6)];
        float v[8], ss = 0.f;
#pragma unroll
        for (int j = 0; j < 8; ++j) { v[j] = ((a[j] + b[j]) + dsk * xs[j]) * siluf(z[j]); ss += v[j] * v[j]; }
        ss = wsum(ss);
        const float rstd = rsqrtf(ss * (1.f / 512.f) + EPS);
        const float* w = p.in(22) + l * 512 + c0;
#pragma unroll
        for (int j = 0; j < 8; ++j) v[j] = (v[j] * rstd) * w[j];
        *(u32x4*)(pr + C_Z + c0) = pack8(v);
    }
    {
        const bf16_t* ORb = (const bf16_t*)(ws + OFF_OR);
        float a[8], b[8], gt[8];
        unpack8(*(const u32x4*)(ORb + (size_t)m * 512 + c0), a);
        unpack8(*(const u32x4*)(ORb + ((size_t)NPT + m) * 512 + c0), b);
        unpack8(*(const u32x4*)(pr + C_RG + c0), gt);
        float v[8], sm = 0.f;
#pragma unroll
        for (int j = 0; j < 8; ++j) { v[j] = a[j] + b[j]; sm += v[j]; }
        sm += __shfl_xor(sm, 1); sm += __shfl_xor(sm, 2); sm += __shfl_xor(sm, 4); sm += __shfl_xor(sm, 8);
        const float mean = sm * (1.f / 128.f);
        float sq = 0.f;
#pragma unroll
        for (int j = 0; j < 8; ++j) { v[j] -= mean; sq += v[j] * v[j]; }
        sq += __shfl_xor(sq, 1); sq += __shfl_xor(sq, 2); sq += __shfl_xor(sq, 4); sq += __shfl_xor(sq, 8);
        const float rstd = rsqrtf(sq * (1.f / 128.f) + EPS);
        const float* w = p.in(24) + l * 512 + c0;
#pragma unroll
        for (int j = 0; j < 8; ++j) v[j] = (v[j] * rstd) * w[j] * siluf(gt[j]);
        *(u32x4*)(pr + C_RG + c0) = pack8(v);
    }
}

DI void phase_act(const Ctx& p, int l, int ps, int tid) {
    tid = launder(tid);
    const int lane = tid & 63, wv = tid >> 6;
    const bf16_t* U = (const bf16_t*)(p.ws() + OFF_U);
    bf16_t* A = (bf16_t*)(p.ws() + OFF_ACT);
    const float* cw = p.in(39) + (size_t)l * 3 * 5632; const float* cb = p.in(40) + (size_t)l * 5632;
    for (int item = blockIdx.x * 4 + wv; item < 512 * 6; item += gridDim.x * 4) {
        const int run = item / 6, cbk = item % 6;
        const int j0 = cbk * 512 + lane * 8;
        if (j0 >= DFF) continue;
        const int m0 = run * 16;
        const Tok k = tok_info(m0, ps);
        float wu[4][8], wg[4][8];
#pragma unroll
        for (int tp = 0; tp < 3; ++tp) {
            const f32x4 a0 = *(const f32x4*)(cw + tp * 5632 + j0), a1 = *(const f32x4*)(cw + tp * 5632 + j0 + 4);
            const f32x4 g0 = *(const f32x4*)(cw + tp * 5632 + DFF + j0), g1 = *(const f32x4*)(cw + tp * 5632 + DFF + j0 + 4);
#pragma unroll
            for (int e = 0; e < 4; ++e) { wu[tp][e] = a0[e]; wu[tp][4 + e] = a1[e]; wg[tp][e] = g0[e]; wg[tp][4 + e] = g1[e]; }
        }
        {
            const f32x4 a0 = *(const f32x4*)(cb + j0), a1 = *(const f32x4*)(cb + j0 + 4);
            const f32x4 g0 = *(const f32x4*)(cb + DFF + j0), g1 = *(const f32x4*)(cb + DFF + j0 + 4);
#pragma unroll
            for (int e = 0; e < 4; ++e) { wu[3][e] = a0[e]; wu[3][4 + e] = a1[e]; wg[3][e] = g0[e]; wg[3][4 + e] = g1[e]; }
        }
        const bf16_t* ub = U + (size_t)m0 * 5632 + j0;
        const u32x4 zero = {0u, 0u, 0u, 0u};
        u32x4 pu = zero, pg = zero, cu, cg;
        if (k.t > 0) { pu = gld16(ub - 5632); pg = gld16(ub - 5632 + DFF); }
        cu = gld16(ub); cg = gld16(ub + DFF);
#pragma unroll 4
        for (int i = 0; i < 16; ++i) {
            u32x4 nu = zero, ng = zero;
            if (k.t + i + 1 < k.L) { nu = gld16(ub + (size_t)(i + 1) * 5632); ng = gld16(ub + (size_t)(i + 1) * 5632 + DFF); }
            float a[8], b[8], c[8], o[8];
            unpack8(pu, a); unpack8(cu, b); unpack8(nu, c);
            float up[8];
#pragma unroll
            for (int e = 0; e < 8; ++e) up[e] = wu[3][e] + wu[0][e] * a[e] + wu[1][e] * b[e] + wu[2][e] * c[e];
            unpack8(pg, a); unpack8(cg, b); unpack8(ng, c);
#pragma unroll
            for (int e = 0; e < 8; ++e) { const float gt = wg[3][e] + wg[0][e] * a[e] + wg[1][e] * b[e] + wg[2][e] * c[e]; o[e] = siluf(gt) * up[e]; }
            *(u32x4*)(A + (size_t)(m0 + i) * DFF + j0) = pack8(o);
            pu = cu; pg = cg; cu = nu; cg = ng;
        }
    }
}

DI int next_item(unsigned* ctr, volatile LAS unsigned* slot, int tid) {
    __syncthreads();
    if (tid == 0) *slot = __hip_atomic_fetch_add(ctr, 1u, __ATOMIC_RELAXED, __HIP_MEMORY_SCOPE_AGENT);
    __syncthreads();
    return (int)*slot;
}

#ifndef ONLY2
#define ONLY2 -1
#endif
DI void phase_mix1(const Ctx& p, int l, int ps, unsigned* ctr, volatile LAS unsigned* slot, char* smem, int tid) {
    for (;;) {
        int it = next_item(ctr, slot, tid);
        if (it >= 1872) break;
        if (it < 32) { if (ONLY2 < 0 || ONLY2 == 0) scan_ssd_item(p, l, ps, 16 + (it >> 4), (it >> 1) & 7, it & 1, smem, tid); }
        else if (it < 48) { const int k = it - 32; if (ONLY2 < 0 || ONLY2 == 1) scan_ret_item(p, l, ps, 16 + (k >> 3), (k >> 1) & 3, k & 1, smem, tid); }
        else if (it < 304) { const int k = it - 48; if (ONLY2 < 0 || ONLY2 == 2) attn_gqa_item(p, l, 16 + (k >> 7), (k >> 4) & 7, k & 15, ps, smem, tid); }
        else if (it < 688) { if (ONLY2 < 0 || ONLY2 == 3) gemm_uq_tile(p, l, ps, it - 304, smem, tid); }
        else if (it < 1232) { if (ONLY2 < 0 || ONLY2 == 4) gemm_ukv_tile(p, l, it - 688, smem, tid); }
        else if (it < 1488) { const int k = it - 1232; if (ONLY2 < 0 || ONLY2 == 0) scan_ssd_item(p, l, ps, k >> 4, (k >> 1) & 7, k & 1, smem, tid); }
        else if (it < 1616) { const int k = it - 1488; if (ONLY2 < 0 || ONLY2 == 1) scan_ret_item(p, l, ps, k >> 3, (k >> 1) & 3, k & 1, smem, tid); }
        else { const int k = it - 1616; if (ONLY2 < 0 || ONLY2 == 2) attn_gqa_item(p, l, k >> 4, (k >> 1) & 7, k & 1, ps, smem, tid); }
    }
}
DI void phase_mix2(const Ctx& p, int l, int ps, unsigned* ctr, volatile LAS unsigned* slot, char* smem, int tid, int rep) {
    const int lane = tid & 63, wv = tid >> 6;
    for (;;) {
        int it = next_item(ctr, slot, tid);
        if (it >= 768) break;
        if (it < 256) { attn_mla_item(p, 16 + (it >> 7), (it >> 4) & 7, it & 15, ps, smem, tid); }
        else if (it < 512) { const int k = it - 256; if (rep == 0) for (int i = 0; i < 8; ++i) postscan_token(p, l, k * 32 + i * 4 + wv, lane); }
        else { const int k = it - 512; attn_mla_item(p, k >> 4, (k >> 1) & 7, k & 1, ps, smem, tid); }
    }
}

constexpr int NPHASE = 1 + 2 * (1 + 2 * 11);
DI void run_phase(const Ctx& p, int ph, int rep, volatile LAS unsigned* slot, char* smem, int tid) {
#ifndef EXCL
#define EXCL -2
#endif
#ifndef ONLY
#define ONLY -1
#endif
    if (ph == 0) { if ((ONLY < 0 || ONLY == 100) && EXCL != 100) phase_prep_w(p, smem, tid); return; }
    const int q = ph - 1, ps = q / 23, r = q % 23;
    if (r == 0) { if ((ONLY < 0 || ONLY == 101) && EXCL != 101) phase_h1(p, ps, tid); return; }
    const int l = (r - 1) / 11, k = (r - 1) % 11;
    char* ws = p.ws();
    unsigned* ctr = (unsigned*)(p.ws() + OFF_CTR) + ph + 64 * rep;
    switch (k) {
    case 0: if ((ONLY < 0 || ONLY == 0) && EXCL != 0) phase_gemm_in(p, l, smem, tid); break;
    case 1: if ((ONLY < 0 || ONLY == 1) && EXCL != 1) phase_prep(p, l, ps, tid); break;
    case 2: if ((ONLY < 0 || ONLY == 2) && EXCL != 2) phase_mix1(p, l, ps, ctr, slot, smem, tid); break;
    case 3: if ((ONLY < 0 || ONLY == 3) && EXCL != 3) phase_mix2(p, l, ps, ctr, slot, smem, tid, rep); break;
    case 4: if ((ONLY < 0 || ONLY == 4) && EXCL != 4) phase_merge(p, l, smem, tid); break;
    case 5: if ((ONLY < 0 || ONLY == 5) && EXCL != 5) phase_gemm_plain<true>((const bf16_t*)(ws + OFF_WOUT) + (size_t)l * SZ_WOUT, 1024, (const bf16_t*)(ws + OFF_MERGED), 1024, 64, 8, ws + OFF_MO, 1024, smem, tid); break;
    case 6: if ((ONLY < 0 || ONLY == 6) && EXCL != 6) phase_res(p, ps, l, 0, tid); break;
    case 7: if ((ONLY < 0 || ONLY == 7) && EXCL != 7) phase_gemm_plain<false>((const bf16_t*)(ws + OFF_WUP) + (size_t)l * SZ_WUP, 1024, (const bf16_t*)(ws + OFF_H), 1024, 64, 44, ws + OFF_U, 5632, smem, tid); break;
    case 8: if ((ONLY < 0 || ONLY == 8) && EXCL != 8) phase_act(p, l, ps, tid); break;
    case 9: if ((ONLY < 0 || ONLY == 9) && EXCL != 9) phase_gemm_plain<true>((const bf16_t*)(ws + OFF_WDN) + (size_t)l * SZ_WDN, 2816, (const bf16_t*)(ws + OFF_ACT), 2816, 64, 8, ws + OFF_FO, 1024, smem, tid); break;
    default: if ((ONLY < 0 || ONLY == 10) && EXCL != 10) phase_res(p, ps, l, 1, tid); break;
    }
}

__global__ void __launch_bounds__(256, 2) fwd_kernel(Params prm, int ph_lo, int ph_hi, int rep) {
    __shared__ __attribute__((aligned(16))) char smem[65536 + 32 + 352];
    int tid = threadIdx.x;
    volatile LAS unsigned* xw = (volatile LAS unsigned*)(smem + 65536);
    volatile LAS unsigned* tbl = (volatile LAS unsigned*)(smem + 65536 + 32);
    if (tid == 0) { xw[0] = 0u; xw[1] = 0u; xw[2] = 0u; xw[3] = 0u; }
    if (tid == 0) {
#pragma unroll
        for (int i = 0; i < 44; ++i) {
            const unsigned long long v = (i < 42) ? (unsigned long long)prm.in[i < 42 ? i : 0] : (i == 42 ? (unsigned long long)prm.out : (unsigned long long)prm.ws);
            tbl[2 * i] = (unsigned)v; tbl[2 * i + 1] = (unsigned)(v >> 32);
        }
    }
    __syncthreads();
    Ctx p; p.tbl = tbl;
    XcdBarrier bar;
    const bool multi = (ph_hi - ph_lo) > 1;
    if (multi) bar = xcd_barrier_post((unsigned*)(p.ws() + OFF_BAR), xw);
    for (int ph = ph_lo; ph < ph_hi; ++ph) {
        tid = launder(tid);
        run_phase(p, ph, rep, xw + 2, smem, tid);
        if (multi && ph + 1 < ph_hi) xcd_barrier(bar);
    }
}

#ifndef MK_ONE_LAUNCH
#define MK_ONE_LAUNCH 1
#endif

extern "C" void kernel_launch(void* const* d_in, const int* in_sizes, int n_in, void* d_out, int out_size, void* d_ws, size_t ws_size, hipStream_t stream) {
    (void)in_sizes; (void)n_in; (void)out_size;
    if (ws_size < WS_NEED) { fprintf(stderr, "workspace too small: %zu < %zu\n", ws_size, (size_t)WS_NEED); return; }
    Params p{};
    for (int i = 0; i < 42; ++i) p.in[i] = (const float*)d_in[i];
    p.out = (float*)d_out; p.ws = (char*)d_ws;
    static int grid_blocks = 0;
    if (!grid_blocks) {
        int dev = 0, cus = 0, per_cu = 0;
        hipGetDevice(&dev);
        hipDeviceGetAttribute(&cus, hipDeviceAttributeMultiprocessorCount, dev);
        hipOccupancyMaxActiveBlocksPerMultiprocessor(&per_cu, fwd_kernel, 256, 0);
        if (per_cu > 2) per_cu = 2;
        if (per_cu < 1) per_cu = 1;
        grid_blocks = cus * per_cu;
    }
    hipMemsetAsync((char*)d_ws + OFF_BAR, 0, BAR_BYTES + CTR_BYTES, stream);
#if MK_ONE_LAUNCH
    {
        int lo = 0, hi = NPHASE, rep = 0;
        void* args[] = {&p, &lo, &hi, &rep};
        hipError_t e = hipLaunchCooperativeKernel((void*)fwd_kernel, dim3(grid_blocks), dim3(256), args, 0, stream);
        if (e != hipSuccess) fprintf(stderr, "cooperative launch failed: %s (grid %d)\n", hipGetErrorString(e), grid_blocks);
    }
#else
#ifndef PROBE_REP
#define PROBE_REP 0
#endif
    for (int ph = 0; ph < NPHASE; ++ph) {
        fwd_kernel<<<grid_blocks, 256, 0, stream>>>(p, ph, ph + 1, 0);
        int kind = -1;
        if (ph == 0) kind = 11; else { const int r = (ph - 1) % 23; kind = (r == 0) ? 12 : (r - 1) % 11; }
        if ((PROBE_REP >> kind) & 1) fwd_kernel<<<grid_blocks, 256, 0, stream>>>(p, ph, ph + 1, 1);
    }
#endif
}
```

```cpp
#include <hip/hip_runtime.h>
#include <cstdio>
#include <cstdint>
#include <cmath>

typedef unsigned short bf16_t;
typedef short bf16x8 __attribute__((ext_vector_type(8)));
typedef float f32x4 __attribute__((ext_vector_type(4)));
typedef unsigned u32x4 __attribute__((ext_vector_type(4)));
typedef unsigned u32x2 __attribute__((ext_vector_type(2)));
#define DI __device__ __forceinline__
#define LAS __attribute__((address_space(3)))

constexpr int DM = 1024, INW = 4272, INWP = 4352, DFF = 2816;
constexpr int NPT = 8192;
constexpr int KROWS = 8704;
constexpr float EPS = 1e-6f;
constexpr int C_Z = 0, C_XBC = 512, C_DT = 1280, C_RQ = 1296, C_RK = 1552, C_RV = 1808, C_RG = 2320, C_AQ = 2832, C_AK = 3344, C_AV = 3472,
              C_MCQ = 3600, C_MCKV = 3984;
constexpr size_t O_YS = 8388608, O_SSD = 16777216, O_RET = 20971520, O_CK = 25165824, O_CV = 27262976, O_CC = 29360128, O_CR = 33554432;

constexpr size_t al256(size_t x) { return (x + 255) & ~(size_t)255; }
constexpr size_t SZ_WIN = (size_t)INWP * 1024, SZ_WM = (size_t)4096 * 1024, SZ_WUQ = (size_t)768 * 384, SZ_WUKV = (size_t)1024 * 256,
                 SZ_WBR = (size_t)4 * 1024 * 512, SZ_WOUT = (size_t)1024 * 1024, SZ_WUP = (size_t)5632 * 1024, SZ_WDN = (size_t)1024 * 2816;
constexpr size_t OFF_WIN = 0;
constexpr size_t OFF_WM = OFF_WIN + 4 * SZ_WIN;
constexpr size_t OFF_WUQ = OFF_WM + 4 * SZ_WM;
constexpr size_t OFF_WUKV = OFF_WUQ + 4 * SZ_WUQ;
constexpr size_t OFF_WBR = OFF_WUKV + 4 * SZ_WUKV;
constexpr size_t OFF_WOUT = OFF_WBR + 4 * SZ_WBR;
constexpr size_t OFF_WUP = OFF_WOUT + 4 * SZ_WOUT;
constexpr size_t OFF_WDN = OFF_WUP + 4 * SZ_WUP;
constexpr size_t OFF_MOD = al256(OFF_WDN + 4 * SZ_WDN);
constexpr size_t OFF_T16 = al256(OFF_MOD + (size_t)2 * 5 * 6144 * 4);
constexpr size_t OFF_T8 = OFF_T16 + 2 * 64 * 16 * 4;
constexpr size_t OFF_BAR = al256(OFF_T8 + 2 * 64 * 8 * 4);
constexpr size_t BAR_BYTES = 3456 * 4, CTR_BYTES = (256 + 4 * 128) * 4;
constexpr size_t OFF_CTR = OFF_BAR + BAR_BYTES;
constexpr size_t OFF_DTRAW = al256(OFF_CTR + CTR_BYTES);
constexpr size_t OFF_DT = OFF_DTRAW + (size_t)NPT * 16 * 4;
constexpr size_t OFF_H = al256(OFF_DT + (size_t)NPT * 16 * 4);
constexpr size_t OFF_PROJ = OFF_H + (size_t)NPT * 1024 * 2;
constexpr size_t OFF_XBCA = OFF_PROJ + (size_t)NPT * INWP * 2;
constexpr size_t OFF_KA = OFF_XBCA + (size_t)NPT * 768 * 2;
constexpr size_t OFF_VAT = OFF_KA + (size_t)KROWS * 128 * 2;
constexpr size_t OFF_CKV = OFF_VAT + (size_t)KROWS * 128 * 2;
constexpr size_t OFF_KRP = OFF_CKV + (size_t)KROWS * 256 * 2;
constexpr size_t OFF_QM = OFF_KRP + (size_t)KROWS * 32 * 2;
constexpr size_t OFF_KN = OFF_QM + (size_t)NPT * 768 * 2;
constexpr size_t OFF_VMT = OFF_KN + (size_t)KROWS * 512 * 2;
constexpr size_t OFF_OS = OFF_VMT + (size_t)KROWS * 512 * 2;
constexpr size_t OFF_OR = OFF_OS + (size_t)2 * NPT * 512 * 2;
constexpr size_t OFF_OM = OFF_OR + (size_t)2 * NPT * 512 * 2;
constexpr size_t OFF_OA = OFF_OM + (size_t)NPT * 512 * 2;
constexpr int NSEG = 4, SEGTOK = 2048 / NSEG;
constexpr size_t OFF_SEG = OFF_OA + (size_t)NPT * 512 * 2;
constexpr size_t OFF_SEGD = OFF_SEG + (size_t)64 * NSEG * 4096 * 2;
constexpr size_t WS_END1 = OFF_SEGD + 64 * NSEG * 4;
constexpr size_t OFF_MERGED = OFF_OS;
constexpr size_t OFF_MO = OFF_XBCA;
constexpr size_t OFF_U = OFF_PROJ;
constexpr size_t OFF_ACT = OFF_QM;
constexpr size_t OFF_FO = OFF_PROJ;
static_assert(OFF_MO + (size_t)NPT * 1024 * 4 <= OFF_MERGED, "MO overlaps MERGED");
static_assert(OFF_U + (size_t)NPT * 5632 * 2 <= OFF_ACT, "U overlaps ACT");
static_assert(OFF_ACT + (size_t)NPT * 2816 * 2 <= WS_END1, "ACT beyond end");
constexpr size_t WS_NEED = WS_END1;

struct Params {
    const float* in[42];
    float* out;
    char* ws;
};
struct Ctx {
    volatile LAS unsigned* tbl;
    __device__ __forceinline__ unsigned long long ld(int i) const {
        const unsigned lo = tbl[2 * i], hi = tbl[2 * i + 1];
        return ((unsigned long long)(unsigned)__builtin_amdgcn_readfirstlane((int)hi) << 32) | (unsigned)__builtin_amdgcn_readfirstlane((int)lo);
    }
    __device__ __forceinline__ const float* in(int i) const { return (const float*)ld(i); }
    __device__ __forceinline__ float* out() const { return (float*)ld(42); }
    __device__ __forceinline__ char* ws() const { return (char*)ld(43); }
};

DI float bf2f(unsigned short h) { return __uint_as_float((unsigned)h << 16); }
DI unsigned short f2bf(float f) { return __builtin_bit_cast(unsigned short, (__bf16)f); }
typedef __bf16 bf16x2_t __attribute__((ext_vector_type(2)));
DI unsigned pk2(float lo, float hi) { bf16x2_t v; v[0] = (__bf16)lo; v[1] = (__bf16)hi; return __builtin_bit_cast(unsigned, v); }
DI void unpack8(const u32x4& w, float* v) {
#pragma unroll
    for (int i = 0; i < 4; ++i) { v[2 * i] = __uint_as_float(w[i] << 16); v[2 * i + 1] = __uint_as_float(w[i] & 0xffff0000u); }
}
DI u32x4 pack8(const float* v) { u32x4 w; w[0] = pk2(v[0], v[1]); w[1] = pk2(v[2], v[3]); w[2] = pk2(v[4], v[5]); w[3] = pk2(v[6], v[7]); return w; }
DI float log1pe(float e) { return e < 1e-4f ? e - 0.5f * e * e : __builtin_amdgcn_logf(1.f + e) * 0.6931471805599453f; }
DI float siluf(float x) { return x / (1.f + __expf(-x)); }
DI float sigmoidf(float x) { return 1.f / (1.f + __expf(-x)); }
DI int lanel() { int l = (int)__lane_id(); asm volatile("" : "+v"(l)); return l; }
DI float shx(float v, int m) { const int l = lanel(); return __int_as_float(__builtin_amdgcn_ds_bpermute((l ^ m) << 2, __float_as_int(v))); }
DI float shf(float v, int src) { return __int_as_float(__builtin_amdgcn_ds_bpermute(src << 2, __float_as_int(v))); }
DI float shu(float v, int d) { const int l = lanel(); const int sidx = (l - d) < 0 ? l : (l - d); return __int_as_float(__builtin_amdgcn_ds_bpermute(sidx << 2, __float_as_int(v))); }
DI float gmax4(float v) {
    auto a = __builtin_amdgcn_permlane16_swap(__float_as_uint(v), __float_as_uint(v), false, false);
    v = fmaxf(__uint_as_float(a[0]), __uint_as_float(a[1]));
    auto b = __builtin_amdgcn_permlane32_swap(__float_as_uint(v), __float_as_uint(v), false, false);
    return fmaxf(__uint_as_float(b[0]), __uint_as_float(b[1]));
}
DI float gsum4(float v) {
    auto a = __builtin_amdgcn_permlane16_swap(__float_as_uint(v), __float_as_uint(v), false, false);
    v = __uint_as_float(a[0]) + __uint_as_float(a[1]);
    auto b = __builtin_amdgcn_permlane32_swap(__float_as_uint(v), __float_as_uint(v), false, false);
    return __uint_as_float(b[0]) + __uint_as_float(b[1]);
}
DI float wsum(float v) {
#pragma unroll
    for (int o = 32; o >= 1; o >>= 1) v += shx(v, o);
    return v;
}
typedef const __attribute__((address_space(1))) u32x4* gp128;
DI u32x4 gld16(const void* p) { return *(gp128)(unsigned long long)p; }
DI void st_wt8(void* p, u32x2 v) { __hip_atomic_store((unsigned long long*)p, ((unsigned long long)v[1] << 32) | v[0], __ATOMIC_RELAXED, __HIP_MEMORY_SCOPE_AGENT); }
DI void st_wt16(void* p, u32x4 v) { st_wt8(p, (u32x2){v[0], v[1]}); st_wt8((char*)p + 8, (u32x2){v[2], v[3]}); }
DI void st_wt2(bf16_t* p, bf16_t v) { __hip_atomic_store(p, v, __ATOMIC_RELAXED, __HIP_MEMORY_SCOPE_AGENT); }
DI void st_wt4f(float* p, float v) { __hip_atomic_store(p, v, __ATOMIC_RELAXED, __HIP_MEMORY_SCOPE_AGENT); }
DI int launder(int x) { asm volatile("" : "+v"(x)); return x; }
DI int launder_s(int x) { asm volatile("" : "+s"(x)); return x; }
#define BIDX launder_s((int)blockIdx.x)
DI int FQ(int q) { return (4 - q) & 3; }
DI int tile_off(int rows, int ks, int row, int g, int q) { return (ks * rows + row) * 64 + ((g ^ FQ(q)) << 4); }

#define XB_TMO      128
#define XB_XCNT(j)  (256  + 64 * (j))
#define XB_XSUB(j)  (1280 + 64 * (j))
#define XB_XGEN(j)  (2304 + 64 * (j))
#define XB_TOP      3328
#define XB_TOPGEN   3392
#define XB_SPIN_CAP (1u << 22)
DI unsigned xb_ld(unsigned* p) { return __hip_atomic_load(p, __ATOMIC_RELAXED, __HIP_MEMORY_SCOPE_AGENT); }
DI unsigned xb_add(unsigned* p, unsigned v) { return __hip_atomic_fetch_add(p, v, __ATOMIC_RELAXED, __HIP_MEMORY_SCOPE_AGENT); }
DI unsigned xb_xcc_id() { return (unsigned)__builtin_amdgcn_s_getreg((3 << 11) | 20) & 0xFu; }
#define XB_SPIN(cond, bar) do { unsigned _sp = 0; while (cond) { __builtin_amdgcn_s_sleep(1); \
    if ((++_sp & 255u) == 0u) { if (xb_ld(&(bar)[XB_TMO])) break; if (_sp > XB_SPIN_CAP) { atomicAdd(&(bar)[XB_TMO], 1u); break; } } } } while (0)
struct XcdBarrier { unsigned* bar; unsigned x; volatile LAS unsigned* st; };
DI XcdBarrier xcd_barrier_post(unsigned* bar, volatile LAS unsigned* st, int tid) {
    XcdBarrier b; b.bar = bar; b.x = xb_xcc_id(); b.st = st;
    if (tid == 0) (void)xb_add(&bar[XB_XCNT(b.x)], 1u);
    return b;
}
DI void xcd_barrier_complete(unsigned* bar, unsigned x, unsigned& nloc, unsigned& nx) {
    const unsigned G = gridDim.x * gridDim.y * gridDim.z;
    unsigned sum, cnt, mine, sp = 0u;
    for (;;) {
        sum = 0u; cnt = 0u; mine = 0u;
#pragma unroll
        for (unsigned j = 0; j < 16; ++j) { const unsigned c = xb_ld(&bar[XB_XCNT(j)]); sum += c; cnt += (c > 0u) ? 1u : 0u; mine = (j == x) ? c : mine; }
        if (sum == G) break;
        __builtin_amdgcn_s_sleep(1);
        if ((++sp & 255u) == 0u) { if (xb_ld(&bar[XB_TMO])) break; if (sp > XB_SPIN_CAP) { atomicAdd(&bar[XB_TMO], 1u); break; } }
    }
    nloc = mine > 0u ? mine : 1u; nx = cnt > 0u ? cnt : 1u;
}
DI void xcd_barrier(const XcdBarrier& b, int tid) {
    asm volatile("s_waitcnt vmcnt(0)" ::: "memory");
    __syncthreads();
    if (tid == 0) {
        unsigned* bar = b.bar;
        __builtin_amdgcn_s_waitcnt(0);
        unsigned nloc = b.st[0], nx = b.st[1];
        if (nloc == 0u) { xcd_barrier_complete(bar, b.x, nloc, nx); b.st[0] = nloc; b.st[1] = nx; }
        const unsigned old = xb_add(&bar[XB_XSUB(b.x)], 1u);
        const unsigned gen = old / nloc;
        if (old + 1u == (gen + 1u) * nloc) {
            __builtin_amdgcn_fence(__ATOMIC_RELEASE, "agent");
            asm volatile("s_waitcnt vmcnt(0)" ::: "memory");
            const unsigned og = xb_add(&bar[XB_TOP], 1u);
            const unsigned tg = og / nx;
            if (og + 1u == (tg + 1u) * nx) xb_add(&bar[XB_TOPGEN], 1u);
            else XB_SPIN(xb_ld(&bar[XB_TOPGEN]) == tg, bar);
            __builtin_amdgcn_fence(__ATOMIC_ACQUIRE, "agent");
            xb_add(&bar[XB_XGEN(b.x)], 1u);
            asm volatile("s_waitcnt vmcnt(0)" ::: "memory");
        } else {
            XB_SPIN(xb_ld(&bar[XB_XGEN(b.x)]) == gen, bar);
            __builtin_amdgcn_fence(__ATOMIC_ACQUIRE, "agent");
            asm volatile("s_waitcnt vmcnt(0)" ::: "memory");
        }
    }
    __syncthreads();
}

struct Tok { int lat, b, t, L, cond, krow, seq0; size_t gx; };
DI Tok tok_info(int m, int ps) {
    Tok k;
    if (m < 4096) { k.lat = 0; k.b = ps * 16 + (m >> 8); k.t = m & 255; k.L = 256; k.cond = 0; k.krow = m; k.seq0 = m & ~255; k.gx = (size_t)ps * 4096 + m; }
    else { const int mm = m - 4096, j = mm >> 11; k.lat = 1; k.b = ps * 2 + j; k.t = mm & 2047; k.L = 2048; k.cond = 1 + k.b; k.krow = 4096 + j * 2304 + 256 + k.t;
           k.seq0 = 4096 + j * 2048; k.gx = (size_t)8192 + (size_t)ps * 4096 + mm; }
    return k;
}

template <int NTA, int NTB, bool LOWREG = false>
DI void gemm_kloop(f32x4 (&acc)[NTA][NTB], const bf16_t* __restrict__ W, size_t ldw, const bf16_t* __restrict__ X, size_t ldx, int K, char* smem, int tid) {
    constexpr int BF = 32 * NTA, BT = 32 * NTB;
    constexpr int WB = BF * 64, STG = (BF + BT) * 64;
    constexpr int NPW = BF / 16, NPX = BT / 16, PPW = (NPW + NPX) / 4, PWW = NPW / 4, PXX = PPW - PWW;
    static_assert(PPW == 4 && 4 * STG <= 65536, "ring geometry");
    tid = launder(tid);
    const int lane = tid & 63, wv = tid >> 6, wn = wv >> 1, wt = wv & 1, fr = lane & 15, g = lane >> 4;
    const int wvu = __builtin_amdgcn_readfirstlane(wv);
    unsigned poff[PPW];
#pragma unroll
    for (int j = 0; j < PPW; ++j) {
        const bool isw = j < PWW;
        const int rb = isw ? wvu * PWW + j : wvu * PXX + (j - PWW);
        const int rl = lane >> 2;
        const int q = isw ? (((rb * 16 + rl) / (4 * NTA)) & 3) : ((rl >> 2) & 3);
        const int gl = (lane & 3) ^ FQ(q);
        poff[j] = (unsigned)rl * (unsigned)(isw ? ldw : ldx) + (unsigned)(gl * 8);
    }
    auto issue = [&](int k0, char* sdst) {
#pragma unroll
        for (int j = 0; j < PPW; ++j) {
            const bool isw = j < PWW;
            const int rb = isw ? wvu * PWW + j : wvu * PXX + (j - PWW);
            const bf16_t* base = (isw ? W + (size_t)(rb * 16) * ldw : X + (size_t)(rb * 16) * ldx) + k0;
            __builtin_amdgcn_global_load_lds((const unsigned*)(base + poff[j]), (unsigned*)(sdst + (isw ? 0 : WB) + rb * 16 * 64), 16, 0, 0);
        }
    };
    const int aoff = tile_off(BF, 0, wn * 16 * NTA + 4 * NTA * (fr >> 2) + (fr & 3), g, fr >> 2);
    const int boff = WB + tile_off(BT, 0, wt * 16 * NTB + fr, g, (fr >> 2) & 3);
    const int nk = K >> 5;
    issue(0, smem); issue(32, smem + STG); issue(64, smem + 2 * STG);
    asm volatile("s_waitcnt vmcnt(8)" ::: "memory");
    asm volatile("s_waitcnt lgkmcnt(0)" ::: "memory");
    __builtin_amdgcn_s_barrier();
    for (int kt = 0; kt < nk; ++kt) {
        if (kt + 3 < nk) issue((kt + 3) << 5, smem + ((kt + 3) & 3) * STG);
        __builtin_amdgcn_sched_barrier(0);
        const char* sb = smem + (kt & 3) * STG;
        __builtin_amdgcn_s_setprio(1);
        {
            bf16x8 af[NTA], bfr[NTB];
#pragma unroll
            for (int a = 0; a < NTA; ++a) af[a] = *(const bf16x8*)(sb + aoff + a * 256);
#pragma unroll
            for (int mt = 0; mt < NTB; ++mt) bfr[mt] = *(const bf16x8*)(sb + boff + mt * 1024);
#pragma unroll
            for (int a = 0; a < NTA; ++a)
#pragma unroll
                for (int mt = 0; mt < NTB; ++mt) acc[a][mt] = __builtin_amdgcn_mfma_f32_16x16x32_bf16(af[a], bfr[mt], acc[a][mt], 0, 0, 0);
        }
        __builtin_amdgcn_s_setprio(0);
        __builtin_amdgcn_sched_barrier(0);
        if (kt + 3 < nk) asm volatile("s_waitcnt vmcnt(8)" ::: "memory");
        else if (kt + 2 < nk) asm volatile("s_waitcnt vmcnt(4)" ::: "memory");
        else asm volatile("s_waitcnt vmcnt(0)" ::: "memory");
        asm volatile("s_waitcnt lgkmcnt(0)" ::: "memory");
        __builtin_amdgcn_s_barrier();
    }
}

struct WTile { const float* src; bf16_t* dst; int K, N, k0, n0; };
DI WTile wtile_decode(const Ctx& p, int it) {
    constexpr int T_IN = 16 * 68, T_M = 16 * 64, T_UQ = 6 * 12, T_UKV = 4 * 16, T_BR = 8 * 16, T_OUT = 16 * 16, T_UP = 16 * 88, T_DN = 44 * 16;
    constexpr int T_LAYER = T_IN + T_M + T_UQ + T_UKV + 4 * T_BR + T_OUT + T_UP + T_DN;
    char* ws = p.ws();
    const int l = it / T_LAYER; int k = it % T_LAYER;
    WTile t; int ntn;
    if (k < T_IN) { t.src = p.in(16) + (size_t)l * 1024 * INW; t.dst = (bf16_t*)(ws + OFF_WIN) + (size_t)l * SZ_WIN; t.K = 1024; t.N = INW; ntn = 68; }
    else if ((k -= T_IN) < T_M) { t.src = p.in(35) + (size_t)l * 1024 * 4096; t.dst = (bf16_t*)(ws + OFF_WM) + (size_t)l * SZ_WM; t.K = 1024; t.N = 4096; ntn = 64; }
    else if ((k -= T_M) < T_UQ) { t.src = p.in(28) + (size_t)l * 384 * 768; t.dst = (bf16_t*)(ws + OFF_WUQ) + (size_t)l * SZ_WUQ; t.K = 384; t.N = 768; ntn = 12; }
    else if ((k -= T_UQ) < T_UKV) { t.src = p.in(30) + (size_t)l * 256 * 1024; t.dst = (bf16_t*)(ws + OFF_WUKV) + (size_t)l * SZ_WUKV; t.K = 256; t.N = 1024; ntn = 16; }
    else if ((k -= T_UKV) < 4 * T_BR) { const int j = k / T_BR; k -= j * T_BR; t.src = (j == 0 ? p.in(31) : j == 1 ? p.in(32) : j == 2 ? p.in(33) : p.in(34)) + (size_t)l * 512 * 1024;
                                        t.dst = (bf16_t*)(ws + OFF_WBR) + (size_t)(l * 4 + j) * 1024 * 512; t.K = 512; t.N = 1024; ntn = 16; }
    else if ((k -= 4 * T_BR) < T_OUT) { t.src = p.in(37) + (size_t)l * 1024 * 1024; t.dst = (bf16_t*)(ws + OFF_WOUT) + (size_t)l * SZ_WOUT; t.K = 1024; t.N = 1024; ntn = 16; }
    else if ((k -= T_OUT) < T_UP) { t.src = p.in(38) + (size_t)l * 1024 * 5632; t.dst = (bf16_t*)(ws + OFF_WUP) + (size_t)l * SZ_WUP; t.K = 1024; t.N = 5632; ntn = 88; }
    else { k -= T_UP; t.src = p.in(41) + (size_t)l * 2816 * 1024; t.dst = (bf16_t*)(ws + OFF_WDN) + (size_t)l * SZ_WDN; t.K = 2816; t.N = 1024; ntn = 16; }
    t.k0 = (k / ntn) * 64; t.n0 = (k % ntn) * 64;
    return t;
}
DI void wtile_load(const WTile& t, int tid, f32x4 (&v)[4]) {
    const int r = tid >> 4, c4 = tid & 15;
#pragma unroll
    for (int i = 0; i < 4; ++i) {
        v[i] = (f32x4){0.f, 0.f, 0.f, 0.f};
        if (t.n0 + 4 * c4 < t.N) v[i] = *(const f32x4*)(t.src + (size_t)(t.k0 + r + 16 * i) * t.N + t.n0 + 4 * c4);
    }
}
DI void wtile_finish(const WTile& t, const f32x4 (&v)[4], char* smem, int tid) {
    float* tl = (float*)smem;
    const int r = tid >> 4, c4 = tid & 15;
#pragma unroll
    for (int i = 0; i < 4; ++i) {
        const int row = r + 16 * i;
        tl[row * 65 + 4 * c4 + 0] = v[i][0]; tl[row * 65 + 4 * c4 + 1] = v[i][1]; tl[row * 65 + 4 * c4 + 2] = v[i][2]; tl[row * 65 + 4 * c4 + 3] = v[i][3];
    }
    __syncthreads();
#pragma unroll
    for (int i = 0; i < 2; ++i) {
        const int q = tid + 256 * i, n = q >> 3, c = q & 7;
        float o[8];
#pragma unroll
        for (int j = 0; j < 8; ++j) o[j] = tl[(8 * c + j) * 65 + n];
        *(u32x4*)(t.dst + (size_t)(t.n0 + n) * t.K + t.k0 + 8 * c) = pack8(o);
    }
    __syncthreads();
}

DI void phase_prep_w(const Ctx& p, char* smem, int tid) {
    char* ws = p.ws();
    constexpr int T_IN = 16 * 68, T_M = 16 * 64, T_UQ = 6 * 12, T_UKV = 4 * 16, T_BR = 8 * 16, T_OUT = 16 * 16, T_UP = 16 * 88, T_DN = 44 * 16;
    constexpr int T_LAYER = T_IN + T_M + T_UQ + T_UKV + 4 * T_BR + T_OUT + T_UP + T_DN;
    constexpr int N_MOD = 2 * 96;
    const int total = 2 * T_LAYER + N_MOD + 1;
    constexpr int N_MODI = 2 * 192;
    for (int it = BIDX; it < N_MODI + 1; it += gridDim.x) {
        if (it < N_MODI) {
            const int l = it / 192, cb = it % 192;
            float* sc = (float*)smem;
            float* red = sc + 5 * 1024;
            __syncthreads();
            for (int e = tid; e < 5 * 1024; e += 256) {
                const int c = e >> 10, kk = e & 1023;
                const float v = (c == 0) ? p.in(9)[kk] : p.in(8)[(c - 1) * 1024 + kk];
                sc[e] = siluf(v);
            }
            __syncthreads();
            const int col = tid & 31, kg = tid >> 5;
            float a[5] = {0.f, 0.f, 0.f, 0.f, 0.f};
            const float* w = p.in(10) + ((size_t)l * 1024 + kg * 128) * 6144 + cb * 32 + col;
#pragma unroll 1
            for (int k0 = 0; k0 < 128; k0 += 16) {
                float wv[16];
#pragma unroll
                for (int j = 0; j < 16; ++j) wv[j] = w[(size_t)(k0 + j) * 6144];
#pragma unroll
                for (int j = 0; j < 16; ++j)
#pragma unroll
                    for (int c = 0; c < 5; ++c) a[c] += wv[j] * sc[c * 1024 + kg * 128 + k0 + j];
            }
#pragma unroll
            for (int c = 0; c < 5; ++c) red[(kg * 5 + c) * 32 + col] = a[c];
            __syncthreads();
            if (tid < 160) {
                const int c = tid >> 5, cl = tid & 31;
                float sm = 0.f;
#pragma unroll
                for (int k8 = 0; k8 < 8; ++k8) sm += red[(k8 * 5 + c) * 32 + cl];
                float* mod = (float*)(ws + OFF_MOD);
                mod[((size_t)l * 5 + c) * 6144 + cb * 32 + cl] = sm + p.in(11)[(size_t)l * 6144 + cb * 32 + cl];
            }
            __syncthreads();
        } else {
            float* t16 = (float*)(ws + OFF_T16); float* t8 = (float*)(ws + OFF_T8);
            for (int e = tid; e < 64 * 16 + 64 * 8; e += 256) {
                const bool small = e >= 1024;
                const int ee = small ? e - 1024 : e;
                const int pos = small ? (ee >> 3) : (ee >> 4), i = small ? (ee & 7) : (ee & 15);
                const double r = small ? 0.31622776601683794 : 0.5623413251903491;
                double th = 1.0;
                for (int j = 0; j < i; ++j) th *= r;
                const double t2 = th * th;
                double c1 = 1.0, s1 = th;
                double tc = 1.0, tsn = th;
                for (int k = 1; k < 14; ++k) {
                    tc = -tc * t2 / (double)((2 * k - 1) * (2 * k));
                    tsn = -tsn * t2 / (double)((2 * k) * (2 * k + 1));
                    c1 += tc; s1 += tsn;
                }
                double c = 1.0, sn = 0.0;
                for (int j = 0; j < pos; ++j) { const double cn = c * c1 - sn * s1, snn = sn * c1 + c * s1; c = cn; sn = snn; }
                if (small) { t8[ee] = (float)c; t8[512 + ee] = (float)sn; } else { t16[ee] = (float)c; t16[1024 + ee] = (float)sn; }
            }
        }
    }
    {
        int it = BIDX;
        f32x4 va[4];
        if (it < 2 * T_LAYER) { const WTile c0 = wtile_decode(p, it); wtile_load(c0, tid, va); }
        while (it < 2 * T_LAYER) {
            const int nx = it + gridDim.x;
            f32x4 vb[4];
            if (nx < 2 * T_LAYER) { const WTile nt = wtile_decode(p, nx); wtile_load(nt, tid, vb); }
            { const WTile cur = wtile_decode(p, launder(it)); wtile_finish(cur, va, smem, tid); }
#pragma unroll
            for (int i = 0; i < 4; ++i) va[i] = vb[i];
            it = nx;
        }
    }
}

DI void row_load(const float* r, int lane, f32x4 (&v)[4]) {
#pragma unroll
    for (int i = 0; i < 4; ++i) v[i] = *(const f32x4*)(r + 4 * lane + 256 * i);
}
DI float row_ss(const f32x4 (&v)[4]) {
    float s = 0.f;
#pragma unroll
    for (int i = 0; i < 4; ++i) s += v[i][0] * v[i][0] + v[i][1] * v[i][1] + v[i][2] * v[i][2] + v[i][3] * v[i][3];
    return wsum(s);
}
DI void row_modnorm_store(const f32x4 (&x)[4], const float* gw, const float* sh, const float* sc, bf16_t* dst, int lane) {
    const float rstd = rsqrtf(row_ss(x) * (1.f / 1024.f) + EPS);
#pragma unroll
    for (int i = 0; i < 4; ++i) {
        const int c = 4 * lane + 256 * i;
        const f32x4 g = *(const f32x4*)(gw + c), s = *(const f32x4*)(sh + c), q = *(const f32x4*)(sc + c);
        float o[4];
#pragma unroll
        for (int j = 0; j < 4; ++j) o[j] = (x[i][j] * rstd) * g[j] * (1.f + q[j]) + s[j];
        u32x2 w; w[0] = pk2(o[0], o[1]); w[1] = pk2(o[2], o[3]);
        *(u32x2*)(dst + c) = w;
    }
}
DI const float* x_in_row(const Ctx& p, int m, int ps) {
    return (m < 4096) ? p.in(0) + ((size_t)ps * 4096 + m) * 1024 : p.in(1) + ((size_t)ps * 4096 + (m - 4096)) * 1024;
}
DI void phase_h1(const Ctx& p, int ps, int tid) {
    const int lane = tid & 63, wv = tid >> 6;
    const float* mod = (const float*)(p.ws() + OFF_MOD);
    bf16_t* H = (bf16_t*)(p.ws() + OFF_H);
    for (int m = BIDX * 4 + wv; m < NPT; m += gridDim.x * 4) {
        const Tok k = tok_info(m, ps);
        f32x4 x[4]; row_load(x_in_row(p, m, ps), lane, x);
        const float* md = mod + (size_t)(0 * 5 + k.cond) * 6144;
        row_modnorm_store(x, p.in(12), md + 0, md + 1024, H + (size_t)m * 1024, lane);
    }
}
DI void phase_res(const Ctx& p, int ps, int l, int which, int tid) {
    const int lane = tid & 63, wv = tid >> 6;
    const float* mod = (const float*)(p.ws() + OFF_MOD);
    bf16_t* H = (bf16_t*)(p.ws() + OFF_H);
    const float* Y = (const float*)(p.ws() + (which ? OFF_FO : OFF_MO));
    const float* gpost = (which ? p.in(15) : p.in(13)) + (size_t)l * 1024;
    const int bid = BIDX, rbase = (bid & 7) * 1024 + (bid >> 3) * 4 + wv, rstep = (gridDim.x >> 3) * 4;
    for (int mo = 0; (bid >> 3) * 4 + wv + mo < 1024; mo += rstep) {
        const int m = rbase + mo;
        const Tok k = tok_info(m, ps);
        const float* md = mod + (size_t)(l * 5 + k.cond) * 6144;
        const float* gate = md + (which ? 5 * 1024 : 2 * 1024);
        f32x4 x[4], y[4];
        if (l == 0 && which == 0) row_load(x_in_row(p, m, ps), lane, x); else row_load(p.out() + k.gx * 1024, lane, x);
        row_load(Y + (size_t)m * 1024, lane, y);
        const float rstd = rsqrtf(row_ss(y) * (1.f / 1024.f) + EPS);
#pragma unroll
        for (int i = 0; i < 4; ++i) {
            const int c = 4 * lane + 256 * i;
            const f32x4 g = *(const f32x4*)(gate + c), w = *(const f32x4*)(gpost + c);
#pragma unroll
            for (int j = 0; j < 4; ++j) x[i][j] = x[i][j] + g[j] * ((y[i][j] * rstd) * w[j]);
            *(f32x4*)(p.out() + k.gx * 1024 + c) = x[i];
        }
        if (which == 0) row_modnorm_store(x, p.in(14) + (size_t)l * 1024, md + 3 * 1024, md + 4 * 1024, H + (size_t)m * 1024, lane);
        else if (l + 1 < 2) { const float* md2 = mod + (size_t)((l + 1) * 5 + k.cond) * 6144;
                              row_modnorm_store(x, p.in(12) + (size_t)(l + 1) * 1024, md2, md2 + 1024, H + (size_t)m * 1024, lane); }
    }
}

DI bool xcd_tile(int it, int Mt, int Nt, int B, int& mt, int& nt) {
    const int x = BIDX & 7, loc = BIDX >> 3, nloc = gridDim.x >> 3;
    const int MP = Mt >> 3;
    const int idx = it * nloc + loc;
    if (idx >= MP * Nt) return false;
    const int ng = idx / (MP * B);
    const int bw = min(B, Nt - ng * B);
    const int r = idx - ng * MP * B;
    mt = x * MP + r / bw; nt = ng * B + r % bw;
    return true;
}
DI void phase_gemm_in(const Ctx& p, int l, char* smem, int tid) {
    const bf16_t* W = (const bf16_t*)(p.ws() + OFF_WIN) + (size_t)l * SZ_WIN;
    const bf16_t* X = (const bf16_t*)(p.ws() + OFF_H);
    bf16_t* PROJ = (bf16_t*)(p.ws() + OFF_PROJ);
    float* DTRAW = (float*)(p.ws() + OFF_DTRAW);
    const int lane = tid & 63, wv = tid >> 6, wn = wv >> 1, wt = wv & 1, fr = lane & 15, g = lane >> 4;
    for (int it = 0;; ++it) {
        int mt0, nt0; if (!xcd_tile(it, 64, 34, 8, mt0, nt0)) break;
        const int m0 = mt0 * 128, n0 = nt0 * 128;
        f32x4 acc[4][4];
#pragma unroll
        for (int a = 0; a < 4; ++a)
#pragma unroll
            for (int b = 0; b < 4; ++b) acc[a][b] = (f32x4){0.f, 0.f, 0.f, 0.f};
        gemm_kloop<4, 4>(acc, W + (size_t)n0 * 1024, 1024, X + (size_t)m0 * 1024, 1024, 1024, smem, tid);
        const int fb = n0 + wn * 64 + 16 * g;
#pragma unroll
        for (int mt = 0; mt < 4; ++mt) {
            const int m = m0 + wt * 64 + 16 * mt + fr;
            float v[16];
#pragma unroll
            for (int a = 0; a < 4; ++a)
#pragma unroll
                for (int r = 0; r < 4; ++r) v[4 * a + r] = acc[a][mt][r];
            bf16_t* d = PROJ + (size_t)m * INWP + fb;
            *(u32x4*)d = pack8(v); *(u32x4*)(d + 8) = pack8(v + 8);
            if (fb == C_DT) {
                float* dd = DTRAW + (size_t)m * 16;
#pragma unroll
                for (int a = 0; a < 4; ++a) *(f32x4*)(dd + 4 * a) = acc[a][mt];
            }
        }
    }
}

template <bool F32OUT>
DI void phase_gemm_plain(const bf16_t* W, int K, const bf16_t* X, size_t ldx, int Mtiles, int Ntiles, void* out, size_t ldo, char* smem, int tid) {
    const int lane = tid & 63, wv = tid >> 6, wn = wv >> 1, wt = wv & 1, fr = lane & 15, g = lane >> 4;
    for (int it = 0;; ++it) {
        int mt0, nt0; if (!xcd_tile(it, Mtiles, Ntiles, 8, mt0, nt0)) break;
        const int m0 = mt0 * 128, n0 = nt0 * 128;
        f32x4 acc[4][4];
#pragma unroll
        for (int a = 0; a < 4; ++a)
#pragma unroll
            for (int b = 0; b < 4; ++b) acc[a][b] = (f32x4){0.f, 0.f, 0.f, 0.f};
        gemm_kloop<4, 4>(acc, W + (size_t)n0 * K, K, X + (size_t)m0 * ldx, ldx, K, smem, tid);
        const int fb = n0 + wn * 64 + 16 * g;
#pragma unroll
        for (int mt = 0; mt < 4; ++mt) {
            const int m = m0 + wt * 64 + 16 * mt + fr;
            if (F32OUT) {
                float* d = (float*)out + (size_t)m * ldo + fb;
#pragma unroll
                for (int a = 0; a < 4; ++a) *(f32x4*)(d + 4 * a) = acc[a][mt];
            } else {
                float v[16];
#pragma unroll
                for (int a = 0; a < 4; ++a)
#pragma unroll
                    for (int r = 0; r < 4; ++r) v[4 * a + r] = acc[a][mt][r];
                bf16_t* d = (bf16_t*)out + (size_t)m * ldo + fb;
                *(u32x4*)d = pack8(v); *(u32x4*)(d + 8) = pack8(v + 8);
            }
        }
    }
}

DI void gemm_uq_tile(const Ctx& p, int l, int ps, int tile, char* smem, int tid) {
    const bf16_t* W = (const bf16_t*)(p.ws() + OFF_WUQ) + (size_t)l * SZ_WUQ;
    const bf16_t* X = (const bf16_t*)(p.ws() + OFF_PROJ) + C_MCQ;
    bf16_t* QM = (bf16_t*)(p.ws() + OFF_QM);
    const float* t8 = (const float*)(p.ws() + OFF_T8);
    const int lane = tid & 63, wv = tid >> 6, wn = wv >> 1, wt = wv & 1, fr = lane & 15, g = lane >> 4;
    const int mt0 = tile / 6, nt0 = tile % 6, m0 = mt0 * 128, n0 = nt0 * 128;
    f32x4 acc[4][4];
#pragma unroll
    for (int a = 0; a < 4; ++a)
#pragma unroll
        for (int b = 0; b < 4; ++b) acc[a][b] = (f32x4){0.f, 0.f, 0.f, 0.f};
    gemm_kloop<4, 4>(acc, W + (size_t)n0 * 384, 384, X + (size_t)m0 * INWP, INWP, 384, smem, tid);
    const int fb = n0 + wn * 64 + 16 * g;
    const int o = fb % 96;
#pragma unroll
    for (int mt = 0; mt < 4; ++mt) {
        const int m = m0 + wt * 64 + 16 * mt + fr;
        float v[16];
#pragma unroll
        for (int a = 0; a < 4; ++a)
#pragma unroll
            for (int r = 0; r < 4; ++r) v[4 * a + r] = acc[a][mt][r];
        if (m >= 4096 && o >= 64) {
            const int t = (m - 4096) & 2047;
            const int pos = (o == 64) ? (t >> 6) : (t & 63);
#pragma unroll
            for (int j = 0; j < 8; ++j) {
                const float c = t8[pos * 8 + j], s = t8[512 + pos * 8 + j];
                const float x1 = v[j], x2 = v[j + 8];
                v[j] = x1 * c - x2 * s; v[j + 8] = x2 * c + x1 * s;
            }
        }
        bf16_t* d = QM + (size_t)m * 768 + fb;
        st_wt16(d, pack8(v)); st_wt16(d + 8, pack8(v + 8));
    }
}

DI void gemm_ukv_tile(const Ctx& p, int l, int tile, char* smem, int tid) {
    const bf16_t* W = (const bf16_t*)(p.ws() + OFF_WUKV) + (size_t)l * SZ_WUKV;
    const bf16_t* X = (const bf16_t*)(p.ws() + OFF_CKV);
    bf16_t* KN = (bf16_t*)(p.ws() + OFF_KN);
    bf16_t* VMT = (bf16_t*)(p.ws() + OFF_VMT);
    const int lane = tid & 63, wv = tid >> 6, wn = wv >> 1, wt = wv & 1, fr = lane & 15, g = lane >> 4;
    const int mt0 = tile / 8, nt0 = tile % 8, m0 = mt0 * 128, n0 = nt0 * 128;
    f32x4 acc[4][4];
#pragma unroll
    for (int a = 0; a < 4; ++a)
#pragma unroll
        for (int b = 0; b < 4; ++b) acc[a][b] = (f32x4){0.f, 0.f, 0.f, 0.f};
    gemm_kloop<4, 4>(acc, W + (size_t)n0 * 256, 256, X + (size_t)m0 * 256, 256, 256, smem, tid);
    const int fb = n0 + wn * 64 + 16 * g;
    const int head = fb >> 7, o = fb & 127;
    int key0, Lk;
    if (m0 < 4096) { key0 = m0 & ~255; Lk = 256; } else { const int j = (m0 - 4096) / 2304; key0 = 4096 + j * 2304; Lk = 2304; }
#pragma unroll
    for (int mt = 0; mt < 4; ++mt) {
        const int m = m0 + wt * 64 + 16 * mt + fr;
        float v[16];
#pragma unroll
        for (int a = 0; a < 4; ++a)
#pragma unroll
            for (int r = 0; r < 4; ++r) v[4 * a + r] = acc[a][mt][r];
        if (o < 64) {
            bf16_t* d = KN + (size_t)m * 512 + head * 64 + o;
            st_wt16(d, pack8(v)); st_wt16(d + 8, pack8(v + 8));
        } else {
            bf16_t* d = VMT + (size_t)key0 * 512 + (size_t)(head * 64 + (o - 64)) * Lk + (m - key0);
#pragma unroll
            for (int i = 0; i < 16; ++i) st_wt2(d + (size_t)i * Lk, f2bf(v[i]));
        }
    }
}

DI void phase_merge(const Ctx& p, int l, char* smem, int tid) {
    for (int it = 0;; ++it) {
        int mt0, nt0; if (!xcd_tile(it, 64, 8, 8, mt0, nt0)) break;
        const int m0 = mt0 * 128, n0 = nt0 * 128;
        u32x2 mgp[4][4];
#pragma unroll
        for (int a = 0; a < 4; ++a)
#pragma unroll
            for (int b = 0; b < 4; ++b) mgp[a][b] = (u32x2){0u, 0u};
#pragma unroll 1
        for (int br = 0; br < 4; ++br) {
            u32x2 gpk[4][4];
            {
                f32x4 ga[4][4];
#pragma unroll
                for (int a = 0; a < 4; ++a)
#pragma unroll
                    for (int b = 0; b < 4; ++b) ga[a][b] = (f32x4){0.f, 0.f, 0.f, 0.f};
                gemm_kloop<4, 4, false>(ga, (const bf16_t*)(p.ws() + OFF_WM) + (size_t)l * SZ_WM + (size_t)(br * 1024 + n0) * 1024, 1024,
                                       (const bf16_t*)(p.ws() + OFF_H) + (size_t)m0 * 1024, 1024, 1024, smem, tid);
                const int t2 = launder(tid);
                const int fb = n0 + (t2 >> 7) * 64 + 16 * ((t2 & 63) >> 4);
                const float* bm = p.in(36) + (size_t)l * 4096;
#pragma unroll
                for (int a = 0; a < 4; ++a) {
                    const f32x4 bv = *(const f32x4*)(bm + br * 1024 + fb + 4 * a);
#pragma unroll
                    for (int mt = 0; mt < 4; ++mt) {
                        gpk[a][mt][0] = pk2(sigmoidf(ga[a][mt][0] + bv[0]), sigmoidf(ga[a][mt][1] + bv[1]));
                        gpk[a][mt][1] = pk2(sigmoidf(ga[a][mt][2] + bv[2]), sigmoidf(ga[a][mt][3] + bv[3]));
                    }
                }
            }
            f32x4 pa[4][4];
#pragma unroll
            for (int a = 0; a < 4; ++a)
#pragma unroll
                for (int b = 0; b < 4; ++b) pa[a][b] = (f32x4){0.f, 0.f, 0.f, 0.f};
            const bf16_t* xb; size_t ldb;
            const bf16_t* PROJ = (const bf16_t*)(p.ws() + OFF_PROJ);
            if (br == 0) { xb = PROJ + (size_t)m0 * INWP + C_Z; ldb = INWP; }
            else if (br == 1) { xb = PROJ + (size_t)m0 * INWP + C_RG; ldb = INWP; }
            else if (br == 2) { xb = (const bf16_t*)(p.ws() + OFF_OA) + (size_t)m0 * 512; ldb = 512; }
            else { xb = (const bf16_t*)(p.ws() + OFF_OM) + (size_t)m0 * 512; ldb = 512; }
            gemm_kloop<4, 4, false>(pa, (const bf16_t*)(p.ws() + OFF_WBR) + (size_t)l * SZ_WBR + (size_t)br * 1024 * 512 + (size_t)n0 * 512, 512, xb, ldb, 512, smem, tid);
#pragma unroll
            for (int a = 0; a < 4; ++a)
#pragma unroll
                for (int mt = 0; mt < 4; ++mt) {
                    const float m0 = __uint_as_float(mgp[a][mt][0] << 16) + __uint_as_float(gpk[a][mt][0] << 16) * pa[a][mt][0];
                    const float m1 = __uint_as_float(mgp[a][mt][0] & 0xffff0000u) + __uint_as_float(gpk[a][mt][0] & 0xffff0000u) * pa[a][mt][1];
                    const float m2 = __uint_as_float(mgp[a][mt][1] << 16) + __uint_as_float(gpk[a][mt][1] << 16) * pa[a][mt][2];
                    const float m3 = __uint_as_float(mgp[a][mt][1] & 0xffff0000u) + __uint_as_float(gpk[a][mt][1] & 0xffff0000u) * pa[a][mt][3];
                    mgp[a][mt][0] = pk2(m0, m1); mgp[a][mt][1] = pk2(m2, m3);
                }
        }
        const int t3 = launder(tid);
        const int fr = t3 & 15, g = (t3 & 63) >> 4, wn = t3 >> 7, wt = (t3 >> 6) & 1;
        const int fb = n0 + wn * 64 + 16 * g;
        bf16_t* MG = (bf16_t*)(p.ws() + OFF_MERGED);
#pragma unroll
        for (int mt = 0; mt < 4; ++mt) {
            const int m = m0 + wt * 64 + 16 * mt + fr;
            bf16_t* d = MG + (size_t)m * 1024 + fb;
            *(u32x4*)d = (u32x4){mgp[0][mt][0], mgp[0][mt][1], mgp[1][mt][0], mgp[1][mt][1]};
            *(u32x4*)(d + 8) = (u32x4){mgp[2][mt][0], mgp[2][mt][1], mgp[3][mt][0], mgp[3][mt][1]};
        }
    }
}

DI void prep_token(const Ctx& p, int l, int ps, int m, int lane) {
    char* ws = p.ws();
    bf16_t* PROJ = (bf16_t*)(ws + OFF_PROJ);
    const float* t16 = (const float*)(ws + OFF_T16);
    const float* t8 = (const float*)(ws + OFF_T8);
    const Tok k = tok_info(m, ps);
    bf16_t* pr = PROJ + (size_t)m * INWP;
    if (lane < 16) {
        const float v = ((const float*)(ws + OFF_DTRAW))[(size_t)m * 16 + lane] + p.in(19)[l * 16 + lane];
        const float sp = v > 20.f ? v : log1pe(__expf(v));
        ((float*)(ws + OFF_DT))[(size_t)m * 16 + lane] = sp;
    }
    {
        const int seqkey0 = k.lat ? (k.krow - 256 - k.t) : (k.krow - k.t);
        const int Lk = k.lat ? 2304 : 256;
        const int keyidx = k.krow - seqkey0;
        float v[8];
        if (lane < 32) unpack8(*(const u32x4*)(pr + C_AK + lane * 8), v);
        else {
#pragma unroll
            for (int j = 0; j < 8; ++j) v[j] = 0.f;
        }
        float ss = 0.f;
#pragma unroll
        for (int j = 0; j < 8; ++j) ss += v[j] * v[j];
        ss += shx(ss, 1); ss += shx(ss, 2); ss += shx(ss, 4);
        const float rstd = rsqrtf(ss * (1.f / 64.f) + EPS);
        const int u = lane & 7, axis = u >> 2, pos = axis ? (k.t & 63) : (k.t >> 6);
        float kv[8];
        const float* w = p.in(26) + l * 64 + u * 8;
#pragma unroll
        for (int j = 0; j < 8; ++j) kv[j] = (v[j] * rstd) * w[j];
        float kr[8];
#pragma unroll
        for (int j = 0; j < 8; ++j) {
            const float other = shx(kv[j], 2);
            const int fi = (u & 1) * 8 + j;
            const float c = t16[pos * 16 + fi], s = t16[1024 + pos * 16 + fi];
            kr[j] = (u & 2) ? (kv[j] * c + other * s) : (kv[j] * c - other * s);
        }
        if (lane < 16) {
            if (!k.lat) {
                float* o = p.out() + O_CK + ((size_t)(k.b * 2 + l) * 256 + k.t) * 128 + lane * 8;
                *(f32x4*)o = (f32x4){kv[0], kv[1], kv[2], kv[3]}; *(f32x4*)(o + 4) = (f32x4){kv[4], kv[5], kv[6], kv[7]};
            }
            bf16_t* ka = (bf16_t*)(ws + OFF_KA) + (size_t)k.krow * 128 + lane * 8;
            *(u32x4*)ka = k.lat ? pack8(kr) : pack8(kv);
        } else if (lane < 32) {
            const int d0 = (lane - 16) * 8;
            if (!k.lat) {
                float* o = p.out() + O_CV + ((size_t)(k.b * 2 + l) * 256 + k.t) * 128 + d0;
                *(f32x4*)o = (f32x4){v[0], v[1], v[2], v[3]}; *(f32x4*)(o + 4) = (f32x4){v[4], v[5], v[6], v[7]};
            }
            bf16_t* vt = (bf16_t*)(ws + OFF_VAT) + (size_t)seqkey0 * 128 + (size_t)d0 * Lk + keyidx;
#pragma unroll
            for (int j = 0; j < 8; ++j) vt[(size_t)j * Lk] = f2bf(v[j]);
        }
    }
    {
        float v[8];
        if (lane < 48) unpack8(*(const u32x4*)(pr + C_MCQ + lane * 8), v);
        else {
#pragma unroll
            for (int j = 0; j < 8; ++j) v[j] = 0.f;
        }
        float ss = 0.f;
#pragma unroll
        for (int j = 0; j < 8; ++j) ss += v[j] * v[j];
        ss = wsum(ss);
        const float rstd = rsqrtf(ss * (1.f / 384.f) + EPS);
        if (lane < 48) {
            const float* w = p.in(27) + l * 384 + lane * 8;
#pragma unroll
            for (int j = 0; j < 8; ++j) v[j] = (v[j] * rstd) * w[j];
            *(u32x4*)(pr + C_MCQ + lane * 8) = pack8(v);
        }
    }
    {
        float v[8];
        if (lane < 36) unpack8(*(const u32x4*)(pr + C_MCKV + lane * 8), v);
        else {
#pragma unroll
            for (int j = 0; j < 8; ++j) v[j] = 0.f;
        }
        float ss = 0.f;
        if (lane < 32) {
#pragma unroll
            for (int j = 0; j < 8; ++j) ss += v[j] * v[j];
        }
        ss = wsum(ss);
        const float rstd = rsqrtf(ss * (1.f / 256.f) + EPS);
        const int u = (lane - 32) & 3, axis = u >> 1, pos = axis ? (k.t & 63) : (k.t >> 6);
        float kr[8];
#pragma unroll
        for (int j = 0; j < 8; ++j) {
            const float other = shx(v[j], 1);
            const float c = t8[pos * 8 + j], s = t8[512 + pos * 8 + j];
            kr[j] = (u & 1) ? (v[j] * c + other * s) : (v[j] * c - other * s);
        }
        if (lane < 32) {
            const float* w = p.in(29) + l * 256 + lane * 8;
            float c[8];
#pragma unroll
            for (int j = 0; j < 8; ++j) c[j] = (v[j] * rstd) * w[j];
            if (!k.lat) {
                float* o = p.out() + O_CC + ((size_t)(k.b * 2 + l) * 256 + k.t) * 256 + lane * 8;
                *(f32x4*)o = (f32x4){c[0], c[1], c[2], c[3]}; *(f32x4*)(o + 4) = (f32x4){c[4], c[5], c[6], c[7]};
            }
            *(u32x4*)((bf16_t*)(ws + OFF_CKV) + (size_t)k.krow * 256 + lane * 8) = pack8(c);
        } else if (lane < 36) {
            const int d0 = (lane - 32) * 8;
            if (!k.lat) {
                float* o = p.out() + O_CR + ((size_t)(k.b * 2 + l) * 256 + k.t) * 32 + d0;
                *(f32x4*)o = (f32x4){v[0], v[1], v[2], v[3]}; *(f32x4*)(o + 4) = (f32x4){v[4], v[5], v[6], v[7]};
            }
            *(u32x4*)((bf16_t*)(ws + OFF_KRP) + (size_t)k.krow * 32 + d0) = k.lat ? pack8(kr) : pack8(v);
        }
    }
}
DI void prep_conv_item(const Ctx& p, int l, int ps, int item, int lane) {
    const int run = item >> 1, cbk = item & 1;
    const int c0 = cbk * 512 + lane * 8;
    if (c0 >= 768) return;
    const int m0 = run * 16;
    const Tok k = tok_info(m0, ps);
    const float* cw = p.in(17) + (size_t)l * 3 * 768; const float* cb = p.in(18) + (size_t)l * 768;
    float w[4][8];
#pragma unroll
    for (int tp = 0; tp < 4; ++tp) {
        const float* src = (tp < 3) ? cw + tp * 768 + c0 : cb + c0;
        const f32x4 a0 = *(const f32x4*)src, a1 = *(const f32x4*)(src + 4);
#pragma unroll
        for (int e = 0; e < 4; ++e) { w[tp][e] = a0[e]; w[tp][4 + e] = a1[e]; }
    }
    const bf16_t* xb = (const bf16_t*)(p.ws() + OFF_PROJ) + (size_t)m0 * INWP + C_XBC + c0;
    bf16_t* xo = (bf16_t*)(p.ws() + OFF_XBCA) + (size_t)m0 * 768 + c0;
    const u32x4 zero = {0u, 0u, 0u, 0u};
    u32x4 pv = zero, cv;
    if (k.t > 0) pv = gld16(xb - INWP);
    cv = gld16(xb);
#pragma unroll 4
    for (int i = 0; i < 16; ++i) {
        u32x4 nv = zero;
        if (k.t + i + 1 < k.L) nv = gld16(xb + (size_t)(i + 1) * INWP);
        float a[8], b[8], c[8], o[8];
        unpack8(pv, a); unpack8(cv, b); unpack8(nv, c);
#pragma unroll
        for (int e = 0; e < 8; ++e) o[e] = siluf(w[3][e] + w[0][e] * a[e] + w[1][e] * b[e] + w[2][e] * c[e]);
        *(u32x4*)(xo + (size_t)i * 768) = pack8(o);
        pv = cv; cv = nv;
    }
}
DI void prep_cache_row(const Ctx& p, int l, int ps, int r, int lane) {
    char* ws = p.ws();
    const int j = r >> 8, c = r & 255, b = ps * 2 + j;
    const int key0 = 4096 + j * 2304, krow = key0 + c, Lk = 2304;
    const size_t src = (size_t)(b * 2 + l) * 256 + c;
    if (lane < 16) {
        const float* s = p.in(4) + src * 128 + lane * 8; float v[8];
#pragma unroll
        for (int i = 0; i < 8; ++i) v[i] = s[i];
        *(u32x4*)((bf16_t*)(ws + OFF_KA) + (size_t)krow * 128 + lane * 8) = pack8(v);
    } else if (lane < 32) {
        const int d0 = (lane - 16) * 8;
        const float* s = p.in(5) + src * 128 + d0;
        bf16_t* vt = (bf16_t*)(ws + OFF_VAT) + (size_t)key0 * 128 + (size_t)d0 * Lk + c;
#pragma unroll
        for (int i = 0; i < 8; ++i) vt[(size_t)i * Lk] = f2bf(s[i]);
    } else if (lane < 36) {
        const int d0 = (lane - 32) * 8;
        const float* s = p.in(7) + src * 32 + d0; float v[8];
#pragma unroll
        for (int i = 0; i < 8; ++i) v[i] = s[i];
        *(u32x4*)((bf16_t*)(ws + OFF_KRP) + (size_t)krow * 32 + d0) = pack8(v);
    }
    if (lane < 32) {
        const float* s = p.in(6) + src * 256 + lane * 8; float v[8];
#pragma unroll
        for (int i = 0; i < 8; ++i) v[i] = s[i];
        *(u32x4*)((bf16_t*)(ws + OFF_CKV) + (size_t)krow * 256 + lane * 8) = pack8(v);
    }
}
DI void phase_prep(const Ctx& p, int l, int ps, int tid) {
    const int lane = tid & 63, wv = tid >> 6;
    for (int m = BIDX * 4 + wv; m < NPT + 512 + 1024; m += gridDim.x * 4) {
        if (m < NPT) prep_token(p, l, ps, m, lane); else if (m < NPT + 512) prep_cache_row(p, l, ps, m - NPT, lane); else prep_conv_item(p, l, ps, m - NPT - 512, lane);
    }
}

template <int KC, int NQT>
DI void attn_tile(const bf16_t* __restrict__ Q, size_t ldq, const bf16_t* __restrict__ K1, size_t ldk1, const bf16_t* __restrict__ K2, size_t ldk2,
                  const bf16_t* __restrict__ VT, size_t ldvt, int nkt, float c2, bf16_t* __restrict__ O, size_t ldo,
                  const float* __restrict__ qnw  , const float* __restrict__ rope, int t0  , char* smem, int tid) {
    constexpr int KB = KC * 4096, STG = KB + 8192;
    tid = launder(tid);
    const int lane = tid & 63, w = tid >> 6, fr = lane & 15, g = lane >> 4;
    bf16x8 qf[NQT][KC];
#pragma unroll
    for (int qt = 0; qt < NQT; ++qt)
#pragma unroll
        for (int ks = 0; ks < KC; ++ks) { const u32x4 t4 = gld16(Q + (size_t)(16 * NQT * w + 16 * qt + fr) * ldq + ks * 32 + 8 * g); qf[qt][ks] = __builtin_bit_cast(bf16x8, t4); }
    if (KC == 2 && qnw) {
#pragma unroll
        for (int qt = 0; qt < NQT; ++qt) {
            float v[2][8]; float ss = 0.f;
#pragma unroll
            for (int ks = 0; ks < 2; ++ks) {
                const u32x4 t4 = __builtin_bit_cast(u32x4, qf[qt][ks]); unpack8(t4, v[ks]);
#pragma unroll
                for (int j = 0; j < 8; ++j) ss += v[ks][j] * v[ks][j];
            }
            ss += shx(ss, 16); ss += shx(ss, 32);
            const float rstd = rsqrtf(ss * (1.f / 64.f) + EPS);
            const int t = t0 + 16 * NQT * w + 16 * qt + fr;
#pragma unroll
            for (int ks = 0; ks < 2; ++ks) {
                const int pos = ks ? (t & 63) : (t >> 6);
#pragma unroll
                for (int j = 0; j < 8; ++j) {
                    float x = (v[ks][j] * rstd) * qnw[32 * ks + 8 * g + j];
                    if (rope) {
                        const float other = shx(x, 32);
                        const int fi = (g & 1) * 8 + j;
                        const float c = rope[pos * 16 + fi], sn = rope[1024 + pos * 16 + fi];
                        x = (g & 2) ? (x * c + other * sn) : (x * c - other * sn);
                    }
                    v[ks][j] = x;
                }
                const u32x4 t4 = pack8(v[ks]); qf[qt][ks] = __builtin_bit_cast(bf16x8, t4);
            }
        }
    }
    constexpr int NPK = KC * 4, PPW = (NPK + 8) / 4;
    static_assert((NPK + 8) % 4 == 0, "pieces must divide over 4 waves");
    const int wvu = __builtin_amdgcn_readfirstlane(w);
    unsigned poff[PPW];
#pragma unroll
    for (int j = 0; j < PPW; ++j) {
        const int pc = wvu * PPW + j;
        const bool isk = pc < NPK;
        const int pp = isk ? pc : pc - NPK;
        const int ks = pp >> 2, rb = pp & 3;
        const int rl = lane >> 2, row = rb * 16 + rl;
        const int q = isk ? ((row >> 3) & 3) : ((rl >> 2) & 3);
        const int gl = (lane & 3) ^ FQ(q);
        const unsigned ld = isk ? ((KC == 2 || ks < 2) ? (unsigned)ldk1 : (unsigned)ldk2) : (unsigned)ldvt;
        poff[j] = (unsigned)rl * ld + (unsigned)(gl * 8);
    }
    auto issue = [&](int kt, char* stage) {
#pragma unroll
        for (int j = 0; j < PPW; ++j) {
            const int pc = wvu * PPW + j;
            const bool isk = pc < NPK;
            const int pp = isk ? pc : pc - NPK;
            const int ks = pp >> 2, rb = pp & 3;
            const bf16_t* base;
            if (isk) { if (KC == 2 || ks < 2) base = K1 + ks * 32 + (size_t)(kt * 64 + rb * 16) * ldk1; else base = K2 + (size_t)(kt * 64 + rb * 16) * ldk2; }
            else base = VT + ks * 32 + (size_t)kt * 64 + (size_t)(rb * 16) * ldvt;
            __builtin_amdgcn_global_load_lds((const unsigned*)(base + poff[j]), (unsigned*)(stage + (isk ? 0 : KB) + (ks * 64 + rb * 16) * 64), 16, 0, 0);
        }
    };
    const int koff = tile_off(64, 0, 8 * (fr >> 2) + (fr & 3), g, fr >> 2);
    const int voff = KB + tile_off(64, 0, fr, g, (fr >> 2) & 3);
    f32x4 o[4][NQT];
#pragma unroll
    for (int a = 0; a < 4; ++a)
#pragma unroll
        for (int qt = 0; qt < NQT; ++qt) o[a][qt] = (f32x4){0.f, 0.f, 0.f, 0.f};
    float mrun[NQT], lrun[NQT];
#pragma unroll
    for (int qt = 0; qt < NQT; ++qt) { mrun[qt] = -1e30f; lrun[qt] = 0.f; }
    __syncthreads();
    issue(0, smem);
    if (nkt > 1) {
        issue(1, smem + STG);
        if (PPW == 4) asm volatile("s_waitcnt vmcnt(4)" ::: "memory"); else asm volatile("s_waitcnt vmcnt(5)" ::: "memory");
    } else asm volatile("s_waitcnt vmcnt(0)" ::: "memory");
    __syncthreads();
    int so_cur = 0, so_nn = 2 * STG;
    for (int kt = 0; kt < nkt; ++kt) {
        if (kt + 2 < nkt) issue(kt + 2, smem + so_nn);
        __builtin_amdgcn_sched_barrier(0);
        const char* sb = smem + so_cur;
        f32x4 s[4][NQT];
#pragma unroll
        for (int a = 0; a < 4; ++a)
#pragma unroll
            for (int qt = 0; qt < NQT; ++qt) s[a][qt] = (f32x4){0.f, 0.f, 0.f, 0.f};
        bf16x8 kf[KC][4];
#pragma unroll
        for (int ks = 0; ks < KC; ++ks)
#pragma unroll
            for (int a = 0; a < 4; ++a) kf[ks][a] = *(const bf16x8*)(sb + koff + ((a >> 1) * 32 + (a & 1) * 4) * 64 + ks * 4096);
        __builtin_amdgcn_sched_barrier(0);
#pragma unroll
        for (int ks = 0; ks < KC; ++ks)
#pragma unroll
            for (int a = 0; a < 4; ++a) {
#pragma unroll
                for (int qt = 0; qt < NQT; ++qt) s[a][qt] = __builtin_amdgcn_mfma_f32_16x16x32_bf16(kf[ks][a], qf[qt][ks], s[a][qt], 0, 0, 0);
            }
        bf16x8 vfr[2][4];
#pragma unroll
        for (int s2 = 0; s2 < 2; ++s2)
#pragma unroll
            for (int dt = 0; dt < 4; ++dt) vfr[s2][dt] = *(const bf16x8*)(sb + voff + dt * 1024 + s2 * 4096);
        __builtin_amdgcn_sched_barrier(0);
        bf16x8 pf[NQT][2];
#pragma unroll
        for (int qt = 0; qt < NQT; ++qt) {
            float mx = s[0][qt][0];
#pragma unroll
            for (int a = 0; a < 4; ++a)
#pragma unroll
                for (int r = 0; r < 4; ++r) mx = fmaxf(mx, s[a][qt][r]);
            mx = gmax4(mx);
            const float mnew = fmaxf(mrun[qt], mx);
            const float alpha = __builtin_amdgcn_exp2f((mrun[qt] - mnew) * c2);
            mrun[qt] = mnew;
            const float mc = mnew * c2;
            float ls = 0.f; float pv[16];
#pragma unroll
            for (int a = 0; a < 4; ++a)
#pragma unroll
                for (int r = 0; r < 4; ++r) { const float e = __builtin_amdgcn_exp2f(s[a][qt][r] * c2 - mc); pv[4 * a + r] = e; ls += e; }
            lrun[qt] = lrun[qt] * alpha + ls;
#pragma unroll
            for (int a = 0; a < 4; ++a) o[a][qt] = o[a][qt] * alpha;
            u32x4 w0 = pack8(pv), w1 = pack8(pv + 8);
            pf[qt][0] = __builtin_bit_cast(bf16x8, w0); pf[qt][1] = __builtin_bit_cast(bf16x8, w1);
        }
        __builtin_amdgcn_sched_barrier(0);
#pragma unroll
        for (int s2 = 0; s2 < 2; ++s2)
#pragma unroll
            for (int dt = 0; dt < 4; ++dt) {
#pragma unroll
                for (int qt = 0; qt < NQT; ++qt) o[dt][qt] = __builtin_amdgcn_mfma_f32_16x16x32_bf16(vfr[s2][dt], pf[qt][s2], o[dt][qt], 0, 0, 0);
            }
        __builtin_amdgcn_sched_barrier(0);
        if (kt + 2 < nkt) { if (PPW == 4) asm volatile("s_waitcnt vmcnt(4)" ::: "memory"); else asm volatile("s_waitcnt vmcnt(5)" ::: "memory"); }
        else asm volatile("s_waitcnt vmcnt(0)" ::: "memory");
        asm volatile("s_waitcnt lgkmcnt(0)" ::: "memory");
        __builtin_amdgcn_s_barrier();
        so_cur = (so_cur == 2 * STG) ? 0 : so_cur + STG;
        so_nn = (so_nn == 2 * STG) ? 0 : so_nn + STG;
    }
#pragma unroll
    for (int qt = 0; qt < NQT; ++qt) {
        float l = gsum4(lrun[qt]);
        const float inv = 1.f / l;
        bf16_t* orow = O + (size_t)(16 * NQT * w + 16 * qt + fr) * ldo + 4 * g;
#pragma unroll
        for (int dt = 0; dt < 4; ++dt) {
            u32x2 wv2; wv2[0] = pk2(o[dt][qt][0] * inv, o[dt][qt][1] * inv); wv2[1] = pk2(o[dt][qt][2] * inv, o[dt][qt][3] * inv);
            *(u32x2*)(orow + 16 * dt) = wv2;
        }
    }
}

struct Seq { int lat, tok0, L, key0, Lk, b; };
DI Seq seq_info(int s, int ps) {
    Seq q;
    if (s < 16) { q.lat = 0; q.tok0 = s * 256; q.L = 256; q.key0 = s * 256; q.Lk = 256; q.b = ps * 16 + s; }
    else { const int j = s - 16; q.lat = 1; q.tok0 = 4096 + j * 2048; q.L = 2048; q.key0 = 4096 + j * 2304; q.Lk = 2304; q.b = ps * 2 + j; }
    return q;
}
DI void attn_gqa_item(const Ctx& p, int l, int s, int head, int qb, int ps, char* smem, int tid) {
    const Seq q = seq_info(s, ps);
    const int rows = 128;
    const bf16_t* PROJ = (const bf16_t*)(p.ws() + OFF_PROJ);
    const bf16_t* Q = PROJ + (size_t)(q.tok0 + qb * rows) * INWP + C_AQ + head * 64;
    const int kh = head >> 2;
    const bf16_t* K = (const bf16_t*)(p.ws() + OFF_KA) + (size_t)q.key0 * 128 + kh * 64;
    const bf16_t* VT = (const bf16_t*)(p.ws() + OFF_VAT) + (size_t)q.key0 * 128 + (size_t)kh * 64 * q.Lk;
    bf16_t* O = (bf16_t*)(p.ws() + OFF_OA) + (size_t)(q.tok0 + qb * rows) * 512 + head * 64;
    const float c2 = 0.125f * 1.4426950408889634f;
    attn_tile<2, 2>(Q, INWP, K, 128, K, 128, VT, q.Lk, q.Lk / 64, c2, O, 512, p.in(25) + l * 64, q.lat ? (const float*)(p.ws() + OFF_T16) : nullptr, qb * 128, smem, tid);
}
DI void attn_mla_item(const Ctx& p, int s, int head, int qb, int ps, char* smem, int tid) {
    const Seq q = seq_info(s, ps);
    const int rows = 128;
    const bf16_t* Q = (const bf16_t*)(p.ws() + OFF_QM) + (size_t)(q.tok0 + qb * rows) * 768 + head * 96;
    const bf16_t* K1 = (const bf16_t*)(p.ws() + OFF_KN) + (size_t)q.key0 * 512 + head * 64;
    const bf16_t* K2 = (const bf16_t*)(p.ws() + OFF_KRP) + (size_t)q.key0 * 32;
    const bf16_t* VT = (const bf16_t*)(p.ws() + OFF_VMT) + (size_t)q.key0 * 512 + (size_t)head * 64 * q.Lk;
    bf16_t* O = (bf16_t*)(p.ws() + OFF_OM) + (size_t)(q.tok0 + qb * rows) * 512 + head * 64;
    const float c2 = 0.10206207261596577f * 1.4426950408889634f;
    attn_tile<3, 2>(Q, 768, K1, 512, K2, 32, VT, q.Lk, q.Lk / 64, c2, O, 512, nullptr, nullptr, 0, smem, tid);
}

template <int ET>
DI void scan_item(const bf16_t* __restrict__ Qp, size_t ldq, const bf16_t* __restrict__ Kp, size_t ldk, const bf16_t* __restrict__ Vp, size_t ldv,
                  const float* __restrict__ dtp  , float acoef  ,
                  int L, int dir, const float* __restrict__ s0, float* __restrict__ sout, int lds_state  , bf16_t* __restrict__ Op, size_t ldo,
                  const float* __restrict__ rope  , float kmul,
                  int nbase  , int nch  , const bf16_t* __restrict__ s0b  ,
                  bf16_t* __restrict__ lout  , float* __restrict__ dout  , char* smem, int tid) {
    constexpr int DV = 16 * ET;
    const bool stateonly = (lout != nullptr);
    constexpr int QS = 0, KS = 8192, KT = 16384, VTO = 24576, STO = VTO + DV * 128, ACO = STO + DV * 128;
    constexpr int NV = DV / 32;
    tid = launder(tid);
    const int lane = tid & 63, w = tid >> 6, fr = lane & 15, g = lane >> 4;
    float* acs = (float*)(smem + ACO);
    f32x4 sacc[ET];
#pragma unroll
    for (int et = 0; et < ET; ++et) {
        if (s0) {
#pragma unroll
            for (int r = 0; r < 4; ++r) sacc[et][r] = s0[(size_t)(16 * w + 4 * g + r) * lds_state + 16 * et + fr];
        } else if (s0b) {
#pragma unroll
            for (int r = 0; r < 4; ++r) sacc[et][r] = bf2f(s0b[(16 * w + 4 * g + r) * DV + 16 * et + fr]);
        } else sacc[et] = (f32x4){0.f, 0.f, 0.f, 0.f};
    }
    const int st_off = STO + ((w >> 1) * DV) * 64 + (g & 1) * 8;
    const int st_gg = (2 * w + (g >> 1)) & 3;
    __syncthreads();
    float* ropeL = (float*)(smem + ACO + 256);
    if (rope) {
#pragma unroll
        for (int i = 0; i < 2; ++i) *(f32x4*)(ropeL + (tid + 256 * i) * 4) = *(const f32x4*)(rope + (tid + 256 * i) * 4);
    }
#pragma unroll
    for (int et = 0; et < ET; ++et) {
        const int e = 16 * et + fr;
        u32x2 wv2; wv2[0] = pk2(sacc[et][0], sacc[et][1]); wv2[1] = pk2(sacc[et][2], sacc[et][3]);
        *(u32x2*)(smem + st_off + e * 64 + ((st_gg ^ FQ((e >> 2) & 3)) << 4)) = wv2;
    }
    __syncthreads();
    float dprod = 1.f;
    const int qoff = QS + tile_off(64, 0, 16 * w + fr, g, (fr >> 2) & 3);
    const int koff = KS + tile_off(64, 0, 8 * (fr >> 2) + (fr & 3), g, fr >> 2);
    const int ktoff = KT + tile_off(64, 0, 16 * w + fr, g, (fr >> 2) & 3);
    const int vtoff = VTO + tile_off(DV, 0, fr, g, (fr >> 2) & 3);
    const int stoff = STO + tile_off(DV, 0, fr, g, (fr >> 2) & 3);
    u32x4 gq[2], gk[2], gv[NV]; float gdt = 1.f;
    auto issue = [&](int c) {
        const int n0 = nbase + c * 64;
        {
            const int row = tid >> 2, cc0 = (tid & 1) | ((tid & 2) << 1);
            const int tl = dir ? (L - 1 - (n0 + row)) : (n0 + row);
#pragma unroll
            for (int i = 0; i < 2; ++i) {
                gq[i] = gld16(Qp + (size_t)tl * ldq + (cc0 + 2 * i) * 8);
                gk[i] = gld16(Kp + (size_t)tl * ldk + (cc0 + 2 * i) * 8);
            }
        }
#pragma unroll
        for (int i = 0; i < NV; ++i) {
            const int q = tid + 256 * i, row = q / (DV / 8), cc = q % (DV / 8);
            const int tl = dir ? (L - 1 - (n0 + row)) : (n0 + row);
            gv[i] = gld16(Vp + (size_t)tl * ldv + cc * 8);
        }
        if (dtp) { const int tl = dir ? (L - 1 - (n0 + lane)) : (n0 + lane); gdt = dtp[(size_t)tl * 16]; }
    };
    issue(0);
    for (int c = 0; c < nch; ++c) {
        const int n0 = nbase + c * 64;
        const float dtv = gdt;
        const float la = dtp ? dtv * acoef : acoef;
        float ac, aend;
        if (dtp) {
            ac = la;
#pragma unroll
            for (int o = 1; o < 64; o <<= 1) { const float t = shu(ac, o); if (lane >= o) ac += t; }
            aend = shf(ac, 63);
        } else { ac = (float)(lane + 1) * la; aend = 64.f * la; }
        if (w == 0) acs[lane] = ac;
        {
            const int row = tid >> 2, cc0 = (tid & 1) | ((tid & 2) << 1);
            const float ksc = shf(dtv, row) * kmul, wend = __expf(aend - shf(ac, row));
            float qa[2][8], ka[2][8];
#pragma unroll
            for (int i = 0; i < 2; ++i) { unpack8(gq[i], qa[i]); unpack8(gk[i], ka[i]); }
            if (rope) {
                const int tlr = dir ? (L - 1 - (n0 + row)) : (n0 + row);
                const int pos = (cc0 >> 2) ? (tlr & 63) : (tlr >> 6);
                const float* rp = ropeL + pos * 16 + (cc0 & 1) * 8;
                f32x4 rc[2], rs[2];
                rc[0] = *(const f32x4*)rp; rc[1] = *(const f32x4*)(rp + 4); rs[0] = *(const f32x4*)(rp + 1024); rs[1] = *(const f32x4*)(rp + 1028);
#pragma unroll
                for (int j = 0; j < 8; ++j) {
                    const float c = rc[j >> 2][j & 3], sn = rs[j >> 2][j & 3];
                    const float q1 = qa[0][j], q2 = qa[1][j], k1 = ka[0][j], k2 = ka[1][j];
                    qa[0][j] = q1 * c - q2 * sn; qa[1][j] = q2 * c + q1 * sn;
                    ka[0][j] = k1 * c - k2 * sn; ka[1][j] = k2 * c + k1 * sn;
                }
            }
#pragma unroll
            for (int i = 0; i < 2; ++i) {
                const int cc = cc0 + 2 * i;
                if (rope) *(u32x4*)(smem + QS + tile_off(64, cc >> 2, row, cc & 3, (row >> 2) & 3)) = pack8(qa[i]);
                else *(u32x4*)(smem + QS + tile_off(64, cc >> 2, row, cc & 3, (row >> 2) & 3)) = gq[i];
#pragma unroll
                for (int j = 0; j < 8; ++j) ka[i][j] *= ksc;
                *(u32x4*)(smem + KS + tile_off(64, cc >> 2, row, cc & 3, (row >> 3) & 3)) = pack8(ka[i]);
#pragma unroll
                for (int j = 0; j < 8; ++j) {
                    const int d = cc * 8 + j;
                    *(bf16_t*)(smem + KT + tile_off(64, row >> 5, d, (row >> 3) & 3, (d >> 2) & 3) + (row & 7) * 2) = f2bf(ka[i][j] * wend);
                }
            }
        }
#pragma unroll
        for (int i = 0; i < NV; ++i) {
            const int q = tid + 256 * i, row = q / (DV / 8), cc = q % (DV / 8);
            const u32x4 vv = gv[i];
#pragma unroll
            for (int j = 0; j < 8; ++j) {
                const int e = cc * 8 + j;
                const unsigned short h = (unsigned short)(vv[j >> 1] >> (16 * (j & 1)));
                *(bf16_t*)(smem + VTO + tile_off(DV, row >> 5, e, (row >> 3) & 3, (e >> 2) & 3) + (row & 7) * 2) = h;
            }
        }
        if (c + 1 < nch) issue(c + 1);
        __builtin_amdgcn_sched_barrier(0);
        __syncthreads();
        {
            const int irow = 16 * w + fr;
            const int ns = (w >> 1) + 1;
            bf16x8 qfr[2], sf[ET][2], kfa[2][2][2], vf[2][ET], kt2[2];
            qfr[0] = *(const bf16x8*)(smem + qoff); qfr[1] = *(const bf16x8*)(smem + qoff + 4096);
#pragma unroll
            for (int et = 0; et < ET; ++et)
#pragma unroll
                for (int ks = 0; ks < 2; ++ks) sf[et][ks] = *(const bf16x8*)(smem + stoff + et * 1024 + ks * DV * 64);
#pragma unroll
            for (int aa = 0; aa < 2; ++aa)
#pragma unroll
                for (int ks = 0; ks < 2; ++ks) kfa[0][aa][ks] = *(const bf16x8*)(smem + koff + (4 * aa) * 64 + ks * 4096);
            const float ai = acs[irow];
            f32x4 ajv[2][2];
#pragma unroll
            for (int aa = 0; aa < 2; ++aa) ajv[0][aa] = *(const f32x4*)(acs + 8 * g + 4 * aa);
            const float cd = __expf(acs[63]);
            __builtin_amdgcn_sched_barrier(0);
            f32x4 o[ET];
            if (!stateonly) {
#pragma unroll
                for (int et = 0; et < ET; ++et) {
                    o[et] = (f32x4){0.f, 0.f, 0.f, 0.f};
#pragma unroll
                    for (int ks = 0; ks < 2; ++ks) o[et] = __builtin_amdgcn_mfma_f32_16x16x32_bf16(sf[et][ks], qfr[ks], o[et], 0, 0, 0);
                }
            }
#pragma unroll
            for (int aa = 0; aa < 2; ++aa)
#pragma unroll
                for (int ks = 0; ks < 2; ++ks) kfa[1][aa][ks] = *(const bf16x8*)(smem + koff + (32 + 4 * aa) * 64 + ks * 4096);
#pragma unroll
            for (int ks = 0; ks < 2; ++ks) {
#pragma unroll
                for (int et = 0; et < ET; ++et) vf[ks][et] = *(const bf16x8*)(smem + vtoff + et * 1024 + ks * DV * 64);
                kt2[ks] = *(const bf16x8*)(smem + ktoff + ks * 4096);
            }
#pragma unroll
            for (int aa = 0; aa < 2; ++aa) ajv[1][aa] = *(const f32x4*)(acs + 32 + 8 * g + 4 * aa);
            __builtin_amdgcn_sched_barrier(0);
            if (!stateonly) {
                const float ei = __expf(ai);
#pragma unroll
                for (int et = 0; et < ET; ++et) o[et] = o[et] * ei;
#pragma unroll
                for (int s2 = 0; s2 < 2; ++s2) {
                    if (s2 < ns) {
                        f32x4 pp[2];
#pragma unroll
                        for (int aa = 0; aa < 2; ++aa) {
                            pp[aa] = (f32x4){0.f, 0.f, 0.f, 0.f};
#pragma unroll
                            for (int ks = 0; ks < 2; ++ks) pp[aa] = __builtin_amdgcn_mfma_f32_16x16x32_bf16(kfa[s2][aa][ks], qfr[ks], pp[aa], 0, 0, 0);
                        }
                        float pv[8];
#pragma unroll
                        for (int aa = 0; aa < 2; ++aa) {
                            const int j0 = 32 * s2 + 8 * g + 4 * aa;
#pragma unroll
                            for (int r = 0; r < 4; ++r) {
                                const float dec = __expf(fminf(ai - ajv[s2][aa][r], 0.f));
                                pv[4 * aa + r] = (j0 + r <= irow) ? pp[aa][r] * dec : 0.f;
                            }
                        }
                        const u32x4 pw = pack8(pv);
                        const bf16x8 pf = __builtin_bit_cast(bf16x8, pw);
#pragma unroll
                        for (int et = 0; et < ET; ++et) o[et] = __builtin_amdgcn_mfma_f32_16x16x32_bf16(vf[s2][et], pf, o[et], 0, 0, 0);
                    }
                }
                const int tl = dir ? (L - 1 - (n0 + irow)) : (n0 + irow);
                bf16_t* orow = Op + (size_t)tl * ldo + 4 * g;
#pragma unroll
                for (int et = 0; et < ET; ++et) {
                    u32x2 wv2; wv2[0] = pk2(o[et][0], o[et][1]); wv2[1] = pk2(o[et][2], o[et][3]);
                    st_wt8(orow + 16 * et, wv2);
                }
            }
            dprod *= cd;
#pragma unroll
            for (int et = 0; et < ET; ++et) sacc[et] = sacc[et] * cd;
#pragma unroll
            for (int ks = 0; ks < 2; ++ks)
#pragma unroll
                for (int et = 0; et < ET; ++et) sacc[et] = __builtin_amdgcn_mfma_f32_16x16x32_bf16(kt2[ks], vf[ks][et], sacc[et], 0, 0, 0);
        }
        __syncthreads();
#pragma unroll
        for (int et = 0; et < ET; ++et) {
            const int e = 16 * et + fr;
            u32x2 wv2; wv2[0] = pk2(sacc[et][0], sacc[et][1]); wv2[1] = pk2(sacc[et][2], sacc[et][3]);
            *(u32x2*)(smem + st_off + e * 64 + ((st_gg ^ FQ((e >> 2) & 3)) << 4)) = wv2;
        }
    }
    if (sout) {
#pragma unroll
        for (int et = 0; et < ET; ++et)
#pragma unroll
            for (int r = 0; r < 4; ++r) sout[(size_t)(16 * w + 4 * g + r) * lds_state + 16 * et + fr] = sacc[et][r];
    }
    if (lout) {
#pragma unroll
        for (int et = 0; et < ET; ++et)
#pragma unroll
            for (int r = 0; r < 4; ++r) st_wt2(lout + (16 * w + 4 * g + r) * DV + 16 * et + fr, f2bf(sacc[et][r]));
        if (tid == 0) st_wt4f(dout, dprod);
    }
    __syncthreads();
}

DI void scan_any_item(const Ctx& p, int l, int ps, int isret, int s, int h, int dir, int half, int mode, int seg, int sid, char* smem, int tid) {
    const Seq q = seq_info(s, ps);
    const bf16_t *Qp, *Kp, *Vp; size_t ld; const float* dtp; float acoef, kmul; const float* rope; bf16_t* O; float* so; int lds;
    if (isret) {
        const bf16_t* PR = (const bf16_t*)(p.ws() + OFF_PROJ) + (size_t)q.tok0 * INWP;
        const float x = p.in(23)[l * 8 + dir * 4 + h];
        acoef = fminf(x, 0.f) - log1pe(__expf(-fabsf(x)));
        Qp = PR + C_RQ + h * 64; Kp = PR + C_RK + h * 64; Vp = PR + C_RV + h * 128 + half * 64; ld = INWP; dtp = nullptr; kmul = 0.125f;
        rope = q.lat ? (const float*)(p.ws() + OFF_T16) : nullptr;
        O = (bf16_t*)(p.ws() + OFF_OR) + ((size_t)dir * NPT + q.tok0) * 512 + h * 128 + half * 64;
        so = p.out() + O_RET + ((size_t)((q.b * 2 + l) * 2 + dir) * 4 + h) * 8192 + half * 64; lds = 128;
    } else {
        const bf16_t* XB = (const bf16_t*)(p.ws() + OFF_XBCA) + (size_t)q.tok0 * 768;
        const int grp = h >> 2;
        Qp = XB + 640 + grp * 64; Kp = XB + 512 + grp * 64; Vp = XB + h * 64; ld = 768; kmul = 1.f; rope = nullptr;
        dtp = (const float*)(p.ws() + OFF_DT) + (size_t)q.tok0 * 16 + dir * 8 + h;
        acoef = -__expf(p.in(20)[l * 16 + dir * 8 + h]);
        O = (bf16_t*)(p.ws() + OFF_OS) + ((size_t)dir * NPT + q.tok0) * 512 + h * 64;
        so = p.out() + O_SSD + ((size_t)((q.b * 2 + l) * 2 + dir) * 8 + h) * 4096; lds = 64;
    }
    bf16_t* segb = (bf16_t*)(p.ws() + OFF_SEG) + (size_t)(sid * NSEG + seg) * 4096;
    float* segd = (float*)(p.ws() + OFF_SEGD) + sid * NSEG + seg;
    scan_item<4>(Qp, ld, Kp, ld, Vp, ld, dtp, acoef, q.L, dir, nullptr, mode == 0 ? so : nullptr, lds, O, 512, rope, kmul,
                 mode == 0 ? 0 : seg * SEGTOK, mode == 0 ? (q.L >> 6) : (SEGTOK >> 6), mode == 3 ? segb : nullptr, mode == 1 ? segb : nullptr, mode == 1 ? segd : nullptr, smem, tid);
}
DI void scan_combine_item(const Ctx& p, int l, int ps, int sid, int tid) {
    const float* s0; int ld;
    if (sid < 32) { const int b = ps * 2 + (sid >> 4), h = (sid >> 1) & 7, dir = sid & 1; s0 = p.in(2) + ((size_t)((b * 2 + l) * 2 + dir) * 8 + h) * 4096; ld = 64; }
    else { const int k = sid - 32, b = ps * 2 + (k >> 4), h = (k >> 2) & 3, dir = (k >> 1) & 1, half = k & 1;
           s0 = p.in(3) + ((size_t)((b * 2 + l) * 2 + dir) * 4 + h) * 8192 + half * 64; ld = 128; }
    bf16_t* segb = (bf16_t*)(p.ws() + OFF_SEG) + (size_t)sid * NSEG * 4096;
    const float* segd = (const float*)(p.ws() + OFF_SEGD) + sid * NSEG;
    const int t2 = launder(tid);
    const float* sp = s0 + (size_t)(t2 >> 2) * ld + (t2 & 3) * 16;
    bf16_t* bp = segb + t2 * 16;
    float S[16];
#pragma unroll
    for (int k = 0; k < 4; ++k) { const f32x4 v = *(const f32x4*)(sp + 4 * k); S[4 * k] = v[0]; S[4 * k + 1] = v[1]; S[4 * k + 2] = v[2]; S[4 * k + 3] = v[3]; }
#pragma unroll 1
    for (int g2 = 0; g2 < NSEG; ++g2) {
        float loc[16]; float d = 0.f;
        if (g2 < NSEG - 1) { d = segd[g2]; unpack8(*(const u32x4*)(bp + g2 * 4096), loc); unpack8(*(const u32x4*)(bp + g2 * 4096 + 8), loc + 8); }
        else {
#pragma unroll
            for (int k = 0; k < 16; ++k) loc[k] = 0.f;
        }
        st_wt16(bp + g2 * 4096, pack8(S)); st_wt16(bp + g2 * 4096 + 8, pack8(S + 8));
#pragma unroll
        for (int k = 0; k < 16; ++k) S[k] = S[k] * d + loc[k];
    }
}

DI void postscan_token(const Ctx& p, int l, int m, int lane) {
    char* ws = p.ws();
    bf16_t* pr = (bf16_t*)(ws + OFF_PROJ) + (size_t)m * INWP;
    const int c0 = lane * 8;
    {
        const bf16_t* OS = (const bf16_t*)(ws + OFF_OS);
        float a[8], b[8], xs[8], z[8];
        unpack8(*(const u32x4*)(OS + (size_t)m * 512 + c0), a);
        unpack8(*(const u32x4*)(OS + ((size_t)NPT + m) * 512 + c0), b);
        unpack8(*(const u32x4*)((const bf16_t*)(ws + OFF_XBCA) + (size_t)m * 768 + c0), xs);
        unpack8(*(const u32x4*)(pr + C_Z + c0), z);
        const float dsk = p.in(21)[l * 8 + (c0 >> 6)];
        float v[8], ss = 0.f;
#pragma unroll
        for (int j = 0; j < 8; ++j) { v[j] = ((a[j] + b[j]) + dsk * xs[j]) * siluf(z[j]); ss += v[j] * v[j]; }
        ss = wsum(ss);
        const float rstd = rsqrtf(ss * (1.f / 512.f) + EPS);
        const float* w = p.in(22) + l * 512 + c0;
#pragma unroll
        for (int j = 0; j < 8; ++j) v[j] = (v[j] * rstd) * w[j];
        *(u32x4*)(pr + C_Z + c0) = pack8(v);
    }
    {
        const bf16_t* ORb = (const bf16_t*)(ws + OFF_OR);
        float a[8], b[8], gt[8];
        unpack8(*(const u32x4*)(ORb + (size_t)m * 512 + c0), a);
        unpack8(*(const u32x4*)(ORb + ((size_t)NPT + m) * 512 + c0), b);
        unpack8(*(const u32x4*)(pr + C_RG + c0), gt);
        float v[8], sm = 0.f;
#pragma unroll
        for (int j = 0; j < 8; ++j) { v[j] = a[j] + b[j]; sm += v[j]; }
        sm += shx(sm, 1); sm += shx(sm, 2); sm += shx(sm, 4); sm += shx(sm, 8);
        const float mean = sm * (1.f / 128.f);
        float sq = 0.f;
#pragma unroll
        for (int j = 0; j < 8; ++j) { v[j] -= mean; sq += v[j] * v[j]; }
        sq += shx(sq, 1); sq += shx(sq, 2); sq += shx(sq, 4); sq += shx(sq, 8);
        const float rstd = rsqrtf(sq * (1.f / 128.f) + EPS);
        const float* w = p.in(24) + l * 512 + c0;
#pragma unroll
        for (int j = 0; j < 8; ++j) v[j] = (v[j] * rstd) * w[j] * siluf(gt[j]);
        *(u32x4*)(pr + C_RG + c0) = pack8(v);
    }
}

DI void phase_act(const Ctx& p, int l, int ps, int tid) {
    tid = launder(tid);
    const int lane = tid & 63, wv = tid >> 6;
    const bf16_t* U = (const bf16_t*)(p.ws() + OFF_U);
    bf16_t* A = (bf16_t*)(p.ws() + OFF_ACT);
    const float* cw = p.in(39) + (size_t)l * 3 * 5632; const float* cb = p.in(40) + (size_t)l * 5632;
    for (int item = BIDX * 4 + wv; item < 512 * 6; item += gridDim.x * 4) {
        const int run = item / 6, cbk = item % 6;
        const int j0 = cbk * 512 + lane * 8;
        if (j0 >= DFF) continue;
        const int m0 = run * 16;
        const Tok k = tok_info(m0, ps);
        float wu[4][8], wg[4][8];
#pragma unroll
        for (int tp = 0; tp < 3; ++tp) {
            const f32x4 a0 = *(const f32x4*)(cw + tp * 5632 + j0), a1 = *(const f32x4*)(cw + tp * 5632 + j0 + 4);
            const f32x4 g0 = *(const f32x4*)(cw + tp * 5632 + DFF + j0), g1 = *(const f32x4*)(cw + tp * 5632 + DFF + j0 + 4);
#pragma unroll
            for (int e = 0; e < 4; ++e) { wu[tp][e] = a0[e]; wu[tp][4 + e] = a1[e]; wg[tp][e] = g0[e]; wg[tp][4 + e] = g1[e]; }
        }
        {
            const f32x4 a0 = *(const f32x4*)(cb + j0), a1 = *(const f32x4*)(cb + j0 + 4);
            const f32x4 g0 = *(const f32x4*)(cb + DFF + j0), g1 = *(const f32x4*)(cb + DFF + j0 + 4);
#pragma unroll
            for (int e = 0; e < 4; ++e) { wu[3][e] = a0[e]; wu[3][4 + e] = a1[e]; wg[3][e] = g0[e]; wg[3][4 + e] = g1[e]; }
        }
        const bf16_t* ub = U + (size_t)m0 * 5632 + j0;
        const u32x4 zero = {0u, 0u, 0u, 0u};
        u32x4 pu = zero, pg = zero, cu, cg;
        if (k.t > 0) { pu = gld16(ub - 5632); pg = gld16(ub - 5632 + DFF); }
        cu = gld16(ub); cg = gld16(ub + DFF);
#pragma unroll 4
        for (int i = 0; i < 16; ++i) {
            u32x4 nu = zero, ng = zero;
            if (k.t + i + 1 < k.L) { nu = gld16(ub + (size_t)(i + 1) * 5632); ng = gld16(ub + (size_t)(i + 1) * 5632 + DFF); }
            float a[8], b[8], c[8], o[8];
            unpack8(pu, a); unpack8(cu, b); unpack8(nu, c);
            float up[8];
#pragma unroll
            for (int e = 0; e < 8; ++e) up[e] = wu[3][e] + wu[0][e] * a[e] + wu[1][e] * b[e] + wu[2][e] * c[e];
            unpack8(pg, a); unpack8(cg, b); unpack8(ng, c);
#pragma unroll
            for (int e = 0; e < 8; ++e) { const float gt = wg[3][e] + wg[0][e] * a[e] + wg[1][e] * b[e] + wg[2][e] * c[e]; o[e] = siluf(gt) * up[e]; }
            *(u32x4*)(A + (size_t)(m0 + i) * DFF + j0) = pack8(o);
            pu = cu; pg = cg; cu = nu; cg = ng;
        }
    }
}

DI int next_item(unsigned* ctr, volatile LAS unsigned* slot, int tid) {
    __syncthreads();
    if (tid == 0) *slot = __hip_atomic_fetch_add(ctr, 1u, __ATOMIC_RELAXED, __HIP_MEMORY_SCOPE_AGENT);
    __syncthreads();
    return (int)*slot;
}

#ifndef ONLY2
#define ONLY2 -1
#endif
#ifndef PROBE_KIND
#define PROBE_KIND -1
#endif
DI void item_publish(unsigned* cnt, int tid) {
    asm volatile("s_waitcnt vmcnt(0)" ::: "memory");
    __syncthreads();
    if (tid == 0) __hip_atomic_fetch_add(cnt, 1u, __ATOMIC_RELAXED, __HIP_MEMORY_SCOPE_AGENT);
}
DI void item_wait(unsigned* cnt, unsigned need, int tid) {
    if (tid == 0) {
        unsigned sp = 0;
        while (__hip_atomic_load(cnt, __ATOMIC_RELAXED, __HIP_MEMORY_SCOPE_AGENT) < need) { __builtin_amdgcn_s_sleep(2); if (++sp > (1u << 24)) break; }
        __builtin_amdgcn_fence(__ATOMIC_ACQUIRE, "agent");
        asm volatile("s_waitcnt vmcnt(0)" ::: "memory");
    }
    __syncthreads();
}
DI void phase_mix(const Ctx& p, int l, int ps, unsigned* ctr, unsigned* c12, volatile LAS unsigned* slot, char* smem, int tid) {
    unsigned* gdone = ctr + 64; unsigned* sdone = ctr + 128;
    unsigned* c1 = c12; unsigned* c2 = c12 + 64;
    constexpr int N1 = 64 * (NSEG - 1), N3 = 64 * NSEG;
    constexpr int A0 = N1, A1 = A0 + 384, A2 = A1 + 544, A3 = A2 + 256, A4 = A3 + 64, A5 = A4 + N3, A6 = A5 + 256, A7 = A6 + 256, A8 = A7 + 256, A9 = A8 + 256, A10 = A9 + 256, A11 = A10 + 256;
    for (;;) {
        tid = launder(tid);
        l = launder_s(l); ps = launder_s(ps);
        int it = next_item(ctr, slot, tid);
        if (it >= A11) break;
        int sc = -1, isret = 0, sq = 0, hd = 0, dr = 0, hf = 0, md = 0, sg = 0, sid = 0; unsigned* pub = sdone;
        if (it < A0) { sid = it / (NSEG - 1); sg = it % (NSEG - 1); md = 1; sc = 1; pub = c1 + sid; }
        else if (it >= A4 && it < A5) { const int k = it - A4; sid = k / NSEG; sg = k % NSEG; md = 3; sc = 1; }
        else if (it >= A6 && it < A7) { const int k = it - A6; sq = k >> 4; hd = (k >> 1) & 7; dr = k & 1; sc = 0; }
        else if (it >= A7 && it < A8) { const int k = it - A7; isret = 1; sq = k >> 4; hd = (k >> 2) & 3; dr = (k >> 1) & 1; hf = k & 1; sc = 0; }
        if (sc == 1) {
            if (sid < 32) { isret = 0; sq = 16 + (sid >> 4); hd = (sid >> 1) & 7; dr = sid & 1; hf = 0; }
            else { const int k = sid - 32; isret = 1; sq = 16 + (k >> 4); hd = (k >> 2) & 3; dr = (k >> 1) & 1; hf = k & 1; }
        }
        if (sc >= 0) {
            if (md == 3) item_wait(c2 + sid, 1u, tid);
            scan_any_item(p, l, ps, isret, sq, hd, dr, hf, md, sg, sid, smem, tid);
            item_publish(pub, tid);
        }
        else if (it < A1) { gemm_uq_tile(p, l, ps, it - A0, smem, tid); item_publish(gdone, tid); }
        else if (it < A2) { gemm_ukv_tile(p, l, it - A1, smem, tid); item_publish(gdone, tid); }
        else if (it < A3) { const int k = it - A2; attn_gqa_item(p, l, 16 + (k >> 7), (k >> 4) & 7, k & 15, ps, smem, tid); }
        else if (it < A4) { const int sd = it - A3; item_wait(c1 + sd, (unsigned)(NSEG - 1), tid); scan_combine_item(p, l, ps, sd, tid); item_publish(c2 + sd, tid); }
        else if (it < A6) { const int k = it - A5; item_wait(gdone, 928u, tid); attn_mla_item(p, 16 + (k >> 7), (k >> 4) & 7, k & 15, ps, smem, tid); }
        else if (it < A9) { const int k = it - A8; attn_gqa_item(p, l, k >> 4, (k >> 1) & 7, k & 1, ps, smem, tid); }
        else if (it < A10) { const int k = it - A9; item_wait(gdone, 928u, tid); attn_mla_item(p, k >> 4, (k >> 1) & 7, k & 1, ps, smem, tid); }
        else { item_wait(sdone, (unsigned)(N3 + 512), tid); const int k = it - A10; const int t5 = launder(tid); for (int i = 0; i < 8; ++i) postscan_token(p, l, k * 32 + i * 4 + (t5 >> 6), t5 & 63); }
    }
}

constexpr int NPL = 10;
constexpr int NPP = 1 + 2 * NPL;
constexpr int NPHASE = 1 + 2 * NPP;
DI void run_phase(const Ctx& p, int ph, int rep, volatile LAS unsigned* slot, char* smem, int tid) {
#ifndef EXCL
#define EXCL -2
#endif
#ifndef ONLY
#define ONLY -1
#endif
    if (ph == 0) { phase_prep_w(p, smem, tid); return; }
    const int q = ph - 1, ps = q / NPP, r = q % NPP;
    if (r == 0) { phase_h1(p, ps, tid); return; }
    const int l = (r - 1) / NPL, k = (r - 1) % NPL;
    char* ws = p.ws();
    unsigned* ctr = (unsigned*)(p.ws() + OFF_CTR) + ph;
    switch (k) {
    case 0: phase_gemm_in(p, l, smem, tid); break;
    case 1: phase_prep(p, l, ps, tid); break;
    case 2: phase_mix(p, l, ps, ctr, (unsigned*)(p.ws() + OFF_CTR) + 256 + (ps * 2 + l) * 128, slot, smem, tid); break;
    case 3: phase_merge(p, l, smem, tid); break;
    case 4: phase_gemm_plain<true>((const bf16_t*)(ws + OFF_WOUT) + (size_t)l * SZ_WOUT, 1024, (const bf16_t*)(ws + OFF_MERGED), 1024, 64, 8, ws + OFF_MO, 1024, smem, tid); break;
    case 5: phase_res(p, ps, l, 0, tid); break;
    case 6: phase_gemm_plain<false>((const bf16_t*)(ws + OFF_WUP) + (size_t)l * SZ_WUP, 1024, (const bf16_t*)(ws + OFF_H), 1024, 64, 44, ws + OFF_U, 5632, smem, tid); break;
    case 7: phase_act(p, l, ps, tid); break;
    case 8: phase_gemm_plain<true>((const bf16_t*)(ws + OFF_WDN) + (size_t)l * SZ_WDN, 2816, (const bf16_t*)(ws + OFF_ACT), 2816, 64, 8, ws + OFF_FO, 1024, smem, tid); break;
    default: phase_res(p, ps, l, 1, tid); if (ps == 0 && l == 1) phase_h1(p, 1, tid); break;
    }
}

constexpr unsigned long long probe_mask(int kind) {
    unsigned long long m = 0;
    for (int ph = 0; ph < NPHASE; ++ph) {
        int k = 11; if (ph > 0) { const int r = (ph - 1) % NPP; k = (r == 0) ? 12 : (r - 1) % NPL; }
        if (k == kind) m |= 1ull << ph;
    }
    return m;
}
__global__ void __launch_bounds__(256, 2) fwd_kernel(Params prm, int ph_lo, int ph_hi, int rep) {
    __shared__ __attribute__((aligned(16))) char smem[65536 + 32 + 352];
    int tid = threadIdx.x;
    volatile LAS unsigned* xw = (volatile LAS unsigned*)(smem + 65536);
    volatile LAS unsigned* tbl = (volatile LAS unsigned*)(smem + 65536 + 32);
    if (tid == 0) { xw[0] = 0u; xw[1] = 0u; xw[2] = 0u; xw[3] = 0u; }
    if (tid == 0) {
#pragma unroll
        for (int i = 0; i < 44; ++i) {
            const unsigned long long v = (i < 42) ? (unsigned long long)prm.in[i < 42 ? i : 0] : (i == 42 ? (unsigned long long)prm.out : (unsigned long long)prm.ws);
            tbl[2 * i] = (unsigned)v; tbl[2 * i + 1] = (unsigned)(v >> 32);
        }
    }
    __syncthreads();
    Ctx p; p.tbl = tbl;
    XcdBarrier bar;
    if (ph_hi - ph_lo > 1) bar = xcd_barrier_post((unsigned*)(p.ws() + OFF_BAR), xw, tid);
    constexpr unsigned long long PMASK = probe_mask(PROBE_KIND);
    if (PROBE_KIND >= 0 && BIDX == 0 && tid == 0) { xw[3] = 0u; xw[4] = (unsigned)__builtin_amdgcn_s_memrealtime(); }
    for (int ph = ph_lo; ph < ph_hi; ++ph) {
        if (ph == 1 + NPP) continue;
        tid = launder(tid);
        run_phase(p, ph, rep, xw + 2, smem, tid);
        if (PROBE_KIND == 13 && BIDX == 0 && tid == 0) xw[5] = (unsigned)__builtin_amdgcn_s_memrealtime();
        if (launder_s(ph_hi) - launder_s(ph_lo) > 1 && ph + 1 < ph_hi) xcd_barrier(bar, tid);
        if (PROBE_KIND >= 0 && BIDX == 0 && tid == 0) {
            const unsigned tn = (unsigned)__builtin_amdgcn_s_memrealtime();
            if (PROBE_KIND == 13) xw[3] = xw[3] + (tn - xw[5]);
            else if ((PMASK >> ph) & 1ull) xw[3] = xw[3] + (tn - xw[4]);
            xw[4] = tn;
        }
    }
    if (PROBE_KIND >= 0 && BIDX == 0 && tid == 0) {
        const unsigned long long tend = __builtin_amdgcn_s_memrealtime() + 9ull * xw[3];
        while (__builtin_amdgcn_s_memrealtime() < tend) __builtin_amdgcn_s_sleep(8);
    }
}

#ifndef MK_ONE_LAUNCH
#define MK_ONE_LAUNCH 1
#endif

extern "C" void kernel_launch(void* const* d_in, const int* in_sizes, int n_in, void* d_out, int out_size, void* d_ws, size_t ws_size, hipStream_t stream) {
    (void)in_sizes; (void)n_in; (void)out_size;
    if (ws_size < WS_NEED) { fprintf(stderr, "workspace too small: %zu < %zu\n", ws_size, (size_t)WS_NEED); return; }
    Params p{};
    for (int i = 0; i < 42; ++i) p.in[i] = (const float*)d_in[i];
    p.out = (float*)d_out; p.ws = (char*)d_ws;
    static int grid_blocks = 0;
    if (!grid_blocks) {
        int dev = 0, cus = 0, per_cu = 0;
        hipGetDevice(&dev);
        hipDeviceGetAttribute(&cus, hipDeviceAttributeMultiprocessorCount, dev);
        hipOccupancyMaxActiveBlocksPerMultiprocessor(&per_cu, fwd_kernel, 256, 0);
        if (per_cu > 2) per_cu = 2;
        if (per_cu < 1) per_cu = 1;
        grid_blocks = cus * per_cu;
    }
    hipMemsetAsync((char*)d_ws + OFF_BAR, 0, BAR_BYTES + CTR_BYTES, stream);
#if MK_ONE_LAUNCH
    {
        int lo = 0, hi = NPHASE, rep = 0;
        void* args[] = {&p, &lo, &hi, &rep};
        hipError_t e = hipLaunchCooperativeKernel((void*)fwd_kernel, dim3(grid_blocks), dim3(256), args, 0, stream);
        if (e != hipSuccess) fprintf(stderr, "cooperative launch failed: %s (grid %d)\n", hipGetErrorString(e), grid_blocks);
    }
#else
#ifndef PROBE_REP
#define PROBE_REP 0
#endif
    for (int ph = 0; ph < NPHASE; ++ph) {
        fwd_kernel<<<grid_blocks, 256, 0, stream>>>(p, ph, ph + 1, 0);
        int kind = -1;
        if (ph == 0) kind = 11; else { const int r = (ph - 1) % NPP; kind = (r == 0) ? 12 : (r - 1) % NPL; }
        if ((PROBE_REP >> kind) & 1) fwd_kernel<<<grid_blocks, 256, 0, stream>>>(p, ph, ph + 1, 1);
    }
#endif
}
```

```cpp
#include <hip/hip_runtime.h>
#include <cstdio>
#include <cstdint>
#include <cmath>

typedef unsigned short bf16_t;
typedef short bf16x8 __attribute__((ext_vector_type(8)));
typedef float f32x4 __attribute__((ext_vector_type(4)));
typedef unsigned u32x4 __attribute__((ext_vector_type(4)));
typedef unsigned u32x2 __attribute__((ext_vector_type(2)));
#define DI __device__ __forceinline__
#define LAS __attribute__((address_space(3)))

constexpr int DM = 1024, INW = 4272, INWP = 4352, DFF = 2816;
constexpr int NPT = 8192;
constexpr int KROWS = 8704;
constexpr float EPS = 1e-6f;
constexpr int C_Z = 0, C_XBC = 512, C_DT = 1280, C_RQ = 1296, C_RK = 1552, C_RV = 1808, C_RG = 2320, C_AQ = 2832, C_AK = 3344, C_AV = 3472,
              C_MCQ = 3600, C_MCKV = 3984;
constexpr size_t O_YS = 8388608, O_SSD = 16777216, O_RET = 20971520, O_CK = 25165824, O_CV = 27262976, O_CC = 29360128, O_CR = 33554432;

constexpr size_t al256(size_t x) { return (x + 255) & ~(size_t)255; }
constexpr size_t SZ_WIN = (size_t)INWP * 1024, SZ_WM = (size_t)4096 * 1024, SZ_WUQ = (size_t)768 * 384, SZ_WUKV = (size_t)1024 * 256,
                 SZ_WBR = (size_t)4 * 1024 * 512, SZ_WOUT = (size_t)1024 * 1024, SZ_WUP = (size_t)5632 * 1024, SZ_WDN = (size_t)1024 * 2816;
constexpr size_t OFF_WIN = 0;
constexpr size_t OFF_WM = OFF_WIN + 4 * SZ_WIN;
constexpr size_t OFF_WUQ = OFF_WM + 4 * SZ_WM;
constexpr size_t OFF_WUKV = OFF_WUQ + 4 * SZ_WUQ;
constexpr size_t OFF_WBR = OFF_WUKV + 4 * SZ_WUKV;
constexpr size_t OFF_WOUT = OFF_WBR + 4 * SZ_WBR;
constexpr size_t OFF_WUP = OFF_WOUT + 4 * SZ_WOUT;
constexpr size_t OFF_WDN = OFF_WUP + 4 * SZ_WUP;
constexpr size_t OFF_MOD = al256(OFF_WDN + 4 * SZ_WDN);
constexpr size_t OFF_T16 = al256(OFF_MOD + (size_t)2 * 5 * 6144 * 4);
constexpr size_t OFF_T8 = OFF_T16 + 2 * 64 * 16 * 4;
constexpr size_t OFF_BAR = al256(OFF_T8 + 2 * 64 * 8 * 4);
constexpr size_t BAR_BYTES = 3456 * 4, CTR_BYTES = (256 + 4 * 128) * 4;
constexpr size_t OFF_CTR = OFF_BAR + BAR_BYTES;
constexpr size_t OFF_DTRAW = al256(OFF_CTR + CTR_BYTES);
constexpr size_t OFF_DT = OFF_DTRAW + (size_t)NPT * 16 * 4;
constexpr size_t OFF_H = al256(OFF_DT + (size_t)NPT * 16 * 4);
constexpr size_t OFF_PROJ = OFF_H + (size_t)NPT * 1024 * 2;
constexpr size_t OFF_XBCA = OFF_PROJ + (size_t)NPT * INWP * 2;
constexpr size_t OFF_KA = OFF_XBCA + (size_t)NPT * 768 * 2;
constexpr size_t OFF_VAT = OFF_KA + (size_t)KROWS * 128 * 2;
constexpr size_t OFF_CKV = OFF_VAT + (size_t)KROWS * 128 * 2;
constexpr size_t OFF_KRP = OFF_CKV + (size_t)KROWS * 256 * 2;
constexpr size_t OFF_QM = OFF_KRP + (size_t)KROWS * 32 * 2;
constexpr size_t OFF_KN = OFF_QM + (size_t)NPT * 768 * 2;
constexpr size_t OFF_VMT = OFF_KN + (size_t)KROWS * 512 * 2;
constexpr size_t OFF_OS = OFF_VMT + (size_t)KROWS * 512 * 2;
constexpr size_t OFF_OR = OFF_OS + (size_t)2 * NPT * 512 * 2;
constexpr size_t OFF_OM = OFF_OR + (size_t)2 * NPT * 512 * 2;
constexpr size_t OFF_OA = OFF_OM + (size_t)NPT * 512 * 2;
constexpr int NSEG = 4, SEGTOK = 2048 / NSEG;
constexpr size_t OFF_SEG = OFF_OA + (size_t)NPT * 512 * 2;
constexpr size_t OFF_SEGD = OFF_SEG + (size_t)64 * NSEG * 4096 * 2;
constexpr size_t WS_END1 = OFF_SEGD + 64 * NSEG * 4;
constexpr size_t OFF_MERGED = OFF_OS;
constexpr size_t OFF_MO = OFF_XBCA;
constexpr size_t OFF_U = OFF_PROJ;
constexpr size_t OFF_ACT = OFF_QM;
constexpr size_t OFF_FO = OFF_PROJ;
static_assert(OFF_MO + (size_t)NPT * 1024 * 4 <= OFF_MERGED, "MO overlaps MERGED");
static_assert(OFF_U + (size_t)NPT * 5632 * 2 <= OFF_ACT, "U overlaps ACT");
static_assert(OFF_ACT + (size_t)NPT * 2816 * 2 <= WS_END1, "ACT beyond end");
constexpr size_t WS_NEED = WS_END1;

struct Params {
    const float* in[42];
    float* out;
    char* ws;
};
struct Ctx {
    volatile LAS unsigned* tbl;
    __device__ __forceinline__ unsigned long long ld(int i) const {
        const unsigned lo = tbl[2 * i], hi = tbl[2 * i + 1];
        return ((unsigned long long)(unsigned)__builtin_amdgcn_readfirstlane((int)hi) << 32) | (unsigned)__builtin_amdgcn_readfirstlane((int)lo);
    }
    __device__ __forceinline__ const float* in(int i) const { return (const float*)ld(i); }
    __device__ __forceinline__ float* out() const { return (float*)ld(42); }
    __device__ __forceinline__ char* ws() const { return (char*)ld(43); }
};

DI float bf2f(unsigned short h) { return __uint_as_float((unsigned)h << 16); }
DI unsigned short f2bf(float f) { return __builtin_bit_cast(unsigned short, (__bf16)f); }
typedef __bf16 bf16x2_t __attribute__((ext_vector_type(2)));
DI unsigned pk2(float lo, float hi) { bf16x2_t v; v[0] = (__bf16)lo; v[1] = (__bf16)hi; return __builtin_bit_cast(unsigned, v); }
DI void unpack8(const u32x4& w, float* v) {
#pragma unroll
    for (int i = 0; i < 4; ++i) { v[2 * i] = __uint_as_float(w[i] << 16); v[2 * i + 1] = __uint_as_float(w[i] & 0xffff0000u); }
}
DI u32x4 pack8(const float* v) { u32x4 w; w[0] = pk2(v[0], v[1]); w[1] = pk2(v[2], v[3]); w[2] = pk2(v[4], v[5]); w[3] = pk2(v[6], v[7]); return w; }
DI float log1pe(float e) { return e < 1e-4f ? e - 0.5f * e * e : __builtin_amdgcn_logf(1.f + e) * 0.6931471805599453f; }
DI float siluf(float x) { return x / (1.f + __expf(-x)); }
DI float sigmoidf(float x) { return 1.f / (1.f + __expf(-x)); }
DI int lanel() { int l = (int)__lane_id(); asm volatile("" : "+v"(l)); return l; }
DI float shx(float v, int m) { const int l = lanel(); return __int_as_float(__builtin_amdgcn_ds_bpermute((l ^ m) << 2, __float_as_int(v))); }
DI float shf(float v, int src) { return __int_as_float(__builtin_amdgcn_ds_bpermute(src << 2, __float_as_int(v))); }
DI float shu(float v, int d) { const int l = lanel(); const int sidx = (l - d) < 0 ? l : (l - d); return __int_as_float(__builtin_amdgcn_ds_bpermute(sidx << 2, __float_as_int(v))); }
DI float gmax4(float v) {
    auto a = __builtin_amdgcn_permlane16_swap(__float_as_uint(v), __float_as_uint(v), false, false);
    v = fmaxf(__uint_as_float(a[0]), __uint_as_float(a[1]));
    auto b = __builtin_amdgcn_permlane32_swap(__float_as_uint(v), __float_as_uint(v), false, false);
    return fmaxf(__uint_as_float(b[0]), __uint_as_float(b[1]));
}
DI float gsum4(float v) {
    auto a = __builtin_amdgcn_permlane16_swap(__float_as_uint(v), __float_as_uint(v), false, false);
    v = __uint_as_float(a[0]) + __uint_as_float(a[1]);
    auto b = __builtin_amdgcn_permlane32_swap(__float_as_uint(v), __float_as_uint(v), false, false);
    return __uint_as_float(b[0]) + __uint_as_float(b[1]);
}
DI float wsum(float v) {
#pragma unroll
    for (int o = 32; o >= 1; o >>= 1) v += shx(v, o);
    return v;
}
typedef const __attribute__((address_space(1))) u32x4* gp128;
DI u32x4 gld16(const void* p) { return *(gp128)(unsigned long long)p; }
DI void st_wt8(void* p, u32x2 v) { __hip_atomic_store((unsigned long long*)p, ((unsigned long long)v[1] << 32) | v[0], __ATOMIC_RELAXED, __HIP_MEMORY_SCOPE_AGENT); }
DI void st_wt16(void* p, u32x4 v) { st_wt8(p, (u32x2){v[0], v[1]}); st_wt8((char*)p + 8, (u32x2){v[2], v[3]}); }
DI void st_wt2(bf16_t* p, bf16_t v) { __hip_atomic_store(p, v, __ATOMIC_RELAXED, __HIP_MEMORY_SCOPE_AGENT); }
DI void st_wt4f(float* p, float v) { __hip_atomic_store(p, v, __ATOMIC_RELAXED, __HIP_MEMORY_SCOPE_AGENT); }
DI int launder(int x) { asm volatile("" : "+v"(x)); return x; }
DI int launder_s(int x) { asm volatile("" : "+s"(x)); return x; }
#define BIDX launder_s((int)blockIdx.x)
DI int FQ(int q) { return (4 - q) & 3; }
DI int tile_off(int rows, int ks, int row, int g, int q) { return (ks * rows + row) * 64 + ((g ^ FQ(q)) << 4); }

#define XB_TMO      128
#define XB_XCNT(j)  (256  + 64 * (j))
#define XB_XSUB(j)  (1280 + 64 * (j))
#define XB_XGEN(j)  (2304 + 64 * (j))
#define XB_TOP      3328
#define XB_TOPGEN   3392
#define XB_SPIN_CAP (1u << 22)
DI unsigned xb_ld(unsigned* p) { return __hip_atomic_load(p, __ATOMIC_RELAXED, __HIP_MEMORY_SCOPE_AGENT); }
DI unsigned xb_add(unsigned* p, unsigned v) { return __hip_atomic_fetch_add(p, v, __ATOMIC_RELAXED, __HIP_MEMORY_SCOPE_AGENT); }
DI unsigned xb_xcc_id() { return (unsigned)__builtin_amdgcn_s_getreg((3 << 11) | 20) & 0xFu; }
#define XB_SPIN(cond, bar) do { unsigned _sp = 0; while (cond) { __builtin_amdgcn_s_sleep(1); \
    if ((++_sp & 255u) == 0u) { if (xb_ld(&(bar)[XB_TMO])) break; if (_sp > XB_SPIN_CAP) { atomicAdd(&(bar)[XB_TMO], 1u); break; } } } } while (0)
struct XcdBarrier { unsigned* bar; unsigned x; volatile LAS unsigned* st; };
DI XcdBarrier xcd_barrier_post(unsigned* bar, volatile LAS unsigned* st, int tid) {
    XcdBarrier b; b.bar = bar; b.x = xb_xcc_id(); b.st = st;
    if (tid == 0) (void)xb_add(&bar[XB_XCNT(b.x)], 1u);
    return b;
}
DI void xcd_barrier_complete(unsigned* bar, unsigned x, unsigned& nloc, unsigned& nx) {
    const unsigned G = gridDim.x * gridDim.y * gridDim.z;
    unsigned sum, cnt, mine, sp = 0u;
    for (;;) {
        sum = 0u; cnt = 0u; mine = 0u;
#pragma unroll
        for (unsigned j = 0; j < 16; ++j) { const unsigned c = xb_ld(&bar[XB_XCNT(j)]); sum += c; cnt += (c > 0u) ? 1u : 0u; mine = (j == x) ? c : mine; }
        if (sum == G) break;
        __builtin_amdgcn_s_sleep(1);
        if ((++sp & 255u) == 0u) { if (xb_ld(&bar[XB_TMO])) break; if (sp > XB_SPIN_CAP) { atomicAdd(&bar[XB_TMO], 1u); break; } }
    }
    nloc = mine > 0u ? mine : 1u; nx = cnt > 0u ? cnt : 1u;
}
DI void xcd_barrier(const XcdBarrier& b, int tid) {
    asm volatile("s_waitcnt vmcnt(0)" ::: "memory");
    __syncthreads();
    if (tid == 0) {
        unsigned* bar = b.bar;
        __builtin_amdgcn_s_waitcnt(0);
        unsigned nloc = b.st[0], nx = b.st[1];
        if (nloc == 0u) { xcd_barrier_complete(bar, b.x, nloc, nx); b.st[0] = nloc; b.st[1] = nx; }
        const unsigned old = xb_add(&bar[XB_XSUB(b.x)], 1u);
        const unsigned gen = old / nloc;
        if (old + 1u == (gen + 1u) * nloc) {
            __builtin_amdgcn_fence(__ATOMIC_RELEASE, "agent");
            asm volatile("s_waitcnt vmcnt(0)" ::: "memory");
            const unsigned og = xb_add(&bar[XB_TOP], 1u);
            const unsigned tg = og / nx;
            if (og + 1u == (tg + 1u) * nx) xb_add(&bar[XB_TOPGEN], 1u);
            else XB_SPIN(xb_ld(&bar[XB_TOPGEN]) == tg, bar);
            __builtin_amdgcn_fence(__ATOMIC_ACQUIRE, "agent");
            xb_add(&bar[XB_XGEN(b.x)], 1u);
            asm volatile("s_waitcnt vmcnt(0)" ::: "memory");
        } else {
            XB_SPIN(xb_ld(&bar[XB_XGEN(b.x)]) == gen, bar);
            __builtin_amdgcn_fence(__ATOMIC_ACQUIRE, "agent");
            asm volatile("s_waitcnt vmcnt(0)" ::: "memory");
        }
    }
    __syncthreads();
}

struct Tok { int lat, b, t, L, cond, krow, seq0; size_t gx; };
DI Tok tok_info(int m, int ps) {
    Tok k;
    if (m < 4096) { k.lat = 0; k.b = ps * 16 + (m >> 8); k.t = m & 255; k.L = 256; k.cond = 0; k.krow = m; k.seq0 = m & ~255; k.gx = (size_t)ps * 4096 + m; }
    else { const int mm = m - 4096, j = mm >> 11; k.lat = 1; k.b = ps * 2 + j; k.t = mm & 2047; k.L = 2048; k.cond = 1 + k.b; k.krow = 4096 + j * 2304 + 256 + k.t;
           k.seq0 = 4096 + j * 2048; k.gx = (size_t)8192 + (size_t)ps * 4096 + mm; }
    return k;
}

template <int NTA, int NTB, bool LOWREG = false>
DI void gemm_kloop(f32x4 (&acc)[NTA][NTB], const bf16_t* __restrict__ W, size_t ldw, const bf16_t* __restrict__ X, size_t ldx, int K, char* smem, int tid) {
    constexpr int BF = 32 * NTA, BT = 32 * NTB;
    constexpr int WB = BF * 128, STG = (BF + BT) * 128;
    constexpr int NPW = BF / 8, NPX = BT / 8, NPIECE = NPW + NPX, PPW = NPIECE / 4;
    static_assert(NPIECE % 4 == 0, "pieces must divide over 4 waves");
    tid = launder(tid);
    const int lane = tid & 63, wv = tid >> 6, wn = wv >> 1, wt = wv & 1, fr = lane & 15, g = lane >> 4;
    constexpr int PWW = NPW / 4, PXX = PPW - PWW;
    const int wvu = __builtin_amdgcn_readfirstlane(wv);
    auto lane_off = [&](int j, int ln) -> unsigned {
        const bool isw = j < PWW;
        const int pp = isw ? wvu * PWW + j : wvu * PXX + (j - PWW);
        const int rows = isw ? BF : BT;
        const int rb = pp % (rows / 16);
        const int rl = ln >> 2;
        const int q = isw ? (((rb * 16 + rl) / (4 * NTA)) & 3) : ((rl >> 2) & 3);
        const int gl = (ln & 3) ^ FQ(q);
        return (unsigned)rl * (unsigned)(isw ? ldw : ldx) + (unsigned)(gl * 8);
    };
    unsigned poff[PPW];
    if (!LOWREG) {
#pragma unroll
        for (int j = 0; j < PPW; ++j) poff[j] = lane_off(j, lane);
    }
    auto issue = [&](int k0, char* sdst) {
        const int ln = LOWREG ? launder(lane) : lane;
#pragma unroll
        for (int j = 0; j < PPW; ++j) {
            const bool isw = j < PWW;
            const int pp = isw ? wvu * PWW + j : wvu * PXX + (j - PWW);
            const int rows = isw ? BF : BT;
            const int ks = pp / (rows / 16), rb = pp % (rows / 16);
            const bf16_t* base = (isw ? W + (size_t)(rb * 16) * ldw : X + (size_t)(rb * 16) * ldx) + k0 + ks * 32;
            const unsigned off = LOWREG ? lane_off(j, ln) : poff[j];
            __builtin_amdgcn_global_load_lds((const unsigned*)(base + off), (unsigned*)(sdst + (isw ? 0 : WB) + (ks * rows + rb * 16) * 64), 16, 0, 0);
        }
    };
    const int aoff = tile_off(BF, 0, wn * 16 * NTA + 4 * NTA * (fr >> 2) + (fr & 3), g, fr >> 2);
    const int boff = WB + tile_off(BT, 0, wt * 16 * NTB + fr, g, (fr >> 2) & 3);
    const int nk = K >> 6;
    issue(0, smem);
    asm volatile("s_waitcnt vmcnt(0)" ::: "memory");
    __syncthreads();
    for (int kt = 0; kt < nk; ++kt) {
        if (kt + 1 < nk) issue((kt + 1) << 6, smem + ((kt + 1) & 1) * STG);
        const char* sb = smem + (kt & 1) * STG;
        __builtin_amdgcn_s_setprio(1);
#pragma unroll
        for (int kk = 0; kk < 2; ++kk) {
            if (LOWREG) {
                bf16x8 bfr[NTB];
#pragma unroll
                for (int mt = 0; mt < NTB; ++mt) bfr[mt] = *(const bf16x8*)(sb + boff + mt * 1024 + kk * BT * 64);
#pragma unroll
                for (int a = 0; a < NTA; ++a) {
                    const bf16x8 af1 = *(const bf16x8*)(sb + aoff + a * 256 + kk * BF * 64);
#pragma unroll
                    for (int mt = 0; mt < NTB; ++mt) acc[a][mt] = __builtin_amdgcn_mfma_f32_16x16x32_bf16(af1, bfr[mt], acc[a][mt], 0, 0, 0);
                    __builtin_amdgcn_sched_barrier(0);
                }
            } else {
                bf16x8 af[NTA], bfr[NTB];
#pragma unroll
                for (int a = 0; a < NTA; ++a) af[a] = *(const bf16x8*)(sb + aoff + a * 256 + kk * BF * 64);
#pragma unroll
                for (int mt = 0; mt < NTB; ++mt) bfr[mt] = *(const bf16x8*)(sb + boff + mt * 1024 + kk * BT * 64);
#pragma unroll
                for (int a = 0; a < NTA; ++a)
#pragma unroll
                    for (int mt = 0; mt < NTB; ++mt) acc[a][mt] = __builtin_amdgcn_mfma_f32_16x16x32_bf16(af[a], bfr[mt], acc[a][mt], 0, 0, 0);
            }
        }
        __builtin_amdgcn_s_setprio(0);
        asm volatile("s_waitcnt vmcnt(0)" ::: "memory");
        __syncthreads();
    }
}

DI void gemm_kloop_wide(f32x4 (&acc)[8][4], const bf16_t* __restrict__ W, size_t ldw, const bf16_t* __restrict__ X, size_t ldx, int K, char* smem, int tid) {
    constexpr int BF = 256, BT = 128, WB = BF * 64, STG = (BF + BT) * 64;
    tid = launder(tid);
    const int lane = tid & 63, wv = tid >> 6, wn = wv >> 1, wt = wv & 1, fr = lane & 15, g = lane >> 4;
    const int wvu = __builtin_amdgcn_readfirstlane(wv);
    unsigned poff[6];
#pragma unroll
    for (int j = 0; j < 6; ++j) {
        const bool isw = j < 4;
        const int rb = isw ? wvu * 4 + j : wvu * 2 + (j - 4);
        const int rl = lane >> 2;
        const int q = isw ? (((rb * 16 + rl) >> 5) & 3) : ((rl >> 2) & 3);
        const int gl = (lane & 3) ^ FQ(q);
        poff[j] = (unsigned)rl * (unsigned)(isw ? ldw : ldx) + (unsigned)(gl * 8);
    }
    auto issue = [&](int k0, char* sdst) {
#pragma unroll
        for (int j = 0; j < 6; ++j) {
            const bool isw = j < 4;
            const int rb = isw ? wvu * 4 + j : wvu * 2 + (j - 4);
            const bf16_t* base = (isw ? W + (size_t)(rb * 16) * ldw : X + (size_t)(rb * 16) * ldx) + k0;
            __builtin_amdgcn_global_load_lds((const unsigned*)(base + poff[j]), (unsigned*)(sdst + (isw ? 0 : WB) + rb * 16 * 64), 16, 0, 0);
        }
    };
    const int aoff = tile_off(BF, 0, wn * 128 + 32 * (fr >> 2) + (fr & 3), g, fr >> 2);
    const int boff = WB + tile_off(BT, 0, wt * 64 + fr, g, (fr >> 2) & 3);
    const int nk = K >> 5;
    issue(0, smem);
    asm volatile("s_waitcnt vmcnt(0)" ::: "memory");
    __syncthreads();
    for (int kt = 0; kt < nk; ++kt) {
        if (kt + 1 < nk) issue((kt + 1) << 5, smem + ((kt + 1) & 1) * STG);
        const char* sb = smem + (kt & 1) * STG;
        __builtin_amdgcn_s_setprio(1);
        {
            bf16x8 bfr[4];
#pragma unroll
            for (int mt = 0; mt < 4; ++mt) bfr[mt] = *(const bf16x8*)(sb + boff + mt * 1024);
#pragma unroll
            for (int h2 = 0; h2 < 2; ++h2) {
                bf16x8 af[4];
#pragma unroll
                for (int a = 0; a < 4; ++a) af[a] = *(const bf16x8*)(sb + aoff + (4 * h2 + a) * 256);
#pragma unroll
                for (int a = 0; a < 4; ++a)
#pragma unroll
                    for (int mt = 0; mt < 4; ++mt) acc[4 * h2 + a][mt] = __builtin_amdgcn_mfma_f32_16x16x32_bf16(af[a], bfr[mt], acc[4 * h2 + a][mt], 0, 0, 0);
            }
        }
        __builtin_amdgcn_s_setprio(0);
        asm volatile("s_waitcnt vmcnt(0)" ::: "memory");
        __syncthreads();
    }
}

struct WTile { const float* src; bf16_t* dst; int K, N, k0, n0; };
DI WTile wtile_decode(const Ctx& p, int it) {
    constexpr int T_IN = 16 * 68, T_M = 16 * 64, T_UQ = 6 * 12, T_UKV = 4 * 16, T_BR = 8 * 16, T_OUT = 16 * 16, T_UP = 16 * 88, T_DN = 44 * 16;
    constexpr int T_LAYER = T_IN + T_M + T_UQ + T_UKV + 4 * T_BR + T_OUT + T_UP + T_DN;
    char* ws = p.ws();
    const int l = it / T_LAYER; int k = it % T_LAYER;
    WTile t; int ntn;
    if (k < T_IN) { t.src = p.in(16) + (size_t)l * 1024 * INW; t.dst = (bf16_t*)(ws + OFF_WIN) + (size_t)l * SZ_WIN; t.K = 1024; t.N = INW; ntn = 68; }
    else if ((k -= T_IN) < T_M) { t.src = p.in(35) + (size_t)l * 1024 * 4096; t.dst = (bf16_t*)(ws + OFF_WM) + (size_t)l * SZ_WM; t.K = 1024; t.N = 4096; ntn = 64; }
    else if ((k -= T_M) < T_UQ) { t.src = p.in(28) + (size_t)l * 384 * 768; t.dst = (bf16_t*)(ws + OFF_WUQ) + (size_t)l * SZ_WUQ; t.K = 384; t.N = 768; ntn = 12; }
    else if ((k -= T_UQ) < T_UKV) { t.src = p.in(30) + (size_t)l * 256 * 1024; t.dst = (bf16_t*)(ws + OFF_WUKV) + (size_t)l * SZ_WUKV; t.K = 256; t.N = 1024; ntn = 16; }
    else if ((k -= T_UKV) < 4 * T_BR) { const int j = k / T_BR; k -= j * T_BR; t.src = (j == 0 ? p.in(31) : j == 1 ? p.in(32) : j == 2 ? p.in(33) : p.in(34)) + (size_t)l * 512 * 1024;
                                        t.dst = (bf16_t*)(ws + OFF_WBR) + (size_t)(l * 4 + j) * 1024 * 512; t.K = 512; t.N = 1024; ntn = 16; }
    else if ((k -= 4 * T_BR) < T_OUT) { t.src = p.in(37) + (size_t)l * 1024 * 1024; t.dst = (bf16_t*)(ws + OFF_WOUT) + (size_t)l * SZ_WOUT; t.K = 1024; t.N = 1024; ntn = 16; }
    else if ((k -= T_OUT) < T_UP) { t.src = p.in(38) + (size_t)l * 1024 * 5632; t.dst = (bf16_t*)(ws + OFF_WUP) + (size_t)l * SZ_WUP; t.K = 1024; t.N = 5632; ntn = 88; }
    else { k -= T_UP; t.src = p.in(41) + (size_t)l * 2816 * 1024; t.dst = (bf16_t*)(ws + OFF_WDN) + (size_t)l * SZ_WDN; t.K = 2816; t.N = 1024; ntn = 16; }
    t.k0 = (k / ntn) * 64; t.n0 = (k % ntn) * 64;
    return t;
}
DI void wtile_load(const WTile& t, int tid, f32x4 (&v)[4]) {
    const int r = tid >> 4, c4 = tid & 15;
#pragma unroll
    for (int i = 0; i < 4; ++i) {
        v[i] = (f32x4){0.f, 0.f, 0.f, 0.f};
        if (t.n0 + 4 * c4 < t.N) v[i] = *(const f32x4*)(t.src + (size_t)(t.k0 + r + 16 * i) * t.N + t.n0 + 4 * c4);
    }
}
DI void wtile_finish(const WTile& t, const f32x4 (&v)[4], char* smem, int tid) {
    float* tl = (float*)smem;
    const int r = tid >> 4, c4 = tid & 15;
#pragma unroll
    for (int i = 0; i < 4; ++i) {
        const int row = r + 16 * i;
        tl[row * 65 + 4 * c4 + 0] = v[i][0]; tl[row * 65 + 4 * c4 + 1] = v[i][1]; tl[row * 65 + 4 * c4 + 2] = v[i][2]; tl[row * 65 + 4 * c4 + 3] = v[i][3];
    }
    __syncthreads();
#pragma unroll
    for (int i = 0; i < 2; ++i) {
        const int q = tid + 256 * i, n = q >> 3, c = q & 7;
        float o[8];
#pragma unroll
        for (int j = 0; j < 8; ++j) o[j] = tl[(8 * c + j) * 65 + n];
        *(u32x4*)(t.dst + (size_t)(t.n0 + n) * t.K + t.k0 + 8 * c) = pack8(o);
    }
    __syncthreads();
}

DI void phase_prep_w(const Ctx& p, char* smem, int tid) {
    char* ws = p.ws();
    constexpr int T_IN = 16 * 68, T_M = 16 * 64, T_UQ = 6 * 12, T_UKV = 4 * 16, T_BR = 8 * 16, T_OUT = 16 * 16, T_UP = 16 * 88, T_DN = 44 * 16;
    constexpr int T_LAYER = T_IN + T_M + T_UQ + T_UKV + 4 * T_BR + T_OUT + T_UP + T_DN;
    constexpr int N_MOD = 2 * 96;
    const int total = 2 * T_LAYER + N_MOD + 1;
    constexpr int N_MODI = 2 * 192;
    for (int it = BIDX; it < N_MODI + 1; it += gridDim.x) {
        if (it < N_MODI) {
            const int l = it / 192, cb = it % 192;
            float* sc = (float*)smem;
            float* red = sc + 5 * 1024;
            __syncthreads();
            for (int e = tid; e < 5 * 1024; e += 256) {
                const int c = e >> 10, kk = e & 1023;
                const float v = (c == 0) ? p.in(9)[kk] : p.in(8)[(c - 1) * 1024 + kk];
                sc[e] = siluf(v);
            }
            __syncthreads();
            const int col = tid & 31, kg = tid >> 5;
            float a[5] = {0.f, 0.f, 0.f, 0.f, 0.f};
            const float* w = p.in(10) + ((size_t)l * 1024 + kg * 128) * 6144 + cb * 32 + col;
#pragma unroll 1
            for (int k0 = 0; k0 < 128; k0 += 16) {
                float wv[16];
#pragma unroll
                for (int j = 0; j < 16; ++j) wv[j] = w[(size_t)(k0 + j) * 6144];
#pragma unroll
                for (int j = 0; j < 16; ++j)
#pragma unroll
                    for (int c = 0; c < 5; ++c) a[c] += wv[j] * sc[c * 1024 + kg * 128 + k0 + j];
            }
#pragma unroll
            for (int c = 0; c < 5; ++c) red[(kg * 5 + c) * 32 + col] = a[c];
            __syncthreads();
            if (tid < 160) {
                const int c = tid >> 5, cl = tid & 31;
                float sm = 0.f;
#pragma unroll
                for (int k8 = 0; k8 < 8; ++k8) sm += red[(k8 * 5 + c) * 32 + cl];
                float* mod = (float*)(ws + OFF_MOD);
                mod[((size_t)l * 5 + c) * 6144 + cb * 32 + cl] = sm + p.in(11)[(size_t)l * 6144 + cb * 32 + cl];
            }
            __syncthreads();
        } else {
            float* t16 = (float*)(ws + OFF_T16); float* t8 = (float*)(ws + OFF_T8);
            for (int e = tid; e < 64 * 16 + 64 * 8; e += 256) {
                const bool small = e >= 1024;
                const int ee = small ? e - 1024 : e;
                const int pos = small ? (ee >> 3) : (ee >> 4), i = small ? (ee & 7) : (ee & 15);
                const double r = small ? 0.31622776601683794 : 0.5623413251903491;
                double th = 1.0;
                for (int j = 0; j < i; ++j) th *= r;
                const double t2 = th * th;
                double c1 = 1.0, s1 = th;
                double tc = 1.0, tsn = th;
                for (int k = 1; k < 14; ++k) {
                    tc = -tc * t2 / (double)((2 * k - 1) * (2 * k));
                    tsn = -tsn * t2 / (double)((2 * k) * (2 * k + 1));
                    c1 += tc; s1 += tsn;
                }
                double c = 1.0, sn = 0.0;
                for (int j = 0; j < pos; ++j) { const double cn = c * c1 - sn * s1, snn = sn * c1 + c * s1; c = cn; sn = snn; }
                if (small) { t8[ee] = (float)c; t8[512 + ee] = (float)sn; } else { t16[ee] = (float)c; t16[1024 + ee] = (float)sn; }
            }
        }
    }
    {
        int it = BIDX;
        f32x4 va[4];
        if (it < 2 * T_LAYER) { const WTile c0 = wtile_decode(p, it); wtile_load(c0, tid, va); }
        while (it < 2 * T_LAYER) {
            const int nx = it + gridDim.x;
            f32x4 vb[4];
            if (nx < 2 * T_LAYER) { const WTile nt = wtile_decode(p, nx); wtile_load(nt, tid, vb); }
            { const WTile cur = wtile_decode(p, launder(it)); wtile_finish(cur, va, smem, tid); }
#pragma unroll
            for (int i = 0; i < 4; ++i) va[i] = vb[i];
            it = nx;
        }
    }
}

DI void row_load(const float* r, int lane, f32x4 (&v)[4]) {
#pragma unroll
    for (int i = 0; i < 4; ++i) v[i] = *(const f32x4*)(r + 4 * lane + 256 * i);
}
DI float row_ss(const f32x4 (&v)[4]) {
    float s = 0.f;
#pragma unroll
    for (int i = 0; i < 4; ++i) s += v[i][0] * v[i][0] + v[i][1] * v[i][1] + v[i][2] * v[i][2] + v[i][3] * v[i][3];
    return wsum(s);
}
DI void row_modnorm_store(const f32x4 (&x)[4], const float* gw, const float* sh, const float* sc, bf16_t* dst, int lane) {
    const float rstd = rsqrtf(row_ss(x) * (1.f / 1024.f) + EPS);
#pragma unroll
    for (int i = 0; i < 4; ++i) {
        const int c = 4 * lane + 256 * i;
        const f32x4 g = *(const f32x4*)(gw + c), s = *(const f32x4*)(sh + c), q = *(const f32x4*)(sc + c);
        float o[4];
#pragma unroll
        for (int j = 0; j < 4; ++j) o[j] = (x[i][j] * rstd) * g[j] * (1.f + q[j]) + s[j];
        u32x2 w; w[0] = pk2(o[0], o[1]); w[1] = pk2(o[2], o[3]);
        *(u32x2*)(dst + c) = w;
    }
}
DI const float* x_in_row(const Ctx& p, int m, int ps) {
    return (m < 4096) ? p.in(0) + ((size_t)ps * 4096 + m) * 1024 : p.in(1) + ((size_t)ps * 4096 + (m - 4096)) * 1024;
}
DI void phase_h1(const Ctx& p, int ps, int tid) {
    const int lane = tid & 63, wv = tid >> 6;
    const float* mod = (const float*)(p.ws() + OFF_MOD);
    bf16_t* H = (bf16_t*)(p.ws() + OFF_H);
    for (int m = BIDX * 4 + wv; m < NPT; m += gridDim.x * 4) {
        const Tok k = tok_info(m, ps);
        f32x4 x[4]; row_load(x_in_row(p, m, ps), lane, x);
        const float* md = mod + (size_t)(0 * 5 + k.cond) * 6144;
        row_modnorm_store(x, p.in(12), md + 0, md + 1024, H + (size_t)m * 1024, lane);
    }
}
DI void phase_res(const Ctx& p, int ps, int l, int which, int tid) {
    const int lane = tid & 63, wv = tid >> 6;
    const float* mod = (const float*)(p.ws() + OFF_MOD);
    bf16_t* H = (bf16_t*)(p.ws() + OFF_H);
    const float* Y = (const float*)(p.ws() + (which ? OFF_FO : OFF_MO));
    const float* gpost = (which ? p.in(15) : p.in(13)) + (size_t)l * 1024;
    const int bid = BIDX, rbase = (bid & 7) * 1024 + (bid >> 3) * 4 + wv, rstep = (gridDim.x >> 3) * 4;
    for (int mo = 0; (bid >> 3) * 4 + wv + mo < 1024; mo += rstep) {
        const int m = rbase + mo;
        const Tok k = tok_info(m, ps);
        const float* md = mod + (size_t)(l * 5 + k.cond) * 6144;
        const float* gate = md + (which ? 5 * 1024 : 2 * 1024);
        f32x4 x[4], y[4];
        if (l == 0 && which == 0) row_load(x_in_row(p, m, ps), lane, x); else row_load(p.out() + k.gx * 1024, lane, x);
        row_load(Y + (size_t)m * 1024, lane, y);
        const float rstd = rsqrtf(row_ss(y) * (1.f / 1024.f) + EPS);
#pragma unroll
        for (int i = 0; i < 4; ++i) {
            const int c = 4 * lane + 256 * i;
            const f32x4 g = *(const f32x4*)(gate + c), w = *(const f32x4*)(gpost + c);
#pragma unroll
            for (int j = 0; j < 4; ++j) x[i][j] = x[i][j] + g[j] * ((y[i][j] * rstd) * w[j]);
            *(f32x4*)(p.out() + k.gx * 1024 + c) = x[i];
        }
        if (which == 0) row_modnorm_store(x, p.in(14) + (size_t)l * 1024, md + 3 * 1024, md + 4 * 1024, H + (size_t)m * 1024, lane);
        else if (l + 1 < 2) { const float* md2 = mod + (size_t)((l + 1) * 5 + k.cond) * 6144;
                              row_modnorm_store(x, p.in(12) + (size_t)(l + 1) * 1024, md2, md2 + 1024, H + (size_t)m * 1024, lane); }
    }
}

DI bool xcd_tile(int it, int Mt, int Nt, int B, int& mt, int& nt) {
    const int x = BIDX & 7, loc = BIDX >> 3, nloc = gridDim.x >> 3;
    const int MP = Mt >> 3;
    const int idx = it * nloc + loc;
    if (idx >= MP * Nt) return false;
    const int ng = idx / (MP * B);
    const int bw = min(B, Nt - ng * B);
    const int r = idx - ng * MP * B;
    mt = x * MP + r / bw; nt = ng * B + r % bw;
    return true;
}
DI void gemm_wide_tile(const Ctx& p, const bf16_t* W, const bf16_t* X, int m0, int n0, bf16_t* out, size_t ldo, bool dtcol, char* smem, int tid) {
    f32x4 acc[8][4];
#pragma unroll
    for (int a = 0; a < 8; ++a)
#pragma unroll
        for (int b = 0; b < 4; ++b) acc[a][b] = (f32x4){0.f, 0.f, 0.f, 0.f};
    gemm_kloop_wide(acc, W + (size_t)n0 * 1024, 1024, X + (size_t)m0 * 1024, 1024, 1024, smem, tid);
    const int t2 = launder(tid);
    const int lane = t2 & 63, wv = t2 >> 6, wn = wv >> 1, wt = wv & 1, fr = lane & 15, g = lane >> 4;
    const int fb = n0 + wn * 128 + 32 * g;
#pragma unroll
    for (int mt = 0; mt < 4; ++mt) {
        const int m = m0 + wt * 64 + 16 * mt + fr;
        bf16_t* d = out + (size_t)m * ldo + fb;
#pragma unroll
        for (int h2 = 0; h2 < 4; ++h2) {
            float v[8];
#pragma unroll
            for (int r = 0; r < 4; ++r) { v[r] = acc[2 * h2][mt][r]; v[4 + r] = acc[2 * h2 + 1][mt][r]; }
            *(u32x4*)(d + 8 * h2) = pack8(v);
        }
        if (dtcol && fb == C_DT) {
            float* dd = (float*)(p.ws() + OFF_DTRAW) + (size_t)m * 16;
#pragma unroll
            for (int a = 0; a < 4; ++a) *(f32x4*)(dd + 4 * a) = acc[a][mt];
        }
    }
}
DI void phase_gemm_in(const Ctx& p, int l, char* smem, int tid) {
    for (int it = 0;; ++it) {
        int mt0, nt0; if (!xcd_tile(it, 64, 16, 8, mt0, nt0)) break;
        gemm_wide_tile(p, (const bf16_t*)(p.ws() + OFF_WIN) + (size_t)l * SZ_WIN, (const bf16_t*)(p.ws() + OFF_H), mt0 * 128, nt0 * 256,
                       (bf16_t*)(p.ws() + OFF_PROJ), INWP, true, smem, tid);
    }
    const bf16_t* W = (const bf16_t*)(p.ws() + OFF_WIN) + (size_t)l * SZ_WIN;
    const bf16_t* X = (const bf16_t*)(p.ws() + OFF_H);
    bf16_t* PROJ = (bf16_t*)(p.ws() + OFF_PROJ);
    const int lane = tid & 63, wv = tid >> 6, wn = wv >> 1, wt = wv & 1, fr = lane & 15, g = lane >> 4;
    for (int it = 0;; ++it) {
        int mt0, nt0; if (!xcd_tile(it, 64, 2, 8, mt0, nt0)) break;
        const int m0 = mt0 * 128, n0 = 4096 + nt0 * 128;
        f32x4 acc[4][4];
#pragma unroll
        for (int a = 0; a < 4; ++a)
#pragma unroll
            for (int b = 0; b < 4; ++b) acc[a][b] = (f32x4){0.f, 0.f, 0.f, 0.f};
        gemm_kloop<4, 4>(acc, W + (size_t)n0 * 1024, 1024, X + (size_t)m0 * 1024, 1024, 1024, smem, tid);
        const int fb = n0 + wn * 64 + 16 * g;
#pragma unroll
        for (int mt = 0; mt < 4; ++mt) {
            const int m = m0 + wt * 64 + 16 * mt + fr;
            float v[16];
#pragma unroll
            for (int a = 0; a < 4; ++a)
#pragma unroll
                for (int r = 0; r < 4; ++r) v[4 * a + r] = acc[a][mt][r];
            bf16_t* d = PROJ + (size_t)m * INWP + fb;
            *(u32x4*)d = pack8(v); *(u32x4*)(d + 8) = pack8(v + 8);
        }
    }
}

DI void phase_gemm_up(const Ctx& p, int l, char* smem, int tid) {
    for (int it = 0;; ++it) {
        int mt0, nt0; if (!xcd_tile(it, 64, 22, 8, mt0, nt0)) break;
        gemm_wide_tile(p, (const bf16_t*)(p.ws() + OFF_WUP) + (size_t)l * SZ_WUP, (const bf16_t*)(p.ws() + OFF_H), mt0 * 128, nt0 * 256,
                       (bf16_t*)(p.ws() + OFF_U), 5632, false, smem, tid);
    }
}

template <bool F32OUT>
DI void phase_gemm_plain(const bf16_t* W, int K, const bf16_t* X, size_t ldx, int Mtiles, int Ntiles, void* out, size_t ldo, char* smem, int tid) {
    const int lane = tid & 63, wv = tid >> 6, wn = wv >> 1, wt = wv & 1, fr = lane & 15, g = lane >> 4;
    for (int it = 0;; ++it) {
        int mt0, nt0; if (!xcd_tile(it, Mtiles, Ntiles, 8, mt0, nt0)) break;
        const int m0 = mt0 * 128, n0 = nt0 * 128;
        f32x4 acc[4][4];
#pragma unroll
        for (int a = 0; a < 4; ++a)
#pragma unroll
            for (int b = 0; b < 4; ++b) acc[a][b] = (f32x4){0.f, 0.f, 0.f, 0.f};
        gemm_kloop<4, 4>(acc, W + (size_t)n0 * K, K, X + (size_t)m0 * ldx, ldx, K, smem, tid);
        const int fb = n0 + wn * 64 + 16 * g;
#pragma unroll
        for (int mt = 0; mt < 4; ++mt) {
            const int m = m0 + wt * 64 + 16 * mt + fr;
            if (F32OUT) {
                float* d = (float*)out + (size_t)m * ldo + fb;
#pragma unroll
                for (int a = 0; a < 4; ++a) *(f32x4*)(d + 4 * a) = acc[a][mt];
            } else {
                float v[16];
#pragma unroll
                for (int a = 0; a < 4; ++a)
#pragma unroll
                    for (int r = 0; r < 4; ++r) v[4 * a + r] = acc[a][mt][r];
                bf16_t* d = (bf16_t*)out + (size_t)m * ldo + fb;
                *(u32x4*)d = pack8(v); *(u32x4*)(d + 8) = pack8(v + 8);
            }
        }
    }
}

DI void gemm_uq_tile(const Ctx& p, int l, int ps, int tile, char* smem, int tid) {
    const bf16_t* W = (const bf16_t*)(p.ws() + OFF_WUQ) + (size_t)l * SZ_WUQ;
    const bf16_t* X = (const bf16_t*)(p.ws() + OFF_PROJ) + C_MCQ;
    bf16_t* QM = (bf16_t*)(p.ws() + OFF_QM);
    const float* t8 = (const float*)(p.ws() + OFF_T8);
    const int lane = tid & 63, wv = tid >> 6, wn = wv >> 1, wt = wv & 1, fr = lane & 15, g = lane >> 4;
    const int mt0 = tile / 6, nt0 = tile % 6, m0 = mt0 * 128, n0 = nt0 * 128;
    f32x4 acc[4][4];
#pragma unroll
    for (int a = 0; a < 4; ++a)
#pragma unroll
        for (int b = 0; b < 4; ++b) acc[a][b] = (f32x4){0.f, 0.f, 0.f, 0.f};
    gemm_kloop<4, 4>(acc, W + (size_t)n0 * 384, 384, X + (size_t)m0 * INWP, INWP, 384, smem, tid);
    const int fb = n0 + wn * 64 + 16 * g;
    const int o = fb % 96;
#pragma unroll
    for (int mt = 0; mt < 4; ++mt) {
        const int m = m0 + wt * 64 + 16 * mt + fr;
        float v[16];
#pragma unroll
        for (int a = 0; a < 4; ++a)
#pragma unroll
            for (int r = 0; r < 4; ++r) v[4 * a + r] = acc[a][mt][r];
        if (m >= 4096 && o >= 64) {
            const int t = (m - 4096) & 2047;
            const int pos = (o == 64) ? (t >> 6) : (t & 63);
#pragma unroll
            for (int j = 0; j < 8; ++j) {
                const float c = t8[pos * 8 + j], s = t8[512 + pos * 8 + j];
                const float x1 = v[j], x2 = v[j + 8];
                v[j] = x1 * c - x2 * s; v[j + 8] = x2 * c + x1 * s;
            }
        }
        bf16_t* d = QM + (size_t)m * 768 + fb;
        st_wt16(d, pack8(v)); st_wt16(d + 8, pack8(v + 8));
    }
}

DI void gemm_ukv_tile(const Ctx& p, int l, int tile, char* smem, int tid) {
    const bf16_t* W = (const bf16_t*)(p.ws() + OFF_WUKV) + (size_t)l * SZ_WUKV;
    const bf16_t* X = (const bf16_t*)(p.ws() + OFF_CKV);
    bf16_t* KN = (bf16_t*)(p.ws() + OFF_KN);
    bf16_t* VMT = (bf16_t*)(p.ws() + OFF_VMT);
    const int lane = tid & 63, wv = tid >> 6, wn = wv >> 1, wt = wv & 1, fr = lane & 15, g = lane >> 4;
    const int mt0 = tile / 8, nt0 = tile % 8, m0 = mt0 * 128, n0 = nt0 * 128;
    f32x4 acc[4][4];
#pragma unroll
    for (int a = 0; a < 4; ++a)
#pragma unroll
        for (int b = 0; b < 4; ++b) acc[a][b] = (f32x4){0.f, 0.f, 0.f, 0.f};
    gemm_kloop<4, 4>(acc, W + (size_t)n0 * 256, 256, X + (size_t)m0 * 256, 256, 256, smem, tid);
    const int fb = n0 + wn * 64 + 16 * g;
    const int head = fb >> 7, o = fb & 127;
    int key0, Lk;
    if (m0 < 4096) { key0 = m0 & ~255; Lk = 256; } else { const int j = (m0 - 4096) / 2304; key0 = 4096 + j * 2304; Lk = 2304; }
#pragma unroll
    for (int mt = 0; mt < 4; ++mt) {
        const int m = m0 + wt * 64 + 16 * mt + fr;
        float v[16];
#pragma unroll
        for (int a = 0; a < 4; ++a)
#pragma unroll
            for (int r = 0; r < 4; ++r) v[4 * a + r] = acc[a][mt][r];
        if (o < 64) {
            bf16_t* d = KN + (size_t)m * 512 + head * 64 + o;
            st_wt16(d, pack8(v)); st_wt16(d + 8, pack8(v + 8));
        } else {
            bf16_t* d = VMT + (size_t)key0 * 512 + (size_t)(head * 64 + (o - 64)) * Lk + (m - key0);
#pragma unroll
            for (int i = 0; i < 16; ++i) st_wt2(d + (size_t)i * Lk, f2bf(v[i]));
        }
    }
}

DI void phase_merge(const Ctx& p, int l, char* smem, int tid) {
    for (int it = 0;; ++it) {
        int mt0, nt0; if (!xcd_tile(it, 64, 8, 8, mt0, nt0)) break;
        const int m0 = mt0 * 128, n0 = nt0 * 128;
        u32x2 mgp[4][4];
#pragma unroll
        for (int a = 0; a < 4; ++a)
#pragma unroll
            for (int b = 0; b < 4; ++b) mgp[a][b] = (u32x2){0u, 0u};
#pragma unroll 1
        for (int br = 0; br < 4; ++br) {
            u32x2 gpk[4][4];
            {
                f32x4 ga[4][4];
#pragma unroll
                for (int a = 0; a < 4; ++a)
#pragma unroll
                    for (int b = 0; b < 4; ++b) ga[a][b] = (f32x4){0.f, 0.f, 0.f, 0.f};
                gemm_kloop<4, 4, false>(ga, (const bf16_t*)(p.ws() + OFF_WM) + (size_t)l * SZ_WM + (size_t)(br * 1024 + n0) * 1024, 1024,
                                       (const bf16_t*)(p.ws() + OFF_H) + (size_t)m0 * 1024, 1024, 1024, smem, tid);
                const int t2 = launder(tid);
                const int fb = n0 + (t2 >> 7) * 64 + 16 * ((t2 & 63) >> 4);
                const float* bm = p.in(36) + (size_t)l * 4096;
#pragma unroll
                for (int a = 0; a < 4; ++a) {
                    const f32x4 bv = *(const f32x4*)(bm + br * 1024 + fb + 4 * a);
#pragma unroll
                    for (int mt = 0; mt < 4; ++mt) {
                        gpk[a][mt][0] = pk2(sigmoidf(ga[a][mt][0] + bv[0]), sigmoidf(ga[a][mt][1] + bv[1]));
                        gpk[a][mt][1] = pk2(sigmoidf(ga[a][mt][2] + bv[2]), sigmoidf(ga[a][mt][3] + bv[3]));
                    }
                }
            }
            f32x4 pa[4][4];
#pragma unroll
            for (int a = 0; a < 4; ++a)
#pragma unroll
                for (int b = 0; b < 4; ++b) pa[a][b] = (f32x4){0.f, 0.f, 0.f, 0.f};
            const bf16_t* xb; size_t ldb;
            const bf16_t* PROJ = (const bf16_t*)(p.ws() + OFF_PROJ);
            if (br == 0) { xb = PROJ + (size_t)m0 * INWP + C_Z; ldb = INWP; }
            else if (br == 1) { xb = PROJ + (size_t)m0 * INWP + C_RG; ldb = INWP; }
            else if (br == 2) { xb = (const bf16_t*)(p.ws() + OFF_OA) + (size_t)m0 * 512; ldb = 512; }
            else { xb = (const bf16_t*)(p.ws() + OFF_OM) + (size_t)m0 * 512; ldb = 512; }
            gemm_kloop<4, 4, false>(pa, (const bf16_t*)(p.ws() + OFF_WBR) + (size_t)l * SZ_WBR + (size_t)br * 1024 * 512 + (size_t)n0 * 512, 512, xb, ldb, 512, smem, tid);
#pragma unroll
            for (int a = 0; a < 4; ++a)
#pragma unroll
                for (int mt = 0; mt < 4; ++mt) {
                    const float m0 = __uint_as_float(mgp[a][mt][0] << 16) + __uint_as_float(gpk[a][mt][0] << 16) * pa[a][mt][0];
                    const float m1 = __uint_as_float(mgp[a][mt][0] & 0xffff0000u) + __uint_as_float(gpk[a][mt][0] & 0xffff0000u) * pa[a][mt][1];
                    const float m2 = __uint_as_float(mgp[a][mt][1] << 16) + __uint_as_float(gpk[a][mt][1] << 16) * pa[a][mt][2];
                    const float m3 = __uint_as_float(mgp[a][mt][1] & 0xffff0000u) + __uint_as_float(gpk[a][mt][1] & 0xffff0000u) * pa[a][mt][3];
                    mgp[a][mt][0] = pk2(m0, m1); mgp[a][mt][1] = pk2(m2, m3);
                }
        }
        const int t3 = launder(tid);
        const int fr = t3 & 15, g = (t3 & 63) >> 4, wn = t3 >> 7, wt = (t3 >> 6) & 1;
        const int fb = n0 + wn * 64 + 16 * g;
        bf16_t* MG = (bf16_t*)(p.ws() + OFF_MERGED);
#pragma unroll
        for (int mt = 0; mt < 4; ++mt) {
            const int m = m0 + wt * 64 + 16 * mt + fr;
            bf16_t* d = MG + (size_t)m * 1024 + fb;
            *(u32x4*)d = (u32x4){mgp[0][mt][0], mgp[0][mt][1], mgp[1][mt][0], mgp[1][mt][1]};
            *(u32x4*)(d + 8) = (u32x4){mgp[2][mt][0], mgp[2][mt][1], mgp[3][mt][0], mgp[3][mt][1]};
        }
    }
}

DI void prep_token(const Ctx& p, int l, int ps, int m, int lane) {
    char* ws = p.ws();
    bf16_t* PROJ = (bf16_t*)(ws + OFF_PROJ);
    const float* t16 = (const float*)(ws + OFF_T16);
    const float* t8 = (const float*)(ws + OFF_T8);
    const Tok k = tok_info(m, ps);
    bf16_t* pr = PROJ + (size_t)m * INWP;
    if (lane < 16) {
        const float v = ((const float*)(ws + OFF_DTRAW))[(size_t)m * 16 + lane] + p.in(19)[l * 16 + lane];
        const float sp = v > 20.f ? v : log1pe(__expf(v));
        ((float*)(ws + OFF_DT))[(size_t)m * 16 + lane] = sp;
    }
    {
        const int seqkey0 = k.lat ? (k.krow - 256 - k.t) : (k.krow - k.t);
        const int Lk = k.lat ? 2304 : 256;
        const int keyidx = k.krow - seqkey0;
        float v[8];
        if (lane < 32) unpack8(*(const u32x4*)(pr + C_AK + lane * 8), v);
        else {
#pragma unroll
            for (int j = 0; j < 8; ++j) v[j] = 0.f;
        }
        float ss = 0.f;
#pragma unroll
        for (int j = 0; j < 8; ++j) ss += v[j] * v[j];
        ss += shx(ss, 1); ss += shx(ss, 2); ss += shx(ss, 4);
        const float rstd = rsqrtf(ss * (1.f / 64.f) + EPS);
        const int u = lane & 7, axis = u >> 2, pos = axis ? (k.t & 63) : (k.t >> 6);
        float kv[8];
        const float* w = p.in(26) + l * 64 + u * 8;
#pragma unroll
        for (int j = 0; j < 8; ++j) kv[j] = (v[j] * rstd) * w[j];
        float kr[8];
#pragma unroll
        for (int j = 0; j < 8; ++j) {
            const float other = shx(kv[j], 2);
            const int fi = (u & 1) * 8 + j;
            const float c = t16[pos * 16 + fi], s = t16[1024 + pos * 16 + fi];
            kr[j] = (u & 2) ? (kv[j] * c + other * s) : (kv[j] * c - other * s);
        }
        if (lane < 16) {
            if (!k.lat) {
                float* o = p.out() + O_CK + ((size_t)(k.b * 2 + l) * 256 + k.t) * 128 + lane * 8;
                *(f32x4*)o = (f32x4){kv[0], kv[1], kv[2], kv[3]}; *(f32x4*)(o + 4) = (f32x4){kv[4], kv[5], kv[6], kv[7]};
            }
            bf16_t* ka = (bf16_t*)(ws + OFF_KA) + (size_t)k.krow * 128 + lane * 8;
            *(u32x4*)ka = k.lat ? pack8(kr) : pack8(kv);
        } else if (lane < 32) {
            const int d0 = (lane - 16) * 8;
            if (!k.lat) {
                float* o = p.out() + O_CV + ((size_t)(k.b * 2 + l) * 256 + k.t) * 128 + d0;
                *(f32x4*)o = (f32x4){v[0], v[1], v[2], v[3]}; *(f32x4*)(o + 4) = (f32x4){v[4], v[5], v[6], v[7]};
            }
            bf16_t* vt = (bf16_t*)(ws + OFF_VAT) + (size_t)seqkey0 * 128 + (size_t)d0 * Lk + keyidx;
#pragma unroll
            for (int j = 0; j < 8; ++j) vt[(size_t)j * Lk] = f2bf(v[j]);
        }
    }
    {
        float v[8];
        if (lane < 48) unpack8(*(const u32x4*)(pr + C_MCQ + lane * 8), v);
        else {
#pragma unroll
            for (int j = 0; j < 8; ++j) v[j] = 0.f;
        }
        float ss = 0.f;
#pragma unroll
        for (int j = 0; j < 8; ++j) ss += v[j] * v[j];
        ss = wsum(ss);
        const float rstd = rsqrtf(ss * (1.f / 384.f) + EPS);
        if (lane < 48) {
            const float* w = p.in(27) + l * 384 + lane * 8;
#pragma unroll
            for (int j = 0; j < 8; ++j) v[j] = (v[j] * rstd) * w[j];
            *(u32x4*)(pr + C_MCQ + lane * 8) = pack8(v);
        }
    }
    {
        float v[8];
        if (lane < 36) unpack8(*(const u32x4*)(pr + C_MCKV + lane * 8), v);
        else {
#pragma unroll
            for (int j = 0; j < 8; ++j) v[j] = 0.f;
        }
        float ss = 0.f;
        if (lane < 32) {
#pragma unroll
            for (int j = 0; j < 8; ++j) ss += v[j] * v[j];
        }
        ss = wsum(ss);
        const float rstd = rsqrtf(ss * (1.f / 256.f) + EPS);
        const int u = (lane - 32) & 3, axis = u >> 1, pos = axis ? (k.t & 63) : (k.t >> 6);
        float kr[8];
#pragma unroll
        for (int j = 0; j < 8; ++j) {
            const float other = shx(v[j], 1);
            const float c = t8[pos * 8 + j], s = t8[512 + pos * 8 + j];
            kr[j] = (u & 1) ? (v[j] * c + other * s) : (v[j] * c - other * s);
        }
        if (lane < 32) {
            const float* w = p.in(29) + l * 256 + lane * 8;
            float c[8];
#pragma unroll
            for (int j = 0; j < 8; ++j) c[j] = (v[j] * rstd) * w[j];
            if (!k.lat) {
                float* o = p.out() + O_CC + ((size_t)(k.b * 2 + l) * 256 + k.t) * 256 + lane * 8;
                *(f32x4*)o = (f32x4){c[0], c[1], c[2], c[3]}; *(f32x4*)(o + 4) = (f32x4){c[4], c[5], c[6], c[7]};
            }
            *(u32x4*)((bf16_t*)(ws + OFF_CKV) + (size_t)k.krow * 256 + lane * 8) = pack8(c);
        } else if (lane < 36) {
            const int d0 = (lane - 32) * 8;
            if (!k.lat) {
                float* o = p.out() + O_CR + ((size_t)(k.b * 2 + l) * 256 + k.t) * 32 + d0;
                *(f32x4*)o = (f32x4){v[0], v[1], v[2], v[3]}; *(f32x4*)(o + 4) = (f32x4){v[4], v[5], v[6], v[7]};
            }
            *(u32x4*)((bf16_t*)(ws + OFF_KRP) + (size_t)k.krow * 32 + d0) = k.lat ? pack8(kr) : pack8(v);
        }
    }
}
DI void prep_conv_item(const Ctx& p, int l, int ps, int item, int lane) {
    const int run = item >> 1, cbk = item & 1;
    const int c0 = cbk * 512 + lane * 8;
    if (c0 >= 768) return;
    const int m0 = run * 16;
    const Tok k = tok_info(m0, ps);
    const float* cw = p.in(17) + (size_t)l * 3 * 768; const float* cb = p.in(18) + (size_t)l * 768;
    float w[4][8];
#pragma unroll
    for (int tp = 0; tp < 4; ++tp) {
        const float* src = (tp < 3) ? cw + tp * 768 + c0 : cb + c0;
        const f32x4 a0 = *(const f32x4*)src, a1 = *(const f32x4*)(src + 4);
#pragma unroll
        for (int e = 0; e < 4; ++e) { w[tp][e] = a0[e]; w[tp][4 + e] = a1[e]; }
    }
    const bf16_t* xb = (const bf16_t*)(p.ws() + OFF_PROJ) + (size_t)m0 * INWP + C_XBC + c0;
    bf16_t* xo = (bf16_t*)(p.ws() + OFF_XBCA) + (size_t)m0 * 768 + c0;
    const u32x4 zero = {0u, 0u, 0u, 0u};
    u32x4 pv = zero, cv;
    if (k.t > 0) pv = gld16(xb - INWP);
    cv = gld16(xb);
#pragma unroll 4
    for (int i = 0; i < 16; ++i) {
        u32x4 nv = zero;
        if (k.t + i + 1 < k.L) nv = gld16(xb + (size_t)(i + 1) * INWP);
        float a[8], b[8], c[8], o[8];
        unpack8(pv, a); unpack8(cv, b); unpack8(nv, c);
#pragma unroll
        for (int e = 0; e < 8; ++e) o[e] = siluf(w[3][e] + w[0][e] * a[e] + w[1][e] * b[e] + w[2][e] * c[e]);
        *(u32x4*)(xo + (size_t)i * 768) = pack8(o);
        pv = cv; cv = nv;
    }
}
DI void prep_cache_row(const Ctx& p, int l, int ps, int r, int lane) {
    char* ws = p.ws();
    const int j = r >> 8, c = r & 255, b = ps * 2 + j;
    const int key0 = 4096 + j * 2304, krow = key0 + c, Lk = 2304;
    const size_t src = (size_t)(b * 2 + l) * 256 + c;
    if (lane < 16) {
        const float* s = p.in(4) + src * 128 + lane * 8; float v[8];
#pragma unroll
        for (int i = 0; i < 8; ++i) v[i] = s[i];
        *(u32x4*)((bf16_t*)(ws + OFF_KA) + (size_t)krow * 128 + lane * 8) = pack8(v);
    } else if (lane < 32) {
        const int d0 = (lane - 16) * 8;
        const float* s = p.in(5) + src * 128 + d0;
        bf16_t* vt = (bf16_t*)(ws + OFF_VAT) + (size_t)key0 * 128 + (size_t)d0 * Lk + c;
#pragma unroll
        for (int i = 0; i < 8; ++i) vt[(size_t)i * Lk] = f2bf(s[i]);
    } else if (lane < 36) {
        const int d0 = (lane - 32) * 8;
        const float* s = p.in(7) + src * 32 + d0; float v[8];
#pragma unroll
        for (int i = 0; i < 8; ++i) v[i] = s[i];
        *(u32x4*)((bf16_t*)(ws + OFF_KRP) + (size_t)krow * 32 + d0) = pack8(v);
    }
    if (lane < 32) {
        const float* s = p.in(6) + src * 256 + lane * 8; float v[8];
#pragma unroll
        for (int i = 0; i < 8; ++i) v[i] = s[i];
        *(u32x4*)((bf16_t*)(ws + OFF_CKV) + (size_t)krow * 256 + lane * 8) = pack8(v);
    }
}
DI void phase_prep(const Ctx& p, int l, int ps, int tid) {
    const int lane = tid & 63, wv = tid >> 6;
    for (int m = BIDX * 4 + wv; m < NPT + 512 + 1024; m += gridDim.x * 4) {
        if (m < NPT) prep_token(p, l, ps, m, lane); else if (m < NPT + 512) prep_cache_row(p, l, ps, m - NPT, lane); else prep_conv_item(p, l, ps, m - NPT - 512, lane);
    }
}

template <int KC, int NQT>
DI void attn_tile(const bf16_t* __restrict__ Q, size_t ldq, const bf16_t* __restrict__ K1, size_t ldk1, const bf16_t* __restrict__ K2, size_t ldk2,
                  const bf16_t* __restrict__ VT, size_t ldvt, int nkt, float c2, bf16_t* __restrict__ O, size_t ldo,
                  const float* __restrict__ qnw  , const float* __restrict__ rope, int t0  , char* smem, int tid) {
    constexpr int KB = KC * 4096, STG = KB + 8192;
    tid = launder(tid);
    const int lane = tid & 63, w = tid >> 6, fr = lane & 15, g = lane >> 4;
    bf16x8 qf[NQT][KC];
#pragma unroll
    for (int qt = 0; qt < NQT; ++qt)
#pragma unroll
        for (int ks = 0; ks < KC; ++ks) { const u32x4 t4 = gld16(Q + (size_t)(16 * NQT * w + 16 * qt + fr) * ldq + ks * 32 + 8 * g); qf[qt][ks] = __builtin_bit_cast(bf16x8, t4); }
    if (KC == 2 && qnw) {
#pragma unroll
        for (int qt = 0; qt < NQT; ++qt) {
            float v[2][8]; float ss = 0.f;
#pragma unroll
            for (int ks = 0; ks < 2; ++ks) {
                const u32x4 t4 = __builtin_bit_cast(u32x4, qf[qt][ks]); unpack8(t4, v[ks]);
#pragma unroll
                for (int j = 0; j < 8; ++j) ss += v[ks][j] * v[ks][j];
            }
            ss += shx(ss, 16); ss += shx(ss, 32);
            const float rstd = rsqrtf(ss * (1.f / 64.f) + EPS);
            const int t = t0 + 16 * NQT * w + 16 * qt + fr;
#pragma unroll
            for (int ks = 0; ks < 2; ++ks) {
                const int pos = ks ? (t & 63) : (t >> 6);
#pragma unroll
                for (int j = 0; j < 8; ++j) {
                    float x = (v[ks][j] * rstd) * qnw[32 * ks + 8 * g + j];
                    if (rope) {
                        const float other = shx(x, 32);
                        const int fi = (g & 1) * 8 + j;
                        const float c = rope[pos * 16 + fi], sn = rope[1024 + pos * 16 + fi];
                        x = (g & 2) ? (x * c + other * sn) : (x * c - other * sn);
                    }
                    v[ks][j] = x;
                }
                const u32x4 t4 = pack8(v[ks]); qf[qt][ks] = __builtin_bit_cast(bf16x8, t4);
            }
        }
    }
    constexpr int NPK = KC * 4, PPW = (NPK + 8) / 4;
    static_assert((NPK + 8) % 4 == 0, "pieces must divide over 4 waves");
    const int wvu = __builtin_amdgcn_readfirstlane(w);
    unsigned poff[PPW];
#pragma unroll
    for (int j = 0; j < PPW; ++j) {
        const int pc = wvu * PPW + j;
        const bool isk = pc < NPK;
        const int pp = isk ? pc : pc - NPK;
        const int ks = pp >> 2, rb = pp & 3;
        const int rl = lane >> 2, row = rb * 16 + rl;
        const int q = isk ? ((row >> 3) & 3) : ((rl >> 2) & 3);
        const int gl = (lane & 3) ^ FQ(q);
        const unsigned ld = isk ? ((KC == 2 || ks < 2) ? (unsigned)ldk1 : (unsigned)ldk2) : (unsigned)ldvt;
        poff[j] = (unsigned)rl * ld + (unsigned)(gl * 8);
    }
    auto issue = [&](int kt, char* stage) {
#pragma unroll
        for (int j = 0; j < PPW; ++j) {
            const int pc = wvu * PPW + j;
            const bool isk = pc < NPK;
            const int pp = isk ? pc : pc - NPK;
            const int ks = pp >> 2, rb = pp & 3;
            const bf16_t* base;
            if (isk) { if (KC == 2 || ks < 2) base = K1 + ks * 32 + (size_t)(kt * 64 + rb * 16) * ldk1; else base = K2 + (size_t)(kt * 64 + rb * 16) * ldk2; }
            else base = VT + ks * 32 + (size_t)kt * 64 + (size_t)(rb * 16) * ldvt;
            __builtin_amdgcn_global_load_lds((const unsigned*)(base + poff[j]), (unsigned*)(stage + (isk ? 0 : KB) + (ks * 64 + rb * 16) * 64), 16, 0, 0);
        }
    };
    const int koff = tile_off(64, 0, 8 * (fr >> 2) + (fr & 3), g, fr >> 2);
    const int voff = KB + tile_off(64, 0, fr, g, (fr >> 2) & 3);
    f32x4 o[4][NQT];
#pragma unroll
    for (int a = 0; a < 4; ++a)
#pragma unroll
        for (int qt = 0; qt < NQT; ++qt) o[a][qt] = (f32x4){0.f, 0.f, 0.f, 0.f};
    float mrun[NQT], lrun[NQT];
#pragma unroll
    for (int qt = 0; qt < NQT; ++qt) { mrun[qt] = -1e30f; lrun[qt] = 0.f; }
    __syncthreads();
    issue(0, smem);
    if (nkt > 1) {
        issue(1, smem + STG);
        if (PPW == 4) asm volatile("s_waitcnt vmcnt(4)" ::: "memory"); else asm volatile("s_waitcnt vmcnt(5)" ::: "memory");
    } else asm volatile("s_waitcnt vmcnt(0)" ::: "memory");
    __syncthreads();
    int so_cur = 0, so_nn = 2 * STG;
    for (int kt = 0; kt < nkt; ++kt) {
        if (kt + 2 < nkt) issue(kt + 2, smem + so_nn);
        __builtin_amdgcn_sched_barrier(0);
        const char* sb = smem + so_cur;
        f32x4 s[4][NQT];
#pragma unroll
        for (int a = 0; a < 4; ++a)
#pragma unroll
            for (int qt = 0; qt < NQT; ++qt) s[a][qt] = (f32x4){0.f, 0.f, 0.f, 0.f};
        bf16x8 kf[KC][4];
#pragma unroll
        for (int ks = 0; ks < KC; ++ks)
#pragma unroll
            for (int a = 0; a < 4; ++a) kf[ks][a] = *(const bf16x8*)(sb + koff + ((a >> 1) * 32 + (a & 1) * 4) * 64 + ks * 4096);
        __builtin_amdgcn_sched_barrier(0);
#pragma unroll
        for (int ks = 0; ks < KC; ++ks)
#pragma unroll
            for (int a = 0; a < 4; ++a) {
#pragma unroll
                for (int qt = 0; qt < NQT; ++qt) s[a][qt] = __builtin_amdgcn_mfma_f32_16x16x32_bf16(kf[ks][a], qf[qt][ks], s[a][qt], 0, 0, 0);
            }
        bf16x8 vfr[2][4];
#pragma unroll
        for (int s2 = 0; s2 < 2; ++s2)
#pragma unroll
            for (int dt = 0; dt < 4; ++dt) vfr[s2][dt] = *(const bf16x8*)(sb + voff + dt * 1024 + s2 * 4096);
        __builtin_amdgcn_sched_barrier(0);
        bf16x8 pf[NQT][2];
#pragma unroll
        for (int qt = 0; qt < NQT; ++qt) {
            float mx = s[0][qt][0];
#pragma unroll
            for (int a = 0; a < 4; ++a)
#pragma unroll
                for (int r = 0; r < 4; ++r) mx = fmaxf(mx, s[a][qt][r]);
            mx = gmax4(mx);
            const float mnew = fmaxf(mrun[qt], mx);
            const float alpha = __builtin_amdgcn_exp2f((mrun[qt] - mnew) * c2);
            mrun[qt] = mnew;
            const float mc = mnew * c2;
            float ls = 0.f; float pv[16];
#pragma unroll
            for (int a = 0; a < 4; ++a)
#pragma unroll
                for (int r = 0; r < 4; ++r) { const float e = __builtin_amdgcn_exp2f(s[a][qt][r] * c2 - mc); pv[4 * a + r] = e; ls += e; }
            lrun[qt] = lrun[qt] * alpha + ls;
#pragma unroll
            for (int a = 0; a < 4; ++a) o[a][qt] = o[a][qt] * alpha;
            u32x4 w0 = pack8(pv), w1 = pack8(pv + 8);
            pf[qt][0] = __builtin_bit_cast(bf16x8, w0); pf[qt][1] = __builtin_bit_cast(bf16x8, w1);
        }
        __builtin_amdgcn_sched_barrier(0);
#pragma unroll
        for (int s2 = 0; s2 < 2; ++s2)
#pragma unroll
            for (int dt = 0; dt < 4; ++dt) {
#pragma unroll
                for (int qt = 0; qt < NQT; ++qt) o[dt][qt] = __builtin_amdgcn_mfma_f32_16x16x32_bf16(vfr[s2][dt], pf[qt][s2], o[dt][qt], 0, 0, 0);
            }
        __builtin_amdgcn_sched_barrier(0);
        if (kt + 2 < nkt) { if (PPW == 4) asm volatile("s_waitcnt vmcnt(4)" ::: "memory"); else asm volatile("s_waitcnt vmcnt(5)" ::: "memory"); }
        else asm volatile("s_waitcnt vmcnt(0)" ::: "memory");
        asm volatile("s_waitcnt lgkmcnt(0)" ::: "memory");
        __builtin_amdgcn_s_barrier();
        so_cur = (so_cur == 2 * STG) ? 0 : so_cur + STG;
        so_nn = (so_nn == 2 * STG) ? 0 : so_nn + STG;
    }
#pragma unroll
    for (int qt = 0; qt < NQT; ++qt) {
        float l = gsum4(lrun[qt]);
        const float inv = 1.f / l;
        bf16_t* orow = O + (size_t)(16 * NQT * w + 16 * qt + fr) * ldo + 4 * g;
#pragma unroll
        for (int dt = 0; dt < 4; ++dt) {
            u32x2 wv2; wv2[0] = pk2(o[dt][qt][0] * inv, o[dt][qt][1] * inv); wv2[1] = pk2(o[dt][qt][2] * inv, o[dt][qt][3] * inv);
            *(u32x2*)(orow + 16 * dt) = wv2;
        }
    }
}

struct Seq { int lat, tok0, L, key0, Lk, b; };
DI Seq seq_info(int s, int ps) {
    Seq q;
    if (s < 16) { q.lat = 0; q.tok0 = s * 256; q.L = 256; q.key0 = s * 256; q.Lk = 256; q.b = ps * 16 + s; }
    else { const int j = s - 16; q.lat = 1; q.tok0 = 4096 + j * 2048; q.L = 2048; q.key0 = 4096 + j * 2304; q.Lk = 2304; q.b = ps * 2 + j; }
    return q;
}
DI void attn_gqa_item(const Ctx& p, int l, int s, int head, int qb, int ps, char* smem, int tid) {
    const Seq q = seq_info(s, ps);
    const int rows = 128;
    const bf16_t* PROJ = (const bf16_t*)(p.ws() + OFF_PROJ);
    const bf16_t* Q = PROJ + (size_t)(q.tok0 + qb * rows) * INWP + C_AQ + head * 64;
    const int kh = head >> 2;
    const bf16_t* K = (const bf16_t*)(p.ws() + OFF_KA) + (size_t)q.key0 * 128 + kh * 64;
    const bf16_t* VT = (const bf16_t*)(p.ws() + OFF_VAT) + (size_t)q.key0 * 128 + (size_t)kh * 64 * q.Lk;
    bf16_t* O = (bf16_t*)(p.ws() + OFF_OA) + (size_t)(q.tok0 + qb * rows) * 512 + head * 64;
    const float c2 = 0.125f * 1.4426950408889634f;
    attn_tile<2, 2>(Q, INWP, K, 128, K, 128, VT, q.Lk, q.Lk / 64, c2, O, 512, p.in(25) + l * 64, q.lat ? (const float*)(p.ws() + OFF_T16) : nullptr, qb * 128, smem, tid);
}
DI void attn_mla_item(const Ctx& p, int s, int head, int qb, int ps, char* smem, int tid) {
    const Seq q = seq_info(s, ps);
    const int rows = 128;
    const bf16_t* Q = (const bf16_t*)(p.ws() + OFF_QM) + (size_t)(q.tok0 + qb * rows) * 768 + head * 96;
    const bf16_t* K1 = (const bf16_t*)(p.ws() + OFF_KN) + (size_t)q.key0 * 512 + head * 64;
    const bf16_t* K2 = (const bf16_t*)(p.ws() + OFF_KRP) + (size_t)q.key0 * 32;
    const bf16_t* VT = (const bf16_t*)(p.ws() + OFF_VMT) + (size_t)q.key0 * 512 + (size_t)head * 64 * q.Lk;
    bf16_t* O = (bf16_t*)(p.ws() + OFF_OM) + (size_t)(q.tok0 + qb * rows) * 512 + head * 64;
    const float c2 = 0.10206207261596577f * 1.4426950408889634f;
    attn_tile<3, 2>(Q, 768, K1, 512, K2, 32, VT, q.Lk, q.Lk / 64, c2, O, 512, nullptr, nullptr, 0, smem, tid);
}

template <int ET>
DI void scan_item(const bf16_t* __restrict__ Qp, size_t ldq, const bf16_t* __restrict__ Kp, size_t ldk, const bf16_t* __restrict__ Vp, size_t ldv,
                  const float* __restrict__ dtp  , float acoef  ,
                  int L, int dir, const float* __restrict__ s0, float* __restrict__ sout, int lds_state  , bf16_t* __restrict__ Op, size_t ldo,
                  const float* __restrict__ rope  , float kmul,
                  int nbase  , int nch  , const bf16_t* __restrict__ s0b  ,
                  bf16_t* __restrict__ lout  , float* __restrict__ dout  , char* smem, int tid) {
    constexpr int DV = 16 * ET;
    const bool stateonly = (lout != nullptr);
    constexpr int QS = 0, KS = 8192, KT = 16384, VTO = 24576, STO = VTO + DV * 128, ACO = STO + DV * 128;
    constexpr int NV = DV / 32;
    tid = launder(tid);
    const int lane = tid & 63, w = tid >> 6, fr = lane & 15, g = lane >> 4;
    float* acs = (float*)(smem + ACO);
    f32x4 sacc[ET];
#pragma unroll
    for (int et = 0; et < ET; ++et) {
        if (s0) {
#pragma unroll
            for (int r = 0; r < 4; ++r) sacc[et][r] = s0[(size_t)(16 * w + 4 * g + r) * lds_state + 16 * et + fr];
        } else if (s0b) {
#pragma unroll
            for (int r = 0; r < 4; ++r) sacc[et][r] = bf2f(s0b[(16 * w + 4 * g + r) * DV + 16 * et + fr]);
        } else sacc[et] = (f32x4){0.f, 0.f, 0.f, 0.f};
    }
    const int st_off = STO + ((w >> 1) * DV) * 64 + (g & 1) * 8;
    const int st_gg = (2 * w + (g >> 1)) & 3;
    __syncthreads();
    float* ropeL = (float*)(smem + ACO + 256);
    if (rope) {
#pragma unroll
        for (int i = 0; i < 2; ++i) *(f32x4*)(ropeL + (tid + 256 * i) * 4) = *(const f32x4*)(rope + (tid + 256 * i) * 4);
    }
#pragma unroll
    for (int et = 0; et < ET; ++et) {
        const int e = 16 * et + fr;
        u32x2 wv2; wv2[0] = pk2(sacc[et][0], sacc[et][1]); wv2[1] = pk2(sacc[et][2], sacc[et][3]);
        *(u32x2*)(smem + st_off + e * 64 + ((st_gg ^ FQ((e >> 2) & 3)) << 4)) = wv2;
    }
    __syncthreads();
    float dprod = 1.f;
    const int qoff = QS + tile_off(64, 0, 16 * w + fr, g, (fr >> 2) & 3);
    const int koff = KS + tile_off(64, 0, 8 * (fr >> 2) + (fr & 3), g, fr >> 2);
    const int ktoff = KT + tile_off(64, 0, 16 * w + fr, g, (fr >> 2) & 3);
    const int vtoff = VTO + tile_off(DV, 0, fr, g, (fr >> 2) & 3);
    const int stoff = STO + tile_off(DV, 0, fr, g, (fr >> 2) & 3);
    u32x4 gq[2], gk[2], gv[NV]; float gdt = 1.f;
    auto issue = [&](int c) {
        const int n0 = nbase + c * 64;
        {
            const int row = tid >> 2, cc0 = (tid & 1) | ((tid & 2) << 1);
            const int tl = dir ? (L - 1 - (n0 + row)) : (n0 + row);
#pragma unroll
            for (int i = 0; i < 2; ++i) {
                gq[i] = gld16(Qp + (size_t)tl * ldq + (cc0 + 2 * i) * 8);
                gk[i] = gld16(Kp + (size_t)tl * ldk + (cc0 + 2 * i) * 8);
            }
        }
#pragma unroll
        for (int i = 0; i < NV; ++i) {
            const int q = tid + 256 * i, row = q / (DV / 8), cc = q % (DV / 8);
            const int tl = dir ? (L - 1 - (n0 + row)) : (n0 + row);
            gv[i] = gld16(Vp + (size_t)tl * ldv + cc * 8);
        }
        if (dtp) { const int tl = dir ? (L - 1 - (n0 + lane)) : (n0 + lane); gdt = dtp[(size_t)tl * 16]; }
    };
    issue(0);
    for (int c = 0; c < nch; ++c) {
        const int n0 = nbase + c * 64;
        const float dtv = gdt;
        const float la = dtp ? dtv * acoef : acoef;
        float ac, aend;
        if (dtp) {
            ac = la;
#pragma unroll
            for (int o = 1; o < 64; o <<= 1) { const float t = shu(ac, o); if (lane >= o) ac += t; }
            aend = shf(ac, 63);
        } else { ac = (float)(lane + 1) * la; aend = 64.f * la; }
        if (w == 0) acs[lane] = ac;
        {
            const int row = tid >> 2, cc0 = (tid & 1) | ((tid & 2) << 1);
            const float ksc = shf(dtv, row) * kmul, wend = __expf(aend - shf(ac, row));
            float qa[2][8], ka[2][8];
#pragma unroll
            for (int i = 0; i < 2; ++i) { unpack8(gq[i], qa[i]); unpack8(gk[i], ka[i]); }
            if (rope) {
                const int tlr = dir ? (L - 1 - (n0 + row)) : (n0 + row);
                const int pos = (cc0 >> 2) ? (tlr & 63) : (tlr >> 6);
                const float* rp = ropeL + pos * 16 + (cc0 & 1) * 8;
                f32x4 rc[2], rs[2];
                rc[0] = *(const f32x4*)rp; rc[1] = *(const f32x4*)(rp + 4); rs[0] = *(const f32x4*)(rp + 1024); rs[1] = *(const f32x4*)(rp + 1028);
#pragma unroll
                for (int j = 0; j < 8; ++j) {
                    const float c = rc[j >> 2][j & 3], sn = rs[j >> 2][j & 3];
                    const float q1 = qa[0][j], q2 = qa[1][j], k1 = ka[0][j], k2 = ka[1][j];
                    qa[0][j] = q1 * c - q2 * sn; qa[1][j] = q2 * c + q1 * sn;
                    ka[0][j] = k1 * c - k2 * sn; ka[1][j] = k2 * c + k1 * sn;
                }
            }
#pragma unroll
            for (int i = 0; i < 2; ++i) {
                const int cc = cc0 + 2 * i;
                if (rope) *(u32x4*)(smem + QS + tile_off(64, cc >> 2, row, cc & 3, (row >> 2) & 3)) = pack8(qa[i]);
                else *(u32x4*)(smem + QS + tile_off(64, cc >> 2, row, cc & 3, (row >> 2) & 3)) = gq[i];
#pragma unroll
                for (int j = 0; j < 8; ++j) ka[i][j] *= ksc;
                *(u32x4*)(smem + KS + tile_off(64, cc >> 2, row, cc & 3, (row >> 3) & 3)) = pack8(ka[i]);
#pragma unroll
                for (int j = 0; j < 8; ++j) {
                    const int d = cc * 8 + j;
                    *(bf16_t*)(smem + KT + tile_off(64, row >> 5, d, (row >> 3) & 3, (d >> 2) & 3) + (row & 7) * 2) = f2bf(ka[i][j] * wend);
                }
            }
        }
#pragma unroll
        for (int i = 0; i < NV; ++i) {
            const int q = tid + 256 * i, row = q / (DV / 8), cc = q % (DV / 8);
            const u32x4 vv = gv[i];
#pragma unroll
            for (int j = 0; j < 8; ++j) {
                const int e = cc * 8 + j;
                const unsigned short h = (unsigned short)(vv[j >> 1] >> (16 * (j & 1)));
                *(bf16_t*)(smem + VTO + tile_off(DV, row >> 5, e, (row >> 3) & 3, (e >> 2) & 3) + (row & 7) * 2) = h;
            }
        }
        if (c + 1 < nch) issue(c + 1);
        __builtin_amdgcn_sched_barrier(0);
        __syncthreads();
        {
            const int irow = 16 * w + fr;
            const int ns = (w >> 1) + 1;
            bf16x8 qfr[2], sf[ET][2], kfa[2][2][2], vf[2][ET], kt2[2];
            qfr[0] = *(const bf16x8*)(smem + qoff); qfr[1] = *(const bf16x8*)(smem + qoff + 4096);
#pragma unroll
            for (int et = 0; et < ET; ++et)
#pragma unroll
                for (int ks = 0; ks < 2; ++ks) sf[et][ks] = *(const bf16x8*)(smem + stoff + et * 1024 + ks * DV * 64);
#pragma unroll
            for (int aa = 0; aa < 2; ++aa)
#pragma unroll
                for (int ks = 0; ks < 2; ++ks) kfa[0][aa][ks] = *(const bf16x8*)(smem + koff + (4 * aa) * 64 + ks * 4096);
            const float ai = acs[irow];
            f32x4 ajv[2][2];
#pragma unroll
            for (int aa = 0; aa < 2; ++aa) ajv[0][aa] = *(const f32x4*)(acs + 8 * g + 4 * aa);
            const float cd = __expf(acs[63]);
            __builtin_amdgcn_sched_barrier(0);
            f32x4 o[ET];
            if (!stateonly) {
#pragma unroll
                for (int et = 0; et < ET; ++et) {
                    o[et] = (f32x4){0.f, 0.f, 0.f, 0.f};
#pragma unroll
                    for (int ks = 0; ks < 2; ++ks) o[et] = __builtin_amdgcn_mfma_f32_16x16x32_bf16(sf[et][ks], qfr[ks], o[et], 0, 0, 0);
                }
            }
#pragma unroll
            for (int aa = 0; aa < 2; ++aa)
#pragma unroll
                for (int ks = 0; ks < 2; ++ks) kfa[1][aa][ks] = *(const bf16x8*)(smem + koff + (32 + 4 * aa) * 64 + ks * 4096);
#pragma unroll
            for (int ks = 0; ks < 2; ++ks) {
#pragma unroll
                for (int et = 0; et < ET; ++et) vf[ks][et] = *(const bf16x8*)(smem + vtoff + et * 1024 + ks * DV * 64);
                kt2[ks] = *(const bf16x8*)(smem + ktoff + ks * 4096);
            }
#pragma unroll
            for (int aa = 0; aa < 2; ++aa) ajv[1][aa] = *(const f32x4*)(acs + 32 + 8 * g + 4 * aa);
            __builtin_amdgcn_sched_barrier(0);
            if (!stateonly) {
                const float ei = __expf(ai);
#pragma unroll
                for (int et = 0; et < ET; ++et) o[et] = o[et] * ei;
#pragma unroll
                for (int s2 = 0; s2 < 2; ++s2) {
                    if (s2 < ns) {
                        f32x4 pp[2];
#pragma unroll
                        for (int aa = 0; aa < 2; ++aa) {
                            pp[aa] = (f32x4){0.f, 0.f, 0.f, 0.f};
#pragma unroll
                            for (int ks = 0; ks < 2; ++ks) pp[aa] = __builtin_amdgcn_mfma_f32_16x16x32_bf16(kfa[s2][aa][ks], qfr[ks], pp[aa], 0, 0, 0);
                        }
                        float pv[8];
#pragma unroll
                        for (int aa = 0; aa < 2; ++aa) {
                            const int j0 = 32 * s2 + 8 * g + 4 * aa;
#pragma unroll
                            for (int r = 0; r < 4; ++r) {
                                const float dec = __expf(fminf(ai - ajv[s2][aa][r], 0.f));
                                pv[4 * aa + r] = (j0 + r <= irow) ? pp[aa][r] * dec : 0.f;
                            }
                        }
                        const u32x4 pw = pack8(pv);
                        const bf16x8 pf = __builtin_bit_cast(bf16x8, pw);
#pragma unroll
                        for (int et = 0; et < ET; ++et) o[et] = __builtin_amdgcn_mfma_f32_16x16x32_bf16(vf[s2][et], pf, o[et], 0, 0, 0);
                    }
                }
                const int tl = dir ? (L - 1 - (n0 + irow)) : (n0 + irow);
                bf16_t* orow = Op + (size_t)tl * ldo + 4 * g;
#pragma unroll
                for (int et = 0; et < ET; ++et) {
                    u32x2 wv2; wv2[0] = pk2(o[et][0], o[et][1]); wv2[1] = pk2(o[et][2], o[et][3]);
                    st_wt8(orow + 16 * et, wv2);
                }
            }
            dprod *= cd;
#pragma unroll
            for (int et = 0; et < ET; ++et) sacc[et] = sacc[et] * cd;
#pragma unroll
            for (int ks = 0; ks < 2; ++ks)
#pragma unroll
                for (int et = 0; et < ET; ++et) sacc[et] = __builtin_amdgcn_mfma_f32_16x16x32_bf16(kt2[ks], vf[ks][et], sacc[et], 0, 0, 0);
        }
        __syncthreads();
#pragma unroll
        for (int et = 0; et < ET; ++et) {
            const int e = 16 * et + fr;
            u32x2 wv2; wv2[0] = pk2(sacc[et][0], sacc[et][1]); wv2[1] = pk2(sacc[et][2], sacc[et][3]);
            *(u32x2*)(smem + st_off + e * 64 + ((st_gg ^ FQ((e >> 2) & 3)) << 4)) = wv2;
        }
    }
    if (sout) {
#pragma unroll
        for (int et = 0; et < ET; ++et)
#pragma unroll
            for (int r = 0; r < 4; ++r) sout[(size_t)(16 * w + 4 * g + r) * lds_state + 16 * et + fr] = sacc[et][r];
    }
    if (lout) {
#pragma unroll
        for (int et = 0; et < ET; ++et)
#pragma unroll
            for (int r = 0; r < 4; ++r) st_wt2(lout + (16 * w + 4 * g + r) * DV + 16 * et + fr, f2bf(sacc[et][r]));
        if (tid == 0) st_wt4f(dout, dprod);
    }
    __syncthreads();
}

DI void scan_any_item(const Ctx& p, int l, int ps, int isret, int s, int h, int dir, int half, int mode, int seg, int sid, char* smem, int tid) {
    const Seq q = seq_info(s, ps);
    const bf16_t *Qp, *Kp, *Vp; size_t ld; const float* dtp; float acoef, kmul; const float* rope; bf16_t* O; float* so; int lds;
    if (isret) {
        const bf16_t* PR = (const bf16_t*)(p.ws() + OFF_PROJ) + (size_t)q.tok0 * INWP;
        const float x = p.in(23)[l * 8 + dir * 4 + h];
        acoef = fminf(x, 0.f) - log1pe(__expf(-fabsf(x)));
        Qp = PR + C_RQ + h * 64; Kp = PR + C_RK + h * 64; Vp = PR + C_RV + h * 128 + half * 64; ld = INWP; dtp = nullptr; kmul = 0.125f;
        rope = q.lat ? (const float*)(p.ws() + OFF_T16) : nullptr;
        O = (bf16_t*)(p.ws() + OFF_OR) + ((size_t)dir * NPT + q.tok0) * 512 + h * 128 + half * 64;
        so = p.out() + O_RET + ((size_t)((q.b * 2 + l) * 2 + dir) * 4 + h) * 8192 + half * 64; lds = 128;
    } else {
        const bf16_t* XB = (const bf16_t*)(p.ws() + OFF_XBCA) + (size_t)q.tok0 * 768;
        const int grp = h >> 2;
        Qp = XB + 640 + grp * 64; Kp = XB + 512 + grp * 64; Vp = XB + h * 64; ld = 768; kmul = 1.f; rope = nullptr;
        dtp = (const float*)(p.ws() + OFF_DT) + (size_t)q.tok0 * 16 + dir * 8 + h;
        acoef = -__expf(p.in(20)[l * 16 + dir * 8 + h]);
        O = (bf16_t*)(p.ws() + OFF_OS) + ((size_t)dir * NPT + q.tok0) * 512 + h * 64;
        so = p.out() + O_SSD + ((size_t)((q.b * 2 + l) * 2 + dir) * 8 + h) * 4096; lds = 64;
    }
    bf16_t* segb = (bf16_t*)(p.ws() + OFF_SEG) + (size_t)(sid * NSEG + seg) * 4096;
    float* segd = (float*)(p.ws() + OFF_SEGD) + sid * NSEG + seg;
    scan_item<4>(Qp, ld, Kp, ld, Vp, ld, dtp, acoef, q.L, dir, nullptr, mode == 0 ? so : nullptr, lds, O, 512, rope, kmul,
                 mode == 0 ? 0 : seg * SEGTOK, mode == 0 ? (q.L >> 6) : (SEGTOK >> 6), mode == 3 ? segb : nullptr, mode == 1 ? segb : nullptr, mode == 1 ? segd : nullptr, smem, tid);
}
DI void scan_combine_item(const Ctx& p, int l, int ps, int sid, int tid) {
    const float* s0; int ld;
    if (sid < 32) { const int b = ps * 2 + (sid >> 4), h = (sid >> 1) & 7, dir = sid & 1; s0 = p.in(2) + ((size_t)((b * 2 + l) * 2 + dir) * 8 + h) * 4096; ld = 64; }
    else { const int k = sid - 32, b = ps * 2 + (k >> 4), h = (k >> 2) & 3, dir = (k >> 1) & 1, half = k & 1;
           s0 = p.in(3) + ((size_t)((b * 2 + l) * 2 + dir) * 4 + h) * 8192 + half * 64; ld = 128; }
    bf16_t* segb = (bf16_t*)(p.ws() + OFF_SEG) + (size_t)sid * NSEG * 4096;
    const float* segd = (const float*)(p.ws() + OFF_SEGD) + sid * NSEG;
    const int t2 = launder(tid);
    const float* sp = s0 + (size_t)(t2 >> 2) * ld + (t2 & 3) * 16;
    bf16_t* bp = segb + t2 * 16;
    float S[16];
#pragma unroll
    for (int k = 0; k < 4; ++k) { const f32x4 v = *(const f32x4*)(sp + 4 * k); S[4 * k] = v[0]; S[4 * k + 1] = v[1]; S[4 * k + 2] = v[2]; S[4 * k + 3] = v[3]; }
#pragma unroll 1
    for (int g2 = 0; g2 < NSEG; ++g2) {
        float loc[16]; float d = 0.f;
        if (g2 < NSEG - 1) { d = segd[g2]; unpack8(*(const u32x4*)(bp + g2 * 4096), loc); unpack8(*(const u32x4*)(bp + g2 * 4096 + 8), loc + 8); }
        else {
#pragma unroll
            for (int k = 0; k < 16; ++k) loc[k] = 0.f;
        }
        st_wt16(bp + g2 * 4096, pack8(S)); st_wt16(bp + g2 * 4096 + 8, pack8(S + 8));
#pragma unroll
        for (int k = 0; k < 16; ++k) S[k] = S[k] * d + loc[k];
    }
}

DI void postscan_token(const Ctx& p, int l, int m, int lane) {
    char* ws = p.ws();
    bf16_t* pr = (bf16_t*)(ws + OFF_PROJ) + (size_t)m * INWP;
    const int c0 = lane * 8;
    {
        const bf16_t* OS = (const bf16_t*)(ws + OFF_OS);
        float a[8], b[8], xs[8], z[8];
        unpack8(*(const u32x4*)(OS + (size_t)m * 512 + c0), a);
        unpack8(*(const u32x4*)(OS + ((size_t)NPT + m) * 512 + c0), b);
        unpack8(*(const u32x4*)((const bf16_t*)(ws + OFF_XBCA) + (size_t)m * 768 + c0), xs);
        unpack8(*(const u32x4*)(pr + C_Z + c0), z);
        const float dsk = p.in(21)[l * 8 + (c0 >> 6)];
        float v[8], ss = 0.f;
#pragma unroll
        for (int j = 0; j < 8; ++j) { v[j] = ((a[j] + b[j]) + dsk * xs[j]) * siluf(z[j]); ss += v[j] * v[j]; }
        ss = wsum(ss);
        const float rstd = rsqrtf(ss * (1.f / 512.f) + EPS);
        const float* w = p.in(22) + l * 512 + c0;
#pragma unroll
        for (int j = 0; j < 8; ++j) v[j] = (v[j] * rstd) * w[j];
        *(u32x4*)(pr + C_Z + c0) = pack8(v);
    }
    {
        const bf16_t* ORb = (const bf16_t*)(ws + OFF_OR);
        float a[8], b[8], gt[8];
        unpack8(*(const u32x4*)(ORb + (size_t)m * 512 + c0), a);
        unpack8(*(const u32x4*)(ORb + ((size_t)NPT + m) * 512 + c0), b);
        unpack8(*(const u32x4*)(pr + C_RG + c0), gt);
        float v[8], sm = 0.f;
#pragma unroll
        for (int j = 0; j < 8; ++j) { v[j] = a[j] + b[j]; sm += v[j]; }
        sm += shx(sm, 1); sm += shx(sm, 2); sm += shx(sm, 4); sm += shx(sm, 8);
        const float mean = sm * (1.f / 128.f);
        float sq = 0.f;
#pragma unroll
        for (int j = 0; j < 8; ++j) { v[j] -= mean; sq += v[j] * v[j]; }
        sq += shx(sq, 1); sq += shx(sq, 2); sq += shx(sq, 4); sq += shx(sq, 8);
        const float rstd = rsqrtf(sq * (1.f / 128.f) + EPS);
        const float* w = p.in(24) + l * 512 + c0;
#pragma unroll
        for (int j = 0; j < 8; ++j) v[j] = (v[j] * rstd) * w[j] * siluf(gt[j]);
        *(u32x4*)(pr + C_RG + c0) = pack8(v);
    }
}

DI void phase_act(const Ctx& p, int l, int ps, int tid) {
    tid = launder(tid);
    const int lane = tid & 63, wv = tid >> 6;
    const bf16_t* U = (const bf16_t*)(p.ws() + OFF_U);
    bf16_t* A = (bf16_t*)(p.ws() + OFF_ACT);
    const float* cw = p.in(39) + (size_t)l * 3 * 5632; const float* cb = p.in(40) + (size_t)l * 5632;
    for (int item = BIDX * 4 + wv; item < 512 * 6; item += gridDim.x * 4) {
        const int run = item / 6, cbk = item % 6;
        const int j0 = cbk * 512 + lane * 8;
        if (j0 >= DFF) continue;
        const int m0 = run * 16;
        const Tok k = tok_info(m0, ps);
        float wu[4][8], wg[4][8];
#pragma unroll
        for (int tp = 0; tp < 3; ++tp) {
            const f32x4 a0 = *(const f32x4*)(cw + tp * 5632 + j0), a1 = *(const f32x4*)(cw + tp * 5632 + j0 + 4);
            const f32x4 g0 = *(const f32x4*)(cw + tp * 5632 + DFF + j0), g1 = *(const f32x4*)(cw + tp * 5632 + DFF + j0 + 4);
#pragma unroll
            for (int e = 0; e < 4; ++e) { wu[tp][e] = a0[e]; wu[tp][4 + e] = a1[e]; wg[tp][e] = g0[e]; wg[tp][4 + e] = g1[e]; }
        }
        {
            const f32x4 a0 = *(const f32x4*)(cb + j0), a1 = *(const f32x4*)(cb + j0 + 4);
            const f32x4 g0 = *(const f32x4*)(cb + DFF + j0), g1 = *(const f32x4*)(cb + DFF + j0 + 4);
#pragma unroll
            for (int e = 0; e < 4; ++e) { wu[3][e] = a0[e]; wu[3][4 + e] = a1[e]; wg[3][e] = g0[e]; wg[3][4 + e] = g1[e]; }
        }
        const bf16_t* ub = U + (size_t)m0 * 5632 + j0;
        const u32x4 zero = {0u, 0u, 0u, 0u};
        u32x4 pu = zero, pg = zero, cu, cg;
        if (k.t > 0) { pu = gld16(ub - 5632); pg = gld16(ub - 5632 + DFF); }
        cu = gld16(ub); cg = gld16(ub + DFF);
#pragma unroll 4
        for (int i = 0; i < 16; ++i) {
            u32x4 nu = zero, ng = zero;
            if (k.t + i + 1 < k.L) { nu = gld16(ub + (size_t)(i + 1) * 5632); ng = gld16(ub + (size_t)(i + 1) * 5632 + DFF); }
            float a[8], b[8], c[8], o[8];
            unpack8(pu, a); unpack8(cu, b); unpack8(nu, c);
            float up[8];
#pragma unroll
            for (int e = 0; e < 8; ++e) up[e] = wu[3][e] + wu[0][e] * a[e] + wu[1][e] * b[e] + wu[2][e] * c[e];
            unpack8(pg, a); unpack8(cg, b); unpack8(ng, c);
#pragma unroll
            for (int e = 0; e < 8; ++e) { const float gt = wg[3][e] + wg[0][e] * a[e] + wg[1][e] * b[e] + wg[2][e] * c[e]; o[e] = siluf(gt) * up[e]; }
            *(u32x4*)(A + (size_t)(m0 + i) * DFF + j0) = pack8(o);
            pu = cu; pg = cg; cu = nu; cg = ng;
        }
    }
}

DI int next_item(unsigned* ctr, volatile LAS unsigned* slot, int tid) {
    __syncthreads();
    if (tid == 0) *slot = __hip_atomic_fetch_add(ctr, 1u, __ATOMIC_RELAXED, __HIP_MEMORY_SCOPE_AGENT);
    __syncthreads();
    return (int)*slot;
}

#ifndef ONLY2
#define ONLY2 -1
#endif
#ifndef PROBE_KIND
#define PROBE_KIND -1
#endif
DI void item_publish(unsigned* cnt, int tid) {
    asm volatile("s_waitcnt vmcnt(0)" ::: "memory");
    __syncthreads();
    if (tid == 0) __hip_atomic_fetch_add(cnt, 1u, __ATOMIC_RELAXED, __HIP_MEMORY_SCOPE_AGENT);
}
DI void item_wait(unsigned* cnt, unsigned need, int tid) {
    if (tid == 0) {
        unsigned sp = 0;
        while (__hip_atomic_load(cnt, __ATOMIC_RELAXED, __HIP_MEMORY_SCOPE_AGENT) < need) { __builtin_amdgcn_s_sleep(2); if (++sp > (1u << 24)) break; }
        __builtin_amdgcn_fence(__ATOMIC_ACQUIRE, "agent");
        asm volatile("s_waitcnt vmcnt(0)" ::: "memory");
    }
    __syncthreads();
}
DI void phase_mix(const Ctx& p, int l, int ps, unsigned* ctr, unsigned* c12, volatile LAS unsigned* slot, char* smem, int tid) {
    unsigned* gdone = ctr + 64; unsigned* sdone = ctr + 128;
    unsigned* c1 = c12; unsigned* c2 = c12 + 64;
    constexpr int N1 = 64 * (NSEG - 1), N3 = 64 * NSEG;
    constexpr int A0 = N1, A1 = A0 + 384, A2 = A1 + 544, A3 = A2 + 256, A4 = A3 + 64, A5 = A4 + N3, A6 = A5 + 256, A7 = A6 + 256, A8 = A7 + 256, A9 = A8 + 256, A10 = A9 + 256, A11 = A10 + 256;
    for (;;) {
        tid = launder(tid);
        l = launder_s(l); ps = launder_s(ps);
        int it = next_item(ctr, slot, tid);
        if (it >= A11) break;
        int sc = -1, isret = 0, sq = 0, hd = 0, dr = 0, hf = 0, md = 0, sg = 0, sid = 0; unsigned* pub = sdone;
        if (it < A0) { sid = it / (NSEG - 1); sg = it % (NSEG - 1); md = 1; sc = 1; pub = c1 + sid; }
        else if (it >= A4 && it < A5) { const int k = it - A4; sid = k / NSEG; sg = k % NSEG; md = 3; sc = 1; }
        else if (it >= A6 && it < A7) { const int k = it - A6; sq = k >> 4; hd = (k >> 1) & 7; dr = k & 1; sc = 0; }
        else if (it >= A7 && it < A8) { const int k = it - A7; isret = 1; sq = k >> 4; hd = (k >> 2) & 3; dr = (k >> 1) & 1; hf = k & 1; sc = 0; }
        if (sc == 1) {
            if (sid < 32) { isret = 0; sq = 16 + (sid >> 4); hd = (sid >> 1) & 7; dr = sid & 1; hf = 0; }
            else { const int k = sid - 32; isret = 1; sq = 16 + (k >> 4); hd = (k >> 2) & 3; dr = (k >> 1) & 1; hf = k & 1; }
        }
        if (sc >= 0) {
            if (md == 3) item_wait(c2 + sid, 1u, tid);
            scan_any_item(p, l, ps, isret, sq, hd, dr, hf, md, sg, sid, smem, tid);
            item_publish(pub, tid);
        }
        else if (it < A1) { gemm_uq_tile(p, l, ps, it - A0, smem, tid); item_publish(gdone, tid); }
        else if (it < A2) { gemm_ukv_tile(p, l, it - A1, smem, tid); item_publish(gdone, tid); }
        else if (it < A3) { const int k = it - A2; attn_gqa_item(p, l, 16 + (k >> 7), (k >> 4) & 7, k & 15, ps, smem, tid); }
        else if (it < A4) { const int sd = it - A3; item_wait(c1 + sd, (unsigned)(NSEG - 1), tid); scan_combine_item(p, l, ps, sd, tid); item_publish(c2 + sd, tid); }
        else if (it < A6) { const int k = it - A5; item_wait(gdone, 928u, tid); attn_mla_item(p, 16 + (k >> 7), (k >> 4) & 7, k & 15, ps, smem, tid); }
        else if (it < A9) { const int k = it - A8; attn_gqa_item(p, l, k >> 4, (k >> 1) & 7, k & 1, ps, smem, tid); }
        else if (it < A10) { const int k = it - A9; item_wait(gdone, 928u, tid); attn_mla_item(p, k >> 4, (k >> 1) & 7, k & 1, ps, smem, tid); }
        else { item_wait(sdone, (unsigned)(N3 + 512), tid); const int k = it - A10; const int t5 = launder(tid); for (int i = 0; i < 8; ++i) postscan_token(p, l, k * 32 + i * 4 + (t5 >> 6), t5 & 63); }
    }
}

constexpr int NPL = 10;
constexpr int NPP = 1 + 2 * NPL;
constexpr int NPHASE = 1 + 2 * NPP;
DI void run_phase(const Ctx& p, int ph, int rep, volatile LAS unsigned* slot, char* smem, int tid) {
#ifndef EXCL
#define EXCL -2
#endif
#ifndef ONLY
#define ONLY -1
#endif
    if (ph == 0) { phase_prep_w(p, smem, tid); return; }
    const int q = ph - 1, ps = q / NPP, r = q % NPP;
    if (r == 0) { phase_h1(p, ps, tid); return; }
    const int l = (r - 1) / NPL, k = (r - 1) % NPL;
    char* ws = p.ws();
    unsigned* ctr = (unsigned*)(p.ws() + OFF_CTR) + ph;
    switch (k) {
    case 0: phase_gemm_in(p, l, smem, tid); break;
    case 1: phase_prep(p, l, ps, tid); break;
    case 2: phase_mix(p, l, ps, ctr, (unsigned*)(p.ws() + OFF_CTR) + 256 + (ps * 2 + l) * 128, slot, smem, tid); break;
    case 3: phase_merge(p, l, smem, tid); break;
    case 4: phase_gemm_plain<true>((const bf16_t*)(ws + OFF_WOUT) + (size_t)l * SZ_WOUT, 1024, (const bf16_t*)(ws + OFF_MERGED), 1024, 64, 8, ws + OFF_MO, 1024, smem, tid); break;
    case 5: phase_res(p, ps, l, 0, tid); break;
    case 6: phase_gemm_up(p, l, smem, tid); break;
    case 7: phase_act(p, l, ps, tid); break;
    case 8: phase_gemm_plain<true>((const bf16_t*)(ws + OFF_WDN) + (size_t)l * SZ_WDN, 2816, (const bf16_t*)(ws + OFF_ACT), 2816, 64, 8, ws + OFF_FO, 1024, smem, tid); break;
    default: phase_res(p, ps, l, 1, tid); if (ps == 0 && l == 1) phase_h1(p, 1, tid); break;
    }
}

constexpr unsigned long long probe_mask(int kind) {
    unsigned long long m = 0;
    for (int ph = 0; ph < NPHASE; ++ph) {
        int k = 11; if (ph > 0) { const int r = (ph - 1) % NPP; k = (r == 0) ? 12 : (r - 1) % NPL; }
        if (k == kind) m |= 1ull << ph;
    }
    return m;
}
__global__ void __launch_bounds__(256, 2) fwd_kernel(Params prm, int ph_lo, int ph_hi, int rep) {
    __shared__ __attribute__((aligned(16))) char smem[65536 + 32 + 352];
    int tid = threadIdx.x;
    volatile LAS unsigned* xw = (volatile LAS unsigned*)(smem + 65536);
    volatile LAS unsigned* tbl = (volatile LAS unsigned*)(smem + 65536 + 32);
    if (tid == 0) { xw[0] = 0u; xw[1] = 0u; xw[2] = 0u; xw[3] = 0u; }
    if (tid == 0) {
#pragma unroll
        for (int i = 0; i < 44; ++i) {
            const unsigned long long v = (i < 42) ? (unsigned long long)prm.in[i < 42 ? i : 0] : (i == 42 ? (unsigned long long)prm.out : (unsigned long long)prm.ws);
            tbl[2 * i] = (unsigned)v; tbl[2 * i + 1] = (unsigned)(v >> 32);
        }
    }
    __syncthreads();
    Ctx p; p.tbl = tbl;
    XcdBarrier bar;
    if (ph_hi - ph_lo > 1) bar = xcd_barrier_post((unsigned*)(p.ws() + OFF_BAR), xw, tid);
    constexpr unsigned long long PMASK = probe_mask(PROBE_KIND);
    if (PROBE_KIND >= 0 && BIDX == 0 && tid == 0) { xw[3] = 0u; xw[4] = (unsigned)__builtin_amdgcn_s_memrealtime(); }
    for (int ph = ph_lo; ph < ph_hi; ++ph) {
        if (ph == 1 + NPP) continue;
        tid = launder(tid);
        run_phase(p, ph, rep, xw + 2, smem, tid);
        if (PROBE_KIND == 13 && BIDX == 0 && tid == 0) xw[5] = (unsigned)__builtin_amdgcn_s_memrealtime();
        if (launder_s(ph_hi) - launder_s(ph_lo) > 1 && ph + 1 < ph_hi) xcd_barrier(bar, tid);
        if (PROBE_KIND >= 0 && BIDX == 0 && tid == 0) {
            const unsigned tn = (unsigned)__builtin_amdgcn_s_memrealtime();
            if (PROBE_KIND == 13) xw[3] = xw[3] + (tn - xw[5]);
            else if ((PMASK >> ph) & 1ull) xw[3] = xw[3] + (tn - xw[4]);
            xw[4] = tn;
        }
    }
    if (PROBE_KIND >= 0 && BIDX == 0 && tid == 0) {
        const unsigned long long tend = __builtin_amdgcn_s_memrealtime() + 9ull * xw[3];
        while (__builtin_amdgcn_s_memrealtime() < tend) __builtin_amdgcn_s_sleep(8);
    }
}

#ifndef MK_ONE_LAUNCH
#define MK_ONE_LAUNCH 1
#endif

extern "C" void kernel_launch(void* const* d_in, const int* in_sizes, int n_in, void* d_out, int out_size, void* d_ws, size_t ws_size, hipStream_t stream) {
    (void)in_sizes; (void)n_in; (void)out_size;
    if (ws_size < WS_NEED) { fprintf(stderr, "workspace too small: %zu < %zu\n", ws_size, (size_t)WS_NEED); return; }
    Params p{};
    for (int i = 0; i < 42; ++i) p.in[i] = (const float*)d_in[i];
    p.out = (float*)d_out; p.ws = (char*)d_ws;
    static int grid_blocks = 0;
    if (!grid_blocks) {
        int dev = 0, cus = 0, per_cu = 0;
        hipGetDevice(&dev);
        hipDeviceGetAttribute(&cus, hipDeviceAttributeMultiprocessorCount, dev);
        hipOccupancyMaxActiveBlocksPerMultiprocessor(&per_cu, fwd_kernel, 256, 0);
        if (per_cu > 2) per_cu = 2;
        if (per_cu < 1) per_cu = 1;
        grid_blocks = cus * per_cu;
    }
    hipMemsetAsync((char*)d_ws + OFF_BAR, 0, BAR_BYTES + CTR_BYTES, stream);
#if MK_ONE_LAUNCH
    {
        int lo = 0, hi = NPHASE, rep = 0;
        void* args[] = {&p, &lo, &hi, &rep};
        hipError_t e = hipLaunchCooperativeKernel((void*)fwd_kernel, dim3(grid_blocks), dim3(256), args, 0, stream);
        if (e != hipSuccess) fprintf(stderr, "cooperative launch failed: %s (grid %d)\n", hipGetErrorString(e), grid_blocks);
    }
#else
#ifndef PROBE_REP
#define PROBE_REP 0
#endif
    for (int ph = 0; ph < NPHASE; ++ph) {
        fwd_kernel<<<grid_blocks, 256, 0, stream>>>(p, ph, ph + 1, 0);
        int kind = -1;
        if (ph == 0) kind = 11; else { const int r = (ph - 1) % NPP; kind = (r == 0) ? 12 : (r - 1) % NPL; }
        if ((PROBE_REP >> kind) & 1) fwd_kernel<<<grid_blocks, 256, 0, stream>>>(p, ph, ph + 1, 1);
    }
#endif
}
```

```cpp
#include <hip/hip_runtime.h>
#include <cstdio>
#include <cstdint>
#include <cmath>

typedef unsigned short bf16_t;
typedef short bf16x8 __attribute__((ext_vector_type(8)));
typedef float f32x4 __attribute__((ext_vector_type(4)));
typedef unsigned u32x4 __attribute__((ext_vector_type(4)));
typedef unsigned u32x2 __attribute__((ext_vector_type(2)));
#define DI __device__ __forceinline__
#define LAS __attribute__((address_space(3)))

constexpr int DM = 1024, INW = 4272, INWP = 4352, DFF = 2816;
constexpr int NPT = 8192;
constexpr int KROWS = 8704;
constexpr float EPS = 1e-6f;
constexpr int C_Z = 0, C_XBC = 512, C_DT = 1280, C_RQ = 1296, C_RK = 1552, C_RV = 1808, C_RG = 2320, C_AQ = 2832, C_AK = 3344, C_AV = 3472,
              C_MCQ = 3600, C_MCKV = 3984;
constexpr size_t O_YS = 8388608, O_SSD = 16777216, O_RET = 20971520, O_CK = 25165824, O_CV = 27262976, O_CC = 29360128, O_CR = 33554432;

constexpr size_t al256(size_t x) { return (x + 255) & ~(size_t)255; }
constexpr size_t SZ_WIN = (size_t)INWP * 1024, SZ_WM = (size_t)4096 * 1024, SZ_WUQ = (size_t)768 * 384, SZ_WUKV = (size_t)1024 * 256,
                 SZ_WBR = (size_t)4 * 1024 * 512, SZ_WOUT = (size_t)1024 * 1024, SZ_WUP = (size_t)5632 * 1024, SZ_WDN = (size_t)1024 * 2816;
constexpr size_t OFF_WIN = 0;
constexpr size_t OFF_WM = OFF_WIN + 4 * SZ_WIN;
constexpr size_t OFF_WUQ = OFF_WM + 4 * SZ_WM;
constexpr size_t OFF_WUKV = OFF_WUQ + 4 * SZ_WUQ;
constexpr size_t OFF_WBR = OFF_WUKV + 4 * SZ_WUKV;
constexpr size_t OFF_WOUT = OFF_WBR + 4 * SZ_WBR;
constexpr size_t OFF_WUP = OFF_WOUT + 4 * SZ_WOUT;
constexpr size_t OFF_WDN = OFF_WUP + 4 * SZ_WUP;
constexpr size_t OFF_MOD = al256(OFF_WDN + 4 * SZ_WDN);
constexpr size_t OFF_T16 = al256(OFF_MOD + (size_t)2 * 5 * 6144 * 4);
constexpr size_t OFF_T8 = OFF_T16 + 2 * 64 * 16 * 4;
constexpr size_t OFF_BAR = al256(OFF_T8 + 2 * 64 * 8 * 4);
constexpr size_t BAR_BYTES = 3456 * 4, CTR_BYTES = (256 + 4 * 128) * 4;
constexpr size_t OFF_CTR = OFF_BAR + BAR_BYTES;
constexpr size_t OFF_DTRAW = al256(OFF_CTR + CTR_BYTES);
constexpr size_t OFF_DT = OFF_DTRAW + (size_t)NPT * 16 * 4;
constexpr size_t OFF_H = al256(OFF_DT + (size_t)NPT * 16 * 4);
constexpr size_t OFF_PROJ = OFF_H + (size_t)NPT * 1024 * 2;
constexpr size_t OFF_XBCA = OFF_PROJ + (size_t)NPT * INWP * 2;
constexpr size_t OFF_KA = OFF_XBCA + (size_t)NPT * 768 * 2;
constexpr size_t OFF_VAT = OFF_KA + (size_t)KROWS * 128 * 2;
constexpr size_t OFF_CKV = OFF_VAT + (size_t)KROWS * 128 * 2;
constexpr size_t OFF_KRP = OFF_CKV + (size_t)KROWS * 256 * 2;
constexpr size_t OFF_QM = OFF_KRP + (size_t)KROWS * 32 * 2;
constexpr size_t OFF_KN = OFF_QM + (size_t)NPT * 768 * 2;
constexpr size_t OFF_VMT = OFF_KN + (size_t)KROWS * 512 * 2;
constexpr size_t OFF_OS = OFF_VMT + (size_t)KROWS * 512 * 2;
constexpr size_t OFF_OR = OFF_OS + (size_t)2 * NPT * 512 * 2;
constexpr size_t OFF_OM = OFF_OR + (size_t)2 * NPT * 512 * 2;
constexpr size_t OFF_OA = OFF_OM + (size_t)NPT * 512 * 2;
constexpr int NSEG = 4, SEGTOK = 2048 / NSEG;
constexpr size_t OFF_SEG = OFF_OA + (size_t)NPT * 512 * 2;
constexpr size_t OFF_SEGD = OFF_SEG + (size_t)64 * NSEG * 4096 * 2;
constexpr size_t WS_END1 = OFF_SEGD + 64 * NSEG * 4;
constexpr size_t OFF_MERGED = OFF_OS;
constexpr size_t OFF_MO = OFF_XBCA;
constexpr size_t OFF_U = OFF_PROJ;
constexpr size_t OFF_ACT = OFF_QM;
constexpr size_t OFF_FO = OFF_PROJ;
static_assert(OFF_MO + (size_t)NPT * 1024 * 4 <= OFF_MERGED, "MO overlaps MERGED");
static_assert(OFF_U + (size_t)NPT * 5632 * 2 <= OFF_ACT, "U overlaps ACT");
static_assert(OFF_ACT + (size_t)NPT * 2816 * 2 <= WS_END1, "ACT beyond end");
constexpr size_t WS_NEED = WS_END1;

struct Params {
    const float* in[42];
    float* out;
    char* ws;
};
struct Ctx {
    volatile LAS unsigned* tbl;
    __device__ __forceinline__ unsigned long long ld(int i) const {
        const unsigned lo = tbl[2 * i], hi = tbl[2 * i + 1];
        return ((unsigned long long)(unsigned)__builtin_amdgcn_readfirstlane((int)hi) << 32) | (unsigned)__builtin_amdgcn_readfirstlane((int)lo);
    }
    __device__ __forceinline__ const float* in(int i) const { return (const float*)ld(i); }
    __device__ __forceinline__ float* out() const { return (float*)ld(42); }
    __device__ __forceinline__ char* ws() const { return (char*)ld(43); }
};

DI float bf2f(unsigned short h) { return __uint_as_float((unsigned)h << 16); }
DI unsigned short f2bf(float f) { return __builtin_bit_cast(unsigned short, (__bf16)f); }
typedef __bf16 bf16x2_t __attribute__((ext_vector_type(2)));
DI unsigned pk2(float lo, float hi) { bf16x2_t v; v[0] = (__bf16)lo; v[1] = (__bf16)hi; return __builtin_bit_cast(unsigned, v); }
DI void unpack8(const u32x4& w, float* v) {
#pragma unroll
    for (int i = 0; i < 4; ++i) { v[2 * i] = __uint_as_float(w[i] << 16); v[2 * i + 1] = __uint_as_float(w[i] & 0xffff0000u); }
}
DI u32x4 pack8(const float* v) { u32x4 w; w[0] = pk2(v[0], v[1]); w[1] = pk2(v[2], v[3]); w[2] = pk2(v[4], v[5]); w[3] = pk2(v[6], v[7]); return w; }
DI float log1pe(float e) { return e < 1e-4f ? e - 0.5f * e * e : __builtin_amdgcn_logf(1.f + e) * 0.6931471805599453f; }
DI float siluf(float x) { return x / (1.f + __expf(-x)); }
DI float sigmoidf(float x) { return 1.f / (1.f + __expf(-x)); }
DI int lanel() { int l = (int)__lane_id(); asm volatile("" : "+v"(l)); return l; }
DI float shx(float v, int m) { const int l = lanel(); return __int_as_float(__builtin_amdgcn_ds_bpermute((l ^ m) << 2, __float_as_int(v))); }
DI float shf(float v, int src) { return __int_as_float(__builtin_amdgcn_ds_bpermute(src << 2, __float_as_int(v))); }
DI float shu(float v, int d) { const int l = lanel(); const int sidx = (l - d) < 0 ? l : (l - d); return __int_as_float(__builtin_amdgcn_ds_bpermute(sidx << 2, __float_as_int(v))); }
DI float gmax4(float v) {
    auto a = __builtin_amdgcn_permlane16_swap(__float_as_uint(v), __float_as_uint(v), false, false);
    v = fmaxf(__uint_as_float(a[0]), __uint_as_float(a[1]));
    auto b = __builtin_amdgcn_permlane32_swap(__float_as_uint(v), __float_as_uint(v), false, false);
    return fmaxf(__uint_as_float(b[0]), __uint_as_float(b[1]));
}
DI float gsum4(float v) {
    auto a = __builtin_amdgcn_permlane16_swap(__float_as_uint(v), __float_as_uint(v), false, false);
    v = __uint_as_float(a[0]) + __uint_as_float(a[1]);
    auto b = __builtin_amdgcn_permlane32_swap(__float_as_uint(v), __float_as_uint(v), false, false);
    return __uint_as_float(b[0]) + __uint_as_float(b[1]);
}
DI float wsum(float v) {
#pragma unroll
    for (int o = 32; o >= 1; o >>= 1) v += shx(v, o);
    return v;
}
typedef const __attribute__((address_space(1))) u32x4* gp128;
DI u32x4 gld16(const void* p) { return *(gp128)(unsigned long long)p; }
DI void st_wt8(void* p, u32x2 v) { __hip_atomic_store((unsigned long long*)p, ((unsigned long long)v[1] << 32) | v[0], __ATOMIC_RELAXED, __HIP_MEMORY_SCOPE_AGENT); }
DI void st_wt16(void* p, u32x4 v) { st_wt8(p, (u32x2){v[0], v[1]}); st_wt8((char*)p + 8, (u32x2){v[2], v[3]}); }
DI void st_wt2(bf16_t* p, bf16_t v) { __hip_atomic_store(p, v, __ATOMIC_RELAXED, __HIP_MEMORY_SCOPE_AGENT); }
DI void st_wt4f(float* p, float v) { __hip_atomic_store(p, v, __ATOMIC_RELAXED, __HIP_MEMORY_SCOPE_AGENT); }
DI int launder(int x) { asm volatile("" : "+v"(x)); return x; }
DI int launder_s(int x) { asm volatile("" : "+s"(x)); return x; }
#define BIDX launder_s((int)blockIdx.x)
DI int FQ(int q) { return (4 - q) & 3; }
DI int tile_off(int rows, int ks, int row, int g, int q) { return (ks * rows + row) * 64 + ((g ^ FQ(q)) << 4); }

#define XB_TMO      128
#define XB_XCNT(j)  (256  + 64 * (j))
#define XB_XSUB(j)  (1280 + 64 * (j))
#define XB_XGEN(j)  (2304 + 64 * (j))
#define XB_TOP      3328
#define XB_TOPGEN   3392
#define XB_SPIN_CAP (1u << 22)
DI unsigned xb_ld(unsigned* p) { return __hip_atomic_load(p, __ATOMIC_RELAXED, __HIP_MEMORY_SCOPE_AGENT); }
DI unsigned xb_add(unsigned* p, unsigned v) { return __hip_atomic_fetch_add(p, v, __ATOMIC_RELAXED, __HIP_MEMORY_SCOPE_AGENT); }
DI unsigned xb_xcc_id() { return (unsigned)__builtin_amdgcn_s_getreg((3 << 11) | 20) & 0xFu; }
#define XB_SPIN(cond, bar) do { unsigned _sp = 0; while (cond) { __builtin_amdgcn_s_sleep(1); \
    if ((++_sp & 255u) == 0u) { if (xb_ld(&(bar)[XB_TMO])) break; if (_sp > XB_SPIN_CAP) { atomicAdd(&(bar)[XB_TMO], 1u); break; } } } } while (0)
struct XcdBarrier { unsigned* bar; unsigned x; volatile LAS unsigned* st; };
DI XcdBarrier xcd_barrier_post(unsigned* bar, volatile LAS unsigned* st, int tid) {
    XcdBarrier b; b.bar = bar; b.x = xb_xcc_id(); b.st = st;
    if (tid == 0) (void)xb_add(&bar[XB_XCNT(b.x)], 1u);
    return b;
}
DI void xcd_barrier_complete(unsigned* bar, unsigned x, unsigned& nloc, unsigned& nx) {
    const unsigned G = gridDim.x * gridDim.y * gridDim.z;
    unsigned sum, cnt, mine, sp = 0u;
    for (;;) {
        sum = 0u; cnt = 0u; mine = 0u;
#pragma unroll
        for (unsigned j = 0; j < 16; ++j) { const unsigned c = xb_ld(&bar[XB_XCNT(j)]); sum += c; cnt += (c > 0u) ? 1u : 0u; mine = (j == x) ? c : mine; }
        if (sum == G) break;
        __builtin_amdgcn_s_sleep(1);
        if ((++sp & 255u) == 0u) { if (xb_ld(&bar[XB_TMO])) break; if (sp > XB_SPIN_CAP) { atomicAdd(&bar[XB_TMO], 1u); break; } }
    }
    nloc = mine > 0u ? mine : 1u; nx = cnt > 0u ? cnt : 1u;
}
DI void xcd_barrier(const XcdBarrier& b, int tid) {
    asm volatile("s_waitcnt vmcnt(0)" ::: "memory");
    __syncthreads();
    if (tid == 0) {
        unsigned* bar = b.bar;
        __builtin_amdgcn_s_waitcnt(0);
        unsigned nloc = b.st[0], nx = b.st[1];
        if (nloc == 0u) { xcd_barrier_complete(bar, b.x, nloc, nx); b.st[0] = nloc; b.st[1] = nx; }
        const unsigned old = xb_add(&bar[XB_XSUB(b.x)], 1u);
        const unsigned gen = old / nloc;
        if (old + 1u == (gen + 1u) * nloc) {
            __builtin_amdgcn_fence(__ATOMIC_RELEASE, "agent");
            asm volatile("s_waitcnt vmcnt(0)" ::: "memory");
            const unsigned og = xb_add(&bar[XB_TOP], 1u);
            const unsigned tg = og / nx;
            if (og + 1u == (tg + 1u) * nx) xb_add(&bar[XB_TOPGEN], 1u);
            else XB_SPIN(xb_ld(&bar[XB_TOPGEN]) == tg, bar);
            __builtin_amdgcn_fence(__ATOMIC_ACQUIRE, "agent");
            xb_add(&bar[XB_XGEN(b.x)], 1u);
            asm volatile("s_waitcnt vmcnt(0)" ::: "memory");
        } else {
            XB_SPIN(xb_ld(&bar[XB_XGEN(b.x)]) == gen, bar);
            __builtin_amdgcn_fence(__ATOMIC_ACQUIRE, "agent");
            asm volatile("s_waitcnt vmcnt(0)" ::: "memory");
        }
    }
    __syncthreads();
}

struct Tok { int lat, b, t, L, cond, krow, seq0; size_t gx; };
DI Tok tok_info(int m, int ps) {
    Tok k;
    if (m < 4096) { k.lat = 0; k.b = ps * 16 + (m >> 8); k.t = m & 255; k.L = 256; k.cond = 0; k.krow = m; k.seq0 = m & ~255; k.gx = (size_t)ps * 4096 + m; }
    else { const int mm = m - 4096, j = mm >> 11; k.lat = 1; k.b = ps * 2 + j; k.t = mm & 2047; k.L = 2048; k.cond = 1 + k.b; k.krow = 4096 + j * 2304 + 256 + k.t;
           k.seq0 = 4096 + j * 2048; k.gx = (size_t)8192 + (size_t)ps * 4096 + mm; }
    return k;
}

template <int NTA, int NTB, bool LOWREG = false>
DI void gemm_kloop(f32x4 (&acc)[NTA][NTB], const bf16_t* __restrict__ W, size_t ldw, const bf16_t* __restrict__ X, size_t ldx, int K, char* smem, int tid) {
    constexpr int BF = 32 * NTA, BT = 32 * NTB;
    constexpr int WB = BF * 128, STG = (BF + BT) * 128;
    constexpr int NPW = BF / 8, NPX = BT / 8, NPIECE = NPW + NPX, PPW = NPIECE / 4;
    static_assert(NPIECE % 4 == 0, "pieces must divide over 4 waves");
    tid = launder(tid);
    const int lane = tid & 63, wv = tid >> 6, wn = wv >> 1, wt = wv & 1, fr = lane & 15, g = lane >> 4;
    constexpr int PWW = NPW / 4, PXX = PPW - PWW;
    const int wvu = __builtin_amdgcn_readfirstlane(wv);
    auto lane_off = [&](int j, int ln) -> unsigned {
        const bool isw = j < PWW;
        const int pp = isw ? wvu * PWW + j : wvu * PXX + (j - PWW);
        const int rows = isw ? BF : BT;
        const int rb = pp % (rows / 16);
        const int rl = ln >> 2;
        const int q = isw ? (((rb * 16 + rl) / (4 * NTA)) & 3) : ((rl >> 2) & 3);
        const int gl = (ln & 3) ^ FQ(q);
        return (unsigned)rl * (unsigned)(isw ? ldw : ldx) + (unsigned)(gl * 8);
    };
    unsigned poff[PPW];
    if (!LOWREG) {
#pragma unroll
        for (int j = 0; j < PPW; ++j) poff[j] = lane_off(j, lane);
    }
    auto issue = [&](int k0, char* sdst) {
        const int ln = LOWREG ? launder(lane) : lane;
#pragma unroll
        for (int j = 0; j < PPW; ++j) {
            const bool isw = j < PWW;
            const int pp = isw ? wvu * PWW + j : wvu * PXX + (j - PWW);
            const int rows = isw ? BF : BT;
            const int ks = pp / (rows / 16), rb = pp % (rows / 16);
            const bf16_t* base = (isw ? W + (size_t)(rb * 16) * ldw : X + (size_t)(rb * 16) * ldx) + k0 + ks * 32;
            const unsigned off = LOWREG ? lane_off(j, ln) : poff[j];
            __builtin_amdgcn_global_load_lds((const unsigned*)(base + off), (unsigned*)(sdst + (isw ? 0 : WB) + (ks * rows + rb * 16) * 64), 16, 0, 0);
        }
    };
    const int aoff = tile_off(BF, 0, wn * 16 * NTA + 4 * NTA * (fr >> 2) + (fr & 3), g, fr >> 2);
    const int boff = WB + tile_off(BT, 0, wt * 16 * NTB + fr, g, (fr >> 2) & 3);
    const int nk = K >> 6;
    issue(0, smem);
    asm volatile("s_waitcnt vmcnt(0)" ::: "memory");
    __syncthreads();
    for (int kt = 0; kt < nk; ++kt) {
        if (kt + 1 < nk) issue((kt + 1) << 6, smem + ((kt + 1) & 1) * STG);
        const char* sb = smem + (kt & 1) * STG;
        __builtin_amdgcn_s_setprio(1);
#pragma unroll
        for (int kk = 0; kk < 2; ++kk) {
            if (LOWREG) {
                bf16x8 bfr[NTB];
#pragma unroll
                for (int mt = 0; mt < NTB; ++mt) bfr[mt] = *(const bf16x8*)(sb + boff + mt * 1024 + kk * BT * 64);
#pragma unroll
                for (int a = 0; a < NTA; ++a) {
                    const bf16x8 af1 = *(const bf16x8*)(sb + aoff + a * 256 + kk * BF * 64);
#pragma unroll
                    for (int mt = 0; mt < NTB; ++mt) acc[a][mt] = __builtin_amdgcn_mfma_f32_16x16x32_bf16(af1, bfr[mt], acc[a][mt], 0, 0, 0);
                    __builtin_amdgcn_sched_barrier(0);
                }
            } else {
                bf16x8 af[NTA], bfr[NTB];
#pragma unroll
                for (int a = 0; a < NTA; ++a) af[a] = *(const bf16x8*)(sb + aoff + a * 256 + kk * BF * 64);
#pragma unroll
                for (int mt = 0; mt < NTB; ++mt) bfr[mt] = *(const bf16x8*)(sb + boff + mt * 1024 + kk * BT * 64);
#pragma unroll
                for (int a = 0; a < NTA; ++a)
#pragma unroll
                    for (int mt = 0; mt < NTB; ++mt) acc[a][mt] = __builtin_amdgcn_mfma_f32_16x16x32_bf16(af[a], bfr[mt], acc[a][mt], 0, 0, 0);
            }
        }
        __builtin_amdgcn_s_setprio(0);
        asm volatile("s_waitcnt vmcnt(0)" ::: "memory");
        __syncthreads();
    }
}

struct WTile { const float* src; bf16_t* dst; int K, N, k0, n0; };
DI WTile wtile_decode(const Ctx& p, int it) {
    constexpr int T_IN = 16 * 68, T_M = 16 * 64, T_UQ = 6 * 12, T_UKV = 4 * 16, T_BR = 8 * 16, T_OUT = 16 * 16, T_UP = 16 * 88, T_DN = 44 * 16;
    constexpr int T_LAYER = T_IN + T_M + T_UQ + T_UKV + 4 * T_BR + T_OUT + T_UP + T_DN;
    char* ws = p.ws();
    const int l = it / T_LAYER; int k = it % T_LAYER;
    WTile t; int ntn;
    if (k < T_IN) { t.src = p.in(16) + (size_t)l * 1024 * INW; t.dst = (bf16_t*)(ws + OFF_WIN) + (size_t)l * SZ_WIN; t.K = 1024; t.N = INW; ntn = 68; }
    else if ((k -= T_IN) < T_M) { t.src = p.in(35) + (size_t)l * 1024 * 4096; t.dst = (bf16_t*)(ws + OFF_WM) + (size_t)l * SZ_WM; t.K = 1024; t.N = 4096; ntn = 64; }
    else if ((k -= T_M) < T_UQ) { t.src = p.in(28) + (size_t)l * 384 * 768; t.dst = (bf16_t*)(ws + OFF_WUQ) + (size_t)l * SZ_WUQ; t.K = 384; t.N = 768; ntn = 12; }
    else if ((k -= T_UQ) < T_UKV) { t.src = p.in(30) + (size_t)l * 256 * 1024; t.dst = (bf16_t*)(ws + OFF_WUKV) + (size_t)l * SZ_WUKV; t.K = 256; t.N = 1024; ntn = 16; }
    else if ((k -= T_UKV) < 4 * T_BR) { const int j = k / T_BR; k -= j * T_BR; t.src = (j == 0 ? p.in(31) : j == 1 ? p.in(32) : j == 2 ? p.in(33) : p.in(34)) + (size_t)l * 512 * 1024;
                                        t.dst = (bf16_t*)(ws + OFF_WBR) + (size_t)(l * 4 + j) * 1024 * 512; t.K = 512; t.N = 1024; ntn = 16; }
    else if ((k -= 4 * T_BR) < T_OUT) { t.src = p.in(37) + (size_t)l * 1024 * 1024; t.dst = (bf16_t*)(ws + OFF_WOUT) + (size_t)l * SZ_WOUT; t.K = 1024; t.N = 1024; ntn = 16; }
    else if ((k -= T_OUT) < T_UP) { t.src = p.in(38) + (size_t)l * 1024 * 5632; t.dst = (bf16_t*)(ws + OFF_WUP) + (size_t)l * SZ_WUP; t.K = 1024; t.N = 5632; ntn = 88; }
    else { k -= T_UP; t.src = p.in(41) + (size_t)l * 2816 * 1024; t.dst = (bf16_t*)(ws + OFF_WDN) + (size_t)l * SZ_WDN; t.K = 2816; t.N = 1024; ntn = 16; }
    t.k0 = (k / ntn) * 64; t.n0 = (k % ntn) * 64;
    return t;
}
DI void wtile_load(const WTile& t, int tid, f32x4 (&v)[4]) {
    const int r = tid >> 4, c4 = tid & 15;
#pragma unroll
    for (int i = 0; i < 4; ++i) {
        v[i] = (f32x4){0.f, 0.f, 0.f, 0.f};
        if (t.n0 + 4 * c4 < t.N) v[i] = *(const f32x4*)(t.src + (size_t)(t.k0 + r + 16 * i) * t.N + t.n0 + 4 * c4);
    }
}
DI void wtile_finish(const WTile& t, const f32x4 (&v)[4], char* smem, int tid) {
    float* tl = (float*)smem;
    const int r = tid >> 4, c4 = tid & 15;
#pragma unroll
    for (int i = 0; i < 4; ++i) {
        const int row = r + 16 * i;
        tl[row * 65 + 4 * c4 + 0] = v[i][0]; tl[row * 65 + 4 * c4 + 1] = v[i][1]; tl[row * 65 + 4 * c4 + 2] = v[i][2]; tl[row * 65 + 4 * c4 + 3] = v[i][3];
    }
    __syncthreads();
#pragma unroll
    for (int i = 0; i < 2; ++i) {
        const int q = tid + 256 * i, n = q >> 3, c = q & 7;
        float o[8];
#pragma unroll
        for (int j = 0; j < 8; ++j) o[j] = tl[(8 * c + j) * 65 + n];
        *(u32x4*)(t.dst + (size_t)(t.n0 + n) * t.K + t.k0 + 8 * c) = pack8(o);
    }
    __syncthreads();
}

DI void phase_prep_w(const Ctx& p, char* smem, int tid) {
    char* ws = p.ws();
    constexpr int T_IN = 16 * 68, T_M = 16 * 64, T_UQ = 6 * 12, T_UKV = 4 * 16, T_BR = 8 * 16, T_OUT = 16 * 16, T_UP = 16 * 88, T_DN = 44 * 16;
    constexpr int T_LAYER = T_IN + T_M + T_UQ + T_UKV + 4 * T_BR + T_OUT + T_UP + T_DN;
    constexpr int N_MOD = 2 * 96;
    const int total = 2 * T_LAYER + N_MOD + 1;
    constexpr int N_MODI = 2 * 192;
    for (int it = BIDX; it < N_MODI + 1; it += gridDim.x) {
        if (it < N_MODI) {
            const int l = it / 192, cb = it % 192;
            float* sc = (float*)smem;
            float* red = sc + 5 * 1024;
            __syncthreads();
            for (int e = tid; e < 5 * 1024; e += 256) {
                const int c = e >> 10, kk = e & 1023;
                const float v = (c == 0) ? p.in(9)[kk] : p.in(8)[(c - 1) * 1024 + kk];
                sc[e] = siluf(v);
            }
            __syncthreads();
            const int col = tid & 31, kg = tid >> 5;
            float a[5] = {0.f, 0.f, 0.f, 0.f, 0.f};
            const float* w = p.in(10) + ((size_t)l * 1024 + kg * 128) * 6144 + cb * 32 + col;
#pragma unroll 1
            for (int k0 = 0; k0 < 128; k0 += 16) {
                float wv[16];
#pragma unroll
                for (int j = 0; j < 16; ++j) wv[j] = w[(size_t)(k0 + j) * 6144];
#pragma unroll
                for (int j = 0; j < 16; ++j)
#pragma unroll
                    for (int c = 0; c < 5; ++c) a[c] += wv[j] * sc[c * 1024 + kg * 128 + k0 + j];
            }
#pragma unroll
            for (int c = 0; c < 5; ++c) red[(kg * 5 + c) * 32 + col] = a[c];
            __syncthreads();
            if (tid < 160) {
                const int c = tid >> 5, cl = tid & 31;
                float sm = 0.f;
#pragma unroll
                for (int k8 = 0; k8 < 8; ++k8) sm += red[(k8 * 5 + c) * 32 + cl];
                float* mod = (float*)(ws + OFF_MOD);
                mod[((size_t)l * 5 + c) * 6144 + cb * 32 + cl] = sm + p.in(11)[(size_t)l * 6144 + cb * 32 + cl];
            }
            __syncthreads();
        } else {
            float* t16 = (float*)(ws + OFF_T16); float* t8 = (float*)(ws + OFF_T8);
            for (int e = tid; e < 64 * 16 + 64 * 8; e += 256) {
                const bool small = e >= 1024;
                const int ee = small ? e - 1024 : e;
                const int pos = small ? (ee >> 3) : (ee >> 4), i = small ? (ee & 7) : (ee & 15);
                const double r = small ? 0.31622776601683794 : 0.5623413251903491;
                double th = 1.0;
                for (int j = 0; j < i; ++j) th *= r;
                const double t2 = th * th;
                double c1 = 1.0, s1 = th;
                double tc = 1.0, tsn = th;
                for (int k = 1; k < 14; ++k) {
                    tc = -tc * t2 / (double)((2 * k - 1) * (2 * k));
                    tsn = -tsn * t2 / (double)((2 * k) * (2 * k + 1));
                    c1 += tc; s1 += tsn;
                }
                double c = 1.0, sn = 0.0;
                for (int j = 0; j < pos; ++j) { const double cn = c * c1 - sn * s1, snn = sn * c1 + c * s1; c = cn; sn = snn; }
                if (small) { t8[ee] = (float)c; t8[512 + ee] = (float)sn; } else { t16[ee] = (float)c; t16[1024 + ee] = (float)sn; }
            }
        }
    }
    {
        int it = BIDX;
        f32x4 va[4];
        if (it < 2 * T_LAYER) { const WTile c0 = wtile_decode(p, it); wtile_load(c0, tid, va); }
        while (it < 2 * T_LAYER) {
            const int nx = it + gridDim.x;
            f32x4 vb[4];
            if (nx < 2 * T_LAYER) { const WTile nt = wtile_decode(p, nx); wtile_load(nt, tid, vb); }
            { const WTile cur = wtile_decode(p, launder(it)); wtile_finish(cur, va, smem, tid); }
#pragma unroll
            for (int i = 0; i < 4; ++i) va[i] = vb[i];
            it = nx;
        }
    }
}

DI void row_load(const float* r, int lane, f32x4 (&v)[4]) {
#pragma unroll
    for (int i = 0; i < 4; ++i) v[i] = *(const f32x4*)(r + 4 * lane + 256 * i);
}
DI float row_ss(const f32x4 (&v)[4]) {
    float s = 0.f;
#pragma unroll
    for (int i = 0; i < 4; ++i) s += v[i][0] * v[i][0] + v[i][1] * v[i][1] + v[i][2] * v[i][2] + v[i][3] * v[i][3];
    return wsum(s);
}
DI void row_modnorm_store(const f32x4 (&x)[4], const float* gw, const float* sh, const float* sc, bf16_t* dst, int lane) {
    const float rstd = rsqrtf(row_ss(x) * (1.f / 1024.f) + EPS);
#pragma unroll
    for (int i = 0; i < 4; ++i) {
        const int c = 4 * lane + 256 * i;
        const f32x4 g = *(const f32x4*)(gw + c), s = *(const f32x4*)(sh + c), q = *(const f32x4*)(sc + c);
        float o[4];
#pragma unroll
        for (int j = 0; j < 4; ++j) o[j] = (x[i][j] * rstd) * g[j] * (1.f + q[j]) + s[j];
        u32x2 w; w[0] = pk2(o[0], o[1]); w[1] = pk2(o[2], o[3]);
        *(u32x2*)(dst + c) = w;
    }
}
DI const float* x_in_row(const Ctx& p, int m, int ps) {
    return (m < 4096) ? p.in(0) + ((size_t)ps * 4096 + m) * 1024 : p.in(1) + ((size_t)ps * 4096 + (m - 4096)) * 1024;
}
DI void phase_h1(const Ctx& p, int ps, int tid) {
    const int lane = tid & 63, wv = tid >> 6;
    const float* mod = (const float*)(p.ws() + OFF_MOD);
    bf16_t* H = (bf16_t*)(p.ws() + OFF_H);
    for (int m = BIDX * 4 + wv; m < NPT; m += gridDim.x * 4) {
        const Tok k = tok_info(m, ps);
        f32x4 x[4]; row_load(x_in_row(p, m, ps), lane, x);
        const float* md = mod + (size_t)(0 * 5 + k.cond) * 6144;
        row_modnorm_store(x, p.in(12), md + 0, md + 1024, H + (size_t)m * 1024, lane);
    }
}
DI void phase_res(const Ctx& p, int ps, int l, int which, int tid) {
    const int lane = tid & 63, wv = tid >> 6;
    const float* mod = (const float*)(p.ws() + OFF_MOD);
    bf16_t* H = (bf16_t*)(p.ws() + OFF_H);
    const float* Y = (const float*)(p.ws() + (which ? OFF_FO : OFF_MO));
    const float* gpost = (which ? p.in(15) : p.in(13)) + (size_t)l * 1024;
    const int bid = BIDX, rbase = (bid & 7) * 1024 + (bid >> 3) * 4 + wv, rstep = (gridDim.x >> 3) * 4;
    for (int mo = 0; (bid >> 3) * 4 + wv + mo < 1024; mo += rstep) {
        const int m = rbase + mo;
        const Tok k = tok_info(m, ps);
        const float* md = mod + (size_t)(l * 5 + k.cond) * 6144;
        const float* gate = md + (which ? 5 * 1024 : 2 * 1024);
        f32x4 x[4], y[4];
        if (l == 0 && which == 0) row_load(x_in_row(p, m, ps), lane, x); else row_load(p.out() + k.gx * 1024, lane, x);
        row_load(Y + (size_t)m * 1024, lane, y);
        const float rstd = rsqrtf(row_ss(y) * (1.f / 1024.f) + EPS);
#pragma unroll
        for (int i = 0; i < 4; ++i) {
            const int c = 4 * lane + 256 * i;
            const f32x4 g = *(const f32x4*)(gate + c), w = *(const f32x4*)(gpost + c);
#pragma unroll
            for (int j = 0; j < 4; ++j) x[i][j] = x[i][j] + g[j] * ((y[i][j] * rstd) * w[j]);
            *(f32x4*)(p.out() + k.gx * 1024 + c) = x[i];
        }
        if (which == 0) row_modnorm_store(x, p.in(14) + (size_t)l * 1024, md + 3 * 1024, md + 4 * 1024, H + (size_t)m * 1024, lane);
        else if (l + 1 < 2) { const float* md2 = mod + (size_t)((l + 1) * 5 + k.cond) * 6144;
                              row_modnorm_store(x, p.in(12) + (size_t)(l + 1) * 1024, md2, md2 + 1024, H + (size_t)m * 1024, lane); }
    }
}

DI bool xcd_tile(int it, int Mt, int Nt, int B, int& mt, int& nt) {
    const int x = BIDX & 7, loc = BIDX >> 3, nloc = gridDim.x >> 3;
    const int MP = Mt >> 3;
    const int idx = it * nloc + loc;
    if (idx >= MP * Nt) return false;
    const int ng = idx / (MP * B);
    const int bw = min(B, Nt - ng * B);
    const int r = idx - ng * MP * B;
    mt = x * MP + r / bw; nt = ng * B + r % bw;
    return true;
}
DI void phase_gemm_in(const Ctx& p, int l, char* smem, int tid) {
    const bf16_t* W = (const bf16_t*)(p.ws() + OFF_WIN) + (size_t)l * SZ_WIN;
    const bf16_t* X = (const bf16_t*)(p.ws() + OFF_H);
    bf16_t* PROJ = (bf16_t*)(p.ws() + OFF_PROJ);
    float* DTRAW = (float*)(p.ws() + OFF_DTRAW);
    const int lane = tid & 63, wv = tid >> 6, wn = wv >> 1, wt = wv & 1, fr = lane & 15, g = lane >> 4;
    for (int it = 0;; ++it) {
        int mt0, nt0; if (!xcd_tile(it, 64, 34, 8, mt0, nt0)) break;
        const int m0 = mt0 * 128, n0 = nt0 * 128;
        f32x4 acc[4][4];
#pragma unroll
        for (int a = 0; a < 4; ++a)
#pragma unroll
            for (int b = 0; b < 4; ++b) acc[a][b] = (f32x4){0.f, 0.f, 0.f, 0.f};
        gemm_kloop<4, 4>(acc, W + (size_t)n0 * 1024, 1024, X + (size_t)m0 * 1024, 1024, 1024, smem, tid);
        const int fb = n0 + wn * 64 + 16 * g;
#pragma unroll
        for (int mt = 0; mt < 4; ++mt) {
            const int m = m0 + wt * 64 + 16 * mt + fr;
            float v[16];
#pragma unroll
            for (int a = 0; a < 4; ++a)
#pragma unroll
                for (int r = 0; r < 4; ++r) v[4 * a + r] = acc[a][mt][r];
            bf16_t* d = PROJ + (size_t)m * INWP + fb;
            *(u32x4*)d = pack8(v); *(u32x4*)(d + 8) = pack8(v + 8);
            if (fb == C_DT) {
                float* dd = DTRAW + (size_t)m * 16;
#pragma unroll
                for (int a = 0; a < 4; ++a) *(f32x4*)(dd + 4 * a) = acc[a][mt];
            }
        }
    }
}

template <bool F32OUT>
DI void phase_gemm_plain(const bf16_t* W, int K, const bf16_t* X, size_t ldx, int Mtiles, int Ntiles, void* out, size_t ldo, char* smem, int tid) {
    const int lane = tid & 63, wv = tid >> 6, wn = wv >> 1, wt = wv & 1, fr = lane & 15, g = lane >> 4;
    for (int it = 0;; ++it) {
        int mt0, nt0; if (!xcd_tile(it, Mtiles, Ntiles, 8, mt0, nt0)) break;
        const int m0 = mt0 * 128, n0 = nt0 * 128;
        f32x4 acc[4][4];
#pragma unroll
        for (int a = 0; a < 4; ++a)
#pragma unroll
            for (int b = 0; b < 4; ++b) acc[a][b] = (f32x4){0.f, 0.f, 0.f, 0.f};
        gemm_kloop<4, 4>(acc, W + (size_t)n0 * K, K, X + (size_t)m0 * ldx, ldx, K, smem, tid);
        const int fb = n0 + wn * 64 + 16 * g;
#pragma unroll
        for (int mt = 0; mt < 4; ++mt) {
            const int m = m0 + wt * 64 + 16 * mt + fr;
            if (F32OUT) {
                float* d = (float*)out + (size_t)m * ldo + fb;
#pragma unroll
                for (int a = 0; a < 4; ++a) *(f32x4*)(d + 4 * a) = acc[a][mt];
            } else {
                float v[16];
#pragma unroll
                for (int a = 0; a < 4; ++a)
#pragma unroll
                    for (int r = 0; r < 4; ++r) v[4 * a + r] = acc[a][mt][r];
                bf16_t* d = (bf16_t*)out + (size_t)m * ldo + fb;
                *(u32x4*)d = pack8(v); *(u32x4*)(d + 8) = pack8(v + 8);
            }
        }
    }
}

DI void gemm_uq_tile(const Ctx& p, int l, int ps, int tile, char* smem, int tid) {
    const bf16_t* W = (const bf16_t*)(p.ws() + OFF_WUQ) + (size_t)l * SZ_WUQ;
    const bf16_t* X = (const bf16_t*)(p.ws() + OFF_PROJ) + C_MCQ;
    bf16_t* QM = (bf16_t*)(p.ws() + OFF_QM);
    const float* t8 = (const float*)(p.ws() + OFF_T8);
    const int lane = tid & 63, wv = tid >> 6, wn = wv >> 1, wt = wv & 1, fr = lane & 15, g = lane >> 4;
    const int mt0 = tile / 6, nt0 = tile % 6, m0 = mt0 * 128, n0 = nt0 * 128;
    f32x4 acc[4][4];
#pragma unroll
    for (int a = 0; a < 4; ++a)
#pragma unroll
        for (int b = 0; b < 4; ++b) acc[a][b] = (f32x4){0.f, 0.f, 0.f, 0.f};
    gemm_kloop<4, 4>(acc, W + (size_t)n0 * 384, 384, X + (size_t)m0 * INWP, INWP, 384, smem, tid);
    const int fb = n0 + wn * 64 + 16 * g;
    const int o = fb % 96;
#pragma unroll
    for (int mt = 0; mt < 4; ++mt) {
        const int m = m0 + wt * 64 + 16 * mt + fr;
        float v[16];
#pragma unroll
        for (int a = 0; a < 4; ++a)
#pragma unroll
            for (int r = 0; r < 4; ++r) v[4 * a + r] = acc[a][mt][r];
        if (m >= 4096 && o >= 64) {
            const int t = (m - 4096) & 2047;
            const int pos = (o == 64) ? (t >> 6) : (t & 63);
#pragma unroll
            for (int j = 0; j < 8; ++j) {
                const float c = t8[pos * 8 + j], s = t8[512 + pos * 8 + j];
                const float x1 = v[j], x2 = v[j + 8];
                v[j] = x1 * c - x2 * s; v[j + 8] = x2 * c + x1 * s;
            }
        }
        bf16_t* d = QM + (size_t)m * 768 + fb;
        st_wt16(d, pack8(v)); st_wt16(d + 8, pack8(v + 8));
    }
}

DI void gemm_ukv_tile(const Ctx& p, int l, int tile, char* smem, int tid) {
    const bf16_t* W = (const bf16_t*)(p.ws() + OFF_WUKV) + (size_t)l * SZ_WUKV;
    const bf16_t* X = (const bf16_t*)(p.ws() + OFF_CKV);
    bf16_t* KN = (bf16_t*)(p.ws() + OFF_KN);
    bf16_t* VMT = (bf16_t*)(p.ws() + OFF_VMT);
    const int lane = tid & 63, wv = tid >> 6, wn = wv >> 1, wt = wv & 1, fr = lane & 15, g = lane >> 4;
    const int mt0 = tile / 8, nt0 = tile % 8, m0 = mt0 * 128, n0 = nt0 * 128;
    f32x4 acc[4][4];
#pragma unroll
    for (int a = 0; a < 4; ++a)
#pragma unroll
        for (int b = 0; b < 4; ++b) acc[a][b] = (f32x4){0.f, 0.f, 0.f, 0.f};
    gemm_kloop<4, 4>(acc, W + (size_t)n0 * 256, 256, X + (size_t)m0 * 256, 256, 256, smem, tid);
    const int fb = n0 + wn * 64 + 16 * g;
    const int head = fb >> 7, o = fb & 127;
    int key0, Lk;
    if (m0 < 4096) { key0 = m0 & ~255; Lk = 256; } else { const int j = (m0 - 4096) / 2304; key0 = 4096 + j * 2304; Lk = 2304; }
#pragma unroll
    for (int mt = 0; mt < 4; ++mt) {
        const int m = m0 + wt * 64 + 16 * mt + fr;
        float v[16];
#pragma unroll
        for (int a = 0; a < 4; ++a)
#pragma unroll
            for (int r = 0; r < 4; ++r) v[4 * a + r] = acc[a][mt][r];
        if (o < 64) {
            bf16_t* d = KN + (size_t)m * 512 + head * 64 + o;
            st_wt16(d, pack8(v)); st_wt16(d + 8, pack8(v + 8));
        } else {
            bf16_t* d = VMT + (size_t)key0 * 512 + (size_t)(head * 64 + (o - 64)) * Lk + (m - key0);
#pragma unroll
            for (int i = 0; i < 16; ++i) st_wt2(d + (size_t)i * Lk, f2bf(v[i]));
        }
    }
}

DI void phase_merge(const Ctx& p, int l, char* smem, int tid) {
    for (int it = 0;; ++it) {
        int mt0, nt0; if (!xcd_tile(it, 64, 8, 8, mt0, nt0)) break;
        const int m0 = mt0 * 128, n0 = nt0 * 128;
        u32x2 mgp[4][4];
#pragma unroll
        for (int a = 0; a < 4; ++a)
#pragma unroll
            for (int b = 0; b < 4; ++b) mgp[a][b] = (u32x2){0u, 0u};
#pragma unroll 1
        for (int br = 0; br < 4; ++br) {
            u32x2 gpk[4][4];
            {
                f32x4 ga[4][4];
#pragma unroll
                for (int a = 0; a < 4; ++a)
#pragma unroll
                    for (int b = 0; b < 4; ++b) ga[a][b] = (f32x4){0.f, 0.f, 0.f, 0.f};
                gemm_kloop<4, 4, false>(ga, (const bf16_t*)(p.ws() + OFF_WM) + (size_t)l * SZ_WM + (size_t)(br * 1024 + n0) * 1024, 1024,
                                       (const bf16_t*)(p.ws() + OFF_H) + (size_t)m0 * 1024, 1024, 1024, smem, tid);
                const int t2 = launder(tid);
                const int fb = n0 + (t2 >> 7) * 64 + 16 * ((t2 & 63) >> 4);
                const float* bm = p.in(36) + (size_t)l * 4096;
#pragma unroll
                for (int a = 0; a < 4; ++a) {
                    const f32x4 bv = *(const f32x4*)(bm + br * 1024 + fb + 4 * a);
#pragma unroll
                    for (int mt = 0; mt < 4; ++mt) {
                        gpk[a][mt][0] = pk2(sigmoidf(ga[a][mt][0] + bv[0]), sigmoidf(ga[a][mt][1] + bv[1]));
                        gpk[a][mt][1] = pk2(sigmoidf(ga[a][mt][2] + bv[2]), sigmoidf(ga[a][mt][3] + bv[3]));
                    }
                }
            }
            f32x4 pa[4][4];
#pragma unroll
            for (int a = 0; a < 4; ++a)
#pragma unroll
                for (int b = 0; b < 4; ++b) pa[a][b] = (f32x4){0.f, 0.f, 0.f, 0.f};
            const bf16_t* xb; size_t ldb;
            const bf16_t* PROJ = (const bf16_t*)(p.ws() + OFF_PROJ);
            if (br == 0) { xb = PROJ + (size_t)m0 * INWP + C_Z; ldb = INWP; }
            else if (br == 1) { xb = PROJ + (size_t)m0 * INWP + C_RG; ldb = INWP; }
            else if (br == 2) { xb = (const bf16_t*)(p.ws() + OFF_OA) + (size_t)m0 * 512; ldb = 512; }
            else { xb = (const bf16_t*)(p.ws() + OFF_OM) + (size_t)m0 * 512; ldb = 512; }
            gemm_kloop<4, 4, false>(pa, (const bf16_t*)(p.ws() + OFF_WBR) + (size_t)l * SZ_WBR + (size_t)br * 1024 * 512 + (size_t)n0 * 512, 512, xb, ldb, 512, smem, tid);
#pragma unroll
            for (int a = 0; a < 4; ++a)
#pragma unroll
                for (int mt = 0; mt < 4; ++mt) {
                    const float m0 = __uint_as_float(mgp[a][mt][0] << 16) + __uint_as_float(gpk[a][mt][0] << 16) * pa[a][mt][0];
                    const float m1 = __uint_as_float(mgp[a][mt][0] & 0xffff0000u) + __uint_as_float(gpk[a][mt][0] & 0xffff0000u) * pa[a][mt][1];
                    const float m2 = __uint_as_float(mgp[a][mt][1] << 16) + __uint_as_float(gpk[a][mt][1] << 16) * pa[a][mt][2];
                    const float m3 = __uint_as_float(mgp[a][mt][1] & 0xffff0000u) + __uint_as_float(gpk[a][mt][1] & 0xffff0000u) * pa[a][mt][3];
                    mgp[a][mt][0] = pk2(m0, m1); mgp[a][mt][1] = pk2(m2, m3);
                }
        }
        const int t3 = launder(tid);
        const int fr = t3 & 15, g = (t3 & 63) >> 4, wn = t3 >> 7, wt = (t3 >> 6) & 1;
        const int fb = n0 + wn * 64 + 16 * g;
        bf16_t* MG = (bf16_t*)(p.ws() + OFF_MERGED);
#pragma unroll
        for (int mt = 0; mt < 4; ++mt) {
            const int m = m0 + wt * 64 + 16 * mt + fr;
            bf16_t* d = MG + (size_t)m * 1024 + fb;
            *(u32x4*)d = (u32x4){mgp[0][mt][0], mgp[0][mt][1], mgp[1][mt][0], mgp[1][mt][1]};
            *(u32x4*)(d + 8) = (u32x4){mgp[2][mt][0], mgp[2][mt][1], mgp[3][mt][0], mgp[3][mt][1]};
        }
    }
}

DI void prep_token(const Ctx& p, int l, int ps, int m, int lane) {
    char* ws = p.ws();
    bf16_t* PROJ = (bf16_t*)(ws + OFF_PROJ);
    const float* t16 = (const float*)(ws + OFF_T16);
    const float* t8 = (const float*)(ws + OFF_T8);
    const Tok k = tok_info(m, ps);
    bf16_t* pr = PROJ + (size_t)m * INWP;
    if (lane < 16) {
        const float v = ((const float*)(ws + OFF_DTRAW))[(size_t)m * 16 + lane] + p.in(19)[l * 16 + lane];
        const float sp = v > 20.f ? v : log1pe(__expf(v));
        ((float*)(ws + OFF_DT))[(size_t)m * 16 + lane] = sp;
    }
    {
        const int seqkey0 = k.lat ? (k.krow - 256 - k.t) : (k.krow - k.t);
        const int Lk = k.lat ? 2304 : 256;
        const int keyidx = k.krow - seqkey0;
        float v[8];
        if (lane < 32) unpack8(*(const u32x4*)(pr + C_AK + lane * 8), v);
        else {
#pragma unroll
            for (int j = 0; j < 8; ++j) v[j] = 0.f;
        }
        float ss = 0.f;
#pragma unroll
        for (int j = 0; j < 8; ++j) ss += v[j] * v[j];
        ss += shx(ss, 1); ss += shx(ss, 2); ss += shx(ss, 4);
        const float rstd = rsqrtf(ss * (1.f / 64.f) + EPS);
        const int u = lane & 7, axis = u >> 2, pos = axis ? (k.t & 63) : (k.t >> 6);
        float kv[8];
        const float* w = p.in(26) + l * 64 + u * 8;
#pragma unroll
        for (int j = 0; j < 8; ++j) kv[j] = (v[j] * rstd) * w[j];
        float kr[8];
#pragma unroll
        for (int j = 0; j < 8; ++j) {
            const float other = shx(kv[j], 2);
            const int fi = (u & 1) * 8 + j;
            const float c = t16[pos * 16 + fi], s = t16[1024 + pos * 16 + fi];
            kr[j] = (u & 2) ? (kv[j] * c + other * s) : (kv[j] * c - other * s);
        }
        if (lane < 16) {
            if (!k.lat) {
                float* o = p.out() + O_CK + ((size_t)(k.b * 2 + l) * 256 + k.t) * 128 + lane * 8;
                *(f32x4*)o = (f32x4){kv[0], kv[1], kv[2], kv[3]}; *(f32x4*)(o + 4) = (f32x4){kv[4], kv[5], kv[6], kv[7]};
            }
            bf16_t* ka = (bf16_t*)(ws + OFF_KA) + (size_t)k.krow * 128 + lane * 8;
            *(u32x4*)ka = k.lat ? pack8(kr) : pack8(kv);
        } else if (lane < 32) {
            const int d0 = (lane - 16) * 8;
            if (!k.lat) {
                float* o = p.out() + O_CV + ((size_t)(k.b * 2 + l) * 256 + k.t) * 128 + d0;
                *(f32x4*)o = (f32x4){v[0], v[1], v[2], v[3]}; *(f32x4*)(o + 4) = (f32x4){v[4], v[5], v[6], v[7]};
            }
            bf16_t* vt = (bf16_t*)(ws + OFF_VAT) + (size_t)seqkey0 * 128 + (size_t)d0 * Lk + keyidx;
#pragma unroll
            for (int j = 0; j < 8; ++j) vt[(size_t)j * Lk] = f2bf(v[j]);
        }
    }
    {
        float v[8];
        if (lane < 48) unpack8(*(const u32x4*)(pr + C_MCQ + lane * 8), v);
        else {
#pragma unroll
            for (int j = 0; j < 8; ++j) v[j] = 0.f;
        }
        float ss = 0.f;
#pragma unroll
        for (int j = 0; j < 8; ++j) ss += v[j] * v[j];
        ss = wsum(ss);
        const float rstd = rsqrtf(ss * (1.f / 384.f) + EPS);
        if (lane < 48) {
            const float* w = p.in(27) + l * 384 + lane * 8;
#pragma unroll
            for (int j = 0; j < 8; ++j) v[j] = (v[j] * rstd) * w[j];
            *(u32x4*)(pr + C_MCQ + lane * 8) = pack8(v);
        }
    }
    {
        float v[8];
        if (lane < 36) unpack8(*(const u32x4*)(pr + C_MCKV + lane * 8), v);
        else {
#pragma unroll
            for (int j = 0; j < 8; ++j) v[j] = 0.f;
        }
        float ss = 0.f;
        if (lane < 32) {
#pragma unroll
            for (int j = 0; j < 8; ++j) ss += v[j] * v[j];
        }
        ss = wsum(ss);
        const float rstd = rsqrtf(ss * (1.f / 256.f) + EPS);
        const int u = (lane - 32) & 3, axis = u >> 1, pos = axis ? (k.t & 63) : (k.t >> 6);
        float kr[8];
#pragma unroll
        for (int j = 0; j < 8; ++j) {
            const float other = shx(v[j], 1);
            const float c = t8[pos * 8 + j], s = t8[512 + pos * 8 + j];
            kr[j] = (u & 1) ? (v[j] * c + other * s) : (v[j] * c - other * s);
        }
        if (lane < 32) {
            const float* w = p.in(29) + l * 256 + lane * 8;
            float c[8];
#pragma unroll
            for (int j = 0; j < 8; ++j) c[j] = (v[j] * rstd) * w[j];
            if (!k.lat) {
                float* o = p.out() + O_CC + ((size_t)(k.b * 2 + l) * 256 + k.t) * 256 + lane * 8;
                *(f32x4*)o = (f32x4){c[0], c[1], c[2], c[3]}; *(f32x4*)(o + 4) = (f32x4){c[4], c[5], c[6], c[7]};
            }
            *(u32x4*)((bf16_t*)(ws + OFF_CKV) + (size_t)k.krow * 256 + lane * 8) = pack8(c);
        } else if (lane < 36) {
            const int d0 = (lane - 32) * 8;
            if (!k.lat) {
                float* o = p.out() + O_CR + ((size_t)(k.b * 2 + l) * 256 + k.t) * 32 + d0;
                *(f32x4*)o = (f32x4){v[0], v[1], v[2], v[3]}; *(f32x4*)(o + 4) = (f32x4){v[4], v[5], v[6], v[7]};
            }
            *(u32x4*)((bf16_t*)(ws + OFF_KRP) + (size_t)k.krow * 32 + d0) = k.lat ? pack8(kr) : pack8(v);
        }
    }
}
DI void prep_conv_item(const Ctx& p, int l, int ps, int item, int lane) {
    const int run = item >> 1, cbk = item & 1;
    const int c0 = cbk * 512 + lane * 8;
    if (c0 >= 768) return;
    const int m0 = run * 16;
    const Tok k = tok_info(m0, ps);
    const float* cw = p.in(17) + (size_t)l * 3 * 768; const float* cb = p.in(18) + (size_t)l * 768;
    float w[4][8];
#pragma unroll
    for (int tp = 0; tp < 4; ++tp) {
        const float* src = (tp < 3) ? cw + tp * 768 + c0 : cb + c0;
        const f32x4 a0 = *(const f32x4*)src, a1 = *(const f32x4*)(src + 4);
#pragma unroll
        for (int e = 0; e < 4; ++e) { w[tp][e] = a0[e]; w[tp][4 + e] = a1[e]; }
    }
    const bf16_t* xb = (const bf16_t*)(p.ws() + OFF_PROJ) + (size_t)m0 * INWP + C_XBC + c0;
    bf16_t* xo = (bf16_t*)(p.ws() + OFF_XBCA) + (size_t)m0 * 768 + c0;
    const u32x4 zero = {0u, 0u, 0u, 0u};
    u32x4 pv = zero, cv;
    if (k.t > 0) pv = gld16(xb - INWP);
    cv = gld16(xb);
#pragma unroll 4
    for (int i = 0; i < 16; ++i) {
        u32x4 nv = zero;
        if (k.t + i + 1 < k.L) nv = gld16(xb + (size_t)(i + 1) * INWP);
        float a[8], b[8], c[8], o[8];
        unpack8(pv, a); unpack8(cv, b); unpack8(nv, c);
#pragma unroll
        for (int e = 0; e < 8; ++e) o[e] = siluf(w[3][e] + w[0][e] * a[e] + w[1][e] * b[e] + w[2][e] * c[e]);
        *(u32x4*)(xo + (size_t)i * 768) = pack8(o);
        pv = cv; cv = nv;
    }
}
DI void prep_cache_row(const Ctx& p, int l, int ps, int r, int lane) {
    char* ws = p.ws();
    const int j = r >> 8, c = r & 255, b = ps * 2 + j;
    const int key0 = 4096 + j * 2304, krow = key0 + c, Lk = 2304;
    const size_t src = (size_t)(b * 2 + l) * 256 + c;
    if (lane < 16) {
        const float* s = p.in(4) + src * 128 + lane * 8; float v[8];
#pragma unroll
        for (int i = 0; i < 8; ++i) v[i] = s[i];
        *(u32x4*)((bf16_t*)(ws + OFF_KA) + (size_t)krow * 128 + lane * 8) = pack8(v);
    } else if (lane < 32) {
        const int d0 = (lane - 16) * 8;
        const float* s = p.in(5) + src * 128 + d0;
        bf16_t* vt = (bf16_t*)(ws + OFF_VAT) + (size_t)key0 * 128 + (size_t)d0 * Lk + c;
#pragma unroll
        for (int i = 0; i < 8; ++i) vt[(size_t)i * Lk] = f2bf(s[i]);
    } else if (lane < 36) {
        const int d0 = (lane - 32) * 8;
        const float* s = p.in(7) + src * 32 + d0; float v[8];
#pragma unroll
        for (int i = 0; i < 8; ++i) v[i] = s[i];
        *(u32x4*)((bf16_t*)(ws + OFF_KRP) + (size_t)krow * 32 + d0) = pack8(v);
    }
    if (lane < 32) {
        const float* s = p.in(6) + src * 256 + lane * 8; float v[8];
#pragma unroll
        for (int i = 0; i < 8; ++i) v[i] = s[i];
        *(u32x4*)((bf16_t*)(ws + OFF_CKV) + (size_t)krow * 256 + lane * 8) = pack8(v);
    }
}
DI void phase_prep(const Ctx& p, int l, int ps, int tid) {
    const int lane = tid & 63, wv = tid >> 6;
    for (int m = BIDX * 4 + wv; m < NPT + 512 + 1024; m += gridDim.x * 4) {
        if (m < NPT) prep_token(p, l, ps, m, lane); else if (m < NPT + 512) prep_cache_row(p, l, ps, m - NPT, lane); else prep_conv_item(p, l, ps, m - NPT - 512, lane);
    }
}

template <int KC, int NQT>
DI void attn_tile(const bf16_t* __restrict__ Q, size_t ldq, const bf16_t* __restrict__ K1, size_t ldk1, const bf16_t* __restrict__ K2, size_t ldk2,
                  const bf16_t* __restrict__ VT, size_t ldvt, int nkt, float c2, bf16_t* __restrict__ O, size_t ldo,
                  const float* __restrict__ qnw  , const float* __restrict__ rope, int t0  , char* smem, int tid) {
    constexpr int KB = KC * 4096, STG = KB + 8192;
    tid = launder(tid);
    const int lane = tid & 63, w = tid >> 6, fr = lane & 15, g = lane >> 4;
    bf16x8 qf[NQT][KC];
#pragma unroll
    for (int qt = 0; qt < NQT; ++qt)
#pragma unroll
        for (int ks = 0; ks < KC; ++ks) { const u32x4 t4 = gld16(Q + (size_t)(16 * NQT * w + 16 * qt + fr) * ldq + ks * 32 + 8 * g); qf[qt][ks] = __builtin_bit_cast(bf16x8, t4); }
    if (KC == 2 && qnw) {
#pragma unroll
        for (int qt = 0; qt < NQT; ++qt) {
            float v[2][8]; float ss = 0.f;
#pragma unroll
            for (int ks = 0; ks < 2; ++ks) {
                const u32x4 t4 = __builtin_bit_cast(u32x4, qf[qt][ks]); unpack8(t4, v[ks]);
#pragma unroll
                for (int j = 0; j < 8; ++j) ss += v[ks][j] * v[ks][j];
            }
            ss += shx(ss, 16); ss += shx(ss, 32);
            const float rstd = rsqrtf(ss * (1.f / 64.f) + EPS);
            const int t = t0 + 16 * NQT * w + 16 * qt + fr;
#pragma unroll
            for (int ks = 0; ks < 2; ++ks) {
                const int pos = ks ? (t & 63) : (t >> 6);
#pragma unroll
                for (int j = 0; j < 8; ++j) {
                    float x = (v[ks][j] * rstd) * qnw[32 * ks + 8 * g + j];
                    if (rope) {
                        const float other = shx(x, 32);
                        const int fi = (g & 1) * 8 + j;
                        const float c = rope[pos * 16 + fi], sn = rope[1024 + pos * 16 + fi];
                        x = (g & 2) ? (x * c + other * sn) : (x * c - other * sn);
                    }
                    v[ks][j] = x;
                }
                const u32x4 t4 = pack8(v[ks]); qf[qt][ks] = __builtin_bit_cast(bf16x8, t4);
            }
        }
    }
    constexpr int NPK = KC * 4, PPW = (NPK + 8) / 4;
    static_assert((NPK + 8) % 4 == 0, "pieces must divide over 4 waves");
    const int wvu = __builtin_amdgcn_readfirstlane(w);
    unsigned poff[PPW];
#pragma unroll
    for (int j = 0; j < PPW; ++j) {
        const int pc = wvu * PPW + j;
        const bool isk = pc < NPK;
        const int pp = isk ? pc : pc - NPK;
        const int ks = pp >> 2, rb = pp & 3;
        const int rl = lane >> 2, row = rb * 16 + rl;
        const int q = isk ? ((row >> 3) & 3) : ((rl >> 2) & 3);
        const int gl = (lane & 3) ^ FQ(q);
        const unsigned ld = isk ? ((KC == 2 || ks < 2) ? (unsigned)ldk1 : (unsigned)ldk2) : (unsigned)ldvt;
        poff[j] = (unsigned)rl * ld + (unsigned)(gl * 8);
    }
    auto issue = [&](int kt, char* stage) {
#pragma unroll
        for (int j = 0; j < PPW; ++j) {
            const int pc = wvu * PPW + j;
            const bool isk = pc < NPK;
            const int pp = isk ? pc : pc - NPK;
            const int ks = pp >> 2, rb = pp & 3;
            const bf16_t* base;
            if (isk) { if (KC == 2 || ks < 2) base = K1 + ks * 32 + (size_t)(kt * 64 + rb * 16) * ldk1; else base = K2 + (size_t)(kt * 64 + rb * 16) * ldk2; }
            else base = VT + ks * 32 + (size_t)kt * 64 + (size_t)(rb * 16) * ldvt;
            __builtin_amdgcn_global_load_lds((const unsigned*)(base + poff[j]), (unsigned*)(stage + (isk ? 0 : KB) + (ks * 64 + rb * 16) * 64), 16, 0, 0);
        }
    };
    const int koff = tile_off(64, 0, 8 * (fr >> 2) + (fr & 3), g, fr >> 2);
    const int voff = KB + tile_off(64, 0, fr, g, (fr >> 2) & 3);
    f32x4 o[4][NQT];
#pragma unroll
    for (int a = 0; a < 4; ++a)
#pragma unroll
        for (int qt = 0; qt < NQT; ++qt) o[a][qt] = (f32x4){0.f, 0.f, 0.f, 0.f};
    float mrun[NQT], lrun[NQT];
#pragma unroll
    for (int qt = 0; qt < NQT; ++qt) { mrun[qt] = -1e30f; lrun[qt] = 0.f; }
    __syncthreads();
    issue(0, smem);
    if (nkt > 1) {
        issue(1, smem + STG);
        if (PPW == 4) asm volatile("s_waitcnt vmcnt(4)" ::: "memory"); else asm volatile("s_waitcnt vmcnt(5)" ::: "memory");
    } else asm volatile("s_waitcnt vmcnt(0)" ::: "memory");
    __syncthreads();
    int so_cur = 0, so_nn = 2 * STG;
    for (int kt = 0; kt < nkt; ++kt) {
        if (kt + 2 < nkt) issue(kt + 2, smem + so_nn);
        __builtin_amdgcn_sched_barrier(0);
        const char* sb = smem + so_cur;
        f32x4 s[4][NQT];
#pragma unroll
        for (int a = 0; a < 4; ++a)
#pragma unroll
            for (int qt = 0; qt < NQT; ++qt) s[a][qt] = (f32x4){0.f, 0.f, 0.f, 0.f};
        bf16x8 kf[KC][4];
#pragma unroll
        for (int ks = 0; ks < KC; ++ks)
#pragma unroll
            for (int a = 0; a < 4; ++a) kf[ks][a] = *(const bf16x8*)(sb + koff + ((a >> 1) * 32 + (a & 1) * 4) * 64 + ks * 4096);
        __builtin_amdgcn_sched_barrier(0);
        __builtin_amdgcn_s_setprio(1);
#pragma unroll
        for (int ks = 0; ks < KC; ++ks)
#pragma unroll
            for (int a = 0; a < 4; ++a) {
#pragma unroll
                for (int qt = 0; qt < NQT; ++qt) s[a][qt] = __builtin_amdgcn_mfma_f32_16x16x32_bf16(kf[ks][a], qf[qt][ks], s[a][qt], 0, 0, 0);
            }
        __builtin_amdgcn_s_setprio(0);
        bf16x8 vfr[2][4];
#pragma unroll
        for (int s2 = 0; s2 < 2; ++s2)
#pragma unroll
            for (int dt = 0; dt < 4; ++dt) vfr[s2][dt] = *(const bf16x8*)(sb + voff + dt * 1024 + s2 * 4096);
        __builtin_amdgcn_sched_barrier(0);
        bf16x8 pf[NQT][2];
#pragma unroll
        for (int qt = 0; qt < NQT; ++qt) {
            float mx = s[0][qt][0];
#pragma unroll
            for (int a = 0; a < 4; ++a)
#pragma unroll
                for (int r = 0; r < 4; ++r) mx = fmaxf(mx, s[a][qt][r]);
            mx = gmax4(mx);
            const float mnew = fmaxf(mrun[qt], mx);
            const float alpha = __builtin_amdgcn_exp2f((mrun[qt] - mnew) * c2);
            mrun[qt] = mnew;
            const float mc = mnew * c2;
            float ls = 0.f; float pv[16];
#pragma unroll
            for (int a = 0; a < 4; ++a)
#pragma unroll
                for (int r = 0; r < 4; ++r) { const float e = __builtin_amdgcn_exp2f(s[a][qt][r] * c2 - mc); pv[4 * a + r] = e; ls += e; }
            lrun[qt] = lrun[qt] * alpha + ls;
#pragma unroll
            for (int a = 0; a < 4; ++a) o[a][qt] = o[a][qt] * alpha;
            u32x4 w0 = pack8(pv), w1 = pack8(pv + 8);
            pf[qt][0] = __builtin_bit_cast(bf16x8, w0); pf[qt][1] = __builtin_bit_cast(bf16x8, w1);
        }
        __builtin_amdgcn_sched_barrier(0);
#pragma unroll
        for (int s2 = 0; s2 < 2; ++s2)
#pragma unroll
            for (int dt = 0; dt < 4; ++dt) {
#pragma unroll
                for (int qt = 0; qt < NQT; ++qt) o[dt][qt] = __builtin_amdgcn_mfma_f32_16x16x32_bf16(vfr[s2][dt], pf[qt][s2], o[dt][qt], 0, 0, 0);
            }
        __builtin_amdgcn_sched_barrier(0);
        if (kt + 2 < nkt) { if (PPW == 4) asm volatile("s_waitcnt vmcnt(4)" ::: "memory"); else asm volatile("s_waitcnt vmcnt(5)" ::: "memory"); }
        else asm volatile("s_waitcnt vmcnt(0)" ::: "memory");
        asm volatile("s_waitcnt lgkmcnt(0)" ::: "memory");
        __builtin_amdgcn_s_barrier();
        so_cur = (so_cur == 2 * STG) ? 0 : so_cur + STG;
        so_nn = (so_nn == 2 * STG) ? 0 : so_nn + STG;
    }
#pragma unroll
    for (int qt = 0; qt < NQT; ++qt) {
        float l = gsum4(lrun[qt]);
        const float inv = 1.f / l;
        bf16_t* orow = O + (size_t)(16 * NQT * w + 16 * qt + fr) * ldo + 4 * g;
#pragma unroll
        for (int dt = 0; dt < 4; ++dt) {
            u32x2 wv2; wv2[0] = pk2(o[dt][qt][0] * inv, o[dt][qt][1] * inv); wv2[1] = pk2(o[dt][qt][2] * inv, o[dt][qt][3] * inv);
            *(u32x2*)(orow + 16 * dt) = wv2;
        }
    }
}

struct Seq { int lat, tok0, L, key0, Lk, b; };
DI Seq seq_info(int s, int ps) {
    Seq q;
    if (s < 16) { q.lat = 0; q.tok0 = s * 256; q.L = 256; q.key0 = s * 256; q.Lk = 256; q.b = ps * 16 + s; }
    else { const int j = s - 16; q.lat = 1; q.tok0 = 4096 + j * 2048; q.L = 2048; q.key0 = 4096 + j * 2304; q.Lk = 2304; q.b = ps * 2 + j; }
    return q;
}
DI void attn_gqa_item(const Ctx& p, int l, int s, int head, int qb, int ps, char* smem, int tid) {
    const Seq q = seq_info(s, ps);
    const int rows = 128;
    const bf16_t* PROJ = (const bf16_t*)(p.ws() + OFF_PROJ);
    const bf16_t* Q = PROJ + (size_t)(q.tok0 + qb * rows) * INWP + C_AQ + head * 64;
    const int kh = head >> 2;
    const bf16_t* K = (const bf16_t*)(p.ws() + OFF_KA) + (size_t)q.key0 * 128 + kh * 64;
    const bf16_t* VT = (const bf16_t*)(p.ws() + OFF_VAT) + (size_t)q.key0 * 128 + (size_t)kh * 64 * q.Lk;
    bf16_t* O = (bf16_t*)(p.ws() + OFF_OA) + (size_t)(q.tok0 + qb * rows) * 512 + head * 64;
    const float c2 = 0.125f * 1.4426950408889634f;
    attn_tile<2, 2>(Q, INWP, K, 128, K, 128, VT, q.Lk, q.Lk / 64, c2, O, 512, p.in(25) + l * 64, q.lat ? (const float*)(p.ws() + OFF_T16) : nullptr, qb * 128, smem, tid);
}
DI void attn_mla_item(const Ctx& p, int s, int head, int qb, int ps, char* smem, int tid) {
    const Seq q = seq_info(s, ps);
    const int rows = 128;
    const bf16_t* Q = (const bf16_t*)(p.ws() + OFF_QM) + (size_t)(q.tok0 + qb * rows) * 768 + head * 96;
    const bf16_t* K1 = (const bf16_t*)(p.ws() + OFF_KN) + (size_t)q.key0 * 512 + head * 64;
    const bf16_t* K2 = (const bf16_t*)(p.ws() + OFF_KRP) + (size_t)q.key0 * 32;
    const bf16_t* VT = (const bf16_t*)(p.ws() + OFF_VMT) + (size_t)q.key0 * 512 + (size_t)head * 64 * q.Lk;
    bf16_t* O = (bf16_t*)(p.ws() + OFF_OM) + (size_t)(q.tok0 + qb * rows) * 512 + head * 64;
    const float c2 = 0.10206207261596577f * 1.4426950408889634f;
    attn_tile<3, 2>(Q, 768, K1, 512, K2, 32, VT, q.Lk, q.Lk / 64, c2, O, 512, nullptr, nullptr, 0, smem, tid);
}

template <int ET>
DI void scan_item(const bf16_t* __restrict__ Qp, size_t ldq, const bf16_t* __restrict__ Kp, size_t ldk, const bf16_t* __restrict__ Vp, size_t ldv,
                  const float* __restrict__ dtp  , float acoef  ,
                  int L, int dir, const float* __restrict__ s0, float* __restrict__ sout, int lds_state  , bf16_t* __restrict__ Op, size_t ldo,
                  const float* __restrict__ rope  , float kmul,
                  int nbase  , int nch  , const bf16_t* __restrict__ s0b  ,
                  bf16_t* __restrict__ lout  , float* __restrict__ dout  , char* smem, int tid) {
    constexpr int DV = 16 * ET;
    const bool stateonly = (lout != nullptr);
    constexpr int QS = 0, KS = 8192, KT = 16384, VTO = 24576, STO = VTO + DV * 128, ACO = STO + DV * 128;
    constexpr int NV = DV / 32;
    tid = launder(tid);
    const int lane = tid & 63, w = tid >> 6, fr = lane & 15, g = lane >> 4;
    float* acs = (float*)(smem + ACO);
    f32x4 sacc[ET];
#pragma unroll
    for (int et = 0; et < ET; ++et) {
        if (s0) {
#pragma unroll
            for (int r = 0; r < 4; ++r) sacc[et][r] = s0[(size_t)(16 * w + 4 * g + r) * lds_state + 16 * et + fr];
        } else if (s0b) {
#pragma unroll
            for (int r = 0; r < 4; ++r) sacc[et][r] = bf2f(s0b[(16 * w + 4 * g + r) * DV + 16 * et + fr]);
        } else sacc[et] = (f32x4){0.f, 0.f, 0.f, 0.f};
    }
    const int st_off = STO + ((w >> 1) * DV) * 64 + (g & 1) * 8;
    const int st_gg = (2 * w + (g >> 1)) & 3;
    __syncthreads();
    float* ropeL = (float*)(smem + ACO + 256);
    if (rope) {
#pragma unroll
        for (int i = 0; i < 2; ++i) *(f32x4*)(ropeL + (tid + 256 * i) * 4) = *(const f32x4*)(rope + (tid + 256 * i) * 4);
    }
#pragma unroll
    for (int et = 0; et < ET; ++et) {
        const int e = 16 * et + fr;
        u32x2 wv2; wv2[0] = pk2(sacc[et][0], sacc[et][1]); wv2[1] = pk2(sacc[et][2], sacc[et][3]);
        *(u32x2*)(smem + st_off + e * 64 + ((st_gg ^ FQ((e >> 2) & 3)) << 4)) = wv2;
    }
    __syncthreads();
    float dprod = 1.f;
    const int qoff = QS + tile_off(64, 0, 16 * w + fr, g, (fr >> 2) & 3);
    const int koff = KS + tile_off(64, 0, 8 * (fr >> 2) + (fr & 3), g, fr >> 2);
    const int ktoff = KT + tile_off(64, 0, 16 * w + fr, g, (fr >> 2) & 3);
    const int vtoff = VTO + tile_off(DV, 0, fr, g, (fr >> 2) & 3);
    const int stoff = STO + tile_off(DV, 0, fr, g, (fr >> 2) & 3);
    u32x4 gq[2], gk[2], gv[NV]; float gdt = 1.f;
    auto issue = [&](int c) {
        const int n0 = nbase + c * 64;
        {
            const int row = tid >> 2, cc0 = (tid & 1) | ((tid & 2) << 1);
            const int tl = dir ? (L - 1 - (n0 + row)) : (n0 + row);
#pragma unroll
            for (int i = 0; i < 2; ++i) {
                gq[i] = gld16(Qp + (size_t)tl * ldq + (cc0 + 2 * i) * 8);
                gk[i] = gld16(Kp + (size_t)tl * ldk + (cc0 + 2 * i) * 8);
            }
        }
#pragma unroll
        for (int i = 0; i < NV; ++i) {
            const int q = tid + 256 * i, row = q / (DV / 8), cc = q % (DV / 8);
            const int tl = dir ? (L - 1 - (n0 + row)) : (n0 + row);
            gv[i] = gld16(Vp + (size_t)tl * ldv + cc * 8);
        }
        if (dtp) { const int tl = dir ? (L - 1 - (n0 + lane)) : (n0 + lane); gdt = dtp[(size_t)tl * 16]; }
    };
    issue(0);
    for (int c = 0; c < nch; ++c) {
        const int n0 = nbase + c * 64;
        const float dtv = gdt;
        const float la = dtp ? dtv * acoef : acoef;
        float ac, aend;
        if (dtp) {
            ac = la;
#pragma unroll
            for (int o = 1; o < 64; o <<= 1) { const float t = shu(ac, o); if (lane >= o) ac += t; }
            aend = shf(ac, 63);
        } else { ac = (float)(lane + 1) * la; aend = 64.f * la; }
        if (w == 0) acs[lane] = ac;
        {
            const int row = tid >> 2, cc0 = (tid & 1) | ((tid & 2) << 1);
            const float ksc = shf(dtv, row) * kmul, wend = __expf(aend - shf(ac, row));
            float qa[2][8], ka[2][8];
#pragma unroll
            for (int i = 0; i < 2; ++i) { unpack8(gq[i], qa[i]); unpack8(gk[i], ka[i]); }
            if (rope) {
                const int tlr = dir ? (L - 1 - (n0 + row)) : (n0 + row);
                const int pos = (cc0 >> 2) ? (tlr & 63) : (tlr >> 6);
                const float* rp = ropeL + pos * 16 + (cc0 & 1) * 8;
                f32x4 rc[2], rs[2];
                rc[0] = *(const f32x4*)rp; rc[1] = *(const f32x4*)(rp + 4); rs[0] = *(const f32x4*)(rp + 1024); rs[1] = *(const f32x4*)(rp + 1028);
#pragma unroll
                for (int j = 0; j < 8; ++j) {
                    const float c = rc[j >> 2][j & 3], sn = rs[j >> 2][j & 3];
                    const float q1 = qa[0][j], q2 = qa[1][j], k1 = ka[0][j], k2 = ka[1][j];
                    qa[0][j] = q1 * c - q2 * sn; qa[1][j] = q2 * c + q1 * sn;
                    ka[0][j] = k1 * c - k2 * sn; ka[1][j] = k2 * c + k1 * sn;
                }
            }
#pragma unroll
            for (int i = 0; i < 2; ++i) {
                const int cc = cc0 + 2 * i;
                if (rope) *(u32x4*)(smem + QS + tile_off(64, cc >> 2, row, cc & 3, (row >> 2) & 3)) = pack8(qa[i]);
                else *(u32x4*)(smem + QS + tile_off(64, cc >> 2, row, cc & 3, (row >> 2) & 3)) = gq[i];
#pragma unroll
                for (int j = 0; j < 8; ++j) ka[i][j] *= ksc;
                *(u32x4*)(smem + KS + tile_off(64, cc >> 2, row, cc & 3, (row >> 3) & 3)) = pack8(ka[i]);
#pragma unroll
                for (int j = 0; j < 8; ++j) {
                    const int d = cc * 8 + j;
                    *(bf16_t*)(smem + KT + tile_off(64, row >> 5, d, (row >> 3) & 3, (d >> 2) & 3) + (row & 7) * 2) = f2bf(ka[i][j] * wend);
                }
            }
        }
#pragma unroll
        for (int i = 0; i < NV; ++i) {
            const int q = tid + 256 * i, row = q / (DV / 8), cc = q % (DV / 8);
            const u32x4 vv = gv[i];
#pragma unroll
            for (int j = 0; j < 8; ++j) {
                const int e = cc * 8 + j;
                const unsigned short h = (unsigned short)(vv[j >> 1] >> (16 * (j & 1)));
                *(bf16_t*)(smem + VTO + tile_off(DV, row >> 5, e, (row >> 3) & 3, (e >> 2) & 3) + (row & 7) * 2) = h;
            }
        }
        if (c + 1 < nch) issue(c + 1);
        __builtin_amdgcn_sched_barrier(0);
        __syncthreads();
        {
            const int irow = 16 * w + fr;
            const int ns = (w >> 1) + 1;
            bf16x8 qfr[2], sf[ET][2], kfa[2][2][2], vf[2][ET], kt2[2];
            qfr[0] = *(const bf16x8*)(smem + qoff); qfr[1] = *(const bf16x8*)(smem + qoff + 4096);
#pragma unroll
            for (int et = 0; et < ET; ++et)
#pragma unroll
                for (int ks = 0; ks < 2; ++ks) sf[et][ks] = *(const bf16x8*)(smem + stoff + et * 1024 + ks * DV * 64);
#pragma unroll
            for (int aa = 0; aa < 2; ++aa)
#pragma unroll
                for (int ks = 0; ks < 2; ++ks) kfa[0][aa][ks] = *(const bf16x8*)(smem + koff + (4 * aa) * 64 + ks * 4096);
            const float ai = acs[irow];
            f32x4 ajv[2][2];
#pragma unroll
            for (int aa = 0; aa < 2; ++aa) ajv[0][aa] = *(const f32x4*)(acs + 8 * g + 4 * aa);
            const float cd = __expf(acs[63]);
            __builtin_amdgcn_sched_barrier(0);
            f32x4 o[ET];
            if (!stateonly) {
#pragma unroll
                for (int et = 0; et < ET; ++et) {
                    o[et] = (f32x4){0.f, 0.f, 0.f, 0.f};
#pragma unroll
                    for (int ks = 0; ks < 2; ++ks) o[et] = __builtin_amdgcn_mfma_f32_16x16x32_bf16(sf[et][ks], qfr[ks], o[et], 0, 0, 0);
                }
            }
#pragma unroll
            for (int aa = 0; aa < 2; ++aa)
#pragma unroll
                for (int ks = 0; ks < 2; ++ks) kfa[1][aa][ks] = *(const bf16x8*)(smem + koff + (32 + 4 * aa) * 64 + ks * 4096);
#pragma unroll
            for (int ks = 0; ks < 2; ++ks) {
#pragma unroll
                for (int et = 0; et < ET; ++et) vf[ks][et] = *(const bf16x8*)(smem + vtoff + et * 1024 + ks * DV * 64);
                kt2[ks] = *(const bf16x8*)(smem + ktoff + ks * 4096);
            }
#pragma unroll
            for (int aa = 0; aa < 2; ++aa) ajv[1][aa] = *(const f32x4*)(acs + 32 + 8 * g + 4 * aa);
            __builtin_amdgcn_sched_barrier(0);
            if (!stateonly) {
                const float ei = __expf(ai);
#pragma unroll
                for (int et = 0; et < ET; ++et) o[et] = o[et] * ei;
#pragma unroll
                for (int s2 = 0; s2 < 2; ++s2) {
                    if (s2 < ns) {
                        f32x4 pp[2];
#pragma unroll
                        for (int aa = 0; aa < 2; ++aa) {
                            pp[aa] = (f32x4){0.f, 0.f, 0.f, 0.f};
#pragma unroll
                            for (int ks = 0; ks < 2; ++ks) pp[aa] = __builtin_amdgcn_mfma_f32_16x16x32_bf16(kfa[s2][aa][ks], qfr[ks], pp[aa], 0, 0, 0);
                        }
                        float pv[8];
#pragma unroll
                        for (int aa = 0; aa < 2; ++aa) {
                            const int j0 = 32 * s2 + 8 * g + 4 * aa;
#pragma unroll
                            for (int r = 0; r < 4; ++r) {
                                const float dec = __expf(fminf(ai - ajv[s2][aa][r], 0.f));
                                pv[4 * aa + r] = (j0 + r <= irow) ? pp[aa][r] * dec : 0.f;
                            }
                        }
                        const u32x4 pw = pack8(pv);
                        const bf16x8 pf = __builtin_bit_cast(bf16x8, pw);
#pragma unroll
                        for (int et = 0; et < ET; ++et) o[et] = __builtin_amdgcn_mfma_f32_16x16x32_bf16(vf[s2][et], pf, o[et], 0, 0, 0);
                    }
                }
                const int tl = dir ? (L - 1 - (n0 + irow)) : (n0 + irow);
                bf16_t* orow = Op + (size_t)tl * ldo + 4 * g;
#pragma unroll
                for (int et = 0; et < ET; ++et) {
                    u32x2 wv2; wv2[0] = pk2(o[et][0], o[et][1]); wv2[1] = pk2(o[et][2], o[et][3]);
                    st_wt8(orow + 16 * et, wv2);
                }
            }
            dprod *= cd;
#pragma unroll
            for (int et = 0; et < ET; ++et) sacc[et] = sacc[et] * cd;
#pragma unroll
            for (int ks = 0; ks < 2; ++ks)
#pragma unroll
                for (int et = 0; et < ET; ++et) sacc[et] = __builtin_amdgcn_mfma_f32_16x16x32_bf16(kt2[ks], vf[ks][et], sacc[et], 0, 0, 0);
        }
        __syncthreads();
#pragma unroll
        for (int et = 0; et < ET; ++et) {
            const int e = 16 * et + fr;
            u32x2 wv2; wv2[0] = pk2(sacc[et][0], sacc[et][1]); wv2[1] = pk2(sacc[et][2], sacc[et][3]);
            *(u32x2*)(smem + st_off + e * 64 + ((st_gg ^ FQ((e >> 2) & 3)) << 4)) = wv2;
        }
    }
    if (sout) {
#pragma unroll
        for (int et = 0; et < ET; ++et)
#pragma unroll
            for (int r = 0; r < 4; ++r) sout[(size_t)(16 * w + 4 * g + r) * lds_state + 16 * et + fr] = sacc[et][r];
    }
    if (lout) {
#pragma unroll
        for (int et = 0; et < ET; ++et)
#pragma unroll
            for (int r = 0; r < 4; ++r) st_wt2(lout + (16 * w + 4 * g + r) * DV + 16 * et + fr, f2bf(sacc[et][r]));
        if (tid == 0) st_wt4f(dout, dprod);
    }
    __syncthreads();
}

DI void scan_any_item(const Ctx& p, int l, int ps, int isret, int s, int h, int dir, int half, int mode, int seg, int sid, char* smem, int tid) {
    const Seq q = seq_info(s, ps);
    const bf16_t *Qp, *Kp, *Vp; size_t ld; const float* dtp; float acoef, kmul; const float* rope; bf16_t* O; float* so; int lds;
    if (isret) {
        const bf16_t* PR = (const bf16_t*)(p.ws() + OFF_PROJ) + (size_t)q.tok0 * INWP;
        const float x = p.in(23)[l * 8 + dir * 4 + h];
        acoef = fminf(x, 0.f) - log1pe(__expf(-fabsf(x)));
        Qp = PR + C_RQ + h * 64; Kp = PR + C_RK + h * 64; Vp = PR + C_RV + h * 128 + half * 64; ld = INWP; dtp = nullptr; kmul = 0.125f;
        rope = q.lat ? (const float*)(p.ws() + OFF_T16) : nullptr;
        O = (bf16_t*)(p.ws() + OFF_OR) + ((size_t)dir * NPT + q.tok0) * 512 + h * 128 + half * 64;
        so = p.out() + O_RET + ((size_t)((q.b * 2 + l) * 2 + dir) * 4 + h) * 8192 + half * 64; lds = 128;
    } else {
        const bf16_t* XB = (const bf16_t*)(p.ws() + OFF_XBCA) + (size_t)q.tok0 * 768;
        const int grp = h >> 2;
        Qp = XB + 640 + grp * 64; Kp = XB + 512 + grp * 64; Vp = XB + h * 64; ld = 768; kmul = 1.f; rope = nullptr;
        dtp = (const float*)(p.ws() + OFF_DT) + (size_t)q.tok0 * 16 + dir * 8 + h;
        acoef = -__expf(p.in(20)[l * 16 + dir * 8 + h]);
        O = (bf16_t*)(p.ws() + OFF_OS) + ((size_t)dir * NPT + q.tok0) * 512 + h * 64;
        so = p.out() + O_SSD + ((size_t)((q.b * 2 + l) * 2 + dir) * 8 + h) * 4096; lds = 64;
    }
    bf16_t* segb = (bf16_t*)(p.ws() + OFF_SEG) + (size_t)(sid * NSEG + seg) * 4096;
    float* segd = (float*)(p.ws() + OFF_SEGD) + sid * NSEG + seg;
    scan_item<4>(Qp, ld, Kp, ld, Vp, ld, dtp, acoef, q.L, dir, nullptr, mode == 0 ? so : nullptr, lds, O, 512, rope, kmul,
                 mode == 0 ? 0 : seg * SEGTOK, mode == 0 ? (q.L >> 6) : (SEGTOK >> 6), mode == 3 ? segb : nullptr, mode == 1 ? segb : nullptr, mode == 1 ? segd : nullptr, smem, tid);
}
DI void scan_combine_item(const Ctx& p, int l, int ps, int sid, int tid) {
    const float* s0; int ld;
    if (sid < 32) { const int b = ps * 2 + (sid >> 4), h = (sid >> 1) & 7, dir = sid & 1; s0 = p.in(2) + ((size_t)((b * 2 + l) * 2 + dir) * 8 + h) * 4096; ld = 64; }
    else { const int k = sid - 32, b = ps * 2 + (k >> 4), h = (k >> 2) & 3, dir = (k >> 1) & 1, half = k & 1;
           s0 = p.in(3) + ((size_t)((b * 2 + l) * 2 + dir) * 4 + h) * 8192 + half * 64; ld = 128; }
    bf16_t* segb = (bf16_t*)(p.ws() + OFF_SEG) + (size_t)sid * NSEG * 4096;
    const float* segd = (const float*)(p.ws() + OFF_SEGD) + sid * NSEG;
    const int t2 = launder(tid);
    const float* sp = s0 + (size_t)(t2 >> 2) * ld + (t2 & 3) * 16;
    bf16_t* bp = segb + t2 * 16;
    float S[16];
#pragma unroll
    for (int k = 0; k < 4; ++k) { const f32x4 v = *(const f32x4*)(sp + 4 * k); S[4 * k] = v[0]; S[4 * k + 1] = v[1]; S[4 * k + 2] = v[2]; S[4 * k + 3] = v[3]; }
#pragma unroll 1
    for (int g2 = 0; g2 < NSEG; ++g2) {
        float loc[16]; float d = 0.f;
        if (g2 < NSEG - 1) { d = segd[g2]; unpack8(*(const u32x4*)(bp + g2 * 4096), loc); unpack8(*(const u32x4*)(bp + g2 * 4096 + 8), loc + 8); }
        else {
#pragma unroll
            for (int k = 0; k < 16; ++k) loc[k] = 0.f;
        }
        st_wt16(bp + g2 * 4096, pack8(S)); st_wt16(bp + g2 * 4096 + 8, pack8(S + 8));
#pragma unroll
        for (int k = 0; k < 16; ++k) S[k] = S[k] * d + loc[k];
    }
}

DI void postscan_token(const Ctx& p, int l, int m, int lane) {
    char* ws = p.ws();
    bf16_t* pr = (bf16_t*)(ws + OFF_PROJ) + (size_t)m * INWP;
    const int c0 = lane * 8;
    {
        const bf16_t* OS = (const bf16_t*)(ws + OFF_OS);
        float a[8], b[8], xs[8], z[8];
        unpack8(*(const u32x4*)(OS + (size_t)m * 512 + c0), a);
        unpack8(*(const u32x4*)(OS + ((size_t)NPT + m) * 512 + c0), b);
        unpack8(*(const u32x4*)((const bf16_t*)(ws + OFF_XBCA) + (size_t)m * 768 + c0), xs);
        unpack8(*(const u32x4*)(pr + C_Z + c0), z);
        const float dsk = p.in(21)[l * 8 + (c0 >> 6)];
        float v[8], ss = 0.f;
#pragma unroll
        for (int j = 0; j < 8; ++j) { v[j] = ((a[j] + b[j]) + dsk * xs[j]) * siluf(z[j]); ss += v[j] * v[j]; }
        ss = wsum(ss);
        const float rstd = rsqrtf(ss * (1.f / 512.f) + EPS);
        const float* w = p.in(22) + l * 512 + c0;
#pragma unroll
        for (int j = 0; j < 8; ++j) v[j] = (v[j] * rstd) * w[j];
        *(u32x4*)(pr + C_Z + c0) = pack8(v);
    }
    {
        const bf16_t* ORb = (const bf16_t*)(ws + OFF_OR);
        float a[8], b[8], gt[8];
        unpack8(*(const u32x4*)(ORb + (size_t)m * 512 + c0), a);
        unpack8(*(const u32x4*)(ORb + ((size_t)NPT + m) * 512 + c0), b);
        unpack8(*(const u32x4*)(pr + C_RG + c0), gt);
        float v[8], sm = 0.f;
#pragma unroll
        for (int j = 0; j < 8; ++j) { v[j] = a[j] + b[j]; sm += v[j]; }
        sm += shx(sm, 1); sm += shx(sm, 2); sm += shx(sm, 4); sm += shx(sm, 8);
        const float mean = sm * (1.f / 128.f);
        float sq = 0.f;
#pragma unroll
        for (int j = 0; j < 8; ++j) { v[j] -= mean; sq += v[j] * v[j]; }
        sq += shx(sq, 1); sq += shx(sq, 2); sq += shx(sq, 4); sq += shx(sq, 8);
        const float rstd = rsqrtf(sq * (1.f / 128.f) + EPS);
        const float* w = p.in(24) + l * 512 + c0;
#pragma unroll
        for (int j = 0; j < 8; ++j) v[j] = (v[j] * rstd) * w[j] * siluf(gt[j]);
        *(u32x4*)(pr + C_RG + c0) = pack8(v);
    }
}

DI void phase_act(const Ctx& p, int l, int ps, int tid) {
    tid = launder(tid);
    const int lane = tid & 63, wv = tid >> 6;
    const bf16_t* U = (const bf16_t*)(p.ws() + OFF_U);
    bf16_t* A = (bf16_t*)(p.ws() + OFF_ACT);
    const float* cw = p.in(39) + (size_t)l * 3 * 5632; const float* cb = p.in(40) + (size_t)l * 5632;
    for (int item = BIDX * 4 + wv; item < 512 * 6; item += gridDim.x * 4) {
        const int run = item / 6, cbk = item % 6;
        const int j0 = cbk * 512 + lane * 8;
        if (j0 >= DFF) continue;
        const int m0 = run * 16;
        const Tok k = tok_info(m0, ps);
        float wu[4][8], wg[4][8];
#pragma unroll
        for (int tp = 0; tp < 3; ++tp) {
            const f32x4 a0 = *(const f32x4*)(cw + tp * 5632 + j0), a1 = *(const f32x4*)(cw + tp * 5632 + j0 + 4);
            const f32x4 g0 = *(const f32x4*)(cw + tp * 5632 + DFF + j0), g1 = *(const f32x4*)(cw + tp * 5632 + DFF + j0 + 4);
#pragma unroll
            for (int e = 0; e < 4; ++e) { wu[tp][e] = a0[e]; wu[tp][4 + e] = a1[e]; wg[tp][e] = g0[e]; wg[tp][4 + e] = g1[e]; }
        }
        {
            const f32x4 a0 = *(const f32x4*)(cb + j0), a1 = *(const f32x4*)(cb + j0 + 4);
            const f32x4 g0 = *(const f32x4*)(cb + DFF + j0), g1 = *(const f32x4*)(cb + DFF + j0 + 4);
#pragma unroll
            for (int e = 0; e < 4; ++e) { wu[3][e] = a0[e]; wu[3][4 + e] = a1[e]; wg[3][e] = g0[e]; wg[3][4 + e] = g1[e]; }
        }
        const bf16_t* ub = U + (size_t)m0 * 5632 + j0;
        const u32x4 zero = {0u, 0u, 0u, 0u};
        u32x4 pu = zero, pg = zero, cu, cg;
        if (k.t > 0) { pu = gld16(ub - 5632); pg = gld16(ub - 5632 + DFF); }
        cu = gld16(ub); cg = gld16(ub + DFF);
#pragma unroll 4
        for (int i = 0; i < 16; ++i) {
            u32x4 nu = zero, ng = zero;
            if (k.t + i + 1 < k.L) { nu = gld16(ub + (size_t)(i + 1) * 5632); ng = gld16(ub + (size_t)(i + 1) * 5632 + DFF); }
            float a[8], b[8], c[8], o[8];
            unpack8(pu, a); unpack8(cu, b); unpack8(nu, c);
            float up[8];
#pragma unroll
            for (int e = 0; e < 8; ++e) up[e] = wu[3][e] + wu[0][e] * a[e] + wu[1][e] * b[e] + wu[2][e] * c[e];
            unpack8(pg, a); unpack8(cg, b); unpack8(ng, c);
#pragma unroll
            for (int e = 0; e < 8; ++e) { const float gt = wg[3][e] + wg[0][e] * a[e] + wg[1][e] * b[e] + wg[2][e] * c[e]; o[e] = siluf(gt) * up[e]; }
            *(u32x4*)(A + (size_t)(m0 + i) * DFF + j0) = pack8(o);
            pu = cu; pg = cg; cu = nu; cg = ng;
        }
    }
}

DI int next_item(unsigned* ctr, volatile LAS unsigned* slot, int tid) {
    __syncthreads();
    if (tid == 0) *slot = __hip_atomic_fetch_add(ctr, 1u, __ATOMIC_RELAXED, __HIP_MEMORY_SCOPE_AGENT);
    __syncthreads();
    return (int)*slot;
}

#ifndef ONLY2
#define ONLY2 -1
#endif
#ifndef PROBE_KIND
#define PROBE_KIND -1
#endif
DI void item_publish(unsigned* cnt, int tid) {
    asm volatile("s_waitcnt vmcnt(0)" ::: "memory");
    __syncthreads();
    if (tid == 0) __hip_atomic_fetch_add(cnt, 1u, __ATOMIC_RELAXED, __HIP_MEMORY_SCOPE_AGENT);
}
DI void item_wait(unsigned* cnt, unsigned need, int tid) {
    if (tid == 0) {
        unsigned sp = 0;
        while (__hip_atomic_load(cnt, __ATOMIC_RELAXED, __HIP_MEMORY_SCOPE_AGENT) < need) { __builtin_amdgcn_s_sleep(2); if (++sp > (1u << 24)) break; }
        __builtin_amdgcn_fence(__ATOMIC_ACQUIRE, "agent");
        asm volatile("s_waitcnt vmcnt(0)" ::: "memory");
    }
    __syncthreads();
}
DI void phase_mix(const Ctx& p, int l, int ps, unsigned* ctr, unsigned* c12, volatile LAS unsigned* slot, char* smem, int tid) {
    unsigned* gdone = ctr + 64; unsigned* sdone = ctr + 128;
    unsigned* c1 = c12; unsigned* c2 = c12 + 64;
    constexpr int N1 = 64 * (NSEG - 1), N3 = 64 * NSEG;
    constexpr int A0 = N1, A1 = A0 + 384, A2 = A1 + 544, A3 = A2 + 256, A4 = A3 + 64, A5 = A4 + N3, A6 = A5 + 256, A7 = A6 + 256, A8 = A7 + 256, A9 = A8 + 256, A10 = A9 + 256, A11 = A10 + 256;
    for (;;) {
        tid = launder(tid);
        l = launder_s(l); ps = launder_s(ps);
        int it = next_item(ctr, slot, tid);
        if (it >= A11) break;
        int sc = -1, isret = 0, sq = 0, hd = 0, dr = 0, hf = 0, md = 0, sg = 0, sid = 0; unsigned* pub = sdone;
        if (it < A0) { sid = it / (NSEG - 1); sg = it % (NSEG - 1); md = 1; sc = 1; pub = c1 + sid; }
        else if (it >= A4 && it < A5) { const int k = it - A4; sid = k / NSEG; sg = k % NSEG; md = 3; sc = 1; }
        else if (it >= A6 && it < A7) { const int k = it - A6; sq = k >> 4; hd = (k >> 1) & 7; dr = k & 1; sc = 0; }
        else if (it >= A7 && it < A8) { const int k = it - A7; isret = 1; sq = k >> 4; hd = (k >> 2) & 3; dr = (k >> 1) & 1; hf = k & 1; sc = 0; }
        if (sc == 1) {
            if (sid < 32) { isret = 0; sq = 16 + (sid >> 4); hd = (sid >> 1) & 7; dr = sid & 1; hf = 0; }
            else { const int k = sid - 32; isret = 1; sq = 16 + (k >> 4); hd = (k >> 2) & 3; dr = (k >> 1) & 1; hf = k & 1; }
        }
        if (sc >= 0) {
            if (md == 3) item_wait(c2 + sid, 1u, tid);
            scan_any_item(p, l, ps, isret, sq, hd, dr, hf, md, sg, sid, smem, tid);
            item_publish(pub, tid);
        }
        else if (it < A1) { gemm_uq_tile(p, l, ps, it - A0, smem, tid); item_publish(gdone, tid); }
        else if (it < A2) { gemm_ukv_tile(p, l, it - A1, smem, tid); item_publish(gdone, tid); }
        else if (it < A3) { const int k = it - A2; attn_gqa_item(p, l, 16 + (k >> 7), (k >> 4) & 7, k & 15, ps, smem, tid); }
        else if (it < A4) { const int sd = it - A3; item_wait(c1 + sd, (unsigned)(NSEG - 1), tid); scan_combine_item(p, l, ps, sd, tid); item_publish(c2 + sd, tid); }
        else if (it < A6) { const int k = it - A5; item_wait(gdone, 928u, tid); attn_mla_item(p, 16 + (k >> 7), (k >> 4) & 7, k & 15, ps, smem, tid); }
        else if (it < A9) { const int k = it - A8; attn_gqa_item(p, l, k >> 4, (k >> 1) & 7, k & 1, ps, smem, tid); }
        else if (it < A10) { const int k = it - A9; item_wait(gdone, 928u, tid); attn_mla_item(p, k >> 4, (k >> 1) & 7, k & 1, ps, smem, tid); }
        else { item_wait(sdone, (unsigned)(N3 + 512), tid); const int k = it - A10; const int t5 = launder(tid); for (int i = 0; i < 8; ++i) postscan_token(p, l, k * 32 + i * 4 + (t5 >> 6), t5 & 63); }
    }
}

constexpr int NPL = 10;
constexpr int NPP = 1 + 2 * NPL;
constexpr int NPHASE = 1 + 2 * NPP;
DI void run_phase(const Ctx& p, int ph, int rep, volatile LAS unsigned* slot, char* smem, int tid) {
#ifndef EXCL
#define EXCL -2
#endif
#ifndef ONLY
#define ONLY -1
#endif
    if (ph == 0) { phase_prep_w(p, smem, tid); return; }
    const int q = ph - 1, ps = q / NPP, r = q % NPP;
    if (r == 0) { phase_h1(p, ps, tid); return; }
    const int l = (r - 1) / NPL, k = (r - 1) % NPL;
    char* ws = p.ws();
    unsigned* ctr = (unsigned*)(p.ws() + OFF_CTR) + ph;
    switch (k) {
    case 0: phase_gemm_in(p, l, smem, tid); break;
    case 1: phase_prep(p, l, ps, tid); break;
    case 2: phase_mix(p, l, ps, ctr, (unsigned*)(p.ws() + OFF_CTR) + 256 + (ps * 2 + l) * 128, slot, smem, tid); break;
    case 3: phase_merge(p, l, smem, tid); break;
    case 4: phase_gemm_plain<true>((const bf16_t*)(ws + OFF_WOUT) + (size_t)l * SZ_WOUT, 1024, (const bf16_t*)(ws + OFF_MERGED), 1024, 64, 8, ws + OFF_MO, 1024, smem, tid); break;
    case 5: phase_res(p, ps, l, 0, tid); break;
    case 6: phase_gemm_plain<false>((const bf16_t*)(ws + OFF_WUP) + (size_t)l * SZ_WUP, 1024, (const bf16_t*)(ws + OFF_H), 1024, 64, 44, ws + OFF_U, 5632, smem, tid); break;
    case 7: phase_act(p, l, ps, tid); break;
    case 8: phase_gemm_plain<true>((const bf16_t*)(ws + OFF_WDN) + (size_t)l * SZ_WDN, 2816, (const bf16_t*)(ws + OFF_ACT), 2816, 64, 8, ws + OFF_FO, 1024, smem, tid); break;
    default: phase_res(p, ps, l, 1, tid); if (ps == 0 && l == 1) phase_h1(p, 1, tid); break;
    }
}

constexpr unsigned long long probe_mask(int kind) {
    unsigned long long m = 0;
    for (int ph = 0; ph < NPHASE; ++ph) {
        int k = 11; if (ph > 0) { const int r = (ph - 1) % NPP; k = (r == 0) ? 12 : (r - 1) % NPL; }
        if (k == kind) m |= 1ull << ph;
    }
    return m;
}
__global__ void __launch_bounds__(256, 2) fwd_kernel(Params prm, int ph_lo, int ph_hi, int rep) {
    __shared__ __attribute__((aligned(16))) char smem[65536 + 32 + 352];
    int tid = threadIdx.x;
    volatile LAS unsigned* xw = (volatile LAS unsigned*)(smem + 65536);
    volatile LAS unsigned* tbl = (volatile LAS unsigned*)(smem + 65536 + 32);
    if (tid == 0) { xw[0] = 0u; xw[1] = 0u; xw[2] = 0u; xw[3] = 0u; }
    if (tid == 0) {
#pragma unroll
        for (int i = 0; i < 44; ++i) {
            const unsigned long long v = (i < 42) ? (unsigned long long)prm.in[i < 42 ? i : 0] : (i == 42 ? (unsigned long long)prm.out : (unsigned long long)prm.ws);
            tbl[2 * i] = (unsigned)v; tbl[2 * i + 1] = (unsigned)(v >> 32);
        }
    }
    __syncthreads();
    Ctx p; p.tbl = tbl;
    XcdBarrier bar;
    if (ph_hi - ph_lo > 1) bar = xcd_barrier_post((unsigned*)(p.ws() + OFF_BAR), xw, tid);
    constexpr unsigned long long PMASK = probe_mask(PROBE_KIND);
    if (PROBE_KIND >= 0 && BIDX == 0 && tid == 0) { xw[3] = 0u; xw[4] = (unsigned)__builtin_amdgcn_s_memrealtime(); }
    for (int ph = ph_lo; ph < ph_hi; ++ph) {
        if (ph == 1 + NPP) continue;
        tid = launder(tid);
        run_phase(p, ph, rep, xw + 2, smem, tid);
        if (PROBE_KIND == 13 && BIDX == 0 && tid == 0) xw[5] = (unsigned)__builtin_amdgcn_s_memrealtime();
        if (launder_s(ph_hi) - launder_s(ph_lo) > 1 && ph + 1 < ph_hi) xcd_barrier(bar, tid);
        if (PROBE_KIND >= 0 && BIDX == 0 && tid == 0) {
            const unsigned tn = (unsigned)__builtin_amdgcn_s_memrealtime();
            if (PROBE_KIND == 13) xw[3] = xw[3] + (tn - xw[5]);
            else if ((PMASK >> ph) & 1ull) xw[3] = xw[3] + (tn - xw[4]);
            xw[4] = tn;
        }
    }
    if (PROBE_KIND >= 0 && BIDX == 0 && tid == 0) {
        const unsigned long long tend = __builtin_amdgcn_s_memrealtime() + 9ull * xw[3];
        while (__builtin_amdgcn_s_memrealtime() < tend) __builtin_amdgcn_s_sleep(8);
    }
}

#ifndef MK_ONE_LAUNCH
#define MK_ONE_LAUNCH 1
#endif

extern "C" void kernel_launch(void* const* d_in, const int* in_sizes, int n_in, void* d_out, int out_size, void* d_ws, size_t ws_size, hipStream_t stream) {
    (void)in_sizes; (void)n_in; (void)out_size;
    if (ws_size < WS_NEED) { fprintf(stderr, "workspace too small: %zu < %zu\n", ws_size, (size_t)WS_NEED); return; }
    Params p{};
    for (int i = 0; i < 42; ++i) p.in[i] = (const float*)d_in[i];
    p.out = (float*)d_out; p.ws = (char*)d_ws;
    static int grid_blocks = 0;
    if (!grid_blocks) {
        int dev = 0, cus = 0, per_cu = 0;
        hipGetDevice(&dev);
        hipDeviceGetAttribute(&cus, hipDeviceAttributeMultiprocessorCount, dev);
        hipOccupancyMaxActiveBlocksPerMultiprocessor(&per_cu, fwd_kernel, 256, 0);
        if (per_cu > 2) per_cu = 2;
        if (per_cu < 1) per_cu = 1;
        grid_blocks = cus * per_cu;
    }
    hipMemsetAsync((char*)d_ws + OFF_BAR, 0, BAR_BYTES + CTR_BYTES, stream);
#if MK_ONE_LAUNCH
    {
        int lo = 0, hi = NPHASE, rep = 0;
        void* args[] = {&p, &lo, &hi, &rep};
        hipError_t e = hipLaunchCooperativeKernel((void*)fwd_kernel, dim3(grid_blocks), dim3(256), args, 0, stream);
        if (e != hipSuccess) fprintf(stderr, "cooperative launch failed: %s (grid %d)\n", hipGetErrorString(e), grid_blocks);
    }
#else
#ifndef PROBE_REP
#define PROBE_REP 0
#endif
    for (int ph = 0; ph < NPHASE; ++ph) {
        fwd_kernel<<<grid_blocks, 256, 0, stream>>>(p, ph, ph + 1, 0);
        int kind = -1;
        if (ph == 0) kind = 11; else { const int r = (ph - 1) % NPP; kind = (r == 0) ? 12 : (r - 1) % NPL; }
        if ((PROBE_REP >> kind) & 1) fwd_kernel<<<grid_blocks, 256, 0, stream>>>(p, ph, ph + 1, 1);
    }
#endif
}
```

```cpp
#include <hip/hip_runtime.h>
#include <cstdio>
#include <cstdint>
#include <cmath>

typedef unsigned short bf16_t;
typedef short bf16x8 __attribute__((ext_vector_type(8)));
typedef float f32x4 __attribute__((ext_vector_type(4)));
typedef unsigned u32x4 __attribute__((ext_vector_type(4)));
typedef unsigned u32x2 __attribute__((ext_vector_type(2)));
#define DI __device__ __forceinline__
#define LAS __attribute__((address_space(3)))

constexpr int DM = 1024, INW = 4272, INWP = 4352, DFF = 2816;
constexpr int NPT = 8192;
constexpr int KROWS = 8704;
constexpr float EPS = 1e-6f;
constexpr int C_Z = 0, C_XBC = 512, C_DT = 1280, C_RQ = 1296, C_RK = 1552, C_RV = 1808, C_RG = 2320, C_AQ = 2832, C_AK = 3344, C_AV = 3472,
              C_MCQ = 3600, C_MCKV = 3984;
constexpr size_t O_YS = 8388608, O_SSD = 16777216, O_RET = 20971520, O_CK = 25165824, O_CV = 27262976, O_CC = 29360128, O_CR = 33554432;

constexpr size_t al256(size_t x) { return (x + 255) & ~(size_t)255; }
constexpr size_t SZ_WIN = (size_t)INWP * 1024, SZ_WM = (size_t)4096 * 1024, SZ_WUQ = (size_t)768 * 384, SZ_WUKV = (size_t)1024 * 256,
                 SZ_WBR = (size_t)4 * 1024 * 512, SZ_WOUT = (size_t)1024 * 1024, SZ_WUP = (size_t)5632 * 1024, SZ_WDN = (size_t)1024 * 2816;
constexpr size_t OFF_WIN = 0;
constexpr size_t OFF_WM = OFF_WIN + 4 * SZ_WIN;
constexpr size_t OFF_WUQ = OFF_WM + 4 * SZ_WM;
constexpr size_t OFF_WUKV = OFF_WUQ + 4 * SZ_WUQ;
constexpr size_t OFF_WBR = OFF_WUKV + 4 * SZ_WUKV;
constexpr size_t OFF_WOUT = OFF_WBR + 4 * SZ_WBR;
constexpr size_t OFF_WUP = OFF_WOUT + 4 * SZ_WOUT;
constexpr size_t OFF_WDN = OFF_WUP + 4 * SZ_WUP;
constexpr size_t OFF_MOD = al256(OFF_WDN + 4 * SZ_WDN);
constexpr size_t OFF_T16 = al256(OFF_MOD + (size_t)2 * 5 * 6144 * 4);
constexpr size_t OFF_T8 = OFF_T16 + 2 * 64 * 16 * 4;
constexpr size_t OFF_BAR = al256(OFF_T8 + 2 * 64 * 8 * 4);
constexpr size_t BAR_BYTES = 3456 * 4, CTR_BYTES = (256 + 4 * 128) * 4;
constexpr size_t OFF_CTR = OFF_BAR + BAR_BYTES;
constexpr size_t OFF_DTRAW = al256(OFF_CTR + CTR_BYTES);
constexpr size_t OFF_DT = OFF_DTRAW + (size_t)NPT * 16 * 4;
constexpr size_t OFF_H = al256(OFF_DT + (size_t)NPT * 16 * 4);
constexpr size_t OFF_PROJ = OFF_H + (size_t)NPT * 1024 * 2;
constexpr size_t OFF_XBCA = OFF_PROJ + (size_t)NPT * INWP * 2;
constexpr size_t OFF_KA = OFF_XBCA + (size_t)NPT * 768 * 2;
constexpr size_t OFF_VAT = OFF_KA + (size_t)KROWS * 128 * 2;
constexpr size_t OFF_CKV = OFF_VAT + (size_t)KROWS * 128 * 2;
constexpr size_t OFF_KRP = OFF_CKV + (size_t)KROWS * 256 * 2;
constexpr size_t OFF_QM = OFF_KRP + (size_t)KROWS * 32 * 2;
constexpr size_t OFF_KN = OFF_QM + (size_t)NPT * 768 * 2;
constexpr size_t OFF_VMT = OFF_KN + (size_t)KROWS * 512 * 2;
constexpr size_t OFF_OS = OFF_VMT + (size_t)KROWS * 512 * 2;
constexpr size_t OFF_OR = OFF_OS + (size_t)2 * NPT * 512 * 2;
constexpr size_t OFF_OM = OFF_OR + (size_t)2 * NPT * 512 * 2;
constexpr size_t OFF_OA = OFF_OM + (size_t)NPT * 512 * 2;
constexpr int NSEG = 4, SEGTOK = 2048 / NSEG;
constexpr size_t OFF_SEG = OFF_OA + (size_t)NPT * 512 * 2;
constexpr size_t OFF_SEGD = OFF_SEG + (size_t)64 * NSEG * 4096 * 2;
constexpr size_t WS_END1 = OFF_SEGD + 64 * NSEG * 4;
constexpr size_t OFF_MERGED = OFF_OS;
constexpr size_t OFF_MO = OFF_XBCA;
constexpr size_t OFF_U = OFF_PROJ;
constexpr size_t OFF_ACT = OFF_QM;
constexpr size_t OFF_FO = OFF_PROJ;
constexpr size_t OFF_EDGE = OFF_PROJ + (size_t)36 * 1024 * 1024;
static_assert(OFF_MO + (size_t)NPT * 1024 * 4 <= OFF_MERGED, "MO overlaps MERGED");
static_assert(OFF_U + (size_t)NPT * 5632 * 2 <= OFF_ACT, "U overlaps ACT");
static_assert(OFF_ACT + (size_t)NPT * 2816 * 2 <= WS_END1, "ACT beyond end");
constexpr size_t WS_NEED = WS_END1;

struct Params {
    const float* in[42];
    float* out;
    char* ws;
};
struct Ctx {
    volatile LAS unsigned* tbl;
    __device__ __forceinline__ unsigned long long ld(int i) const {
        const unsigned lo = tbl[2 * i], hi = tbl[2 * i + 1];
        return ((unsigned long long)(unsigned)__builtin_amdgcn_readfirstlane((int)hi) << 32) | (unsigned)__builtin_amdgcn_readfirstlane((int)lo);
    }
    __device__ __forceinline__ const float* in(int i) const { return (const float*)ld(i); }
    __device__ __forceinline__ float* out() const { return (float*)ld(42); }
    __device__ __forceinline__ char* ws() const { return (char*)ld(43); }
};

DI float bf2f(unsigned short h) { return __uint_as_float((unsigned)h << 16); }
DI unsigned short f2bf(float f) { return __builtin_bit_cast(unsigned short, (__bf16)f); }
typedef __bf16 bf16x2_t __attribute__((ext_vector_type(2)));
DI unsigned pk2(float lo, float hi) { bf16x2_t v; v[0] = (__bf16)lo; v[1] = (__bf16)hi; return __builtin_bit_cast(unsigned, v); }
DI void unpack8(const u32x4& w, float* v) {
#pragma unroll
    for (int i = 0; i < 4; ++i) { v[2 * i] = __uint_as_float(w[i] << 16); v[2 * i + 1] = __uint_as_float(w[i] & 0xffff0000u); }
}
DI u32x4 pack8(const float* v) { u32x4 w; w[0] = pk2(v[0], v[1]); w[1] = pk2(v[2], v[3]); w[2] = pk2(v[4], v[5]); w[3] = pk2(v[6], v[7]); return w; }
DI float log1pe(float e) { return e < 1e-4f ? e - 0.5f * e * e : __builtin_amdgcn_logf(1.f + e) * 0.6931471805599453f; }
DI float siluf(float x) { return x / (1.f + __expf(-x)); }
DI float sigmoidf(float x) { return 1.f / (1.f + __expf(-x)); }
DI int lanel() { int l = (int)__lane_id(); asm volatile("" : "+v"(l)); return l; }
DI float shx(float v, int m) { const int l = lanel(); return __int_as_float(__builtin_amdgcn_ds_bpermute((l ^ m) << 2, __float_as_int(v))); }
DI float shf(float v, int src) { return __int_as_float(__builtin_amdgcn_ds_bpermute(src << 2, __float_as_int(v))); }
DI float shu(float v, int d) { const int l = lanel(); const int sidx = (l - d) < 0 ? l : (l - d); return __int_as_float(__builtin_amdgcn_ds_bpermute(sidx << 2, __float_as_int(v))); }
DI float gmax4(float v) {
    auto a = __builtin_amdgcn_permlane16_swap(__float_as_uint(v), __float_as_uint(v), false, false);
    v = fmaxf(__uint_as_float(a[0]), __uint_as_float(a[1]));
    auto b = __builtin_amdgcn_permlane32_swap(__float_as_uint(v), __float_as_uint(v), false, false);
    return fmaxf(__uint_as_float(b[0]), __uint_as_float(b[1]));
}
DI float gsum4(float v) {
    auto a = __builtin_amdgcn_permlane16_swap(__float_as_uint(v), __float_as_uint(v), false, false);
    v = __uint_as_float(a[0]) + __uint_as_float(a[1]);
    auto b = __builtin_amdgcn_permlane32_swap(__float_as_uint(v), __float_as_uint(v), false, false);
    return __uint_as_float(b[0]) + __uint_as_float(b[1]);
}
DI float wsum(float v) {
#pragma unroll
    for (int o = 32; o >= 1; o >>= 1) v += shx(v, o);
    return v;
}
typedef const __attribute__((address_space(1))) u32x4* gp128;
DI u32x4 gld16(const void* p) { return *(gp128)(unsigned long long)p; }
DI void st_wt8(void* p, u32x2 v) { __hip_atomic_store((unsigned long long*)p, ((unsigned long long)v[1] << 32) | v[0], __ATOMIC_RELAXED, __HIP_MEMORY_SCOPE_AGENT); }
DI void st_wt16(void* p, u32x4 v) { st_wt8(p, (u32x2){v[0], v[1]}); st_wt8((char*)p + 8, (u32x2){v[2], v[3]}); }
DI void st_wt2(bf16_t* p, bf16_t v) { __hip_atomic_store(p, v, __ATOMIC_RELAXED, __HIP_MEMORY_SCOPE_AGENT); }
DI void st_wt4f(float* p, float v) { __hip_atomic_store(p, v, __ATOMIC_RELAXED, __HIP_MEMORY_SCOPE_AGENT); }
DI int launder(int x) { asm volatile("" : "+v"(x)); return x; }
DI int launder_s(int x) { asm volatile("" : "+s"(x)); return x; }
#define BIDX launder_s((int)blockIdx.x)
DI int FQ(int q) { return (4 - q) & 3; }
DI int tile_off(int rows, int ks, int row, int g, int q) { return (ks * rows + row) * 64 + ((g ^ FQ(q)) << 4); }

#define XB_TMO      128
#define XB_XCNT(j)  (256  + 64 * (j))
#define XB_XSUB(j)  (1280 + 64 * (j))
#define XB_XGEN(j)  (2304 + 64 * (j))
#define XB_TOP      3328
#define XB_TOPGEN   3392
#define XB_SPIN_CAP (1u << 22)
DI unsigned xb_ld(unsigned* p) { return __hip_atomic_load(p, __ATOMIC_RELAXED, __HIP_MEMORY_SCOPE_AGENT); }
DI unsigned xb_add(unsigned* p, unsigned v) { return __hip_atomic_fetch_add(p, v, __ATOMIC_RELAXED, __HIP_MEMORY_SCOPE_AGENT); }
DI unsigned xb_xcc_id() { return (unsigned)__builtin_amdgcn_s_getreg((3 << 11) | 20) & 0xFu; }
#define XB_SPIN(cond, bar) do { unsigned _sp = 0; while (cond) { __builtin_amdgcn_s_sleep(1); \
    if ((++_sp & 255u) == 0u) { if (xb_ld(&(bar)[XB_TMO])) break; if (_sp > XB_SPIN_CAP) { atomicAdd(&(bar)[XB_TMO], 1u); break; } } } } while (0)
struct XcdBarrier { unsigned* bar; unsigned x; volatile LAS unsigned* st; };
DI XcdBarrier xcd_barrier_post(unsigned* bar, volatile LAS unsigned* st, int tid) {
    XcdBarrier b; b.bar = bar; b.x = xb_xcc_id(); b.st = st;
    if (tid == 0) (void)xb_add(&bar[XB_XCNT(b.x)], 1u);
    return b;
}
DI void xcd_barrier_complete(unsigned* bar, unsigned x, unsigned& nloc, unsigned& nx) {
    const unsigned G = gridDim.x * gridDim.y * gridDim.z;
    unsigned sum, cnt, mine, sp = 0u;
    for (;;) {
        sum = 0u; cnt = 0u; mine = 0u;
#pragma unroll
        for (unsigned j = 0; j < 16; ++j) { const unsigned c = xb_ld(&bar[XB_XCNT(j)]); sum += c; cnt += (c > 0u) ? 1u : 0u; mine = (j == x) ? c : mine; }
        if (sum == G) break;
        __builtin_amdgcn_s_sleep(1);
        if ((++sp & 255u) == 0u) { if (xb_ld(&bar[XB_TMO])) break; if (sp > XB_SPIN_CAP) { atomicAdd(&bar[XB_TMO], 1u); break; } }
    }
    nloc = mine > 0u ? mine : 1u; nx = cnt > 0u ? cnt : 1u;
}
DI void xcd_barrier(const XcdBarrier& b, int tid) {
    asm volatile("s_waitcnt vmcnt(0)" ::: "memory");
    __syncthreads();
    if (tid == 0) {
        unsigned* bar = b.bar;
        __builtin_amdgcn_s_waitcnt(0);
        unsigned nloc = b.st[0], nx = b.st[1];
        if (nloc == 0u) { xcd_barrier_complete(bar, b.x, nloc, nx); b.st[0] = nloc; b.st[1] = nx; }
        const unsigned old = xb_add(&bar[XB_XSUB(b.x)], 1u);
        const unsigned gen = old / nloc;
        if (old + 1u == (gen + 1u) * nloc) {
            __builtin_amdgcn_fence(__ATOMIC_RELEASE, "agent");
            asm volatile("s_waitcnt vmcnt(0)" ::: "memory");
            const unsigned og = xb_add(&bar[XB_TOP], 1u);
            const unsigned tg = og / nx;
            if (og + 1u == (tg + 1u) * nx) xb_add(&bar[XB_TOPGEN], 1u);
            else XB_SPIN(xb_ld(&bar[XB_TOPGEN]) == tg, bar);
            __builtin_amdgcn_fence(__ATOMIC_ACQUIRE, "agent");
            xb_add(&bar[XB_XGEN(b.x)], 1u);
            asm volatile("s_waitcnt vmcnt(0)" ::: "memory");
        } else {
            XB_SPIN(xb_ld(&bar[XB_XGEN(b.x)]) == gen, bar);
            __builtin_amdgcn_fence(__ATOMIC_ACQUIRE, "agent");
            asm volatile("s_waitcnt vmcnt(0)" ::: "memory");
        }
    }
    __syncthreads();
}

struct Tok { int lat, b, t, L, cond, krow, seq0; size_t gx; };
DI Tok tok_info(int m, int ps) {
    Tok k;
    if (m < 4096) { k.lat = 0; k.b = ps * 16 + (m >> 8); k.t = m & 255; k.L = 256; k.cond = 0; k.krow = m; k.seq0 = m & ~255; k.gx = (size_t)ps * 4096 + m; }
    else { const int mm = m - 4096, j = mm >> 11; k.lat = 1; k.b = ps * 2 + j; k.t = mm & 2047; k.L = 2048; k.cond = 1 + k.b; k.krow = 4096 + j * 2304 + 256 + k.t;
           k.seq0 = 4096 + j * 2048; k.gx = (size_t)8192 + (size_t)ps * 4096 + mm; }
    return k;
}

template <int NTA, int NTB, bool LOWREG = false, int WMAP = 0>
DI void gemm_kloop(f32x4 (&acc)[NTA][NTB], const bf16_t* __restrict__ W, size_t ldw, const bf16_t* __restrict__ X, size_t ldx, int K, char* smem, int tid) {
    constexpr int BF = 32 * NTA, BT = 32 * NTB;
    constexpr int WB = BF * 128, STG = (BF + BT) * 128;
    constexpr int NPW = BF / 8, NPX = BT / 8, NPIECE = NPW + NPX, PPW = NPIECE / 4;
    static_assert(NPIECE % 4 == 0, "pieces must divide over 4 waves");
    tid = launder(tid);
    const int lane = tid & 63, wv = tid >> 6, wn = wv >> 1, wt = wv & 1, fr = lane & 15, g = lane >> 4;
    constexpr int PWW = NPW / 4, PXX = PPW - PWW;
    const int wvu = __builtin_amdgcn_readfirstlane(wv);
    auto lane_off = [&](int j, int ln) -> unsigned {
        const bool isw = j < PWW;
        const int pp = isw ? wvu * PWW + j : wvu * PXX + (j - PWW);
        const int rows = isw ? BF : BT;
        const int rb = pp % (rows / 16);
        const int rl = ln >> 2;
        const int q = isw ? (((rb * 16 + rl) / (4 * NTA)) & 3) : ((rl >> 2) & 3);
        const int gl = (ln & 3) ^ FQ(q);
        if (WMAP && isw) return (unsigned)((rl & 7) + (rl >> 3) * DFF) * (unsigned)ldw + (unsigned)(gl * 8);
        return (unsigned)rl * (unsigned)(isw ? ldw : ldx) + (unsigned)(gl * 8);
    };
    unsigned poff[PPW];
    if (!LOWREG) {
#pragma unroll
        for (int j = 0; j < PPW; ++j) poff[j] = lane_off(j, lane);
    }
    auto issue = [&](int k0, char* sdst) {
        const int ln = LOWREG ? launder(lane) : lane;
#pragma unroll
        for (int j = 0; j < PPW; ++j) {
            const bool isw = j < PWW;
            const int pp = isw ? wvu * PWW + j : wvu * PXX + (j - PWW);
            const int rows = isw ? BF : BT;
            const int ks = pp / (rows / 16), rb = pp % (rows / 16);
            const int wrow = WMAP ? 32 * (rb >> 2) + 8 * (rb & 3) : rb * 16;
            const bf16_t* base = (isw ? W + (size_t)wrow * ldw : X + (size_t)(rb * 16) * ldx) + k0 + ks * 32;
            const unsigned off = LOWREG ? lane_off(j, ln) : poff[j];
            __builtin_amdgcn_global_load_lds((const unsigned*)(base + off), (unsigned*)(sdst + (isw ? 0 : WB) + (ks * rows + rb * 16) * 64), 16, 0, 0);
        }
    };
    const int aoff = tile_off(BF, 0, wn * 16 * NTA + 4 * NTA * (fr >> 2) + (fr & 3), g, fr >> 2);
    const int boff = WB + tile_off(BT, 0, wt * 16 * NTB + fr, g, (fr >> 2) & 3);
    const int nk = K >> 6;
    issue(0, smem);
    asm volatile("s_waitcnt vmcnt(0)" ::: "memory");
    __syncthreads();
    for (int kt = 0; kt < nk; ++kt) {
        if (kt + 1 < nk) issue((kt + 1) << 6, smem + ((kt + 1) & 1) * STG);
        const char* sb = smem + (kt & 1) * STG;
        __builtin_amdgcn_s_setprio(1);
#pragma unroll
        for (int kk = 0; kk < 2; ++kk) {
            if (LOWREG) {
                bf16x8 bfr[NTB];
#pragma unroll
                for (int mt = 0; mt < NTB; ++mt) bfr[mt] = *(const bf16x8*)(sb + boff + mt * 1024 + kk * BT * 64);
#pragma unroll
                for (int a = 0; a < NTA; ++a) {
                    const bf16x8 af1 = *(const bf16x8*)(sb + aoff + a * 256 + kk * BF * 64);
#pragma unroll
                    for (int mt = 0; mt < NTB; ++mt) acc[a][mt] = __builtin_amdgcn_mfma_f32_16x16x32_bf16(af1, bfr[mt], acc[a][mt], 0, 0, 0);
                    __builtin_amdgcn_sched_barrier(0);
                }
            } else {
                bf16x8 af[NTA], bfr[NTB];
#pragma unroll
                for (int a = 0; a < NTA; ++a) af[a] = *(const bf16x8*)(sb + aoff + a * 256 + kk * BF * 64);
#pragma unroll
                for (int mt = 0; mt < NTB; ++mt) bfr[mt] = *(const bf16x8*)(sb + boff + mt * 1024 + kk * BT * 64);
#pragma unroll
                for (int a = 0; a < NTA; ++a)
#pragma unroll
                    for (int mt = 0; mt < NTB; ++mt) acc[a][mt] = __builtin_amdgcn_mfma_f32_16x16x32_bf16(af[a], bfr[mt], acc[a][mt], 0, 0, 0);
            }
        }
        __builtin_amdgcn_s_setprio(0);
        asm volatile("s_waitcnt vmcnt(0)" ::: "memory");
        __syncthreads();
    }
}

struct WTile { const float* src; bf16_t* dst; int K, N, k0, n0; };
DI WTile wtile_decode(const Ctx& p, int it) {
    constexpr int T_IN = 16 * 68, T_M = 16 * 64, T_UQ = 6 * 12, T_UKV = 4 * 16, T_BR = 8 * 16, T_OUT = 16 * 16, T_UP = 16 * 88, T_DN = 44 * 16;
    constexpr int T_LAYER = T_IN + T_M + T_UQ + T_UKV + 4 * T_BR + T_OUT + T_UP + T_DN;
    char* ws = p.ws();
    const int l = it / T_LAYER; int k = it % T_LAYER;
    WTile t; int ntn;
    if (k < T_IN) { t.src = p.in(16) + (size_t)l * 1024 * INW; t.dst = (bf16_t*)(ws + OFF_WIN) + (size_t)l * SZ_WIN; t.K = 1024; t.N = INW; ntn = 68; }
    else if ((k -= T_IN) < T_M) { t.src = p.in(35) + (size_t)l * 1024 * 4096; t.dst = (bf16_t*)(ws + OFF_WM) + (size_t)l * SZ_WM; t.K = 1024; t.N = 4096; ntn = 64; }
    else if ((k -= T_M) < T_UQ) { t.src = p.in(28) + (size_t)l * 384 * 768; t.dst = (bf16_t*)(ws + OFF_WUQ) + (size_t)l * SZ_WUQ; t.K = 384; t.N = 768; ntn = 12; }
    else if ((k -= T_UQ) < T_UKV) { t.src = p.in(30) + (size_t)l * 256 * 1024; t.dst = (bf16_t*)(ws + OFF_WUKV) + (size_t)l * SZ_WUKV; t.K = 256; t.N = 1024; ntn = 16; }
    else if ((k -= T_UKV) < 4 * T_BR) { const int j = k / T_BR; k -= j * T_BR; t.src = (j == 0 ? p.in(31) : j == 1 ? p.in(32) : j == 2 ? p.in(33) : p.in(34)) + (size_t)l * 512 * 1024;
                                        t.dst = (bf16_t*)(ws + OFF_WBR) + (size_t)(l * 4 + j) * 1024 * 512; t.K = 512; t.N = 1024; ntn = 16; }
    else if ((k -= 4 * T_BR) < T_OUT) { t.src = p.in(37) + (size_t)l * 1024 * 1024; t.dst = (bf16_t*)(ws + OFF_WOUT) + (size_t)l * SZ_WOUT; t.K = 1024; t.N = 1024; ntn = 16; }
    else if ((k -= T_OUT) < T_UP) { t.src = p.in(38) + (size_t)l * 1024 * 5632; t.dst = (bf16_t*)(ws + OFF_WUP) + (size_t)l * SZ_WUP; t.K = 1024; t.N = 5632; ntn = 88; }
    else { k -= T_UP; t.src = p.in(41) + (size_t)l * 2816 * 1024; t.dst = (bf16_t*)(ws + OFF_WDN) + (size_t)l * SZ_WDN; t.K = 2816; t.N = 1024; ntn = 16; }
    t.k0 = (k / ntn) * 64; t.n0 = (k % ntn) * 64;
    return t;
}
DI void wtile_load(const WTile& t, int tid, f32x4 (&v)[4]) {
    const int r = tid >> 4, c4 = tid & 15;
#pragma unroll
    for (int i = 0; i < 4; ++i) {
        v[i] = (f32x4){0.f, 0.f, 0.f, 0.f};
        if (t.n0 + 4 * c4 < t.N) v[i] = *(const f32x4*)(t.src + (size_t)(t.k0 + r + 16 * i) * t.N + t.n0 + 4 * c4);
    }
}
DI void wtile_finish(const WTile& t, const f32x4 (&v)[4], char* smem, int tid) {
    float* tl = (float*)smem;
    const int r = tid >> 4, c4 = tid & 15;
#pragma unroll
    for (int i = 0; i < 4; ++i) {
        const int row = r + 16 * i;
        tl[row * 65 + 4 * c4 + 0] = v[i][0]; tl[row * 65 + 4 * c4 + 1] = v[i][1]; tl[row * 65 + 4 * c4 + 2] = v[i][2]; tl[row * 65 + 4 * c4 + 3] = v[i][3];
    }
    __syncthreads();
#pragma unroll
    for (int i = 0; i < 2; ++i) {
        const int q = tid + 256 * i, n = q >> 3, c = q & 7;
        float o[8];
#pragma unroll
        for (int j = 0; j < 8; ++j) o[j] = tl[(8 * c + j) * 65 + n];
        *(u32x4*)(t.dst + (size_t)(t.n0 + n) * t.K + t.k0 + 8 * c) = pack8(o);
    }
    __syncthreads();
}

DI void phase_prep_w(const Ctx& p, char* smem, int tid) {
    char* ws = p.ws();
    constexpr int T_IN = 16 * 68, T_M = 16 * 64, T_UQ = 6 * 12, T_UKV = 4 * 16, T_BR = 8 * 16, T_OUT = 16 * 16, T_UP = 16 * 88, T_DN = 44 * 16;
    constexpr int T_LAYER = T_IN + T_M + T_UQ + T_UKV + 4 * T_BR + T_OUT + T_UP + T_DN;
    constexpr int N_MOD = 2 * 96;
    const int total = 2 * T_LAYER + N_MOD + 1;
    constexpr int N_MODI = 2 * 192;
    for (int it = BIDX; it < N_MODI + 1; it += gridDim.x) {
        if (it < N_MODI) {
            const int l = it / 192, cb = it % 192;
            float* sc = (float*)smem;
            float* red = sc + 5 * 1024;
            __syncthreads();
            for (int e = tid; e < 5 * 1024; e += 256) {
                const int c = e >> 10, kk = e & 1023;
                const float v = (c == 0) ? p.in(9)[kk] : p.in(8)[(c - 1) * 1024 + kk];
                sc[e] = siluf(v);
            }
            __syncthreads();
            const int col = tid & 31, kg = tid >> 5;
            float a[5] = {0.f, 0.f, 0.f, 0.f, 0.f};
            const float* w = p.in(10) + ((size_t)l * 1024 + kg * 128) * 6144 + cb * 32 + col;
#pragma unroll 1
            for (int k0 = 0; k0 < 128; k0 += 16) {
                float wv[16];
#pragma unroll
                for (int j = 0; j < 16; ++j) wv[j] = w[(size_t)(k0 + j) * 6144];
#pragma unroll
                for (int j = 0; j < 16; ++j)
#pragma unroll
                    for (int c = 0; c < 5; ++c) a[c] += wv[j] * sc[c * 1024 + kg * 128 + k0 + j];
            }
#pragma unroll
            for (int c = 0; c < 5; ++c) red[(kg * 5 + c) * 32 + col] = a[c];
            __syncthreads();
            if (tid < 160) {
                const int c = tid >> 5, cl = tid & 31;
                float sm = 0.f;
#pragma unroll
                for (int k8 = 0; k8 < 8; ++k8) sm += red[(k8 * 5 + c) * 32 + cl];
                float* mod = (float*)(ws + OFF_MOD);
                mod[((size_t)l * 5 + c) * 6144 + cb * 32 + cl] = sm + p.in(11)[(size_t)l * 6144 + cb * 32 + cl];
            }
            __syncthreads();
        } else {
            float* t16 = (float*)(ws + OFF_T16); float* t8 = (float*)(ws + OFF_T8);
            for (int e = tid; e < 64 * 16 + 64 * 8; e += 256) {
                const bool small = e >= 1024;
                const int ee = small ? e - 1024 : e;
                const int pos = small ? (ee >> 3) : (ee >> 4), i = small ? (ee & 7) : (ee & 15);
                const double r = small ? 0.31622776601683794 : 0.5623413251903491;
                double th = 1.0;
                for (int j = 0; j < i; ++j) th *= r;
                const double t2 = th * th;
                double c1 = 1.0, s1 = th;
                double tc = 1.0, tsn = th;
                for (int k = 1; k < 14; ++k) {
                    tc = -tc * t2 / (double)((2 * k - 1) * (2 * k));
                    tsn = -tsn * t2 / (double)((2 * k) * (2 * k + 1));
                    c1 += tc; s1 += tsn;
                }
                double c = 1.0, sn = 0.0;
                for (int j = 0; j < pos; ++j) { const double cn = c * c1 - sn * s1, snn = sn * c1 + c * s1; c = cn; sn = snn; }
                if (small) { t8[ee] = (float)c; t8[512 + ee] = (float)sn; } else { t16[ee] = (float)c; t16[1024 + ee] = (float)sn; }
            }
        }
    }
    {
        int it = BIDX;
        f32x4 va[4];
        if (it < 2 * T_LAYER) { const WTile c0 = wtile_decode(p, it); wtile_load(c0, tid, va); }
        while (it < 2 * T_LAYER) {
            const int nx = it + gridDim.x;
            f32x4 vb[4];
            if (nx < 2 * T_LAYER) { const WTile nt = wtile_decode(p, nx); wtile_load(nt, tid, vb); }
            { const WTile cur = wtile_decode(p, launder(it)); wtile_finish(cur, va, smem, tid); }
#pragma unroll
            for (int i = 0; i < 4; ++i) va[i] = vb[i];
            it = nx;
        }
    }
}

DI void row_load(const float* r, int lane, f32x4 (&v)[4]) {
#pragma unroll
    for (int i = 0; i < 4; ++i) v[i] = *(const f32x4*)(r + 4 * lane + 256 * i);
}
DI float row_ss(const f32x4 (&v)[4]) {
    float s = 0.f;
#pragma unroll
    for (int i = 0; i < 4; ++i) s += v[i][0] * v[i][0] + v[i][1] * v[i][1] + v[i][2] * v[i][2] + v[i][3] * v[i][3];
    return wsum(s);
}
DI void row_modnorm_store(const f32x4 (&x)[4], const float* gw, const float* sh, const float* sc, bf16_t* dst, int lane) {
    const float rstd = rsqrtf(row_ss(x) * (1.f / 1024.f) + EPS);
#pragma unroll
    for (int i = 0; i < 4; ++i) {
        const int c = 4 * lane + 256 * i;
        const f32x4 g = *(const f32x4*)(gw + c), s = *(const f32x4*)(sh + c), q = *(const f32x4*)(sc + c);
        float o[4];
#pragma unroll
        for (int j = 0; j < 4; ++j) o[j] = (x[i][j] * rstd) * g[j] * (1.f + q[j]) + s[j];
        u32x2 w; w[0] = pk2(o[0], o[1]); w[1] = pk2(o[2], o[3]);
        *(u32x2*)(dst + c) = w;
    }
}
DI const float* x_in_row(const Ctx& p, int m, int ps) {
    return (m < 4096) ? p.in(0) + ((size_t)ps * 4096 + m) * 1024 : p.in(1) + ((size_t)ps * 4096 + (m - 4096)) * 1024;
}
DI void phase_h1(const Ctx& p, int ps, int tid) {
    const int lane = tid & 63, wv = tid >> 6;
    const float* mod = (const float*)(p.ws() + OFF_MOD);
    bf16_t* H = (bf16_t*)(p.ws() + OFF_H);
    for (int m = BIDX * 4 + wv; m < NPT; m += gridDim.x * 4) {
        const Tok k = tok_info(m, ps);
        f32x4 x[4]; row_load(x_in_row(p, m, ps), lane, x);
        const float* md = mod + (size_t)(0 * 5 + k.cond) * 6144;
        row_modnorm_store(x, p.in(12), md + 0, md + 1024, H + (size_t)m * 1024, lane);
    }
}
DI void phase_res(const Ctx& p, int ps, int l, int which, int tid) {
    const int lane = tid & 63, wv = tid >> 6;
    const float* mod = (const float*)(p.ws() + OFF_MOD);
    bf16_t* H = (bf16_t*)(p.ws() + OFF_H);
    const float* Y = (const float*)(p.ws() + (which ? OFF_FO : OFF_MO));
    const float* gpost = (which ? p.in(15) : p.in(13)) + (size_t)l * 1024;
    const int bid = BIDX, rbase = (bid & 7) * 1024 + (bid >> 3) * 4 + wv, rstep = (gridDim.x >> 3) * 4;
    for (int mo = 0; (bid >> 3) * 4 + wv + mo < 1024; mo += rstep) {
        const int m = rbase + mo;
        const Tok k = tok_info(m, ps);
        const float* md = mod + (size_t)(l * 5 + k.cond) * 6144;
        const float* gate = md + (which ? 5 * 1024 : 2 * 1024);
        f32x4 x[4], y[4];
        if (l == 0 && which == 0) row_load(x_in_row(p, m, ps), lane, x); else row_load(p.out() + k.gx * 1024, lane, x);
        row_load(Y + (size_t)m * 1024, lane, y);
        const float rstd = rsqrtf(row_ss(y) * (1.f / 1024.f) + EPS);
#pragma unroll
        for (int i = 0; i < 4; ++i) {
            const int c = 4 * lane + 256 * i;
            const f32x4 g = *(const f32x4*)(gate + c), w = *(const f32x4*)(gpost + c);
#pragma unroll
            for (int j = 0; j < 4; ++j) x[i][j] = x[i][j] + g[j] * ((y[i][j] * rstd) * w[j]);
            *(f32x4*)(p.out() + k.gx * 1024 + c) = x[i];
        }
        if (which == 0) row_modnorm_store(x, p.in(14) + (size_t)l * 1024, md + 3 * 1024, md + 4 * 1024, H + (size_t)m * 1024, lane);
        else if (l + 1 < 2) { const float* md2 = mod + (size_t)((l + 1) * 5 + k.cond) * 6144;
                              row_modnorm_store(x, p.in(12) + (size_t)(l + 1) * 1024, md2, md2 + 1024, H + (size_t)m * 1024, lane); }
    }
}

DI bool xcd_tile(int it, int Mt, int Nt, int B, int& mt, int& nt) {
    const int x = BIDX & 7, loc = BIDX >> 3, nloc = gridDim.x >> 3;
    const int MP = Mt >> 3;
    const int idx = it * nloc + loc;
    if (idx >= MP * Nt) return false;
    const int ng = idx / (MP * B);
    const int bw = min(B, Nt - ng * B);
    const int r = idx - ng * MP * B;
    mt = x * MP + r / bw; nt = ng * B + r % bw;
    return true;
}
DI void phase_gemm_in(const Ctx& p, int l, char* smem, int tid) {
    const bf16_t* W = (const bf16_t*)(p.ws() + OFF_WIN) + (size_t)l * SZ_WIN;
    const bf16_t* X = (const bf16_t*)(p.ws() + OFF_H);
    bf16_t* PROJ = (bf16_t*)(p.ws() + OFF_PROJ);
    float* DTRAW = (float*)(p.ws() + OFF_DTRAW);
    const int lane = tid & 63, wv = tid >> 6, wn = wv >> 1, wt = wv & 1, fr = lane & 15, g = lane >> 4;
    for (int it = 0;; ++it) {
        int mt0, nt0; if (!xcd_tile(it, 64, 34, 8, mt0, nt0)) break;
        const int m0 = mt0 * 128, n0 = nt0 * 128;
        f32x4 acc[4][4];
#pragma unroll
        for (int a = 0; a < 4; ++a)
#pragma unroll
            for (int b = 0; b < 4; ++b) acc[a][b] = (f32x4){0.f, 0.f, 0.f, 0.f};
        gemm_kloop<4, 4>(acc, W + (size_t)n0 * 1024, 1024, X + (size_t)m0 * 1024, 1024, 1024, smem, tid);
        const int fb = n0 + wn * 64 + 16 * g;
#pragma unroll
        for (int mt = 0; mt < 4; ++mt) {
            const int m = m0 + wt * 64 + 16 * mt + fr;
            float v[16];
#pragma unroll
            for (int a = 0; a < 4; ++a)
#pragma unroll
                for (int r = 0; r < 4; ++r) v[4 * a + r] = acc[a][mt][r];
            bf16_t* d = PROJ + (size_t)m * INWP + fb;
            *(u32x4*)d = pack8(v); *(u32x4*)(d + 8) = pack8(v + 8);
            if (fb == C_DT) {
                float* dd = DTRAW + (size_t)m * 16;
#pragma unroll
                for (int a = 0; a < 4; ++a) *(f32x4*)(dd + 4 * a) = acc[a][mt];
            }
        }
    }
}

template <bool F32OUT>
DI void phase_gemm_plain(const bf16_t* W, int K, const bf16_t* X, size_t ldx, int Mtiles, int Ntiles, void* out, size_t ldo, char* smem, int tid) {
    const int lane = tid & 63, wv = tid >> 6, wn = wv >> 1, wt = wv & 1, fr = lane & 15, g = lane >> 4;
    for (int it = 0;; ++it) {
        int mt0, nt0; if (!xcd_tile(it, Mtiles, Ntiles, 8, mt0, nt0)) break;
        const int m0 = mt0 * 128, n0 = nt0 * 128;
        f32x4 acc[4][4];
#pragma unroll
        for (int a = 0; a < 4; ++a)
#pragma unroll
            for (int b = 0; b < 4; ++b) acc[a][b] = (f32x4){0.f, 0.f, 0.f, 0.f};
        gemm_kloop<4, 4>(acc, W + (size_t)n0 * K, K, X + (size_t)m0 * ldx, ldx, K, smem, tid);
        const int fb = n0 + wn * 64 + 16 * g;
#pragma unroll
        for (int mt = 0; mt < 4; ++mt) {
            const int m = m0 + wt * 64 + 16 * mt + fr;
            if (F32OUT) {
                float* d = (float*)out + (size_t)m * ldo + fb;
#pragma unroll
                for (int a = 0; a < 4; ++a) *(f32x4*)(d + 4 * a) = acc[a][mt];
            } else {
                float v[16];
#pragma unroll
                for (int a = 0; a < 4; ++a)
#pragma unroll
                    for (int r = 0; r < 4; ++r) v[4 * a + r] = acc[a][mt][r];
                bf16_t* d = (bf16_t*)out + (size_t)m * ldo + fb;
                *(u32x4*)d = pack8(v); *(u32x4*)(d + 8) = pack8(v + 8);
            }
        }
    }
}


template <int CTRL> DI float dpp0(float v) { return __builtin_bit_cast(float, __builtin_amdgcn_update_dpp(0, __builtin_bit_cast(int, v), CTRL, 0xf, 0xf, true)); }
constexpr int BND_OFF = 65536;
DI void phase_up_act(const Ctx& p, int l, char* smem, int tid) {
    const bf16_t* W = (const bf16_t*)(p.ws() + OFF_WUP) + (size_t)l * SZ_WUP;
    const bf16_t* X = (const bf16_t*)(p.ws() + OFF_H);
    bf16_t* A = (bf16_t*)(p.ws() + OFF_ACT);
    float* EDGE = (float*)(p.ws() + OFF_EDGE);
    const float* cw = p.in(39) + (size_t)l * 3 * 5632; const float* cb = p.in(40) + (size_t)l * 5632;
    float* bnd = (float*)(smem + BND_OFF);
    for (int it = 0;; ++it) {
        int mt0, nt0; if (!xcd_tile(it, 64, 44, 8, mt0, nt0)) break;
        const int m0 = mt0 * 128, cb0 = nt0 * 64;
        f32x4 acc[4][4];
#pragma unroll
        for (int a = 0; a < 4; ++a)
#pragma unroll
            for (int b = 0; b < 4; ++b) acc[a][b] = (f32x4){0.f, 0.f, 0.f, 0.f};
        gemm_kloop<4, 4, false, 1>(acc, W + (size_t)cb0 * 1024, 1024, X + (size_t)m0 * 1024, 1024, 1024, smem, tid);
        const int t2 = launder(tid);
        const int lane = t2 & 63, wv = t2 >> 6, wn = wv >> 1, wt = wv & 1, fr = lane & 15, g = lane >> 4;
        const int c0 = cb0 + 32 * wn + 8 * g;
        if (fr == 0) {
            float* d = bnd + (((wn * 2 + wt) * 2 + 0) * 4 + g) * 16;
#pragma unroll
            for (int a = 0; a < 4; ++a) *(f32x4*)(d + 4 * a) = acc[a][0];
        }
        if (fr == 15) {
            float* d = bnd + (((wn * 2 + wt) * 2 + 1) * 4 + g) * 16;
#pragma unroll
            for (int a = 0; a < 4; ++a) *(f32x4*)(d + 4 * a) = acc[a][3];
        }
        __syncthreads();
        const bool e0 = (wt == 0 && fr == 0), e127 = (wt == 1 && fr == 15);
        u32x2 keep[4];
#pragma unroll
        for (int eh = 0; eh < 2; ++eh) {
            const int c = c0 + 4 * eh;
            const f32x4 w0u = *(const f32x4*)(cw + c), w1u = *(const f32x4*)(cw + 5632 + c), w2u = *(const f32x4*)(cw + 2 * 5632 + c), bu = *(const f32x4*)(cb + c);
            const f32x4 w0g = *(const f32x4*)(cw + DFF + c), w1g = *(const f32x4*)(cw + 5632 + DFF + c), w2g = *(const f32x4*)(cw + 2 * 5632 + DFF + c), bg = *(const f32x4*)(cb + DFF + c);
            const float* bo = bnd + (((wn * 2 + (wt ^ 1)) * 2 + (wt ? 1 : 0)) * 4 + g) * 16;
            const f32x4 bxu = *(const f32x4*)(bo + 4 * eh), bxg = *(const f32x4*)(bo + 8 + 4 * eh);
#pragma unroll
            for (int mt = 0; mt < 4; ++mt) {
                float up[4], gt[4], o[4];
#pragma unroll
                for (int r = 0; r < 4; ++r) {
                    const float cu = acc[eh][mt][r], cg = acc[2 + eh][mt][r];
                    float pu = dpp0<0x111>(cu), pg = dpp0<0x111>(cg), nu = dpp0<0x101>(cu), ng = dpp0<0x101>(cg);
                    if (mt > 0) { pu += dpp0<0x10F>(acc[eh][mt > 0 ? mt - 1 : 0][r]); pg += dpp0<0x10F>(acc[2 + eh][mt > 0 ? mt - 1 : 0][r]); }
                    else if (wt == 1 && fr == 0) { pu = bxu[r]; pg = bxg[r]; }
                    if (mt < 3) { nu += dpp0<0x11F>(acc[eh][mt < 3 ? mt + 1 : 3][r]); ng += dpp0<0x11F>(acc[2 + eh][mt < 3 ? mt + 1 : 3][r]); }
                    else if (wt == 0 && fr == 15) { nu = bxu[r]; ng = bxg[r]; }
                    up[r] = bu[r] + w0u[r] * pu + w1u[r] * cu + w2u[r] * nu;
                    gt[r] = bg[r] + w0g[r] * pg + w1g[r] * cg + w2g[r] * ng;
                    o[r] = siluf(gt[r]) * up[r];
                }
                if (mt == 0 && e0) {
                    float* e = EDGE + ((size_t)mt0 * 4 + 0) * 5632 + c;
                    *(f32x4*)e = (f32x4){up[0], up[1], up[2], up[3]}; *(f32x4*)(e + DFF) = (f32x4){gt[0], gt[1], gt[2], gt[3]};
                    float* e3 = EDGE + ((size_t)mt0 * 4 + 3) * 5632 + c;
                    *(f32x4*)e3 = (f32x4){w2u[0] * acc[eh][0][0], w2u[1] * acc[eh][0][1], w2u[2] * acc[eh][0][2], w2u[3] * acc[eh][0][3]};
                    *(f32x4*)(e3 + DFF) = (f32x4){w2g[0] * acc[2 + eh][0][0], w2g[1] * acc[2 + eh][0][1], w2g[2] * acc[2 + eh][0][2], w2g[3] * acc[2 + eh][0][3]};
                }
                if (mt == 3 && e127) {
                    float* e = EDGE + ((size_t)mt0 * 4 + 2) * 5632 + c;
                    *(f32x4*)e = (f32x4){up[0], up[1], up[2], up[3]}; *(f32x4*)(e + DFF) = (f32x4){gt[0], gt[1], gt[2], gt[3]};
                    float* e1 = EDGE + ((size_t)mt0 * 4 + 1) * 5632 + c;
                    *(f32x4*)e1 = (f32x4){w0u[0] * acc[eh][3][0], w0u[1] * acc[eh][3][1], w0u[2] * acc[eh][3][2], w0u[3] * acc[eh][3][3]};
                    *(f32x4*)(e1 + DFF) = (f32x4){w0g[0] * acc[2 + eh][3][0], w0g[1] * acc[2 + eh][3][1], w0g[2] * acc[2 + eh][3][2], w0g[3] * acc[2 + eh][3][3]};
                }
                const u32x2 pk = {pk2(o[0], o[1]), pk2(o[2], o[3])};
                if (eh == 0) keep[mt] = pk;
                else {
                    const int m = m0 + wt * 64 + 16 * mt + fr;
                    *(u32x4*)(A + (size_t)m * DFF + c0) = (u32x4){keep[mt][0], keep[mt][1], pk[0], pk[1]};
                }
            }
        }
    }
}

DI void phase_down(const Ctx& p, int l, char* smem, int tid) {
    const bf16_t* W = (const bf16_t*)(p.ws() + OFF_WDN) + (size_t)l * SZ_WDN;
    const bf16_t* X = (const bf16_t*)(p.ws() + OFF_ACT);
    bf16_t* A = (bf16_t*)(p.ws() + OFF_ACT);
    const float* EDGE = (const float*)(p.ws() + OFF_EDGE);
    float* out = (float*)(p.ws() + OFF_FO);
    for (int it = 0;; ++it) {
        int mt0, nt0; if (!xcd_tile(it, 64, 8, 8, mt0, nt0)) break;
        const int m0 = mt0 * 128, n0 = nt0 * 128;
        {
            const int t3 = launder(tid);
            const Tok k0 = tok_info(m0, 0);
            const bool hasp = k0.t > 0, hasn = k0.t + 128 < k0.L;
            for (int i = t3; i < 2 * 704; i += 256) {
                const int row = i >= 704 ? 1 : 0, c = (i - row * 704) * 4;
                const float* P = EDGE + ((size_t)mt0 * 4 + (row ? 2 : 0)) * 5632 + c;
                f32x4 u = *(const f32x4*)P, gt = *(const f32x4*)(P + DFF);
                if (row ? hasn : hasp) {
                    const float* C = EDGE + ((size_t)(row ? mt0 + 1 : mt0 - 1) * 4 + (row ? 3 : 1)) * 5632 + c;
                    const f32x4 cu = *(const f32x4*)C, cg = *(const f32x4*)(C + DFF);
                    u += cu; gt += cg;
                }
                const u32x2 pk = {pk2(siluf(gt[0]) * u[0], siluf(gt[1]) * u[1]), pk2(siluf(gt[2]) * u[2], siluf(gt[3]) * u[3])};
                *(u32x2*)(A + (size_t)(m0 + (row ? 127 : 0)) * DFF + c) = pk;
            }
            asm volatile("s_waitcnt vmcnt(0)" ::: "memory");
            __syncthreads();
        }
        f32x4 acc[4][4];
#pragma unroll
        for (int a = 0; a < 4; ++a)
#pragma unroll
            for (int b = 0; b < 4; ++b) acc[a][b] = (f32x4){0.f, 0.f, 0.f, 0.f};
        gemm_kloop<4, 4>(acc, W + (size_t)n0 * DFF, DFF, X + (size_t)m0 * DFF, DFF, DFF, smem, tid);
        const int t2 = launder(tid);
        const int lane = t2 & 63, wv = t2 >> 6, wn = wv >> 1, wt = wv & 1, fr = lane & 15, g = lane >> 4;
        const int fb = n0 + wn * 64 + 16 * g;
#pragma unroll
        for (int mt = 0; mt < 4; ++mt) {
            const int m = m0 + wt * 64 + 16 * mt + fr;
            float* d = out + (size_t)m * 1024 + fb;
#pragma unroll
            for (int a = 0; a < 4; ++a) *(f32x4*)(d + 4 * a) = acc[a][mt];
        }
    }
}

DI void gemm_uq_tile(const Ctx& p, int l, int ps, int tile, char* smem, int tid) {
    const bf16_t* W = (const bf16_t*)(p.ws() + OFF_WUQ) + (size_t)l * SZ_WUQ;
    const bf16_t* X = (const bf16_t*)(p.ws() + OFF_PROJ) + C_MCQ;
    bf16_t* QM = (bf16_t*)(p.ws() + OFF_QM);
    const float* t8 = (const float*)(p.ws() + OFF_T8);
    const int lane = tid & 63, wv = tid >> 6, wn = wv >> 1, wt = wv & 1, fr = lane & 15, g = lane >> 4;
    const int mt0 = tile / 6, nt0 = tile % 6, m0 = mt0 * 128, n0 = nt0 * 128;
    f32x4 acc[4][4];
#pragma unroll
    for (int a = 0; a < 4; ++a)
#pragma unroll
        for (int b = 0; b < 4; ++b) acc[a][b] = (f32x4){0.f, 0.f, 0.f, 0.f};
    gemm_kloop<4, 4>(acc, W + (size_t)n0 * 384, 384, X + (size_t)m0 * INWP, INWP, 384, smem, tid);
    const int fb = n0 + wn * 64 + 16 * g;
    const int o = fb % 96;
#pragma unroll
    for (int mt = 0; mt < 4; ++mt) {
        const int m = m0 + wt * 64 + 16 * mt + fr;
        float v[16];
#pragma unroll
        for (int a = 0; a < 4; ++a)
#pragma unroll
            for (int r = 0; r < 4; ++r) v[4 * a + r] = acc[a][mt][r];
        if (m >= 4096 && o >= 64) {
            const int t = (m - 4096) & 2047;
            const int pos = (o == 64) ? (t >> 6) : (t & 63);
#pragma unroll
            for (int j = 0; j < 8; ++j) {
                const float c = t8[pos * 8 + j], s = t8[512 + pos * 8 + j];
                const float x1 = v[j], x2 = v[j + 8];
                v[j] = x1 * c - x2 * s; v[j + 8] = x2 * c + x1 * s;
            }
        }
        bf16_t* d = QM + (size_t)m * 768 + fb;
        st_wt16(d, pack8(v)); st_wt16(d + 8, pack8(v + 8));
    }
}

DI void gemm_ukv_tile(const Ctx& p, int l, int tile, char* smem, int tid) {
    const bf16_t* W = (const bf16_t*)(p.ws() + OFF_WUKV) + (size_t)l * SZ_WUKV;
    const bf16_t* X = (const bf16_t*)(p.ws() + OFF_CKV);
    bf16_t* KN = (bf16_t*)(p.ws() + OFF_KN);
    bf16_t* VMT = (bf16_t*)(p.ws() + OFF_VMT);
    const int lane = tid & 63, wv = tid >> 6, wn = wv >> 1, wt = wv & 1, fr = lane & 15, g = lane >> 4;
    const int mt0 = tile / 8, nt0 = tile % 8, m0 = mt0 * 128, n0 = nt0 * 128;
    f32x4 acc[4][4];
#pragma unroll
    for (int a = 0; a < 4; ++a)
#pragma unroll
        for (int b = 0; b < 4; ++b) acc[a][b] = (f32x4){0.f, 0.f, 0.f, 0.f};
    gemm_kloop<4, 4>(acc, W + (size_t)n0 * 256, 256, X + (size_t)m0 * 256, 256, 256, smem, tid);
    const int fb = n0 + wn * 64 + 16 * g;
    const int head = fb >> 7, o = fb & 127;
    int key0, Lk;
    if (m0 < 4096) { key0 = m0 & ~255; Lk = 256; } else { const int j = (m0 - 4096) / 2304; key0 = 4096 + j * 2304; Lk = 2304; }
#pragma unroll
    for (int mt = 0; mt < 4; ++mt) {
        const int m = m0 + wt * 64 + 16 * mt + fr;
        float v[16];
#pragma unroll
        for (int a = 0; a < 4; ++a)
#pragma unroll
            for (int r = 0; r < 4; ++r) v[4 * a + r] = acc[a][mt][r];
        if (o < 64) {
            bf16_t* d = KN + (size_t)m * 512 + head * 64 + o;
            st_wt16(d, pack8(v)); st_wt16(d + 8, pack8(v + 8));
        } else {
            bf16_t* d = VMT + (size_t)key0 * 512 + (size_t)(head * 64 + (o - 64)) * Lk + (m - key0);
#pragma unroll
            for (int i = 0; i < 16; ++i) st_wt2(d + (size_t)i * Lk, f2bf(v[i]));
        }
    }
}

DI void phase_merge(const Ctx& p, int l, char* smem, int tid) {
    for (int it = 0;; ++it) {
        int mt0, nt0; if (!xcd_tile(it, 64, 8, 8, mt0, nt0)) break;
        const int m0 = mt0 * 128, n0 = nt0 * 128;
        u32x2 mgp[4][4];
#pragma unroll
        for (int a = 0; a < 4; ++a)
#pragma unroll
            for (int b = 0; b < 4; ++b) mgp[a][b] = (u32x2){0u, 0u};
#pragma unroll 1
        for (int br = 0; br < 4; ++br) {
            u32x2 gpk[4][4];
            {
                f32x4 ga[4][4];
#pragma unroll
                for (int a = 0; a < 4; ++a)
#pragma unroll
                    for (int b = 0; b < 4; ++b) ga[a][b] = (f32x4){0.f, 0.f, 0.f, 0.f};
                gemm_kloop<4, 4, false>(ga, (const bf16_t*)(p.ws() + OFF_WM) + (size_t)l * SZ_WM + (size_t)(br * 1024 + n0) * 1024, 1024,
                                       (const bf16_t*)(p.ws() + OFF_H) + (size_t)m0 * 1024, 1024, 1024, smem, tid);
                const int t2 = launder(tid);
                const int fb = n0 + (t2 >> 7) * 64 + 16 * ((t2 & 63) >> 4);
                const float* bm = p.in(36) + (size_t)l * 4096;
#pragma unroll
                for (int a = 0; a < 4; ++a) {
                    const f32x4 bv = *(const f32x4*)(bm + br * 1024 + fb + 4 * a);
#pragma unroll
                    for (int mt = 0; mt < 4; ++mt) {
                        gpk[a][mt][0] = pk2(sigmoidf(ga[a][mt][0] + bv[0]), sigmoidf(ga[a][mt][1] + bv[1]));
                        gpk[a][mt][1] = pk2(sigmoidf(ga[a][mt][2] + bv[2]), sigmoidf(ga[a][mt][3] + bv[3]));
                    }
                }
            }
            f32x4 pa[4][4];
#pragma unroll
            for (int a = 0; a < 4; ++a)
#pragma unroll
                for (int b = 0; b < 4; ++b) pa[a][b] = (f32x4){0.f, 0.f, 0.f, 0.f};
            const bf16_t* xb; size_t ldb;
            const bf16_t* PROJ = (const bf16_t*)(p.ws() + OFF_PROJ);
            if (br == 0) { xb = PROJ + (size_t)m0 * INWP + C_Z; ldb = INWP; }
            else if (br == 1) { xb = PROJ + (size_t)m0 * INWP + C_RG; ldb = INWP; }
            else if (br == 2) { xb = (const bf16_t*)(p.ws() + OFF_OA) + (size_t)m0 * 512; ldb = 512; }
            else { xb = (const bf16_t*)(p.ws() + OFF_OM) + (size_t)m0 * 512; ldb = 512; }
            gemm_kloop<4, 4, false>(pa, (const bf16_t*)(p.ws() + OFF_WBR) + (size_t)l * SZ_WBR + (size_t)br * 1024 * 512 + (size_t)n0 * 512, 512, xb, ldb, 512, smem, tid);
#pragma unroll
            for (int a = 0; a < 4; ++a)
#pragma unroll
                for (int mt = 0; mt < 4; ++mt) {
                    const float m0 = __uint_as_float(mgp[a][mt][0] << 16) + __uint_as_float(gpk[a][mt][0] << 16) * pa[a][mt][0];
                    const float m1 = __uint_as_float(mgp[a][mt][0] & 0xffff0000u) + __uint_as_float(gpk[a][mt][0] & 0xffff0000u) * pa[a][mt][1];
                    const float m2 = __uint_as_float(mgp[a][mt][1] << 16) + __uint_as_float(gpk[a][mt][1] << 16) * pa[a][mt][2];
                    const float m3 = __uint_as_float(mgp[a][mt][1] & 0xffff0000u) + __uint_as_float(gpk[a][mt][1] & 0xffff0000u) * pa[a][mt][3];
                    mgp[a][mt][0] = pk2(m0, m1); mgp[a][mt][1] = pk2(m2, m3);
                }
        }
        const int t3 = launder(tid);
        const int fr = t3 & 15, g = (t3 & 63) >> 4, wn = t3 >> 7, wt = (t3 >> 6) & 1;
        const int fb = n0 + wn * 64 + 16 * g;
        bf16_t* MG = (bf16_t*)(p.ws() + OFF_MERGED);
#pragma unroll
        for (int mt = 0; mt < 4; ++mt) {
            const int m = m0 + wt * 64 + 16 * mt + fr;
            bf16_t* d = MG + (size_t)m * 1024 + fb;
            *(u32x4*)d = (u32x4){mgp[0][mt][0], mgp[0][mt][1], mgp[1][mt][0], mgp[1][mt][1]};
            *(u32x4*)(d + 8) = (u32x4){mgp[2][mt][0], mgp[2][mt][1], mgp[3][mt][0], mgp[3][mt][1]};
        }
    }
}

DI void prep_token(const Ctx& p, int l, int ps, int m, int lane) {
    char* ws = p.ws();
    bf16_t* PROJ = (bf16_t*)(ws + OFF_PROJ);
    const float* t16 = (const float*)(ws + OFF_T16);
    const float* t8 = (const float*)(ws + OFF_T8);
    const Tok k = tok_info(m, ps);
    bf16_t* pr = PROJ + (size_t)m * INWP;
    if (lane < 16) {
        const float v = ((const float*)(ws + OFF_DTRAW))[(size_t)m * 16 + lane] + p.in(19)[l * 16 + lane];
        const float sp = v > 20.f ? v : log1pe(__expf(v));
        ((float*)(ws + OFF_DT))[(size_t)m * 16 + lane] = sp;
    }
    {
        const int seqkey0 = k.lat ? (k.krow - 256 - k.t) : (k.krow - k.t);
        const int Lk = k.lat ? 2304 : 256;
        const int keyidx = k.krow - seqkey0;
        float v[8];
        if (lane < 32) unpack8(*(const u32x4*)(pr + C_AK + lane * 8), v);
        else {
#pragma unroll
            for (int j = 0; j < 8; ++j) v[j] = 0.f;
        }
        float ss = 0.f;
#pragma unroll
        for (int j = 0; j < 8; ++j) ss += v[j] * v[j];
        ss += shx(ss, 1); ss += shx(ss, 2); ss += shx(ss, 4);
        const float rstd = rsqrtf(ss * (1.f / 64.f) + EPS);
        const int u = lane & 7, axis = u >> 2, pos = axis ? (k.t & 63) : (k.t >> 6);
        float kv[8];
        const float* w = p.in(26) + l * 64 + u * 8;
#pragma unroll
        for (int j = 0; j < 8; ++j) kv[j] = (v[j] * rstd) * w[j];
        float kr[8];
#pragma unroll
        for (int j = 0; j < 8; ++j) {
            const float other = shx(kv[j], 2);
            const int fi = (u & 1) * 8 + j;
            const float c = t16[pos * 16 + fi], s = t16[1024 + pos * 16 + fi];
            kr[j] = (u & 2) ? (kv[j] * c + other * s) : (kv[j] * c - other * s);
        }
        if (lane < 16) {
            if (!k.lat) {
                float* o = p.out() + O_CK + ((size_t)(k.b * 2 + l) * 256 + k.t) * 128 + lane * 8;
                *(f32x4*)o = (f32x4){kv[0], kv[1], kv[2], kv[3]}; *(f32x4*)(o + 4) = (f32x4){kv[4], kv[5], kv[6], kv[7]};
            }
            bf16_t* ka = (bf16_t*)(ws + OFF_KA) + (size_t)k.krow * 128 + lane * 8;
            *(u32x4*)ka = k.lat ? pack8(kr) : pack8(kv);
        } else if (lane < 32) {
            const int d0 = (lane - 16) * 8;
            if (!k.lat) {
                float* o = p.out() + O_CV + ((size_t)(k.b * 2 + l) * 256 + k.t) * 128 + d0;
                *(f32x4*)o = (f32x4){v[0], v[1], v[2], v[3]}; *(f32x4*)(o + 4) = (f32x4){v[4], v[5], v[6], v[7]};
            }
            bf16_t* vt = (bf16_t*)(ws + OFF_VAT) + (size_t)seqkey0 * 128 + (size_t)d0 * Lk + keyidx;
#pragma unroll
            for (int j = 0; j < 8; ++j) vt[(size_t)j * Lk] = f2bf(v[j]);
        }
    }
    {
        float v[8];
        if (lane < 48) unpack8(*(const u32x4*)(pr + C_MCQ + lane * 8), v);
        else {
#pragma unroll
            for (int j = 0; j < 8; ++j) v[j] = 0.f;
        }
        float ss = 0.f;
#pragma unroll
        for (int j = 0; j < 8; ++j) ss += v[j] * v[j];
        ss = wsum(ss);
        const float rstd = rsqrtf(ss * (1.f / 384.f) + EPS);
        if (lane < 48) {
            const float* w = p.in(27) + l * 384 + lane * 8;
#pragma unroll
            for (int j = 0; j < 8; ++j) v[j] = (v[j] * rstd) * w[j];
            *(u32x4*)(pr + C_MCQ + lane * 8) = pack8(v);
        }
    }
    {
        float v[8];
        if (lane < 36) unpack8(*(const u32x4*)(pr + C_MCKV + lane * 8), v);
        else {
#pragma unroll
            for (int j = 0; j < 8; ++j) v[j] = 0.f;
        }
        float ss = 0.f;
        if (lane < 32) {
#pragma unroll
            for (int j = 0; j < 8; ++j) ss += v[j] * v[j];
        }
        ss = wsum(ss);
        const float rstd = rsqrtf(ss * (1.f / 256.f) + EPS);
        const int u = (lane - 32) & 3, axis = u >> 1, pos = axis ? (k.t & 63) : (k.t >> 6);
        float kr[8];
#pragma unroll
        for (int j = 0; j < 8; ++j) {
            const float other = shx(v[j], 1);
            const float c = t8[pos * 8 + j], s = t8[512 + pos * 8 + j];
            kr[j] = (u & 1) ? (v[j] * c + other * s) : (v[j] * c - other * s);
        }
        if (lane < 32) {
            const float* w = p.in(29) + l * 256 + lane * 8;
            float c[8];
#pragma unroll
            for (int j = 0; j < 8; ++j) c[j] = (v[j] * rstd) * w[j];
            if (!k.lat) {
                float* o = p.out() + O_CC + ((size_t)(k.b * 2 + l) * 256 + k.t) * 256 + lane * 8;
                *(f32x4*)o = (f32x4){c[0], c[1], c[2], c[3]}; *(f32x4*)(o + 4) = (f32x4){c[4], c[5], c[6], c[7]};
            }
            *(u32x4*)((bf16_t*)(ws + OFF_CKV) + (size_t)k.krow * 256 + lane * 8) = pack8(c);
        } else if (lane < 36) {
            const int d0 = (lane - 32) * 8;
            if (!k.lat) {
                float* o = p.out() + O_CR + ((size_t)(k.b * 2 + l) * 256 + k.t) * 32 + d0;
                *(f32x4*)o = (f32x4){v[0], v[1], v[2], v[3]}; *(f32x4*)(o + 4) = (f32x4){v[4], v[5], v[6], v[7]};
            }
            *(u32x4*)((bf16_t*)(ws + OFF_KRP) + (size_t)k.krow * 32 + d0) = k.lat ? pack8(kr) : pack8(v);
        }
    }
}
DI void prep_conv_item(const Ctx& p, int l, int ps, int item, int lane) {
    const int run = item >> 1, cbk = item & 1;
    const int c0 = cbk * 512 + lane * 8;
    if (c0 >= 768) return;
    const int m0 = run * 16;
    const Tok k = tok_info(m0, ps);
    const float* cw = p.in(17) + (size_t)l * 3 * 768; const float* cb = p.in(18) + (size_t)l * 768;
    float w[4][8];
#pragma unroll
    for (int tp = 0; tp < 4; ++tp) {
        const float* src = (tp < 3) ? cw + tp * 768 + c0 : cb + c0;
        const f32x4 a0 = *(const f32x4*)src, a1 = *(const f32x4*)(src + 4);
#pragma unroll
        for (int e = 0; e < 4; ++e) { w[tp][e] = a0[e]; w[tp][4 + e] = a1[e]; }
    }
    const bf16_t* xb = (const bf16_t*)(p.ws() + OFF_PROJ) + (size_t)m0 * INWP + C_XBC + c0;
    bf16_t* xo = (bf16_t*)(p.ws() + OFF_XBCA) + (size_t)m0 * 768 + c0;
    const u32x4 zero = {0u, 0u, 0u, 0u};
    u32x4 pv = zero, cv;
    if (k.t > 0) pv = gld16(xb - INWP);
    cv = gld16(xb);
#pragma unroll 4
    for (int i = 0; i < 16; ++i) {
        u32x4 nv = zero;
        if (k.t + i + 1 < k.L) nv = gld16(xb + (size_t)(i + 1) * INWP);
        float a[8], b[8], c[8], o[8];
        unpack8(pv, a); unpack8(cv, b); unpack8(nv, c);
#pragma unroll
        for (int e = 0; e < 8; ++e) o[e] = siluf(w[3][e] + w[0][e] * a[e] + w[1][e] * b[e] + w[2][e] * c[e]);
        *(u32x4*)(xo + (size_t)i * 768) = pack8(o);
        pv = cv; cv = nv;
    }
}
DI void prep_cache_row(const Ctx& p, int l, int ps, int r, int lane) {
    char* ws = p.ws();
    const int j = r >> 8, c = r & 255, b = ps * 2 + j;
    const int key0 = 4096 + j * 2304, krow = key0 + c, Lk = 2304;
    const size_t src = (size_t)(b * 2 + l) * 256 + c;
    if (lane < 16) {
        const float* s = p.in(4) + src * 128 + lane * 8; float v[8];
#pragma unroll
        for (int i = 0; i < 8; ++i) v[i] = s[i];
        *(u32x4*)((bf16_t*)(ws + OFF_KA) + (size_t)krow * 128 + lane * 8) = pack8(v);
    } else if (lane < 32) {
        const int d0 = (lane - 16) * 8;
        const float* s = p.in(5) + src * 128 + d0;
        bf16_t* vt = (bf16_t*)(ws + OFF_VAT) + (size_t)key0 * 128 + (size_t)d0 * Lk + c;
#pragma unroll
        for (int i = 0; i < 8; ++i) vt[(size_t)i * Lk] = f2bf(s[i]);
    } else if (lane < 36) {
        const int d0 = (lane - 32) * 8;
        const float* s = p.in(7) + src * 32 + d0; float v[8];
#pragma unroll
        for (int i = 0; i < 8; ++i) v[i] = s[i];
        *(u32x4*)((bf16_t*)(ws + OFF_KRP) + (size_t)krow * 32 + d0) = pack8(v);
    }
    if (lane < 32) {
        const float* s = p.in(6) + src * 256 + lane * 8; float v[8];
#pragma unroll
        for (int i = 0; i < 8; ++i) v[i] = s[i];
        *(u32x4*)((bf16_t*)(ws + OFF_CKV) + (size_t)krow * 256 + lane * 8) = pack8(v);
    }
}
DI void phase_prep(const Ctx& p, int l, int ps, int tid) {
    const int lane = tid & 63, wv = tid >> 6;
    for (int m = BIDX * 4 + wv; m < NPT + 512 + 1024; m += gridDim.x * 4) {
        if (m < NPT) prep_token(p, l, ps, m, lane); else if (m < NPT + 512) prep_cache_row(p, l, ps, m - NPT, lane); else prep_conv_item(p, l, ps, m - NPT - 512, lane);
    }
}

template <int KC, int NQT>
DI void attn_tile(const bf16_t* __restrict__ Q, size_t ldq, const bf16_t* __restrict__ K1, size_t ldk1, const bf16_t* __restrict__ K2, size_t ldk2,
                  const bf16_t* __restrict__ VT, size_t ldvt, int nkt, float c2, bf16_t* __restrict__ O, size_t ldo,
                  const float* __restrict__ qnw  , const float* __restrict__ rope, int t0  , char* smem, int tid) {
    constexpr int KB = KC * 4096, STG = KB + 8192;
    tid = launder(tid);
    const int lane = tid & 63, w = tid >> 6, fr = lane & 15, g = lane >> 4;
    bf16x8 qf[NQT][KC];
#pragma unroll
    for (int qt = 0; qt < NQT; ++qt)
#pragma unroll
        for (int ks = 0; ks < KC; ++ks) { const u32x4 t4 = gld16(Q + (size_t)(16 * NQT * w + 16 * qt + fr) * ldq + ks * 32 + 8 * g); qf[qt][ks] = __builtin_bit_cast(bf16x8, t4); }
    if (KC == 2 && qnw) {
#pragma unroll
        for (int qt = 0; qt < NQT; ++qt) {
            float v[2][8]; float ss = 0.f;
#pragma unroll
            for (int ks = 0; ks < 2; ++ks) {
                const u32x4 t4 = __builtin_bit_cast(u32x4, qf[qt][ks]); unpack8(t4, v[ks]);
#pragma unroll
                for (int j = 0; j < 8; ++j) ss += v[ks][j] * v[ks][j];
            }
            ss += shx(ss, 16); ss += shx(ss, 32);
            const float rstd = rsqrtf(ss * (1.f / 64.f) + EPS);
            const int t = t0 + 16 * NQT * w + 16 * qt + fr;
#pragma unroll
            for (int ks = 0; ks < 2; ++ks) {
                const int pos = ks ? (t & 63) : (t >> 6);
#pragma unroll
                for (int j = 0; j < 8; ++j) {
                    float x = (v[ks][j] * rstd) * qnw[32 * ks + 8 * g + j];
                    if (rope) {
                        const float other = shx(x, 32);
                        const int fi = (g & 1) * 8 + j;
                        const float c = rope[pos * 16 + fi], sn = rope[1024 + pos * 16 + fi];
                        x = (g & 2) ? (x * c + other * sn) : (x * c - other * sn);
                    }
                    v[ks][j] = x;
                }
                const u32x4 t4 = pack8(v[ks]); qf[qt][ks] = __builtin_bit_cast(bf16x8, t4);
            }
        }
    }
    constexpr int NPK = KC * 4, PPW = (NPK + 8) / 4;
    static_assert((NPK + 8) % 4 == 0, "pieces must divide over 4 waves");
    const int wvu = __builtin_amdgcn_readfirstlane(w);
    unsigned poff[PPW];
#pragma unroll
    for (int j = 0; j < PPW; ++j) {
        const int pc = wvu * PPW + j;
        const bool isk = pc < NPK;
        const int pp = isk ? pc : pc - NPK;
        const int ks = pp >> 2, rb = pp & 3;
        const int rl = lane >> 2, row = rb * 16 + rl;
        const int q = isk ? ((row >> 3) & 3) : ((rl >> 2) & 3);
        const int gl = (lane & 3) ^ FQ(q);
        const unsigned ld = isk ? ((KC == 2 || ks < 2) ? (unsigned)ldk1 : (unsigned)ldk2) : (unsigned)ldvt;
        poff[j] = (unsigned)rl * ld + (unsigned)(gl * 8);
    }
    auto issue = [&](int kt, char* stage) {
#pragma unroll
        for (int j = 0; j < PPW; ++j) {
            const int pc = wvu * PPW + j;
            const bool isk = pc < NPK;
            const int pp = isk ? pc : pc - NPK;
            const int ks = pp >> 2, rb = pp & 3;
            const bf16_t* base;
            if (isk) { if (KC == 2 || ks < 2) base = K1 + ks * 32 + (size_t)(kt * 64 + rb * 16) * ldk1; else base = K2 + (size_t)(kt * 64 + rb * 16) * ldk2; }
            else base = VT + ks * 32 + (size_t)kt * 64 + (size_t)(rb * 16) * ldvt;
            __builtin_amdgcn_global_load_lds((const unsigned*)(base + poff[j]), (unsigned*)(stage + (isk ? 0 : KB) + (ks * 64 + rb * 16) * 64), 16, 0, 0);
        }
    };
    const int koff = tile_off(64, 0, 8 * (fr >> 2) + (fr & 3), g, fr >> 2);
    const int voff = KB + tile_off(64, 0, fr, g, (fr >> 2) & 3);
    f32x4 o[4][NQT];
#pragma unroll
    for (int a = 0; a < 4; ++a)
#pragma unroll
        for (int qt = 0; qt < NQT; ++qt) o[a][qt] = (f32x4){0.f, 0.f, 0.f, 0.f};
    float mrun[NQT], lrun[NQT];
#pragma unroll
    for (int qt = 0; qt < NQT; ++qt) { mrun[qt] = -1e30f; lrun[qt] = 0.f; }
    __syncthreads();
    issue(0, smem);
    if (nkt > 1) {
        issue(1, smem + STG);
        if (PPW == 4) asm volatile("s_waitcnt vmcnt(4)" ::: "memory"); else asm volatile("s_waitcnt vmcnt(5)" ::: "memory");
    } else asm volatile("s_waitcnt vmcnt(0)" ::: "memory");
    __syncthreads();
    int so_cur = 0, so_nn = 2 * STG;
    for (int kt = 0; kt < nkt; ++kt) {
        if (kt + 2 < nkt) issue(kt + 2, smem + so_nn);
        __builtin_amdgcn_sched_barrier(0);
        const char* sb = smem + so_cur;
        f32x4 s[4][NQT];
#pragma unroll
        for (int a = 0; a < 4; ++a)
#pragma unroll
            for (int qt = 0; qt < NQT; ++qt) s[a][qt] = (f32x4){0.f, 0.f, 0.f, 0.f};
        bf16x8 kf[KC][4];
#pragma unroll
        for (int ks = 0; ks < KC; ++ks)
#pragma unroll
            for (int a = 0; a < 4; ++a) kf[ks][a] = *(const bf16x8*)(sb + koff + ((a >> 1) * 32 + (a & 1) * 4) * 64 + ks * 4096);
        __builtin_amdgcn_sched_barrier(0);
#pragma unroll
        for (int ks = 0; ks < KC; ++ks)
#pragma unroll
            for (int a = 0; a < 4; ++a) {
#pragma unroll
                for (int qt = 0; qt < NQT; ++qt) s[a][qt] = __builtin_amdgcn_mfma_f32_16x16x32_bf16(kf[ks][a], qf[qt][ks], s[a][qt], 0, 0, 0);
            }
        bf16x8 vfr[2][4];
#pragma unroll
        for (int s2 = 0; s2 < 2; ++s2)
#pragma unroll
            for (int dt = 0; dt < 4; ++dt) vfr[s2][dt] = *(const bf16x8*)(sb + voff + dt * 1024 + s2 * 4096);
        __builtin_amdgcn_sched_barrier(0);
        bf16x8 pf[NQT][2];
#pragma unroll
        for (int qt = 0; qt < NQT; ++qt) {
            float mx = s[0][qt][0];
#pragma unroll
            for (int a = 0; a < 4; ++a)
#pragma unroll
                for (int r = 0; r < 4; ++r) mx = fmaxf(mx, s[a][qt][r]);
            mx = gmax4(mx);
            const float mnew = fmaxf(mrun[qt], mx);
            const float alpha = __builtin_amdgcn_exp2f((mrun[qt] - mnew) * c2);
            mrun[qt] = mnew;
            const float mc = mnew * c2;
            float ls = 0.f; float pv[16];
#pragma unroll
            for (int a = 0; a < 4; ++a)
#pragma unroll
                for (int r = 0; r < 4; ++r) { const float e = __builtin_amdgcn_exp2f(s[a][qt][r] * c2 - mc); pv[4 * a + r] = e; ls += e; }
            lrun[qt] = lrun[qt] * alpha + ls;
#pragma unroll
            for (int a = 0; a < 4; ++a) o[a][qt] = o[a][qt] * alpha;
            u32x4 w0 = pack8(pv), w1 = pack8(pv + 8);
            pf[qt][0] = __builtin_bit_cast(bf16x8, w0); pf[qt][1] = __builtin_bit_cast(bf16x8, w1);
        }
        __builtin_amdgcn_sched_barrier(0);
#pragma unroll
        for (int s2 = 0; s2 < 2; ++s2)
#pragma unroll
            for (int dt = 0; dt < 4; ++dt) {
#pragma unroll
                for (int qt = 0; qt < NQT; ++qt) o[dt][qt] = __builtin_amdgcn_mfma_f32_16x16x32_bf16(vfr[s2][dt], pf[qt][s2], o[dt][qt], 0, 0, 0);
            }
        __builtin_amdgcn_sched_barrier(0);
        if (kt + 2 < nkt) { if (PPW == 4) asm volatile("s_waitcnt vmcnt(4)" ::: "memory"); else asm volatile("s_waitcnt vmcnt(5)" ::: "memory"); }
        else asm volatile("s_waitcnt vmcnt(0)" ::: "memory");
        asm volatile("s_waitcnt lgkmcnt(0)" ::: "memory");
        __builtin_amdgcn_s_barrier();
        so_cur = (so_cur == 2 * STG) ? 0 : so_cur + STG;
        so_nn = (so_nn == 2 * STG) ? 0 : so_nn + STG;
    }
#pragma unroll
    for (int qt = 0; qt < NQT; ++qt) {
        float l = gsum4(lrun[qt]);
        const float inv = 1.f / l;
        bf16_t* orow = O + (size_t)(16 * NQT * w + 16 * qt + fr) * ldo + 4 * g;
#pragma unroll
        for (int dt = 0; dt < 4; ++dt) {
            u32x2 wv2; wv2[0] = pk2(o[dt][qt][0] * inv, o[dt][qt][1] * inv); wv2[1] = pk2(o[dt][qt][2] * inv, o[dt][qt][3] * inv);
            *(u32x2*)(orow + 16 * dt) = wv2;
        }
    }
}

struct Seq { int lat, tok0, L, key0, Lk, b; };
DI Seq seq_info(int s, int ps) {
    Seq q;
    if (s < 16) { q.lat = 0; q.tok0 = s * 256; q.L = 256; q.key0 = s * 256; q.Lk = 256; q.b = ps * 16 + s; }
    else { const int j = s - 16; q.lat = 1; q.tok0 = 4096 + j * 2048; q.L = 2048; q.key0 = 4096 + j * 2304; q.Lk = 2304; q.b = ps * 2 + j; }
    return q;
}
DI void attn_gqa_item(const Ctx& p, int l, int s, int head, int qb, int ps, char* smem, int tid) {
    const Seq q = seq_info(s, ps);
    const int rows = 128;
    const bf16_t* PROJ = (const bf16_t*)(p.ws() + OFF_PROJ);
    const bf16_t* Q = PROJ + (size_t)(q.tok0 + qb * rows) * INWP + C_AQ + head * 64;
    const int kh = head >> 2;
    const bf16_t* K = (const bf16_t*)(p.ws() + OFF_KA) + (size_t)q.key0 * 128 + kh * 64;
    const bf16_t* VT = (const bf16_t*)(p.ws() + OFF_VAT) + (size_t)q.key0 * 128 + (size_t)kh * 64 * q.Lk;
    bf16_t* O = (bf16_t*)(p.ws() + OFF_OA) + (size_t)(q.tok0 + qb * rows) * 512 + head * 64;
    const float c2 = 0.125f * 1.4426950408889634f;
    attn_tile<2, 2>(Q, INWP, K, 128, K, 128, VT, q.Lk, q.Lk / 64, c2, O, 512, p.in(25) + l * 64, q.lat ? (const float*)(p.ws() + OFF_T16) : nullptr, qb * 128, smem, tid);
}
DI void attn_mla_item(const Ctx& p, int s, int head, int qb, int ps, char* smem, int tid) {
    const Seq q = seq_info(s, ps);
    const int rows = 128;
    const bf16_t* Q = (const bf16_t*)(p.ws() + OFF_QM) + (size_t)(q.tok0 + qb * rows) * 768 + head * 96;
    const bf16_t* K1 = (const bf16_t*)(p.ws() + OFF_KN) + (size_t)q.key0 * 512 + head * 64;
    const bf16_t* K2 = (const bf16_t*)(p.ws() + OFF_KRP) + (size_t)q.key0 * 32;
    const bf16_t* VT = (const bf16_t*)(p.ws() + OFF_VMT) + (size_t)q.key0 * 512 + (size_t)head * 64 * q.Lk;
    bf16_t* O = (bf16_t*)(p.ws() + OFF_OM) + (size_t)(q.tok0 + qb * rows) * 512 + head * 64;
    const float c2 = 0.10206207261596577f * 1.4426950408889634f;
    attn_tile<3, 2>(Q, 768, K1, 512, K2, 32, VT, q.Lk, q.Lk / 64, c2, O, 512, nullptr, nullptr, 0, smem, tid);
}

template <int ET>
DI void scan_item(const bf16_t* __restrict__ Qp, size_t ldq, const bf16_t* __restrict__ Kp, size_t ldk, const bf16_t* __restrict__ Vp, size_t ldv,
                  const float* __restrict__ dtp  , float acoef  ,
                  int L, int dir, const float* __restrict__ s0, float* __restrict__ sout, int lds_state  , bf16_t* __restrict__ Op, size_t ldo,
                  const float* __restrict__ rope  , float kmul,
                  int nbase  , int nch  , const bf16_t* __restrict__ s0b  ,
                  bf16_t* __restrict__ lout  , float* __restrict__ dout  , char* smem, int tid) {
    constexpr int DV = 16 * ET;
    const bool stateonly = (lout != nullptr);
    constexpr int QS = 0, KS = 8192, KT = 16384, VTO = 24576, STO = VTO + DV * 128, ACO = STO + DV * 128;
    constexpr int NV = DV / 32;
    tid = launder(tid);
    const int lane = tid & 63, w = tid >> 6, fr = lane & 15, g = lane >> 4;
    float* acs = (float*)(smem + ACO);
    f32x4 sacc[ET];
#pragma unroll
    for (int et = 0; et < ET; ++et) {
        if (s0) {
#pragma unroll
            for (int r = 0; r < 4; ++r) sacc[et][r] = s0[(size_t)(16 * w + 4 * g + r) * lds_state + 16 * et + fr];
        } else if (s0b) {
#pragma unroll
            for (int r = 0; r < 4; ++r) sacc[et][r] = bf2f(s0b[(16 * w + 4 * g + r) * DV + 16 * et + fr]);
        } else sacc[et] = (f32x4){0.f, 0.f, 0.f, 0.f};
    }
    const int st_off = STO + ((w >> 1) * DV) * 64 + (g & 1) * 8;
    const int st_gg = (2 * w + (g >> 1)) & 3;
    __syncthreads();
    float* ropeL = (float*)(smem + ACO + 256);
    if (rope) {
#pragma unroll
        for (int i = 0; i < 2; ++i) *(f32x4*)(ropeL + (tid + 256 * i) * 4) = *(const f32x4*)(rope + (tid + 256 * i) * 4);
    }
#pragma unroll
    for (int et = 0; et < ET; ++et) {
        const int e = 16 * et + fr;
        u32x2 wv2; wv2[0] = pk2(sacc[et][0], sacc[et][1]); wv2[1] = pk2(sacc[et][2], sacc[et][3]);
        *(u32x2*)(smem + st_off + e * 64 + ((st_gg ^ FQ((e >> 2) & 3)) << 4)) = wv2;
    }
    __syncthreads();
    float dprod = 1.f;
    const int qoff = QS + tile_off(64, 0, 16 * w + fr, g, (fr >> 2) & 3);
    const int koff = KS + tile_off(64, 0, 8 * (fr >> 2) + (fr & 3), g, fr >> 2);
    const int ktoff = KT + tile_off(64, 0, 16 * w + fr, g, (fr >> 2) & 3);
    const int vtoff = VTO + tile_off(DV, 0, fr, g, (fr >> 2) & 3);
    const int stoff = STO + tile_off(DV, 0, fr, g, (fr >> 2) & 3);
    u32x4 gq[2], gk[2], gv[NV]; float gdt = 1.f;
    auto issue = [&](int c) {
        const int n0 = nbase + c * 64;
        {
            const int row = tid >> 2, cc0 = (tid & 1) | ((tid & 2) << 1);
            const int tl = dir ? (L - 1 - (n0 + row)) : (n0 + row);
#pragma unroll
            for (int i = 0; i < 2; ++i) {
                gq[i] = gld16(Qp + (size_t)tl * ldq + (cc0 + 2 * i) * 8);
                gk[i] = gld16(Kp + (size_t)tl * ldk + (cc0 + 2 * i) * 8);
            }
        }
#pragma unroll
        for (int i = 0; i < NV; ++i) {
            const int q = tid + 256 * i, row = q / (DV / 8), cc = q % (DV / 8);
            const int tl = dir ? (L - 1 - (n0 + row)) : (n0 + row);
            gv[i] = gld16(Vp + (size_t)tl * ldv + cc * 8);
        }
        if (dtp) { const int tl = dir ? (L - 1 - (n0 + lane)) : (n0 + lane); gdt = dtp[(size_t)tl * 16]; }
    };
    issue(0);
    for (int c = 0; c < nch; ++c) {
        const int n0 = nbase + c * 64;
        const float dtv = gdt;
        const float la = dtp ? dtv * acoef : acoef;
        float ac, aend;
        if (dtp) {
            ac = la;
#pragma unroll
            for (int o = 1; o < 64; o <<= 1) { const float t = shu(ac, o); if (lane >= o) ac += t; }
            aend = shf(ac, 63);
        } else { ac = (float)(lane + 1) * la; aend = 64.f * la; }
        if (w == 0) acs[lane] = ac;
        {
            const int row = tid >> 2, cc0 = (tid & 1) | ((tid & 2) << 1);
            const float ksc = shf(dtv, row) * kmul, wend = __expf(aend - shf(ac, row));
            float qa[2][8], ka[2][8];
#pragma unroll
            for (int i = 0; i < 2; ++i) { unpack8(gq[i], qa[i]); unpack8(gk[i], ka[i]); }
            if (rope) {
                const int tlr = dir ? (L - 1 - (n0 + row)) : (n0 + row);
                const int pos = (cc0 >> 2) ? (tlr & 63) : (tlr >> 6);
                const float* rp = ropeL + pos * 16 + (cc0 & 1) * 8;
                f32x4 rc[2], rs[2];
                rc[0] = *(const f32x4*)rp; rc[1] = *(const f32x4*)(rp + 4); rs[0] = *(const f32x4*)(rp + 1024); rs[1] = *(const f32x4*)(rp + 1028);
#pragma unroll
                for (int j = 0; j < 8; ++j) {
                    const float c = rc[j >> 2][j & 3], sn = rs[j >> 2][j & 3];
                    const float q1 = qa[0][j], q2 = qa[1][j], k1 = ka[0][j], k2 = ka[1][j];
                    qa[0][j] = q1 * c - q2 * sn; qa[1][j] = q2 * c + q1 * sn;
                    ka[0][j] = k1 * c - k2 * sn; ka[1][j] = k2 * c + k1 * sn;
                }
            }
#pragma unroll
            for (int i = 0; i < 2; ++i) {
                const int cc = cc0 + 2 * i;
                if (rope) *(u32x4*)(smem + QS + tile_off(64, cc >> 2, row, cc & 3, (row >> 2) & 3)) = pack8(qa[i]);
                else *(u32x4*)(smem + QS + tile_off(64, cc >> 2, row, cc & 3, (row >> 2) & 3)) = gq[i];
#pragma unroll
                for (int j = 0; j < 8; ++j) ka[i][j] *= ksc;
                *(u32x4*)(smem + KS + tile_off(64, cc >> 2, row, cc & 3, (row >> 3) & 3)) = pack8(ka[i]);
#pragma unroll
                for (int j = 0; j < 8; ++j) {
                    const int d = cc * 8 + j;
                    *(bf16_t*)(smem + KT + tile_off(64, row >> 5, d, (row >> 3) & 3, (d >> 2) & 3) + (row & 7) * 2) = f2bf(ka[i][j] * wend);
                }
            }
        }
#pragma unroll
        for (int i = 0; i < NV; ++i) {
            const int q = tid + 256 * i, row = q / (DV / 8), cc = q % (DV / 8);
            const u32x4 vv = gv[i];
#pragma unroll
            for (int j = 0; j < 8; ++j) {
                const int e = cc * 8 + j;
                const unsigned short h = (unsigned short)(vv[j >> 1] >> (16 * (j & 1)));
                *(bf16_t*)(smem + VTO + tile_off(DV, row >> 5, e, (row >> 3) & 3, (e >> 2) & 3) + (row & 7) * 2) = h;
            }
        }
        if (c + 1 < nch) issue(c + 1);
        __builtin_amdgcn_sched_barrier(0);
        __syncthreads();
        {
            const int irow = 16 * w + fr;
            const int ns = (w >> 1) + 1;
            bf16x8 qfr[2], sf[ET][2], kfa[2][2][2], vf[2][ET], kt2[2];
            qfr[0] = *(const bf16x8*)(smem + qoff); qfr[1] = *(const bf16x8*)(smem + qoff + 4096);
#pragma unroll
            for (int et = 0; et < ET; ++et)
#pragma unroll
                for (int ks = 0; ks < 2; ++ks) sf[et][ks] = *(const bf16x8*)(smem + stoff + et * 1024 + ks * DV * 64);
#pragma unroll
            for (int aa = 0; aa < 2; ++aa)
#pragma unroll
                for (int ks = 0; ks < 2; ++ks) kfa[0][aa][ks] = *(const bf16x8*)(smem + koff + (4 * aa) * 64 + ks * 4096);
            const float ai = acs[irow];
            f32x4 ajv[2][2];
#pragma unroll
            for (int aa = 0; aa < 2; ++aa) ajv[0][aa] = *(const f32x4*)(acs + 8 * g + 4 * aa);
            const float cd = __expf(acs[63]);
            __builtin_amdgcn_sched_barrier(0);
            f32x4 o[ET];
            if (!stateonly) {
#pragma unroll
                for (int et = 0; et < ET; ++et) {
                    o[et] = (f32x4){0.f, 0.f, 0.f, 0.f};
#pragma unroll
                    for (int ks = 0; ks < 2; ++ks) o[et] = __builtin_amdgcn_mfma_f32_16x16x32_bf16(sf[et][ks], qfr[ks], o[et], 0, 0, 0);
                }
            }
#pragma unroll
            for (int aa = 0; aa < 2; ++aa)
#pragma unroll
                for (int ks = 0; ks < 2; ++ks) kfa[1][aa][ks] = *(const bf16x8*)(smem + koff + (32 + 4 * aa) * 64 + ks * 4096);
#pragma unroll
            for (int ks = 0; ks < 2; ++ks) {
#pragma unroll
                for (int et = 0; et < ET; ++et) vf[ks][et] = *(const bf16x8*)(smem + vtoff + et * 1024 + ks * DV * 64);
                kt2[ks] = *(const bf16x8*)(smem + ktoff + ks * 4096);
            }
#pragma unroll
            for (int aa = 0; aa < 2; ++aa) ajv[1][aa] = *(const f32x4*)(acs + 32 + 8 * g + 4 * aa);
            __builtin_amdgcn_sched_barrier(0);
            if (!stateonly) {
                const float ei = __expf(ai);
#pragma unroll
                for (int et = 0; et < ET; ++et) o[et] = o[et] * ei;
#pragma unroll
                for (int s2 = 0; s2 < 2; ++s2) {
                    if (s2 < ns) {
                        f32x4 pp[2];
#pragma unroll
                        for (int aa = 0; aa < 2; ++aa) {
                            pp[aa] = (f32x4){0.f, 0.f, 0.f, 0.f};
#pragma unroll
                            for (int ks = 0; ks < 2; ++ks) pp[aa] = __builtin_amdgcn_mfma_f32_16x16x32_bf16(kfa[s2][aa][ks], qfr[ks], pp[aa], 0, 0, 0);
                        }
                        float pv[8];
#pragma unroll
                        for (int aa = 0; aa < 2; ++aa) {
                            const int j0 = 32 * s2 + 8 * g + 4 * aa;
#pragma unroll
                            for (int r = 0; r < 4; ++r) {
                                const float dec = __expf(fminf(ai - ajv[s2][aa][r], 0.f));
                                pv[4 * aa + r] = (j0 + r <= irow) ? pp[aa][r] * dec : 0.f;
                            }
                        }
                        const u32x4 pw = pack8(pv);
                        const bf16x8 pf = __builtin_bit_cast(bf16x8, pw);
#pragma unroll
                        for (int et = 0; et < ET; ++et) o[et] = __builtin_amdgcn_mfma_f32_16x16x32_bf16(vf[s2][et], pf, o[et], 0, 0, 0);
                    }
                }
                const int tl = dir ? (L - 1 - (n0 + irow)) : (n0 + irow);
                bf16_t* orow = Op + (size_t)tl * ldo + 4 * g;
#pragma unroll
                for (int et = 0; et < ET; ++et) {
                    u32x2 wv2; wv2[0] = pk2(o[et][0], o[et][1]); wv2[1] = pk2(o[et][2], o[et][3]);
                    st_wt8(orow + 16 * et, wv2);
                }
            }
            dprod *= cd;
#pragma unroll
            for (int et = 0; et < ET; ++et) sacc[et] = sacc[et] * cd;
#pragma unroll
            for (int ks = 0; ks < 2; ++ks)
#pragma unroll
                for (int et = 0; et < ET; ++et) sacc[et] = __builtin_amdgcn_mfma_f32_16x16x32_bf16(kt2[ks], vf[ks][et], sacc[et], 0, 0, 0);
        }
        __syncthreads();
#pragma unroll
        for (int et = 0; et < ET; ++et) {
            const int e = 16 * et + fr;
            u32x2 wv2; wv2[0] = pk2(sacc[et][0], sacc[et][1]); wv2[1] = pk2(sacc[et][2], sacc[et][3]);
            *(u32x2*)(smem + st_off + e * 64 + ((st_gg ^ FQ((e >> 2) & 3)) << 4)) = wv2;
        }
    }
    if (sout) {
#pragma unroll
        for (int et = 0; et < ET; ++et)
#pragma unroll
            for (int r = 0; r < 4; ++r) sout[(size_t)(16 * w + 4 * g + r) * lds_state + 16 * et + fr] = sacc[et][r];
    }
    if (lout) {
#pragma unroll
        for (int et = 0; et < ET; ++et)
#pragma unroll
            for (int r = 0; r < 4; ++r) st_wt2(lout + (16 * w + 4 * g + r) * DV + 16 * et + fr, f2bf(sacc[et][r]));
        if (tid == 0) st_wt4f(dout, dprod);
    }
    __syncthreads();
}

DI void scan_any_item(const Ctx& p, int l, int ps, int isret, int s, int h, int dir, int half, int mode, int seg, int sid, char* smem, int tid) {
    const Seq q = seq_info(s, ps);
    const bf16_t *Qp, *Kp, *Vp; size_t ld; const float* dtp; float acoef, kmul; const float* rope; bf16_t* O; float* so; int lds;
    if (isret) {
        const bf16_t* PR = (const bf16_t*)(p.ws() + OFF_PROJ) + (size_t)q.tok0 * INWP;
        const float x = p.in(23)[l * 8 + dir * 4 + h];
        acoef = fminf(x, 0.f) - log1pe(__expf(-fabsf(x)));
        Qp = PR + C_RQ + h * 64; Kp = PR + C_RK + h * 64; Vp = PR + C_RV + h * 128 + half * 64; ld = INWP; dtp = nullptr; kmul = 0.125f;
        rope = q.lat ? (const float*)(p.ws() + OFF_T16) : nullptr;
        O = (bf16_t*)(p.ws() + OFF_OR) + ((size_t)dir * NPT + q.tok0) * 512 + h * 128 + half * 64;
        so = p.out() + O_RET + ((size_t)((q.b * 2 + l) * 2 + dir) * 4 + h) * 8192 + half * 64; lds = 128;
    } else {
        const bf16_t* XB = (const bf16_t*)(p.ws() + OFF_XBCA) + (size_t)q.tok0 * 768;
        const int grp = h >> 2;
        Qp = XB + 640 + grp * 64; Kp = XB + 512 + grp * 64; Vp = XB + h * 64; ld = 768; kmul = 1.f; rope = nullptr;
        dtp = (const float*)(p.ws() + OFF_DT) + (size_t)q.tok0 * 16 + dir * 8 + h;
        acoef = -__expf(p.in(20)[l * 16 + dir * 8 + h]);
        O = (bf16_t*)(p.ws() + OFF_OS) + ((size_t)dir * NPT + q.tok0) * 512 + h * 64;
        so = p.out() + O_SSD + ((size_t)((q.b * 2 + l) * 2 + dir) * 8 + h) * 4096; lds = 64;
    }
    bf16_t* segb = (bf16_t*)(p.ws() + OFF_SEG) + (size_t)(sid * NSEG + seg) * 4096;
    float* segd = (float*)(p.ws() + OFF_SEGD) + sid * NSEG + seg;
    scan_item<4>(Qp, ld, Kp, ld, Vp, ld, dtp, acoef, q.L, dir, nullptr, mode == 0 ? so : nullptr, lds, O, 512, rope, kmul,
                 mode == 0 ? 0 : seg * SEGTOK, mode == 0 ? (q.L >> 6) : (SEGTOK >> 6), mode == 3 ? segb : nullptr, mode == 1 ? segb : nullptr, mode == 1 ? segd : nullptr, smem, tid);
}
DI void scan_combine_item(const Ctx& p, int l, int ps, int sid, int tid) {
    const float* s0; int ld;
    if (sid < 32) { const int b = ps * 2 + (sid >> 4), h = (sid >> 1) & 7, dir = sid & 1; s0 = p.in(2) + ((size_t)((b * 2 + l) * 2 + dir) * 8 + h) * 4096; ld = 64; }
    else { const int k = sid - 32, b = ps * 2 + (k >> 4), h = (k >> 2) & 3, dir = (k >> 1) & 1, half = k & 1;
           s0 = p.in(3) + ((size_t)((b * 2 + l) * 2 + dir) * 4 + h) * 8192 + half * 64; ld = 128; }
    bf16_t* segb = (bf16_t*)(p.ws() + OFF_SEG) + (size_t)sid * NSEG * 4096;
    const float* segd = (const float*)(p.ws() + OFF_SEGD) + sid * NSEG;
    const int t2 = launder(tid);
    const float* sp = s0 + (size_t)(t2 >> 2) * ld + (t2 & 3) * 16;
    bf16_t* bp = segb + t2 * 16;
    float S[16];
#pragma unroll
    for (int k = 0; k < 4; ++k) { const f32x4 v = *(const f32x4*)(sp + 4 * k); S[4 * k] = v[0]; S[4 * k + 1] = v[1]; S[4 * k + 2] = v[2]; S[4 * k + 3] = v[3]; }
#pragma unroll 1
    for (int g2 = 0; g2 < NSEG; ++g2) {
        float loc[16]; float d = 0.f;
        if (g2 < NSEG - 1) { d = segd[g2]; unpack8(*(const u32x4*)(bp + g2 * 4096), loc); unpack8(*(const u32x4*)(bp + g2 * 4096 + 8), loc + 8); }
        else {
#pragma unroll
            for (int k = 0; k < 16; ++k) loc[k] = 0.f;
        }
        st_wt16(bp + g2 * 4096, pack8(S)); st_wt16(bp + g2 * 4096 + 8, pack8(S + 8));
#pragma unroll
        for (int k = 0; k < 16; ++k) S[k] = S[k] * d + loc[k];
    }
}

DI void postscan_token(const Ctx& p, int l, int m, int lane) {
    char* ws = p.ws();
    bf16_t* pr = (bf16_t*)(ws + OFF_PROJ) + (size_t)m * INWP;
    const int c0 = lane * 8;
    {
        const bf16_t* OS = (const bf16_t*)(ws + OFF_OS);
        float a[8], b[8], xs[8], z[8];
        unpack8(*(const u32x4*)(OS + (size_t)m * 512 + c0), a);
        unpack8(*(const u32x4*)(OS + ((size_t)NPT + m) * 512 + c0), b);
        unpack8(*(const u32x4*)((const bf16_t*)(ws + OFF_XBCA) + (size_t)m * 768 + c0), xs);
        unpack8(*(const u32x4*)(pr + C_Z + c0), z);
        const float dsk = p.in(21)[l * 8 + (c0 >> 6)];
        float v[8], ss = 0.f;
#pragma unroll
        for (int j = 0; j < 8; ++j) { v[j] = ((a[j] + b[j]) + dsk * xs[j]) * siluf(z[j]); ss += v[j] * v[j]; }
        ss = wsum(ss);
        const float rstd = rsqrtf(ss * (1.f / 512.f) + EPS);
        const float* w = p.in(22) + l * 512 + c0;
#pragma unroll
        for (int j = 0; j < 8; ++j) v[j] = (v[j] * rstd) * w[j];
        *(u32x4*)(pr + C_Z + c0) = pack8(v);
    }
    {
        const bf16_t* ORb = (const bf16_t*)(ws + OFF_OR);
        float a[8], b[8], gt[8];
        unpack8(*(const u32x4*)(ORb + (size_t)m * 512 + c0), a);
        unpack8(*(const u32x4*)(ORb + ((size_t)NPT + m) * 512 + c0), b);
        unpack8(*(const u32x4*)(pr + C_RG + c0), gt);
        float v[8], sm = 0.f;
#pragma unroll
        for (int j = 0; j < 8; ++j) { v[j] = a[j] + b[j]; sm += v[j]; }
        sm += shx(sm, 1); sm += shx(sm, 2); sm += shx(sm, 4); sm += shx(sm, 8);
        const float mean = sm * (1.f / 128.f);
        float sq = 0.f;
#pragma unroll
        for (int j = 0; j < 8; ++j) { v[j] -= mean; sq += v[j] * v[j]; }
        sq += shx(sq, 1); sq += shx(sq, 2); sq += shx(sq, 4); sq += shx(sq, 8);
        const float rstd = rsqrtf(sq * (1.f / 128.f) + EPS);
        const float* w = p.in(24) + l * 512 + c0;
#pragma unroll
        for (int j = 0; j < 8; ++j) v[j] = (v[j] * rstd) * w[j] * siluf(gt[j]);
        *(u32x4*)(pr + C_RG + c0) = pack8(v);
    }
}

DI void phase_act(const Ctx& p, int l, int ps, int tid) {
    tid = launder(tid);
    const int lane = tid & 63, wv = tid >> 6;
    const bf16_t* U = (const bf16_t*)(p.ws() + OFF_U);
    bf16_t* A = (bf16_t*)(p.ws() + OFF_ACT);
    const float* cw = p.in(39) + (size_t)l * 3 * 5632; const float* cb = p.in(40) + (size_t)l * 5632;
    for (int item = BIDX * 4 + wv; item < 512 * 6; item += gridDim.x * 4) {
        const int run = item / 6, cbk = item % 6;
        const int j0 = cbk * 512 + lane * 8;
        if (j0 >= DFF) continue;
        const int m0 = run * 16;
        const Tok k = tok_info(m0, ps);
        float wu[4][8], wg[4][8];
#pragma unroll
        for (int tp = 0; tp < 3; ++tp) {
            const f32x4 a0 = *(const f32x4*)(cw + tp * 5632 + j0), a1 = *(const f32x4*)(cw + tp * 5632 + j0 + 4);
            const f32x4 g0 = *(const f32x4*)(cw + tp * 5632 + DFF + j0), g1 = *(const f32x4*)(cw + tp * 5632 + DFF + j0 + 4);
#pragma unroll
            for (int e = 0; e < 4; ++e) { wu[tp][e] = a0[e]; wu[tp][4 + e] = a1[e]; wg[tp][e] = g0[e]; wg[tp][4 + e] = g1[e]; }
        }
        {
            const f32x4 a0 = *(const f32x4*)(cb + j0), a1 = *(const f32x4*)(cb + j0 + 4);
            const f32x4 g0 = *(const f32x4*)(cb + DFF + j0), g1 = *(const f32x4*)(cb + DFF + j0 + 4);
#pragma unroll
            for (int e = 0; e < 4; ++e) { wu[3][e] = a0[e]; wu[3][4 + e] = a1[e]; wg[3][e] = g0[e]; wg[3][4 + e] = g1[e]; }
        }
        const bf16_t* ub = U + (size_t)m0 * 5632 + j0;
        const u32x4 zero = {0u, 0u, 0u, 0u};
        u32x4 pu = zero, pg = zero, cu, cg;
        if (k.t > 0) { pu = gld16(ub - 5632); pg = gld16(ub - 5632 + DFF); }
        cu = gld16(ub); cg = gld16(ub + DFF);
#pragma unroll 4
        for (int i = 0; i < 16; ++i) {
            u32x4 nu = zero, ng = zero;
            if (k.t + i + 1 < k.L) { nu = gld16(ub + (size_t)(i + 1) * 5632); ng = gld16(ub + (size_t)(i + 1) * 5632 + DFF); }
            float a[8], b[8], c[8], o[8];
            unpack8(pu, a); unpack8(cu, b); unpack8(nu, c);
            float up[8];
#pragma unroll
            for (int e = 0; e < 8; ++e) up[e] = wu[3][e] + wu[0][e] * a[e] + wu[1][e] * b[e] + wu[2][e] * c[e];
            unpack8(pg, a); unpack8(cg, b); unpack8(ng, c);
#pragma unroll
            for (int e = 0; e < 8; ++e) { const float gt = wg[3][e] + wg[0][e] * a[e] + wg[1][e] * b[e] + wg[2][e] * c[e]; o[e] = siluf(gt) * up[e]; }
            *(u32x4*)(A + (size_t)(m0 + i) * DFF + j0) = pack8(o);
            pu = cu; pg = cg; cu = nu; cg = ng;
        }
    }
}

DI int next_item(unsigned* ctr, volatile LAS unsigned* slot, int tid) {
    __syncthreads();
    if (tid == 0) *slot = __hip_atomic_fetch_add(ctr, 1u, __ATOMIC_RELAXED, __HIP_MEMORY_SCOPE_AGENT);
    __syncthreads();
    return (int)*slot;
}

#ifndef ONLY2
#define ONLY2 -1
#endif
#ifndef PROBE_KIND
#define PROBE_KIND -1
#endif
DI void item_publish(unsigned* cnt, int tid) {
    asm volatile("s_waitcnt vmcnt(0)" ::: "memory");
    __syncthreads();
    if (tid == 0) __hip_atomic_fetch_add(cnt, 1u, __ATOMIC_RELAXED, __HIP_MEMORY_SCOPE_AGENT);
}
DI void item_wait(unsigned* cnt, unsigned need, int tid) {
    if (tid == 0) {
        unsigned sp = 0;
        while (__hip_atomic_load(cnt, __ATOMIC_RELAXED, __HIP_MEMORY_SCOPE_AGENT) < need) { __builtin_amdgcn_s_sleep(2); if (++sp > (1u << 24)) break; }
        __builtin_amdgcn_fence(__ATOMIC_ACQUIRE, "agent");
        asm volatile("s_waitcnt vmcnt(0)" ::: "memory");
    }
    __syncthreads();
}
DI void phase_mix(const Ctx& p, int l, int ps, unsigned* ctr, unsigned* c12, volatile LAS unsigned* slot, char* smem, int tid) {
    unsigned* gdone = ctr + 64; unsigned* sdone = ctr + 128;
    unsigned* c1 = c12; unsigned* c2 = c12 + 64;
    constexpr int N1 = 64 * (NSEG - 1), N3 = 64 * NSEG;
    constexpr int A0 = N1, A1 = A0 + 384, A2 = A1 + 544, A3 = A2 + 256, A4 = A3 + 64, A5 = A4 + N3, A6 = A5 + 256, A7 = A6 + 256, A8 = A7 + 256, A9 = A8 + 256, A10 = A9 + 256, A11 = A10 + 256;
    for (;;) {
        tid = launder(tid);
        l = launder_s(l); ps = launder_s(ps);
        int it = next_item(ctr, slot, tid);
        if (it >= A11) break;
        int sc = -1, isret = 0, sq = 0, hd = 0, dr = 0, hf = 0, md = 0, sg = 0, sid = 0; unsigned* pub = sdone;
        if (it < A0) { sid = it / (NSEG - 1); sg = it % (NSEG - 1); md = 1; sc = 1; pub = c1 + sid; }
        else if (it >= A4 && it < A5) { const int k = it - A4; sid = k / NSEG; sg = k % NSEG; md = 3; sc = 1; }
        else if (it >= A6 && it < A7) { const int k = it - A6; sq = k >> 4; hd = (k >> 1) & 7; dr = k & 1; sc = 0; }
        else if (it >= A7 && it < A8) { const int k = it - A7; isret = 1; sq = k >> 4; hd = (k >> 2) & 3; dr = (k >> 1) & 1; hf = k & 1; sc = 0; }
        if (sc == 1) {
            if (sid < 32) { isret = 0; sq = 16 + (sid >> 4); hd = (sid >> 1) & 7; dr = sid & 1; hf = 0; }
            else { const int k = sid - 32; isret = 1; sq = 16 + (k >> 4); hd = (k >> 2) & 3; dr = (k >> 1) & 1; hf = k & 1; }
        }
        if (sc >= 0) {
            if (md == 3) item_wait(c2 + sid, 1u, tid);
            scan_any_item(p, l, ps, isret, sq, hd, dr, hf, md, sg, sid, smem, tid);
            item_publish(pub, tid);
        }
        else if (it < A1) { gemm_uq_tile(p, l, ps, it - A0, smem, tid); item_publish(gdone, tid); }
        else if (it < A2) { gemm_ukv_tile(p, l, it - A1, smem, tid); item_publish(gdone, tid); }
        else if (it < A3) { const int k = it - A2; attn_gqa_item(p, l, 16 + (k >> 7), (k >> 4) & 7, k & 15, ps, smem, tid); }
        else if (it < A4) { const int sd = it - A3; item_wait(c1 + sd, (unsigned)(NSEG - 1), tid); scan_combine_item(p, l, ps, sd, tid); item_publish(c2 + sd, tid); }
        else if (it < A6) { const int k = it - A5; item_wait(gdone, 928u, tid); attn_mla_item(p, 16 + (k >> 7), (k >> 4) & 7, k & 15, ps, smem, tid); }
        else if (it < A9) { const int k = it - A8; attn_gqa_item(p, l, k >> 4, (k >> 1) & 7, k & 1, ps, smem, tid); }
        else if (it < A10) { const int k = it - A9; item_wait(gdone, 928u, tid); attn_mla_item(p, k >> 4, (k >> 1) & 7, k & 1, ps, smem, tid); }
        else { item_wait(sdone, (unsigned)(N3 + 512), tid); const int k = it - A10; const int t5 = launder(tid); for (int i = 0; i < 8; ++i) postscan_token(p, l, k * 32 + i * 4 + (t5 >> 6), t5 & 63); }
    }
}

constexpr int NPL = 9;
constexpr int NPP = 1 + 2 * NPL;
constexpr int NPHASE = 1 + 2 * NPP;
DI void run_phase(const Ctx& p, int ph, int rep, volatile LAS unsigned* slot, char* smem, int tid) {
#ifndef EXCL
#define EXCL -2
#endif
#ifndef ONLY
#define ONLY -1
#endif
    if (ph == 0) { phase_prep_w(p, smem, tid); return; }
    const int q = ph - 1, ps = q / NPP, r = q % NPP;
    if (r == 0) { phase_h1(p, ps, tid); return; }
    const int l = (r - 1) / NPL, k = (r - 1) % NPL;
    char* ws = p.ws();
    unsigned* ctr = (unsigned*)(p.ws() + OFF_CTR) + ph;
    switch (k) {
    case 0: phase_gemm_in(p, l, smem, tid); break;
    case 1: phase_prep(p, l, ps, tid); break;
    case 2: phase_mix(p, l, ps, ctr, (unsigned*)(p.ws() + OFF_CTR) + 256 + (ps * 2 + l) * 128, slot, smem, tid); break;
    case 3: phase_merge(p, l, smem, tid); break;
    case 4: phase_gemm_plain<true>((const bf16_t*)(ws + OFF_WOUT) + (size_t)l * SZ_WOUT, 1024, (const bf16_t*)(ws + OFF_MERGED), 1024, 64, 8, ws + OFF_MO, 1024, smem, tid); break;
    case 5: phase_res(p, ps, l, 0, tid); break;
    case 6: phase_up_act(p, l, smem, tid); break;
    case 7: phase_down(p, l, smem, tid); break;
    default: phase_res(p, ps, l, 1, tid); if (ps == 0 && l == 1) phase_h1(p, 1, tid); break;
    }
}

constexpr unsigned long long probe_mask(int kind) {
    unsigned long long m = 0;
    for (int ph = 0; ph < NPHASE; ++ph) {
        int k = 11; if (ph > 0) { const int r = (ph - 1) % NPP; k = (r == 0) ? 12 : (r - 1) % NPL; }
        if (k == kind) m |= 1ull << ph;
    }
    return m;
}
__global__ void __launch_bounds__(256, 2) fwd_kernel(Params prm, int ph_lo, int ph_hi, int rep) {
    __shared__ __attribute__((aligned(16))) char smem_all[512 + 65536 + 2048];
    int tid = threadIdx.x;
    volatile LAS unsigned* xw = (volatile LAS unsigned*)(smem_all);
    volatile LAS unsigned* tbl = (volatile LAS unsigned*)(smem_all + 32);
    char* smem = smem_all + 512;
    if (tid == 0) { xw[0] = 0u; xw[1] = 0u; xw[2] = 0u; xw[3] = 0u; }
    if (tid == 0) {
#pragma unroll
        for (int i = 0; i < 44; ++i) {
            const unsigned long long v = (i < 42) ? (unsigned long long)prm.in[i < 42 ? i : 0] : (i == 42 ? (unsigned long long)prm.out : (unsigned long long)prm.ws);
            tbl[2 * i] = (unsigned)v; tbl[2 * i + 1] = (unsigned)(v >> 32);
        }
    }
    __syncthreads();
    Ctx p; p.tbl = tbl;
    XcdBarrier bar;
    if (ph_hi - ph_lo > 1) bar = xcd_barrier_post((unsigned*)(p.ws() + OFF_BAR), xw, tid);
    constexpr unsigned long long PMASK = probe_mask(PROBE_KIND);
    if (PROBE_KIND >= 0 && BIDX == 0 && tid == 0) { xw[3] = 0u; xw[4] = (unsigned)__builtin_amdgcn_s_memrealtime(); }
    for (int ph = ph_lo; ph < ph_hi; ++ph) {
        if (ph == 1 + NPP) continue;
        tid = launder(tid);
        run_phase(p, ph, rep, xw + 2, smem, tid);
        if (PROBE_KIND == 13 && BIDX == 0 && tid == 0) xw[5] = (unsigned)__builtin_amdgcn_s_memrealtime();
        if (launder_s(ph_hi) - launder_s(ph_lo) > 1 && ph + 1 < ph_hi) xcd_barrier(bar, tid);
        if (PROBE_KIND >= 0 && BIDX == 0 && tid == 0) {
            const unsigned tn = (unsigned)__builtin_amdgcn_s_memrealtime();
            if (PROBE_KIND == 13) xw[3] = xw[3] + (tn - xw[5]);
            else if ((PMASK >> ph) & 1ull) xw[3] = xw[3] + (tn - xw[4]);
            xw[4] = tn;
        }
    }
    if (PROBE_KIND >= 0 && BIDX == 0 && tid == 0) {
        const unsigned long long tend = __builtin_amdgcn_s_memrealtime() + 9ull * xw[3];
        while (__builtin_amdgcn_s_memrealtime() < tend) __builtin_amdgcn_s_sleep(8);
    }
}

#ifndef MK_ONE_LAUNCH
#define MK_ONE_LAUNCH 1
#endif

extern "C" void kernel_launch(void* const* d_in, const int* in_sizes, int n_in, void* d_out, int out_size, void* d_ws, size_t ws_size, hipStream_t stream) {
    (void)in_sizes; (void)n_in; (void)out_size;
    if (ws_size < WS_NEED) { fprintf(stderr, "workspace too small: %zu < %zu\n", ws_size, (size_t)WS_NEED); return; }
    Params p{};
    for (int i = 0; i < 42; ++i) p.in[i] = (const float*)d_in[i];
    p.out = (float*)d_out; p.ws = (char*)d_ws;
    static int grid_blocks = 0;
    if (!grid_blocks) {
        int dev = 0, cus = 0, per_cu = 0;
        hipGetDevice(&dev);
        hipDeviceGetAttribute(&cus, hipDeviceAttributeMultiprocessorCount, dev);
        hipOccupancyMaxActiveBlocksPerMultiprocessor(&per_cu, fwd_kernel, 256, 0);
        if (per_cu > 2) per_cu = 2;
        if (per_cu < 1) per_cu = 1;
        grid_blocks = cus * per_cu;
    }
    hipMemsetAsync((char*)d_ws + OFF_BAR, 0, BAR_BYTES + CTR_BYTES, stream);
#if MK_ONE_LAUNCH
    {
        int lo = 0, hi = NPHASE, rep = 0;
        void* args[] = {&p, &lo, &hi, &rep};
        hipError_t e = hipLaunchCooperativeKernel((void*)fwd_kernel, dim3(grid_blocks), dim3(256), args, 0, stream);
        if (e != hipSuccess) fprintf(stderr, "cooperative launch failed: %s (grid %d)\n", hipGetErrorString(e), grid_blocks);
    }
#else
#ifndef PROBE_REP
#define PROBE_REP 0
#endif
    for (int ph = 0; ph < NPHASE; ++ph) {
        fwd_kernel<<<grid_blocks, 256, 0, stream>>>(p, ph, ph + 1, 0);
        int kind = -1;
        if (ph == 0) kind = 11; else { const int r = (ph - 1) % NPP; kind = (r == 0) ? 12 : (r - 1) % NPL; }
        if ((PROBE_REP >> kind) & 1) fwd_kernel<<<grid_blocks, 256, 0, stream>>>(p, ph, ph + 1, 1);
    }
#endif
}
```

```cpp
#include <hip/hip_runtime.h>
#include <cstdio>
#include <cstdint>
#include <cmath>

typedef unsigned short bf16_t;
typedef short bf16x8 __attribute__((ext_vector_type(8)));
typedef float f32x4 __attribute__((ext_vector_type(4)));
typedef unsigned u32x4 __attribute__((ext_vector_type(4)));
typedef unsigned u32x2 __attribute__((ext_vector_type(2)));
#define DI __device__ __forceinline__
#define LAS __attribute__((address_space(3)))

constexpr int DM = 1024, INW = 4272, INWP = 4352, DFF = 2816;
constexpr int NPT = 8192;
constexpr int KROWS = 8704;
constexpr float EPS = 1e-6f;
constexpr int C_Z = 0, C_XBC = 512, C_DT = 1280, C_RQ = 1296, C_RK = 1552, C_RV = 1808, C_RG = 2320, C_AQ = 2832, C_AK = 3344, C_AV = 3472,
              C_MCQ = 3600, C_MCKV = 3984;
constexpr size_t O_YS = 8388608, O_SSD = 16777216, O_RET = 20971520, O_CK = 25165824, O_CV = 27262976, O_CC = 29360128, O_CR = 33554432;

constexpr size_t al256(size_t x) { return (x + 255) & ~(size_t)255; }
constexpr size_t SZ_WIN = (size_t)INWP * 1024, SZ_WM = (size_t)4096 * 1024, SZ_WUQ = (size_t)768 * 384, SZ_WUKV = (size_t)1024 * 256,
                 SZ_WBR = (size_t)4 * 1024 * 512, SZ_WOUT = (size_t)1024 * 1024, SZ_WUP = (size_t)5632 * 1024, SZ_WDN = (size_t)1024 * 2816;
constexpr size_t OFF_WIN = 0;
constexpr size_t OFF_WM = OFF_WIN + 4 * SZ_WIN;
constexpr size_t OFF_WUQ = OFF_WM + 4 * SZ_WM;
constexpr size_t OFF_WUKV = OFF_WUQ + 4 * SZ_WUQ;
constexpr size_t OFF_WBR = OFF_WUKV + 4 * SZ_WUKV;
constexpr size_t OFF_WOUT = OFF_WBR + 4 * SZ_WBR;
constexpr size_t OFF_WUP = OFF_WOUT + 4 * SZ_WOUT;
constexpr size_t OFF_WDN = OFF_WUP + 4 * SZ_WUP;
constexpr size_t OFF_MOD = al256(OFF_WDN + 4 * SZ_WDN);
constexpr size_t OFF_T16 = al256(OFF_MOD + (size_t)2 * 5 * 6144 * 4);
constexpr size_t OFF_T8 = OFF_T16 + 2 * 64 * 16 * 4;
constexpr size_t OFF_BAR = al256(OFF_T8 + 2 * 64 * 8 * 4);
constexpr size_t BAR_BYTES = 3456 * 4, CTR_BYTES = (256 + 4 * 128) * 4;
constexpr size_t OFF_CTR = OFF_BAR + BAR_BYTES;
constexpr size_t OFF_DTRAW = al256(OFF_CTR + CTR_BYTES);
constexpr size_t OFF_DT = OFF_DTRAW + (size_t)NPT * 16 * 4;
constexpr size_t OFF_H = al256(OFF_DT + (size_t)NPT * 16 * 4);
constexpr size_t OFF_PROJ = OFF_H + (size_t)NPT * 1024 * 2;
constexpr size_t OFF_XBCA = OFF_PROJ + (size_t)NPT * INWP * 2;
constexpr size_t OFF_KA = OFF_XBCA + (size_t)NPT * 768 * 2;
constexpr size_t OFF_VAT = OFF_KA + (size_t)KROWS * 128 * 2;
constexpr size_t OFF_CKV = OFF_VAT + (size_t)KROWS * 128 * 2;
constexpr size_t OFF_KRP = OFF_CKV + (size_t)KROWS * 256 * 2;
constexpr size_t OFF_QM = OFF_KRP + (size_t)KROWS * 32 * 2;
constexpr size_t OFF_KN = OFF_QM + (size_t)NPT * 768 * 2;
constexpr size_t OFF_VMT = OFF_KN + (size_t)KROWS * 512 * 2;
constexpr size_t OFF_OS = OFF_VMT + (size_t)KROWS * 512 * 2;
constexpr size_t OFF_OR = OFF_OS + (size_t)2 * NPT * 512 * 2;
constexpr size_t OFF_OM = OFF_OR + (size_t)2 * NPT * 512 * 2;
constexpr size_t OFF_OA = OFF_OM + (size_t)NPT * 512 * 2;
constexpr int NSEG = 4, SEGTOK = 2048 / NSEG;
constexpr size_t OFF_SEG = OFF_OA + (size_t)NPT * 512 * 2;
constexpr size_t OFF_SEGD = OFF_SEG + (size_t)64 * NSEG * 4096 * 2;
constexpr size_t WS_END1 = OFF_SEGD + 64 * NSEG * 4;
constexpr size_t OFF_MERGED = OFF_OS;
constexpr size_t OFF_MO = OFF_XBCA;
constexpr size_t OFF_U = OFF_PROJ;
constexpr size_t OFF_ACT = OFF_QM;
constexpr size_t OFF_FO = OFF_PROJ;
constexpr size_t OFF_EDGE = OFF_PROJ + (size_t)36 * 1024 * 1024;
static_assert(OFF_MO + (size_t)NPT * 1024 * 4 <= OFF_MERGED, "MO overlaps MERGED");
static_assert(OFF_U + (size_t)NPT * 5632 * 2 <= OFF_ACT, "U overlaps ACT");
static_assert(OFF_ACT + (size_t)NPT * 2816 * 2 <= WS_END1, "ACT beyond end");
constexpr size_t WS_NEED = WS_END1;

struct Params {
    const float* in[42];
    float* out;
    char* ws;
};
struct Ctx {
    volatile LAS unsigned* tbl;
    __device__ __forceinline__ unsigned long long ld(int i) const {
        const unsigned lo = tbl[2 * i], hi = tbl[2 * i + 1];
        return ((unsigned long long)(unsigned)__builtin_amdgcn_readfirstlane((int)hi) << 32) | (unsigned)__builtin_amdgcn_readfirstlane((int)lo);
    }
    __device__ __forceinline__ const float* in(int i) const { return (const float*)ld(i); }
    __device__ __forceinline__ float* out() const { return (float*)ld(42); }
    __device__ __forceinline__ char* ws() const { return (char*)ld(43); }
};

DI float bf2f(unsigned short h) { return __uint_as_float((unsigned)h << 16); }
DI unsigned short f2bf(float f) { return __builtin_bit_cast(unsigned short, (__bf16)f); }
typedef __bf16 bf16x2_t __attribute__((ext_vector_type(2)));
DI unsigned pk2(float lo, float hi) { bf16x2_t v; v[0] = (__bf16)lo; v[1] = (__bf16)hi; return __builtin_bit_cast(unsigned, v); }
DI void unpack8(const u32x4& w, float* v) {
#pragma unroll
    for (int i = 0; i < 4; ++i) { v[2 * i] = __uint_as_float(w[i] << 16); v[2 * i + 1] = __uint_as_float(w[i] & 0xffff0000u); }
}
DI u32x4 pack8(const float* v) { u32x4 w; w[0] = pk2(v[0], v[1]); w[1] = pk2(v[2], v[3]); w[2] = pk2(v[4], v[5]); w[3] = pk2(v[6], v[7]); return w; }
DI float log1pe(float e) { return e < 1e-4f ? e - 0.5f * e * e : __builtin_amdgcn_logf(1.f + e) * 0.6931471805599453f; }
DI float siluf(float x) { return x / (1.f + __expf(-x)); }
DI float sigmoidf(float x) { return 1.f / (1.f + __expf(-x)); }
DI int lanel() { int l = (int)__lane_id(); asm volatile("" : "+v"(l)); return l; }
DI float shx(float v, int m) { const int l = lanel(); return __int_as_float(__builtin_amdgcn_ds_bpermute((l ^ m) << 2, __float_as_int(v))); }
DI float shf(float v, int src) { return __int_as_float(__builtin_amdgcn_ds_bpermute(src << 2, __float_as_int(v))); }
DI float shu(float v, int d) { const int l = lanel(); const int sidx = (l - d) < 0 ? l : (l - d); return __int_as_float(__builtin_amdgcn_ds_bpermute(sidx << 2, __float_as_int(v))); }
DI float gmax4(float v) {
    auto a = __builtin_amdgcn_permlane16_swap(__float_as_uint(v), __float_as_uint(v), false, false);
    v = fmaxf(__uint_as_float(a[0]), __uint_as_float(a[1]));
    auto b = __builtin_amdgcn_permlane32_swap(__float_as_uint(v), __float_as_uint(v), false, false);
    return fmaxf(__uint_as_float(b[0]), __uint_as_float(b[1]));
}
DI float gsum4(float v) {
    auto a = __builtin_amdgcn_permlane16_swap(__float_as_uint(v), __float_as_uint(v), false, false);
    v = __uint_as_float(a[0]) + __uint_as_float(a[1]);
    auto b = __builtin_amdgcn_permlane32_swap(__float_as_uint(v), __float_as_uint(v), false, false);
    return __uint_as_float(b[0]) + __uint_as_float(b[1]);
}
DI float wsum(float v) {
#pragma unroll
    for (int o = 32; o >= 1; o >>= 1) v += shx(v, o);
    return v;
}
typedef const __attribute__((address_space(1))) u32x4* gp128;
DI u32x4 gld16(const void* p) { return *(gp128)(unsigned long long)p; }
DI void st_wt8(void* p, u32x2 v) { __hip_atomic_store((unsigned long long*)p, ((unsigned long long)v[1] << 32) | v[0], __ATOMIC_RELAXED, __HIP_MEMORY_SCOPE_AGENT); }
DI void st_wt16(void* p, u32x4 v) { st_wt8(p, (u32x2){v[0], v[1]}); st_wt8((char*)p + 8, (u32x2){v[2], v[3]}); }
DI void st_wt2(bf16_t* p, bf16_t v) { __hip_atomic_store(p, v, __ATOMIC_RELAXED, __HIP_MEMORY_SCOPE_AGENT); }
DI void st_wt4f(float* p, float v) { __hip_atomic_store(p, v, __ATOMIC_RELAXED, __HIP_MEMORY_SCOPE_AGENT); }
DI int launder(int x) { asm volatile("" : "+v"(x)); return x; }
DI int launder_s(int x) { asm volatile("" : "+s"(x)); return x; }
#define BIDX launder_s((int)blockIdx.x)
DI int FQ(int q) { return (4 - q) & 3; }
DI int tile_off(int rows, int ks, int row, int g, int q) { return (ks * rows + row) * 64 + ((g ^ FQ(q)) << 4); }

#define XB_TMO      128
#define XB_XCNT(j)  (256  + 64 * (j))
#define XB_XSUB(j)  (1280 + 64 * (j))
#define XB_XGEN(j)  (2304 + 64 * (j))
#define XB_TOP      3328
#define XB_TOPGEN   3392
#define XB_SPIN_CAP (1u << 22)
DI unsigned xb_ld(unsigned* p) { return __hip_atomic_load(p, __ATOMIC_RELAXED, __HIP_MEMORY_SCOPE_AGENT); }
DI unsigned xb_add(unsigned* p, unsigned v) { return __hip_atomic_fetch_add(p, v, __ATOMIC_RELAXED, __HIP_MEMORY_SCOPE_AGENT); }
DI unsigned xb_xcc_id() { return (unsigned)__builtin_amdgcn_s_getreg((3 << 11) | 20) & 0xFu; }
#define XB_SPIN(cond, bar) do { unsigned _sp = 0; while (cond) { __builtin_amdgcn_s_sleep(1); \
    if ((++_sp & 255u) == 0u) { if (xb_ld(&(bar)[XB_TMO])) break; if (_sp > XB_SPIN_CAP) { atomicAdd(&(bar)[XB_TMO], 1u); break; } } } } while (0)
struct XcdBarrier { unsigned* bar; unsigned x; volatile LAS unsigned* st; };
DI XcdBarrier xcd_barrier_post(unsigned* bar, volatile LAS unsigned* st, int tid) {
    XcdBarrier b; b.bar = bar; b.x = xb_xcc_id(); b.st = st;
    if (tid == 0) (void)xb_add(&bar[XB_XCNT(b.x)], 1u);
    return b;
}
DI void xcd_barrier_complete(unsigned* bar, unsigned x, unsigned& nloc, unsigned& nx) {
    const unsigned G = gridDim.x * gridDim.y * gridDim.z;
    unsigned sum, cnt, mine, sp = 0u;
    for (;;) {
        sum = 0u; cnt = 0u; mine = 0u;
#pragma unroll
        for (unsigned j = 0; j < 16; ++j) { const unsigned c = xb_ld(&bar[XB_XCNT(j)]); sum += c; cnt += (c > 0u) ? 1u : 0u; mine = (j == x) ? c : mine; }
        if (sum == G) break;
        __builtin_amdgcn_s_sleep(1);
        if ((++sp & 255u) == 0u) { if (xb_ld(&bar[XB_TMO])) break; if (sp > XB_SPIN_CAP) { atomicAdd(&bar[XB_TMO], 1u); break; } }
    }
    nloc = mine > 0u ? mine : 1u; nx = cnt > 0u ? cnt : 1u;
}
DI void xcd_barrier(const XcdBarrier& b, int tid) {
    asm volatile("s_waitcnt vmcnt(0)" ::: "memory");
    __syncthreads();
    if (tid == 0) {
        unsigned* bar = b.bar;
        __builtin_amdgcn_s_waitcnt(0);
        unsigned nloc = b.st[0], nx = b.st[1];
        if (nloc == 0u) { xcd_barrier_complete(bar, b.x, nloc, nx); b.st[0] = nloc; b.st[1] = nx; }
        const unsigned old = xb_add(&bar[XB_XSUB(b.x)], 1u);
        const unsigned gen = old / nloc;
        if (old + 1u == (gen + 1u) * nloc) {
            __builtin_amdgcn_fence(__ATOMIC_RELEASE, "agent");
            asm volatile("s_waitcnt vmcnt(0)" ::: "memory");
            const unsigned og = xb_add(&bar[XB_TOP], 1u);
            const unsigned tg = og / nx;
            if (og + 1u == (tg + 1u) * nx) xb_add(&bar[XB_TOPGEN], 1u);
            else XB_SPIN(xb_ld(&bar[XB_TOPGEN]) == tg, bar);
            __builtin_amdgcn_fence(__ATOMIC_ACQUIRE, "agent");
            xb_add(&bar[XB_XGEN(b.x)], 1u);
            asm volatile("s_waitcnt vmcnt(0)" ::: "memory");
        } else {
            XB_SPIN(xb_ld(&bar[XB_XGEN(b.x)]) == gen, bar);
            __builtin_amdgcn_fence(__ATOMIC_ACQUIRE, "agent");
            asm volatile("s_waitcnt vmcnt(0)" ::: "memory");
        }
    }
    __syncthreads();
}

struct Tok { int lat, b, t, L, cond, krow, seq0; size_t gx; };
DI Tok tok_info(int m, int ps) {
    Tok k;
    if (m < 4096) { k.lat = 0; k.b = ps * 16 + (m >> 8); k.t = m & 255; k.L = 256; k.cond = 0; k.krow = m; k.seq0 = m & ~255; k.gx = (size_t)ps * 4096 + m; }
    else { const int mm = m - 4096, j = mm >> 11; k.lat = 1; k.b = ps * 2 + j; k.t = mm & 2047; k.L = 2048; k.cond = 1 + k.b; k.krow = 4096 + j * 2304 + 256 + k.t;
           k.seq0 = 4096 + j * 2048; k.gx = (size_t)8192 + (size_t)ps * 4096 + mm; }
    return k;
}

template <int NTA, int NTB, bool LOWREG = false, int WMAP = 0>
DI void gemm_kloop(f32x4 (&acc)[NTA][NTB], const bf16_t* __restrict__ W, size_t ldw, const bf16_t* __restrict__ X, size_t ldx, int K, char* smem, int tid) {
    constexpr int BF = 32 * NTA, BT = 32 * NTB;
    constexpr int WB = BF * 128, STG = (BF + BT) * 128;
    constexpr int NPW = BF / 8, NPX = BT / 8, NPIECE = NPW + NPX, PPW = NPIECE / 4;
    static_assert(NPIECE % 4 == 0, "pieces must divide over 4 waves");
    tid = launder(tid);
    const int lane = tid & 63, wv = tid >> 6, wn = wv >> 1, wt = wv & 1, fr = lane & 15, g = lane >> 4;
    constexpr int PWW = NPW / 4, PXX = PPW - PWW;
    const int wvu = __builtin_amdgcn_readfirstlane(wv);
    auto lane_off = [&](int j, int ln) -> unsigned {
        const bool isw = j < PWW;
        const int pp = isw ? wvu * PWW + j : wvu * PXX + (j - PWW);
        const int rows = isw ? BF : BT;
        const int rb = pp % (rows / 16);
        const int rl = ln >> 2;
        const int q = isw ? (((rb * 16 + rl) / (4 * NTA)) & 3) : ((rl >> 2) & 3);
        const int gl = (ln & 3) ^ FQ(q);
        if (WMAP && isw) return (unsigned)((rl & 7) + (rl >> 3) * DFF) * (unsigned)ldw + (unsigned)(gl * 8);
        return (unsigned)rl * (unsigned)(isw ? ldw : ldx) + (unsigned)(gl * 8);
    };
    unsigned poff[PPW];
    if (!LOWREG) {
#pragma unroll
        for (int j = 0; j < PPW; ++j) poff[j] = lane_off(j, lane);
    }
    auto issue = [&](int k0, char* sdst) {
        const int ln = LOWREG ? launder(lane) : lane;
#pragma unroll
        for (int j = 0; j < PPW; ++j) {
            const bool isw = j < PWW;
            const int pp = isw ? wvu * PWW + j : wvu * PXX + (j - PWW);
            const int rows = isw ? BF : BT;
            const int ks = pp / (rows / 16), rb = pp % (rows / 16);
            const int wrow = WMAP ? 32 * (rb >> 2) + 8 * (rb & 3) : rb * 16;
            const bf16_t* base = (isw ? W + (size_t)wrow * ldw : X + (size_t)(rb * 16) * ldx) + k0 + ks * 32;
            const unsigned off = LOWREG ? lane_off(j, ln) : poff[j];
            __builtin_amdgcn_global_load_lds((const unsigned*)(base + off), (unsigned*)(sdst + (isw ? 0 : WB) + (ks * rows + rb * 16) * 64), 16, 0, 0);
        }
    };
    const int aoff = tile_off(BF, 0, wn * 16 * NTA + 4 * NTA * (fr >> 2) + (fr & 3), g, fr >> 2);
    const int boff = WB + tile_off(BT, 0, wt * 16 * NTB + fr, g, (fr >> 2) & 3);
    const int nk = K >> 6;
    issue(0, smem);
    asm volatile("s_waitcnt vmcnt(0)" ::: "memory");
    __syncthreads();
    for (int kt = 0; kt < nk; ++kt) {
        if (kt + 1 < nk) issue((kt + 1) << 6, smem + ((kt + 1) & 1) * STG);
        const char* sb = smem + (kt & 1) * STG;
        __builtin_amdgcn_s_setprio(1);
#pragma unroll
        for (int kk = 0; kk < 2; ++kk) {
            if (LOWREG) {
                bf16x8 bfr[NTB];
#pragma unroll
                for (int mt = 0; mt < NTB; ++mt) bfr[mt] = *(const bf16x8*)(sb + boff + mt * 1024 + kk * BT * 64);
#pragma unroll
                for (int a = 0; a < NTA; ++a) {
                    const bf16x8 af1 = *(const bf16x8*)(sb + aoff + a * 256 + kk * BF * 64);
#pragma unroll
                    for (int mt = 0; mt < NTB; ++mt) acc[a][mt] = __builtin_amdgcn_mfma_f32_16x16x32_bf16(af1, bfr[mt], acc[a][mt], 0, 0, 0);
                    __builtin_amdgcn_sched_barrier(0);
                }
            } else {
                bf16x8 af[NTA], bfr[NTB];
#pragma unroll
                for (int a = 0; a < NTA; ++a) af[a] = *(const bf16x8*)(sb + aoff + a * 256 + kk * BF * 64);
#pragma unroll
                for (int mt = 0; mt < NTB; ++mt) bfr[mt] = *(const bf16x8*)(sb + boff + mt * 1024 + kk * BT * 64);
#pragma unroll
                for (int a = 0; a < NTA; ++a)
#pragma unroll
                    for (int mt = 0; mt < NTB; ++mt) acc[a][mt] = __builtin_amdgcn_mfma_f32_16x16x32_bf16(af[a], bfr[mt], acc[a][mt], 0, 0, 0);
            }
        }
        __builtin_amdgcn_s_setprio(0);
        asm volatile("s_waitcnt vmcnt(0)" ::: "memory");
        __syncthreads();
    }
}

struct WTile { const float* src; bf16_t* dst; int K, N, k0, n0; };
constexpr int T_IN = 16 * 68, T_M = 16 * 64, T_UQ = 6 * 12, T_UKV = 4 * 16, T_BR = 8 * 16, T_OUT = 16 * 16, T_UP = 16 * 88, T_DN = 44 * 16;
constexpr int T_LAYER = T_IN + T_M + T_UQ + T_UKV + 4 * T_BR + T_OUT + T_UP + T_DN;
constexpr int T_MIDEND = T_IN + T_M + T_UQ + T_UKV + 4 * T_BR + T_OUT, T_UPEND = T_MIDEND + T_UP;
DI WTile wtile_decode(const Ctx& p, int it) {
    char* ws = p.ws();
    const int l = it / T_LAYER; int k = it % T_LAYER;
    WTile t; int ntn;
    if (k < T_IN) { t.src = p.in(16) + (size_t)l * 1024 * INW; t.dst = (bf16_t*)(ws + OFF_WIN) + (size_t)l * SZ_WIN; t.K = 1024; t.N = INW; ntn = 68; }
    else if ((k -= T_IN) < T_M) { t.src = p.in(35) + (size_t)l * 1024 * 4096; t.dst = (bf16_t*)(ws + OFF_WM) + (size_t)l * SZ_WM; t.K = 1024; t.N = 4096; ntn = 64; }
    else if ((k -= T_M) < T_UQ) { t.src = p.in(28) + (size_t)l * 384 * 768; t.dst = (bf16_t*)(ws + OFF_WUQ) + (size_t)l * SZ_WUQ; t.K = 384; t.N = 768; ntn = 12; }
    else if ((k -= T_UQ) < T_UKV) { t.src = p.in(30) + (size_t)l * 256 * 1024; t.dst = (bf16_t*)(ws + OFF_WUKV) + (size_t)l * SZ_WUKV; t.K = 256; t.N = 1024; ntn = 16; }
    else if ((k -= T_UKV) < 4 * T_BR) { const int j = k / T_BR; k -= j * T_BR; t.src = (j == 0 ? p.in(31) : j == 1 ? p.in(32) : j == 2 ? p.in(33) : p.in(34)) + (size_t)l * 512 * 1024;
                                        t.dst = (bf16_t*)(ws + OFF_WBR) + (size_t)(l * 4 + j) * 1024 * 512; t.K = 512; t.N = 1024; ntn = 16; }
    else if ((k -= 4 * T_BR) < T_OUT) { t.src = p.in(37) + (size_t)l * 1024 * 1024; t.dst = (bf16_t*)(ws + OFF_WOUT) + (size_t)l * SZ_WOUT; t.K = 1024; t.N = 1024; ntn = 16; }
    else if ((k -= T_OUT) < T_UP) { t.src = p.in(38) + (size_t)l * 1024 * 5632; t.dst = (bf16_t*)(ws + OFF_WUP) + (size_t)l * SZ_WUP; t.K = 1024; t.N = 5632; ntn = 88; }
    else { k -= T_UP; t.src = p.in(41) + (size_t)l * 2816 * 1024; t.dst = (bf16_t*)(ws + OFF_WDN) + (size_t)l * SZ_WDN; t.K = 2816; t.N = 1024; ntn = 16; }
    t.k0 = (k / ntn) * 64; t.n0 = (k % ntn) * 64;
    return t;
}
DI void wtile_load(const WTile& t, int tid, f32x4 (&v)[4]) {
    const int r = tid >> 4, c4 = tid & 15;
#pragma unroll
    for (int i = 0; i < 4; ++i) {
        v[i] = (f32x4){0.f, 0.f, 0.f, 0.f};
        if (t.n0 + 4 * c4 < t.N) v[i] = *(const f32x4*)(t.src + (size_t)(t.k0 + r + 16 * i) * t.N + t.n0 + 4 * c4);
    }
}
DI void wtile_finish(const WTile& t, const f32x4 (&v)[4], char* smem, int tid) {
    float* tl = (float*)smem;
    const int r = tid >> 4, c4 = tid & 15;
#pragma unroll
    for (int i = 0; i < 4; ++i) {
        const int row = r + 16 * i;
        tl[row * 65 + 4 * c4 + 0] = v[i][0]; tl[row * 65 + 4 * c4 + 1] = v[i][1]; tl[row * 65 + 4 * c4 + 2] = v[i][2]; tl[row * 65 + 4 * c4 + 3] = v[i][3];
    }
    __syncthreads();
#pragma unroll
    for (int i = 0; i < 2; ++i) {
        const int q = tid + 256 * i, n = q >> 3, c = q & 7;
        float o[8];
#pragma unroll
        for (int j = 0; j < 8; ++j) o[j] = tl[(8 * c + j) * 65 + n];
        *(u32x4*)(t.dst + (size_t)(t.n0 + n) * t.K + t.k0 + 8 * c) = pack8(o);
    }
    __syncthreads();
}
DI void wtile_run(const Ctx& p, int lo, int hi, int step, char* smem, int tid) {
    int it = lo;
    f32x4 va[4];
    if (it < hi) { const WTile c0 = wtile_decode(p, it); wtile_load(c0, tid, va); }
    while (it < hi) {
        const int nx = it + step;
        f32x4 vb[4];
        if (nx < hi) { const WTile nt = wtile_decode(p, nx); wtile_load(nt, tid, vb); }
        { const WTile cur = wtile_decode(p, launder(it)); wtile_finish(cur, va, smem, tid); }
#pragma unroll
        for (int i = 0; i < 4; ++i) va[i] = vb[i];
        it = nx;
    }
}
DI void wtile_tail(const Ctx& p, int tiles_per_xcd, int lo, int hi, char* smem, int tid) {
    const int x = BIDX & 7, loc = BIDX >> 3, nloc = gridDim.x >> 3;
    const int rem = tiles_per_xcd % nloc;
    const int j = rem ? loc - rem : loc, nidle = rem ? nloc - rem : nloc;
    if (j >= 0) wtile_run(p, lo + j * 8 + x, hi, nidle * 8, smem, tid);
}

DI void phase_prep_w(const Ctx& p, char* smem, int tid) {
    char* ws = p.ws();
    constexpr int N_MODI = 2 * 192;
    for (int it = BIDX; it < N_MODI + 1; it += gridDim.x) {
        if (it < N_MODI) {
            const int l = it / 192, cb = it % 192;
            float* sc = (float*)smem;
            float* red = sc + 5 * 1024;
            __syncthreads();
            for (int e = tid; e < 5 * 1024; e += 256) {
                const int c = e >> 10, kk = e & 1023;
                const float v = (c == 0) ? p.in(9)[kk] : p.in(8)[(c - 1) * 1024 + kk];
                sc[e] = siluf(v);
            }
            __syncthreads();
            const int col = tid & 31, kg = tid >> 5;
            float a[5] = {0.f, 0.f, 0.f, 0.f, 0.f};
            const float* w = p.in(10) + ((size_t)l * 1024 + kg * 128) * 6144 + cb * 32 + col;
#pragma unroll 1
            for (int k0 = 0; k0 < 128; k0 += 16) {
                float wv[16];
#pragma unroll
                for (int j = 0; j < 16; ++j) wv[j] = w[(size_t)(k0 + j) * 6144];
#pragma unroll
                for (int j = 0; j < 16; ++j)
#pragma unroll
                    for (int c = 0; c < 5; ++c) a[c] += wv[j] * sc[c * 1024 + kg * 128 + k0 + j];
            }
#pragma unroll
            for (int c = 0; c < 5; ++c) red[(kg * 5 + c) * 32 + col] = a[c];
            __syncthreads();
            if (tid < 160) {
                const int c = tid >> 5, cl = tid & 31;
                float sm = 0.f;
#pragma unroll
                for (int k8 = 0; k8 < 8; ++k8) sm += red[(k8 * 5 + c) * 32 + cl];
                float* mod = (float*)(ws + OFF_MOD);
                mod[((size_t)l * 5 + c) * 6144 + cb * 32 + cl] = sm + p.in(11)[(size_t)l * 6144 + cb * 32 + cl];
            }
            __syncthreads();
        } else {
            float* t16 = (float*)(ws + OFF_T16); float* t8 = (float*)(ws + OFF_T8);
            for (int e = tid; e < 64 * 16 + 64 * 8; e += 256) {
                const bool small = e >= 1024;
                const int ee = small ? e - 1024 : e;
                const int pos = small ? (ee >> 3) : (ee >> 4), i = small ? (ee & 7) : (ee & 15);
                const double r = small ? 0.31622776601683794 : 0.5623413251903491;
                double th = 1.0;
                for (int j = 0; j < i; ++j) th *= r;
                const double t2 = th * th;
                double c1 = 1.0, s1 = th;
                double tc = 1.0, tsn = th;
                for (int k = 1; k < 14; ++k) {
                    tc = -tc * t2 / (double)((2 * k - 1) * (2 * k));
                    tsn = -tsn * t2 / (double)((2 * k) * (2 * k + 1));
                    c1 += tc; s1 += tsn;
                }
                double c = 1.0, sn = 0.0;
                for (int j = 0; j < pos; ++j) { const double cn = c * c1 - sn * s1, snn = sn * c1 + c * s1; c = cn; sn = snn; }
                if (small) { t8[ee] = (float)c; t8[512 + ee] = (float)sn; } else { t16[ee] = (float)c; t16[1024 + ee] = (float)sn; }
            }
        }
    }
    __syncthreads();
    wtile_run(p, BIDX, T_IN, gridDim.x, smem, tid);
}

DI void row_load(const float* r, int lane, f32x4 (&v)[4]) {
#pragma unroll
    for (int i = 0; i < 4; ++i) v[i] = *(const f32x4*)(r + 4 * lane + 256 * i);
}
DI float row_ss(const f32x4 (&v)[4]) {
    float s = 0.f;
#pragma unroll
    for (int i = 0; i < 4; ++i) s += v[i][0] * v[i][0] + v[i][1] * v[i][1] + v[i][2] * v[i][2] + v[i][3] * v[i][3];
    return wsum(s);
}
DI void row_modnorm_store(const f32x4 (&x)[4], const float* gw, const float* sh, const float* sc, bf16_t* dst, int lane) {
    const float rstd = rsqrtf(row_ss(x) * (1.f / 1024.f) + EPS);
#pragma unroll
    for (int i = 0; i < 4; ++i) {
        const int c = 4 * lane + 256 * i;
        const f32x4 g = *(const f32x4*)(gw + c), s = *(const f32x4*)(sh + c), q = *(const f32x4*)(sc + c);
        float o[4];
#pragma unroll
        for (int j = 0; j < 4; ++j) o[j] = (x[i][j] * rstd) * g[j] * (1.f + q[j]) + s[j];
        u32x2 w; w[0] = pk2(o[0], o[1]); w[1] = pk2(o[2], o[3]);
        *(u32x2*)(dst + c) = w;
    }
}
DI const float* x_in_row(const Ctx& p, int m, int ps) {
    return (m < 4096) ? p.in(0) + ((size_t)ps * 4096 + m) * 1024 : p.in(1) + ((size_t)ps * 4096 + (m - 4096)) * 1024;
}
DI void phase_h1(const Ctx& p, int ps, int tid) {
    const int lane = tid & 63, wv = tid >> 6;
    const float* mod = (const float*)(p.ws() + OFF_MOD);
    bf16_t* H = (bf16_t*)(p.ws() + OFF_H);
    for (int m = BIDX * 4 + wv; m < NPT; m += gridDim.x * 4) {
        const Tok k = tok_info(m, ps);
        f32x4 x[4]; row_load(x_in_row(p, m, ps), lane, x);
        const float* md = mod + (size_t)(0 * 5 + k.cond) * 6144;
        row_modnorm_store(x, p.in(12), md + 0, md + 1024, H + (size_t)m * 1024, lane);
    }
}
DI void phase_res(const Ctx& p, int ps, int l, int which, int tid) {
    const int lane = tid & 63, wv = tid >> 6;
    const float* mod = (const float*)(p.ws() + OFF_MOD);
    bf16_t* H = (bf16_t*)(p.ws() + OFF_H);
    const float* Y = (const float*)(p.ws() + (which ? OFF_FO : OFF_MO));
    const float* gpost = (which ? p.in(15) : p.in(13)) + (size_t)l * 1024;
    const int bid = BIDX, rbase = (bid & 7) * 1024 + (bid >> 3) * 4 + wv, rstep = (gridDim.x >> 3) * 4;
    for (int mo = 0; (bid >> 3) * 4 + wv + mo < 1024; mo += rstep) {
        const int m = rbase + mo;
        const Tok k = tok_info(m, ps);
        const float* md = mod + (size_t)(l * 5 + k.cond) * 6144;
        const float* gate = md + (which ? 5 * 1024 : 2 * 1024);
        f32x4 x[4], y[4];
        if (l == 0 && which == 0) row_load(x_in_row(p, m, ps), lane, x); else row_load(p.out() + k.gx * 1024, lane, x);
        row_load(Y + (size_t)m * 1024, lane, y);
        const float rstd = rsqrtf(row_ss(y) * (1.f / 1024.f) + EPS);
#pragma unroll
        for (int i = 0; i < 4; ++i) {
            const int c = 4 * lane + 256 * i;
            const f32x4 g = *(const f32x4*)(gate + c), w = *(const f32x4*)(gpost + c);
#pragma unroll
            for (int j = 0; j < 4; ++j) x[i][j] = x[i][j] + g[j] * ((y[i][j] * rstd) * w[j]);
            *(f32x4*)(p.out() + k.gx * 1024 + c) = x[i];
        }
        if (which == 0) row_modnorm_store(x, p.in(14) + (size_t)l * 1024, md + 3 * 1024, md + 4 * 1024, H + (size_t)m * 1024, lane);
        else if (l + 1 < 2) { const float* md2 = mod + (size_t)((l + 1) * 5 + k.cond) * 6144;
                              row_modnorm_store(x, p.in(12) + (size_t)(l + 1) * 1024, md2, md2 + 1024, H + (size_t)m * 1024, lane); }
    }
}

DI bool xcd_tile(int it, int Mt, int Nt, int B, int& mt, int& nt) {
    const int x = BIDX & 7, loc = BIDX >> 3, nloc = gridDim.x >> 3;
    const int MP = Mt >> 3;
    const int idx = it * nloc + loc;
    if (idx >= MP * Nt) return false;
    const int ng = idx / (MP * B);
    const int bw = min(B, Nt - ng * B);
    const int r = idx - ng * MP * B;
    mt = x * MP + r / bw; nt = ng * B + r % bw;
    return true;
}
DI void phase_gemm_in(const Ctx& p, int l, int ps, char* smem, int tid) {
    const bf16_t* W = (const bf16_t*)(p.ws() + OFF_WIN) + (size_t)l * SZ_WIN;
    const bf16_t* X = (const bf16_t*)(p.ws() + OFF_H);
    bf16_t* PROJ = (bf16_t*)(p.ws() + OFF_PROJ);
    float* DTRAW = (float*)(p.ws() + OFF_DTRAW);
    const int lane = tid & 63, wv = tid >> 6, wn = wv >> 1, wt = wv & 1, fr = lane & 15, g = lane >> 4;
    for (int it = 0;; ++it) {
        int mt0, nt0; if (!xcd_tile(it, 64, 34, 8, mt0, nt0)) break;
        const int m0 = mt0 * 128, n0 = nt0 * 128;
        f32x4 acc[4][4];
#pragma unroll
        for (int a = 0; a < 4; ++a)
#pragma unroll
            for (int b = 0; b < 4; ++b) acc[a][b] = (f32x4){0.f, 0.f, 0.f, 0.f};
        gemm_kloop<4, 4>(acc, W + (size_t)n0 * 1024, 1024, X + (size_t)m0 * 1024, 1024, 1024, smem, tid);
        const int fb = n0 + wn * 64 + 16 * g;
#pragma unroll
        for (int mt = 0; mt < 4; ++mt) {
            const int m = m0 + wt * 64 + 16 * mt + fr;
            float v[16];
#pragma unroll
            for (int a = 0; a < 4; ++a)
#pragma unroll
                for (int r = 0; r < 4; ++r) v[4 * a + r] = acc[a][mt][r];
            bf16_t* d = PROJ + (size_t)m * INWP + fb;
            *(u32x4*)d = pack8(v); *(u32x4*)(d + 8) = pack8(v + 8);
            if (fb == C_DT) {
                float* dd = DTRAW + (size_t)m * 16;
#pragma unroll
                for (int a = 0; a < 4; ++a) *(f32x4*)(dd + 4 * a) = acc[a][mt];
            }
        }
    }
    if (launder_s(ps) == 0) wtile_tail(p, 8 * 34, l * T_LAYER + T_IN, l * T_LAYER + T_MIDEND, smem, launder(tid));
}

template <bool F32OUT>
DI void phase_gemm_plain(const bf16_t* W, int K, const bf16_t* X, size_t ldx, int Mtiles, int Ntiles, void* out, size_t ldo, char* smem, int tid) {
    const int lane = tid & 63, wv = tid >> 6, wn = wv >> 1, wt = wv & 1, fr = lane & 15, g = lane >> 4;
    for (int it = 0;; ++it) {
        int mt0, nt0; if (!xcd_tile(it, Mtiles, Ntiles, 8, mt0, nt0)) break;
        const int m0 = mt0 * 128, n0 = nt0 * 128;
        f32x4 acc[4][4];
#pragma unroll
        for (int a = 0; a < 4; ++a)
#pragma unroll
            for (int b = 0; b < 4; ++b) acc[a][b] = (f32x4){0.f, 0.f, 0.f, 0.f};
        gemm_kloop<4, 4>(acc, W + (size_t)n0 * K, K, X + (size_t)m0 * ldx, ldx, K, smem, tid);
        const int fb = n0 + wn * 64 + 16 * g;
#pragma unroll
        for (int mt = 0; mt < 4; ++mt) {
            const int m = m0 + wt * 64 + 16 * mt + fr;
            if (F32OUT) {
                float* d = (float*)out + (size_t)m * ldo + fb;
#pragma unroll
                for (int a = 0; a < 4; ++a) *(f32x4*)(d + 4 * a) = acc[a][mt];
            } else {
                float v[16];
#pragma unroll
                for (int a = 0; a < 4; ++a)
#pragma unroll
                    for (int r = 0; r < 4; ++r) v[4 * a + r] = acc[a][mt][r];
                bf16_t* d = (bf16_t*)out + (size_t)m * ldo + fb;
                *(u32x4*)d = pack8(v); *(u32x4*)(d + 8) = pack8(v + 8);
            }
        }
    }
}


template <int CTRL> DI float dpp0(float v) { return __builtin_bit_cast(float, __builtin_amdgcn_update_dpp(0, __builtin_bit_cast(int, v), CTRL, 0xf, 0xf, true)); }
constexpr int BND_OFF = 65536;
DI void phase_up_act(const Ctx& p, int l, int ps, char* smem, int tid) {
    const bf16_t* W = (const bf16_t*)(p.ws() + OFF_WUP) + (size_t)l * SZ_WUP;
    const bf16_t* X = (const bf16_t*)(p.ws() + OFF_H);
    bf16_t* A = (bf16_t*)(p.ws() + OFF_ACT);
    float* EDGE = (float*)(p.ws() + OFF_EDGE);
    const float* cw = p.in(39) + (size_t)l * 3 * 5632; const float* cb = p.in(40) + (size_t)l * 5632;
    float* bnd = (float*)(smem + BND_OFF);
    for (int it = 0;; ++it) {
        int mt0, nt0; if (!xcd_tile(it, 64, 44, 8, mt0, nt0)) break;
        const int m0 = mt0 * 128, cb0 = nt0 * 64;
        f32x4 acc[4][4];
#pragma unroll
        for (int a = 0; a < 4; ++a)
#pragma unroll
            for (int b = 0; b < 4; ++b) acc[a][b] = (f32x4){0.f, 0.f, 0.f, 0.f};
        gemm_kloop<4, 4, false, 1>(acc, W + (size_t)cb0 * 1024, 1024, X + (size_t)m0 * 1024, 1024, 1024, smem, tid);
        const int t2 = launder(tid);
        const int lane = t2 & 63, wv = t2 >> 6, wn = wv >> 1, wt = wv & 1, fr = lane & 15, g = lane >> 4;
        const int c0 = cb0 + 32 * wn + 8 * g;
        if (fr == 0) {
            float* d = bnd + (((wn * 2 + wt) * 2 + 0) * 4 + g) * 16;
#pragma unroll
            for (int a = 0; a < 4; ++a) *(f32x4*)(d + 4 * a) = acc[a][0];
        }
        if (fr == 15) {
            float* d = bnd + (((wn * 2 + wt) * 2 + 1) * 4 + g) * 16;
#pragma unroll
            for (int a = 0; a < 4; ++a) *(f32x4*)(d + 4 * a) = acc[a][3];
        }
        __syncthreads();
        const bool e0 = (wt == 0 && fr == 0), e127 = (wt == 1 && fr == 15);
        u32x2 keep[4];
#pragma unroll
        for (int eh = 0; eh < 2; ++eh) {
            const int c = c0 + 4 * eh;
            const f32x4 w0u = *(const f32x4*)(cw + c), w1u = *(const f32x4*)(cw + 5632 + c), w2u = *(const f32x4*)(cw + 2 * 5632 + c), bu = *(const f32x4*)(cb + c);
            const f32x4 w0g = *(const f32x4*)(cw + DFF + c), w1g = *(const f32x4*)(cw + 5632 + DFF + c), w2g = *(const f32x4*)(cw + 2 * 5632 + DFF + c), bg = *(const f32x4*)(cb + DFF + c);
            const float* bo = bnd + (((wn * 2 + (wt ^ 1)) * 2 + (wt ? 1 : 0)) * 4 + g) * 16;
            const f32x4 bxu = *(const f32x4*)(bo + 4 * eh), bxg = *(const f32x4*)(bo + 8 + 4 * eh);
#pragma unroll
            for (int mt = 0; mt < 4; ++mt) {
                float up[4], gt[4], o[4];
#pragma unroll
                for (int r = 0; r < 4; ++r) {
                    const float cu = acc[eh][mt][r], cg = acc[2 + eh][mt][r];
                    float pu = dpp0<0x111>(cu), pg = dpp0<0x111>(cg), nu = dpp0<0x101>(cu), ng = dpp0<0x101>(cg);
                    if (mt > 0) { pu += dpp0<0x10F>(acc[eh][mt > 0 ? mt - 1 : 0][r]); pg += dpp0<0x10F>(acc[2 + eh][mt > 0 ? mt - 1 : 0][r]); }
                    else if (wt == 1 && fr == 0) { pu = bxu[r]; pg = bxg[r]; }
                    if (mt < 3) { nu += dpp0<0x11F>(acc[eh][mt < 3 ? mt + 1 : 3][r]); ng += dpp0<0x11F>(acc[2 + eh][mt < 3 ? mt + 1 : 3][r]); }
                    else if (wt == 0 && fr == 15) { nu = bxu[r]; ng = bxg[r]; }
                    up[r] = bu[r] + w0u[r] * pu + w1u[r] * cu + w2u[r] * nu;
                    gt[r] = bg[r] + w0g[r] * pg + w1g[r] * cg + w2g[r] * ng;
                    o[r] = siluf(gt[r]) * up[r];
                }
                if (mt == 0 && e0) {
                    float* e = EDGE + ((size_t)mt0 * 4 + 0) * 5632 + c;
                    *(f32x4*)e = (f32x4){up[0], up[1], up[2], up[3]}; *(f32x4*)(e + DFF) = (f32x4){gt[0], gt[1], gt[2], gt[3]};
                    float* e3 = EDGE + ((size_t)mt0 * 4 + 3) * 5632 + c;
                    *(f32x4*)e3 = (f32x4){w2u[0] * acc[eh][0][0], w2u[1] * acc[eh][0][1], w2u[2] * acc[eh][0][2], w2u[3] * acc[eh][0][3]};
                    *(f32x4*)(e3 + DFF) = (f32x4){w2g[0] * acc[2 + eh][0][0], w2g[1] * acc[2 + eh][0][1], w2g[2] * acc[2 + eh][0][2], w2g[3] * acc[2 + eh][0][3]};
                }
                if (mt == 3 && e127) {
                    float* e = EDGE + ((size_t)mt0 * 4 + 2) * 5632 + c;
                    *(f32x4*)e = (f32x4){up[0], up[1], up[2], up[3]}; *(f32x4*)(e + DFF) = (f32x4){gt[0], gt[1], gt[2], gt[3]};
                    float* e1 = EDGE + ((size_t)mt0 * 4 + 1) * 5632 + c;
                    *(f32x4*)e1 = (f32x4){w0u[0] * acc[eh][3][0], w0u[1] * acc[eh][3][1], w0u[2] * acc[eh][3][2], w0u[3] * acc[eh][3][3]};
                    *(f32x4*)(e1 + DFF) = (f32x4){w0g[0] * acc[2 + eh][3][0], w0g[1] * acc[2 + eh][3][1], w0g[2] * acc[2 + eh][3][2], w0g[3] * acc[2 + eh][3][3]};
                }
                const u32x2 pk = {pk2(o[0], o[1]), pk2(o[2], o[3])};
                if (eh == 0) keep[mt] = pk;
                else {
                    const int m = m0 + wt * 64 + 16 * mt + fr;
                    *(u32x4*)(A + (size_t)m * DFF + c0) = (u32x4){keep[mt][0], keep[mt][1], pk[0], pk[1]};
                }
            }
        }
    }
    if (launder_s(ps) == 0) wtile_tail(p, 8 * 44, l * T_LAYER + T_UPEND, l == 0 ? T_LAYER + T_IN : 2 * T_LAYER, smem, launder(tid));
}

DI void phase_down(const Ctx& p, int l, char* smem, int tid) {
    const bf16_t* W = (const bf16_t*)(p.ws() + OFF_WDN) + (size_t)l * SZ_WDN;
    const bf16_t* X = (const bf16_t*)(p.ws() + OFF_ACT);
    bf16_t* A = (bf16_t*)(p.ws() + OFF_ACT);
    const float* EDGE = (const float*)(p.ws() + OFF_EDGE);
    float* out = (float*)(p.ws() + OFF_FO);
    for (int it = 0;; ++it) {
        int mt0, nt0; if (!xcd_tile(it, 64, 8, 8, mt0, nt0)) break;
        const int m0 = mt0 * 128, n0 = nt0 * 128;
        {
            const int t3 = launder(tid);
            const Tok k0 = tok_info(m0, 0);
            const bool hasp = k0.t > 0, hasn = k0.t + 128 < k0.L;
            for (int i = t3; i < 2 * 704; i += 256) {
                const int row = i >= 704 ? 1 : 0, c = (i - row * 704) * 4;
                const float* P = EDGE + ((size_t)mt0 * 4 + (row ? 2 : 0)) * 5632 + c;
                f32x4 u = *(const f32x4*)P, gt = *(const f32x4*)(P + DFF);
                if (row ? hasn : hasp) {
                    const float* C = EDGE + ((size_t)(row ? mt0 + 1 : mt0 - 1) * 4 + (row ? 3 : 1)) * 5632 + c;
                    const f32x4 cu = *(const f32x4*)C, cg = *(const f32x4*)(C + DFF);
                    u += cu; gt += cg;
                }
                const u32x2 pk = {pk2(siluf(gt[0]) * u[0], siluf(gt[1]) * u[1]), pk2(siluf(gt[2]) * u[2], siluf(gt[3]) * u[3])};
                *(u32x2*)(A + (size_t)(m0 + (row ? 127 : 0)) * DFF + c) = pk;
            }
            asm volatile("s_waitcnt vmcnt(0)" ::: "memory");
            __syncthreads();
        }
        f32x4 acc[4][4];
#pragma unroll
        for (int a = 0; a < 4; ++a)
#pragma unroll
            for (int b = 0; b < 4; ++b) acc[a][b] = (f32x4){0.f, 0.f, 0.f, 0.f};
        gemm_kloop<4, 4>(acc, W + (size_t)n0 * DFF, DFF, X + (size_t)m0 * DFF, DFF, DFF, smem, tid);
        const int t2 = launder(tid);
        const int lane = t2 & 63, wv = t2 >> 6, wn = wv >> 1, wt = wv & 1, fr = lane & 15, g = lane >> 4;
        const int fb = n0 + wn * 64 + 16 * g;
#pragma unroll
        for (int mt = 0; mt < 4; ++mt) {
            const int m = m0 + wt * 64 + 16 * mt + fr;
            float* d = out + (size_t)m * 1024 + fb;
#pragma unroll
            for (int a = 0; a < 4; ++a) *(f32x4*)(d + 4 * a) = acc[a][mt];
        }
    }
}

DI void gemm_uq_tile(const Ctx& p, int l, int ps, int tile, char* smem, int tid) {
    const bf16_t* W = (const bf16_t*)(p.ws() + OFF_WUQ) + (size_t)l * SZ_WUQ;
    const bf16_t* X = (const bf16_t*)(p.ws() + OFF_PROJ) + C_MCQ;
    bf16_t* QM = (bf16_t*)(p.ws() + OFF_QM);
    const float* t8 = (const float*)(p.ws() + OFF_T8);
    const int lane = tid & 63, wv = tid >> 6, wn = wv >> 1, wt = wv & 1, fr = lane & 15, g = lane >> 4;
    const int mt0 = tile / 6, nt0 = tile % 6, m0 = mt0 * 128, n0 = nt0 * 128;
    f32x4 acc[4][4];
#pragma unroll
    for (int a = 0; a < 4; ++a)
#pragma unroll
        for (int b = 0; b < 4; ++b) acc[a][b] = (f32x4){0.f, 0.f, 0.f, 0.f};
    gemm_kloop<4, 4>(acc, W + (size_t)n0 * 384, 384, X + (size_t)m0 * INWP, INWP, 384, smem, tid);
    const int fb = n0 + wn * 64 + 16 * g;
    const int o = fb % 96;
#pragma unroll
    for (int mt = 0; mt < 4; ++mt) {
        const int m = m0 + wt * 64 + 16 * mt + fr;
        float v[16];
#pragma unroll
        for (int a = 0; a < 4; ++a)
#pragma unroll
            for (int r = 0; r < 4; ++r) v[4 * a + r] = acc[a][mt][r];
        if (m >= 4096 && o >= 64) {
            const int t = (m - 4096) & 2047;
            const int pos = (o == 64) ? (t >> 6) : (t & 63);
#pragma unroll
            for (int j = 0; j < 8; ++j) {
                const float c = t8[pos * 8 + j], s = t8[512 + pos * 8 + j];
                const float x1 = v[j], x2 = v[j + 8];
                v[j] = x1 * c - x2 * s; v[j + 8] = x2 * c + x1 * s;
            }
        }
        bf16_t* d = QM + (size_t)m * 768 + fb;
        st_wt16(d, pack8(v)); st_wt16(d + 8, pack8(v + 8));
    }
}

DI void gemm_ukv_tile(const Ctx& p, int l, int tile, char* smem, int tid) {
    const bf16_t* W = (const bf16_t*)(p.ws() + OFF_WUKV) + (size_t)l * SZ_WUKV;
    const bf16_t* X = (const bf16_t*)(p.ws() + OFF_CKV);
    bf16_t* KN = (bf16_t*)(p.ws() + OFF_KN);
    bf16_t* VMT = (bf16_t*)(p.ws() + OFF_VMT);
    const int lane = tid & 63, wv = tid >> 6, wn = wv >> 1, wt = wv & 1, fr = lane & 15, g = lane >> 4;
    const int mt0 = tile / 8, nt0 = tile % 8, m0 = mt0 * 128, n0 = nt0 * 128;
    f32x4 acc[4][4];
#pragma unroll
    for (int a = 0; a < 4; ++a)
#pragma unroll
        for (int b = 0; b < 4; ++b) acc[a][b] = (f32x4){0.f, 0.f, 0.f, 0.f};
    gemm_kloop<4, 4>(acc, W + (size_t)n0 * 256, 256, X + (size_t)m0 * 256, 256, 256, smem, tid);
    const int fb = n0 + wn * 64 + 16 * g;
    const int head = fb >> 7, o = fb & 127;
    int key0, Lk;
    if (m0 < 4096) { key0 = m0 & ~255; Lk = 256; } else { const int j = (m0 - 4096) / 2304; key0 = 4096 + j * 2304; Lk = 2304; }
#pragma unroll
    for (int mt = 0; mt < 4; ++mt) {
        const int m = m0 + wt * 64 + 16 * mt + fr;
        float v[16];
#pragma unroll
        for (int a = 0; a < 4; ++a)
#pragma unroll
            for (int r = 0; r < 4; ++r) v[4 * a + r] = acc[a][mt][r];
        if (o < 64) {
            bf16_t* d = KN + (size_t)m * 512 + head * 64 + o;
            st_wt16(d, pack8(v)); st_wt16(d + 8, pack8(v + 8));
        } else {
            bf16_t* d = VMT + (size_t)key0 * 512 + (size_t)(head * 64 + (o - 64)) * Lk + (m - key0);
#pragma unroll
            for (int i = 0; i < 16; ++i) st_wt2(d + (size_t)i * Lk, f2bf(v[i]));
        }
    }
}

DI void phase_merge(const Ctx& p, int l, char* smem, int tid) {
    for (int it = 0;; ++it) {
        int mt0, nt0; if (!xcd_tile(it, 64, 8, 8, mt0, nt0)) break;
        const int m0 = mt0 * 128, n0 = nt0 * 128;
        u32x2 mgp[4][4];
#pragma unroll
        for (int a = 0; a < 4; ++a)
#pragma unroll
            for (int b = 0; b < 4; ++b) mgp[a][b] = (u32x2){0u, 0u};
#pragma unroll 1
        for (int br = 0; br < 4; ++br) {
            u32x2 gpk[4][4];
            {
                f32x4 ga[4][4];
#pragma unroll
                for (int a = 0; a < 4; ++a)
#pragma unroll
                    for (int b = 0; b < 4; ++b) ga[a][b] = (f32x4){0.f, 0.f, 0.f, 0.f};
                gemm_kloop<4, 4, false>(ga, (const bf16_t*)(p.ws() + OFF_WM) + (size_t)l * SZ_WM + (size_t)(br * 1024 + n0) * 1024, 1024,
                                       (const bf16_t*)(p.ws() + OFF_H) + (size_t)m0 * 1024, 1024, 1024, smem, tid);
                const int t2 = launder(tid);
                const int fb = n0 + (t2 >> 7) * 64 + 16 * ((t2 & 63) >> 4);
                const float* bm = p.in(36) + (size_t)l * 4096;
#pragma unroll
                for (int a = 0; a < 4; ++a) {
                    const f32x4 bv = *(const f32x4*)(bm + br * 1024 + fb + 4 * a);
#pragma unroll
                    for (int mt = 0; mt < 4; ++mt) {
                        gpk[a][mt][0] = pk2(sigmoidf(ga[a][mt][0] + bv[0]), sigmoidf(ga[a][mt][1] + bv[1]));
                        gpk[a][mt][1] = pk2(sigmoidf(ga[a][mt][2] + bv[2]), sigmoidf(ga[a][mt][3] + bv[3]));
                    }
                }
            }
            f32x4 pa[4][4];
#pragma unroll
            for (int a = 0; a < 4; ++a)
#pragma unroll
                for (int b = 0; b < 4; ++b) pa[a][b] = (f32x4){0.f, 0.f, 0.f, 0.f};
            const bf16_t* xb; size_t ldb;
            const bf16_t* PROJ = (const bf16_t*)(p.ws() + OFF_PROJ);
            if (br == 0) { xb = PROJ + (size_t)m0 * INWP + C_Z; ldb = INWP; }
            else if (br == 1) { xb = PROJ + (size_t)m0 * INWP + C_RG; ldb = INWP; }
            else if (br == 2) { xb = (const bf16_t*)(p.ws() + OFF_OA) + (size_t)m0 * 512; ldb = 512; }
            else { xb = (const bf16_t*)(p.ws() + OFF_OM) + (size_t)m0 * 512; ldb = 512; }
            gemm_kloop<4, 4, false>(pa, (const bf16_t*)(p.ws() + OFF_WBR) + (size_t)l * SZ_WBR + (size_t)br * 1024 * 512 + (size_t)n0 * 512, 512, xb, ldb, 512, smem, tid);
#pragma unroll
            for (int a = 0; a < 4; ++a)
#pragma unroll
                for (int mt = 0; mt < 4; ++mt) {
                    const float m0 = __uint_as_float(mgp[a][mt][0] << 16) + __uint_as_float(gpk[a][mt][0] << 16) * pa[a][mt][0];
                    const float m1 = __uint_as_float(mgp[a][mt][0] & 0xffff0000u) + __uint_as_float(gpk[a][mt][0] & 0xffff0000u) * pa[a][mt][1];
                    const float m2 = __uint_as_float(mgp[a][mt][1] << 16) + __uint_as_float(gpk[a][mt][1] << 16) * pa[a][mt][2];
                    const float m3 = __uint_as_float(mgp[a][mt][1] & 0xffff0000u) + __uint_as_float(gpk[a][mt][1] & 0xffff0000u) * pa[a][mt][3];
                    mgp[a][mt][0] = pk2(m0, m1); mgp[a][mt][1] = pk2(m2, m3);
                }
        }
        const int t3 = launder(tid);
        const int fr = t3 & 15, g = (t3 & 63) >> 4, wn = t3 >> 7, wt = (t3 >> 6) & 1;
        const int fb = n0 + wn * 64 + 16 * g;
        bf16_t* MG = (bf16_t*)(p.ws() + OFF_MERGED);
#pragma unroll
        for (int mt = 0; mt < 4; ++mt) {
            const int m = m0 + wt * 64 + 16 * mt + fr;
            bf16_t* d = MG + (size_t)m * 1024 + fb;
            *(u32x4*)d = (u32x4){mgp[0][mt][0], mgp[0][mt][1], mgp[1][mt][0], mgp[1][mt][1]};
            *(u32x4*)(d + 8) = (u32x4){mgp[2][mt][0], mgp[2][mt][1], mgp[3][mt][0], mgp[3][mt][1]};
        }
    }
}

DI void prep_token(const Ctx& p, int l, int ps, int m, int lane) {
    char* ws = p.ws();
    bf16_t* PROJ = (bf16_t*)(ws + OFF_PROJ);
    const float* t16 = (const float*)(ws + OFF_T16);
    const float* t8 = (const float*)(ws + OFF_T8);
    const Tok k = tok_info(m, ps);
    bf16_t* pr = PROJ + (size_t)m * INWP;
    if (lane < 16) {
        const float v = ((const float*)(ws + OFF_DTRAW))[(size_t)m * 16 + lane] + p.in(19)[l * 16 + lane];
        const float sp = v > 20.f ? v : log1pe(__expf(v));
        ((float*)(ws + OFF_DT))[(size_t)m * 16 + lane] = sp;
    }
    {
        const int seqkey0 = k.lat ? (k.krow - 256 - k.t) : (k.krow - k.t);
        const int Lk = k.lat ? 2304 : 256;
        const int keyidx = k.krow - seqkey0;
        float v[8];
        if (lane < 32) unpack8(*(const u32x4*)(pr + C_AK + lane * 8), v);
        else {
#pragma unroll
            for (int j = 0; j < 8; ++j) v[j] = 0.f;
        }
        float ss = 0.f;
#pragma unroll
        for (int j = 0; j < 8; ++j) ss += v[j] * v[j];
        ss += shx(ss, 1); ss += shx(ss, 2); ss += shx(ss, 4);
        const float rstd = rsqrtf(ss * (1.f / 64.f) + EPS);
        const int u = lane & 7, axis = u >> 2, pos = axis ? (k.t & 63) : (k.t >> 6);
        float kv[8];
        const float* w = p.in(26) + l * 64 + u * 8;
#pragma unroll
        for (int j = 0; j < 8; ++j) kv[j] = (v[j] * rstd) * w[j];
        float kr[8];
#pragma unroll
        for (int j = 0; j < 8; ++j) {
            const float other = shx(kv[j], 2);
            const int fi = (u & 1) * 8 + j;
            const float c = t16[pos * 16 + fi], s = t16[1024 + pos * 16 + fi];
            kr[j] = (u & 2) ? (kv[j] * c + other * s) : (kv[j] * c - other * s);
        }
        if (lane < 16) {
            if (!k.lat) {
                float* o = p.out() + O_CK + ((size_t)(k.b * 2 + l) * 256 + k.t) * 128 + lane * 8;
                *(f32x4*)o = (f32x4){kv[0], kv[1], kv[2], kv[3]}; *(f32x4*)(o + 4) = (f32x4){kv[4], kv[5], kv[6], kv[7]};
            }
            bf16_t* ka = (bf16_t*)(ws + OFF_KA) + (size_t)k.krow * 128 + lane * 8;
            *(u32x4*)ka = k.lat ? pack8(kr) : pack8(kv);
        } else if (lane < 32) {
            const int d0 = (lane - 16) * 8;
            if (!k.lat) {
                float* o = p.out() + O_CV + ((size_t)(k.b * 2 + l) * 256 + k.t) * 128 + d0;
                *(f32x4*)o = (f32x4){v[0], v[1], v[2], v[3]}; *(f32x4*)(o + 4) = (f32x4){v[4], v[5], v[6], v[7]};
            }
            bf16_t* vt = (bf16_t*)(ws + OFF_VAT) + (size_t)seqkey0 * 128 + (size_t)d0 * Lk + keyidx;
#pragma unroll
            for (int j = 0; j < 8; ++j) vt[(size_t)j * Lk] = f2bf(v[j]);
        }
    }
    {
        float v[8];
        if (lane < 48) unpack8(*(const u32x4*)(pr + C_MCQ + lane * 8), v);
        else {
#pragma unroll
            for (int j = 0; j < 8; ++j) v[j] = 0.f;
        }
        float ss = 0.f;
#pragma unroll
        for (int j = 0; j < 8; ++j) ss += v[j] * v[j];
        ss = wsum(ss);
        const float rstd = rsqrtf(ss * (1.f / 384.f) + EPS);
        if (lane < 48) {
            const float* w = p.in(27) + l * 384 + lane * 8;
#pragma unroll
            for (int j = 0; j < 8; ++j) v[j] = (v[j] * rstd) * w[j];
            *(u32x4*)(pr + C_MCQ + lane * 8) = pack8(v);
        }
    }
    {
        float v[8];
        if (lane < 36) unpack8(*(const u32x4*)(pr + C_MCKV + lane * 8), v);
        else {
#pragma unroll
            for (int j = 0; j < 8; ++j) v[j] = 0.f;
        }
        float ss = 0.f;
        if (lane < 32) {
#pragma unroll
            for (int j = 0; j < 8; ++j) ss += v[j] * v[j];
        }
        ss = wsum(ss);
        const float rstd = rsqrtf(ss * (1.f / 256.f) + EPS);
        const int u = (lane - 32) & 3, axis = u >> 1, pos = axis ? (k.t & 63) : (k.t >> 6);
        float kr[8];
#pragma unroll
        for (int j = 0; j < 8; ++j) {
            const float other = shx(v[j], 1);
            const float c = t8[pos * 8 + j], s = t8[512 + pos * 8 + j];
            kr[j] = (u & 1) ? (v[j] * c + other * s) : (v[j] * c - other * s);
        }
        if (lane < 32) {
            const float* w = p.in(29) + l * 256 + lane * 8;
            float c[8];
#pragma unroll
            for (int j = 0; j < 8; ++j) c[j] = (v[j] * rstd) * w[j];
            if (!k.lat) {
                float* o = p.out() + O_CC + ((size_t)(k.b * 2 + l) * 256 + k.t) * 256 + lane * 8;
                *(f32x4*)o = (f32x4){c[0], c[1], c[2], c[3]}; *(f32x4*)(o + 4) = (f32x4){c[4], c[5], c[6], c[7]};
            }
            *(u32x4*)((bf16_t*)(ws + OFF_CKV) + (size_t)k.krow * 256 + lane * 8) = pack8(c);
        } else if (lane < 36) {
            const int d0 = (lane - 32) * 8;
            if (!k.lat) {
                float* o = p.out() + O_CR + ((size_t)(k.b * 2 + l) * 256 + k.t) * 32 + d0;
                *(f32x4*)o = (f32x4){v[0], v[1], v[2], v[3]}; *(f32x4*)(o + 4) = (f32x4){v[4], v[5], v[6], v[7]};
            }
            *(u32x4*)((bf16_t*)(ws + OFF_KRP) + (size_t)k.krow * 32 + d0) = k.lat ? pack8(kr) : pack8(v);
        }
    }
}
DI void prep_conv_item(const Ctx& p, int l, int ps, int item, int lane) {
    const int run = item >> 1, cbk = item & 1;
    const int c0 = cbk * 512 + lane * 8;
    if (c0 >= 768) return;
    const int m0 = run * 16;
    const Tok k = tok_info(m0, ps);
    const float* cw = p.in(17) + (size_t)l * 3 * 768; const float* cb = p.in(18) + (size_t)l * 768;
    float w[4][8];
#pragma unroll
    for (int tp = 0; tp < 4; ++tp) {
        const float* src = (tp < 3) ? cw + tp * 768 + c0 : cb + c0;
        const f32x4 a0 = *(const f32x4*)src, a1 = *(const f32x4*)(src + 4);
#pragma unroll
        for (int e = 0; e < 4; ++e) { w[tp][e] = a0[e]; w[tp][4 + e] = a1[e]; }
    }
    const bf16_t* xb = (const bf16_t*)(p.ws() + OFF_PROJ) + (size_t)m0 * INWP + C_XBC + c0;
    bf16_t* xo = (bf16_t*)(p.ws() + OFF_XBCA) + (size_t)m0 * 768 + c0;
    const u32x4 zero = {0u, 0u, 0u, 0u};
    u32x4 pv = zero, cv;
    if (k.t > 0) pv = gld16(xb - INWP);
    cv = gld16(xb);
#pragma unroll 4
    for (int i = 0; i < 16; ++i) {
        u32x4 nv = zero;
        if (k.t + i + 1 < k.L) nv = gld16(xb + (size_t)(i + 1) * INWP);
        float a[8], b[8], c[8], o[8];
        unpack8(pv, a); unpack8(cv, b); unpack8(nv, c);
#pragma unroll
        for (int e = 0; e < 8; ++e) o[e] = siluf(w[3][e] + w[0][e] * a[e] + w[1][e] * b[e] + w[2][e] * c[e]);
        *(u32x4*)(xo + (size_t)i * 768) = pack8(o);
        pv = cv; cv = nv;
    }
}
DI void prep_cache_row(const Ctx& p, int l, int ps, int r, int lane) {
    char* ws = p.ws();
    const int j = r >> 8, c = r & 255, b = ps * 2 + j;
    const int key0 = 4096 + j * 2304, krow = key0 + c, Lk = 2304;
    const size_t src = (size_t)(b * 2 + l) * 256 + c;
    if (lane < 16) {
        const float* s = p.in(4) + src * 128 + lane * 8; float v[8];
#pragma unroll
        for (int i = 0; i < 8; ++i) v[i] = s[i];
        *(u32x4*)((bf16_t*)(ws + OFF_KA) + (size_t)krow * 128 + lane * 8) = pack8(v);
    } else if (lane < 32) {
        const int d0 = (lane - 16) * 8;
        const float* s = p.in(5) + src * 128 + d0;
        bf16_t* vt = (bf16_t*)(ws + OFF_VAT) + (size_t)key0 * 128 + (size_t)d0 * Lk + c;
#pragma unroll
        for (int i = 0; i < 8; ++i) vt[(size_t)i * Lk] = f2bf(s[i]);
    } else if (lane < 36) {
        const int d0 = (lane - 32) * 8;
        const float* s = p.in(7) + src * 32 + d0; float v[8];
#pragma unroll
        for (int i = 0; i < 8; ++i) v[i] = s[i];
        *(u32x4*)((bf16_t*)(ws + OFF_KRP) + (size_t)krow * 32 + d0) = pack8(v);
    }
    if (lane < 32) {
        const float* s = p.in(6) + src * 256 + lane * 8; float v[8];
#pragma unroll
        for (int i = 0; i < 8; ++i) v[i] = s[i];
        *(u32x4*)((bf16_t*)(ws + OFF_CKV) + (size_t)krow * 256 + lane * 8) = pack8(v);
    }
}
DI void phase_prep(const Ctx& p, int l, int ps, int tid) {
    const int lane = tid & 63, wv = tid >> 6;
    for (int m = BIDX * 4 + wv; m < NPT + 512 + 1024; m += gridDim.x * 4) {
        if (m < NPT) prep_token(p, l, ps, m, lane); else if (m < NPT + 512) prep_cache_row(p, l, ps, m - NPT, lane); else prep_conv_item(p, l, ps, m - NPT - 512, lane);
    }
}

template <int KC, int NQT>
DI void attn_tile(const bf16_t* __restrict__ Q, size_t ldq, const bf16_t* __restrict__ K1, size_t ldk1, const bf16_t* __restrict__ K2, size_t ldk2,
                  const bf16_t* __restrict__ VT, size_t ldvt, int nkt, float c2, bf16_t* __restrict__ O, size_t ldo,
                  const float* __restrict__ qnw  , const float* __restrict__ rope, int t0  , char* smem, int tid) {
    constexpr int KB = KC * 4096, STG = KB + 8192;
    tid = launder(tid);
    const int lane = tid & 63, w = tid >> 6, fr = lane & 15, g = lane >> 4;
    bf16x8 qf[NQT][KC];
#pragma unroll
    for (int qt = 0; qt < NQT; ++qt)
#pragma unroll
        for (int ks = 0; ks < KC; ++ks) { const u32x4 t4 = gld16(Q + (size_t)(16 * NQT * w + 16 * qt + fr) * ldq + ks * 32 + 8 * g); qf[qt][ks] = __builtin_bit_cast(bf16x8, t4); }
    if (KC == 2 && qnw) {
#pragma unroll
        for (int qt = 0; qt < NQT; ++qt) {
            float v[2][8]; float ss = 0.f;
#pragma unroll
            for (int ks = 0; ks < 2; ++ks) {
                const u32x4 t4 = __builtin_bit_cast(u32x4, qf[qt][ks]); unpack8(t4, v[ks]);
#pragma unroll
                for (int j = 0; j < 8; ++j) ss += v[ks][j] * v[ks][j];
            }
            ss += shx(ss, 16); ss += shx(ss, 32);
            const float rstd = rsqrtf(ss * (1.f / 64.f) + EPS);
            const int t = t0 + 16 * NQT * w + 16 * qt + fr;
#pragma unroll
            for (int ks = 0; ks < 2; ++ks) {
                const int pos = ks ? (t & 63) : (t >> 6);
#pragma unroll
                for (int j = 0; j < 8; ++j) {
                    float x = (v[ks][j] * rstd) * qnw[32 * ks + 8 * g + j];
                    if (rope) {
                        const float other = shx(x, 32);
                        const int fi = (g & 1) * 8 + j;
                        const float c = rope[pos * 16 + fi], sn = rope[1024 + pos * 16 + fi];
                        x = (g & 2) ? (x * c + other * sn) : (x * c - other * sn);
                    }
                    v[ks][j] = x;
                }
                const u32x4 t4 = pack8(v[ks]); qf[qt][ks] = __builtin_bit_cast(bf16x8, t4);
            }
        }
    }
    constexpr int NPK = KC * 4, PPW = (NPK + 8) / 4;
    static_assert((NPK + 8) % 4 == 0, "pieces must divide over 4 waves");
    const int wvu = __builtin_amdgcn_readfirstlane(w);
    unsigned poff[PPW];
#pragma unroll
    for (int j = 0; j < PPW; ++j) {
        const int pc = wvu * PPW + j;
        const bool isk = pc < NPK;
        const int pp = isk ? pc : pc - NPK;
        const int ks = pp >> 2, rb = pp & 3;
        const int rl = lane >> 2, row = rb * 16 + rl;
        const int q = isk ? ((row >> 3) & 3) : ((rl >> 2) & 3);
        const int gl = (lane & 3) ^ FQ(q);
        const unsigned ld = isk ? ((KC == 2 || ks < 2) ? (unsigned)ldk1 : (unsigned)ldk2) : (unsigned)ldvt;
        poff[j] = (unsigned)rl * ld + (unsigned)(gl * 8);
    }
    auto issue = [&](int kt, char* stage) {
#pragma unroll
        for (int j = 0; j < PPW; ++j) {
            const int pc = wvu * PPW + j;
            const bool isk = pc < NPK;
            const int pp = isk ? pc : pc - NPK;
            const int ks = pp >> 2, rb = pp & 3;
            const bf16_t* base;
            if (isk) { if (KC == 2 || ks < 2) base = K1 + ks * 32 + (size_t)(kt * 64 + rb * 16) * ldk1; else base = K2 + (size_t)(kt * 64 + rb * 16) * ldk2; }
            else base = VT + ks * 32 + (size_t)kt * 64 + (size_t)(rb * 16) * ldvt;
            __builtin_amdgcn_global_load_lds((const unsigned*)(base + poff[j]), (unsigned*)(stage + (isk ? 0 : KB) + (ks * 64 + rb * 16) * 64), 16, 0, 0);
        }
    };
    const int koff = tile_off(64, 0, 8 * (fr >> 2) + (fr & 3), g, fr >> 2);
    const int voff = KB + tile_off(64, 0, fr, g, (fr >> 2) & 3);
    f32x4 o[4][NQT];
#pragma unroll
    for (int a = 0; a < 4; ++a)
#pragma unroll
        for (int qt = 0; qt < NQT; ++qt) o[a][qt] = (f32x4){0.f, 0.f, 0.f, 0.f};
    float mrun[NQT], lrun[NQT];
#pragma unroll
    for (int qt = 0; qt < NQT; ++qt) { mrun[qt] = -1e30f; lrun[qt] = 0.f; }
    __syncthreads();
    issue(0, smem);
    if (nkt > 1) {
        issue(1, smem + STG);
        if (PPW == 4) asm volatile("s_waitcnt vmcnt(4)" ::: "memory"); else asm volatile("s_waitcnt vmcnt(5)" ::: "memory");
    } else asm volatile("s_waitcnt vmcnt(0)" ::: "memory");
    __syncthreads();
    int so_cur = 0, so_nn = 2 * STG;
    for (int kt = 0; kt < nkt; ++kt) {
        if (kt + 2 < nkt) issue(kt + 2, smem + so_nn);
        __builtin_amdgcn_sched_barrier(0);
        const char* sb = smem + so_cur;
        f32x4 s[4][NQT];
#pragma unroll
        for (int a = 0; a < 4; ++a)
#pragma unroll
            for (int qt = 0; qt < NQT; ++qt) s[a][qt] = (f32x4){0.f, 0.f, 0.f, 0.f};
        bf16x8 kf[KC][4];
#pragma unroll
        for (int ks = 0; ks < KC; ++ks)
#pragma unroll
            for (int a = 0; a < 4; ++a) kf[ks][a] = *(const bf16x8*)(sb + koff + ((a >> 1) * 32 + (a & 1) * 4) * 64 + ks * 4096);
        __builtin_amdgcn_sched_barrier(0);
#pragma unroll
        for (int ks = 0; ks < KC; ++ks)
#pragma unroll
            for (int a = 0; a < 4; ++a) {
#pragma unroll
                for (int qt = 0; qt < NQT; ++qt) s[a][qt] = __builtin_amdgcn_mfma_f32_16x16x32_bf16(kf[ks][a], qf[qt][ks], s[a][qt], 0, 0, 0);
            }
        bf16x8 vfr[2][4];
#pragma unroll
        for (int s2 = 0; s2 < 2; ++s2)
#pragma unroll
            for (int dt = 0; dt < 4; ++dt) vfr[s2][dt] = *(const bf16x8*)(sb + voff + dt * 1024 + s2 * 4096);
        __builtin_amdgcn_sched_barrier(0);
        bf16x8 pf[NQT][2];
#pragma unroll
        for (int qt = 0; qt < NQT; ++qt) {
            float mx = s[0][qt][0];
#pragma unroll
            for (int a = 0; a < 4; ++a)
#pragma unroll
                for (int r = 0; r < 4; ++r) mx = fmaxf(mx, s[a][qt][r]);
            mx = gmax4(mx);
            const float mnew = fmaxf(mrun[qt], mx);
            const float alpha = __builtin_amdgcn_exp2f((mrun[qt] - mnew) * c2);
            mrun[qt] = mnew;
            const float mc = mnew * c2;
            float ls = 0.f; float pv[16];
#pragma unroll
            for (int a = 0; a < 4; ++a)
#pragma unroll
                for (int r = 0; r < 4; ++r) { const float e = __builtin_amdgcn_exp2f(s[a][qt][r] * c2 - mc); pv[4 * a + r] = e; ls += e; }
            lrun[qt] = lrun[qt] * alpha + ls;
#pragma unroll
            for (int a = 0; a < 4; ++a) o[a][qt] = o[a][qt] * alpha;
            u32x4 w0 = pack8(pv), w1 = pack8(pv + 8);
            pf[qt][0] = __builtin_bit_cast(bf16x8, w0); pf[qt][1] = __builtin_bit_cast(bf16x8, w1);
        }
        __builtin_amdgcn_sched_barrier(0);
#pragma unroll
        for (int s2 = 0; s2 < 2; ++s2)
#pragma unroll
            for (int dt = 0; dt < 4; ++dt) {
#pragma unroll
                for (int qt = 0; qt < NQT; ++qt) o[dt][qt] = __builtin_amdgcn_mfma_f32_16x16x32_bf16(vfr[s2][dt], pf[qt][s2], o[dt][qt], 0, 0, 0);
            }
        __builtin_amdgcn_sched_barrier(0);
        if (kt + 2 < nkt) { if (PPW == 4) asm volatile("s_waitcnt vmcnt(4)" ::: "memory"); else asm volatile("s_waitcnt vmcnt(5)" ::: "memory"); }
        else asm volatile("s_waitcnt vmcnt(0)" ::: "memory");
        asm volatile("s_waitcnt lgkmcnt(0)" ::: "memory");
        __builtin_amdgcn_s_barrier();
        so_cur = (so_cur == 2 * STG) ? 0 : so_cur + STG;
        so_nn = (so_nn == 2 * STG) ? 0 : so_nn + STG;
    }
#pragma unroll
    for (int qt = 0; qt < NQT; ++qt) {
        float l = gsum4(lrun[qt]);
        const float inv = 1.f / l;
        bf16_t* orow = O + (size_t)(16 * NQT * w + 16 * qt + fr) * ldo + 4 * g;
#pragma unroll
        for (int dt = 0; dt < 4; ++dt) {
            u32x2 wv2; wv2[0] = pk2(o[dt][qt][0] * inv, o[dt][qt][1] * inv); wv2[1] = pk2(o[dt][qt][2] * inv, o[dt][qt][3] * inv);
            *(u32x2*)(orow + 16 * dt) = wv2;
        }
    }
}

struct Seq { int lat, tok0, L, key0, Lk, b; };
DI Seq seq_info(int s, int ps) {
    Seq q;
    if (s < 16) { q.lat = 0; q.tok0 = s * 256; q.L = 256; q.key0 = s * 256; q.Lk = 256; q.b = ps * 16 + s; }
    else { const int j = s - 16; q.lat = 1; q.tok0 = 4096 + j * 2048; q.L = 2048; q.key0 = 4096 + j * 2304; q.Lk = 2304; q.b = ps * 2 + j; }
    return q;
}
DI void attn_gqa_item(const Ctx& p, int l, int s, int head, int qb, int ps, char* smem, int tid) {
    const Seq q = seq_info(s, ps);
    const int rows = 128;
    const bf16_t* PROJ = (const bf16_t*)(p.ws() + OFF_PROJ);
    const bf16_t* Q = PROJ + (size_t)(q.tok0 + qb * rows) * INWP + C_AQ + head * 64;
    const int kh = head >> 2;
    const bf16_t* K = (const bf16_t*)(p.ws() + OFF_KA) + (size_t)q.key0 * 128 + kh * 64;
    const bf16_t* VT = (const bf16_t*)(p.ws() + OFF_VAT) + (size_t)q.key0 * 128 + (size_t)kh * 64 * q.Lk;
    bf16_t* O = (bf16_t*)(p.ws() + OFF_OA) + (size_t)(q.tok0 + qb * rows) * 512 + head * 64;
    const float c2 = 0.125f * 1.4426950408889634f;
    attn_tile<2, 2>(Q, INWP, K, 128, K, 128, VT, q.Lk, q.Lk / 64, c2, O, 512, p.in(25) + l * 64, q.lat ? (const float*)(p.ws() + OFF_T16) : nullptr, qb * 128, smem, tid);
}
DI void attn_mla_item(const Ctx& p, int s, int head, int qb, int ps, char* smem, int tid) {
    const Seq q = seq_info(s, ps);
    const int rows = 128;
    const bf16_t* Q = (const bf16_t*)(p.ws() + OFF_QM) + (size_t)(q.tok0 + qb * rows) * 768 + head * 96;
    const bf16_t* K1 = (const bf16_t*)(p.ws() + OFF_KN) + (size_t)q.key0 * 512 + head * 64;
    const bf16_t* K2 = (const bf16_t*)(p.ws() + OFF_KRP) + (size_t)q.key0 * 32;
    const bf16_t* VT = (const bf16_t*)(p.ws() + OFF_VMT) + (size_t)q.key0 * 512 + (size_t)head * 64 * q.Lk;
    bf16_t* O = (bf16_t*)(p.ws() + OFF_OM) + (size_t)(q.tok0 + qb * rows) * 512 + head * 64;
    const float c2 = 0.10206207261596577f * 1.4426950408889634f;
    attn_tile<3, 2>(Q, 768, K1, 512, K2, 32, VT, q.Lk, q.Lk / 64, c2, O, 512, nullptr, nullptr, 0, smem, tid);
}

template <int ET>
DI void scan_item(const bf16_t* __restrict__ Qp, size_t ldq, const bf16_t* __restrict__ Kp, size_t ldk, const bf16_t* __restrict__ Vp, size_t ldv,
                  const float* __restrict__ dtp  , float acoef  ,
                  int L, int dir, const float* __restrict__ s0, float* __restrict__ sout, int lds_state  , bf16_t* __restrict__ Op, size_t ldo,
                  const float* __restrict__ rope  , float kmul,
                  int nbase  , int nch  , const bf16_t* __restrict__ s0b  ,
                  bf16_t* __restrict__ lout  , float* __restrict__ dout  , char* smem, int tid) {
    constexpr int DV = 16 * ET;
    const bool stateonly = (lout != nullptr);
    constexpr int QS = 0, KS = 8192, KT = 16384, VTO = 24576, STO = VTO + DV * 128, ACO = STO + DV * 128;
    constexpr int NV = DV / 32;
    tid = launder(tid);
    const int lane = tid & 63, w = tid >> 6, fr = lane & 15, g = lane >> 4;
    float* acs = (float*)(smem + ACO);
    f32x4 sacc[ET];
#pragma unroll
    for (int et = 0; et < ET; ++et) {
        if (s0) {
#pragma unroll
            for (int r = 0; r < 4; ++r) sacc[et][r] = s0[(size_t)(16 * w + 4 * g + r) * lds_state + 16 * et + fr];
        } else if (s0b) {
#pragma unroll
            for (int r = 0; r < 4; ++r) sacc[et][r] = bf2f(s0b[(16 * w + 4 * g + r) * DV + 16 * et + fr]);
        } else sacc[et] = (f32x4){0.f, 0.f, 0.f, 0.f};
    }
    const int st_off = STO + ((w >> 1) * DV) * 64 + (g & 1) * 8;
    const int st_gg = (2 * w + (g >> 1)) & 3;
    __syncthreads();
    float* ropeL = (float*)(smem + ACO + 256);
    if (rope) {
#pragma unroll
        for (int i = 0; i < 2; ++i) *(f32x4*)(ropeL + (tid + 256 * i) * 4) = *(const f32x4*)(rope + (tid + 256 * i) * 4);
    }
#pragma unroll
    for (int et = 0; et < ET; ++et) {
        const int e = 16 * et + fr;
        u32x2 wv2; wv2[0] = pk2(sacc[et][0], sacc[et][1]); wv2[1] = pk2(sacc[et][2], sacc[et][3]);
        *(u32x2*)(smem + st_off + e * 64 + ((st_gg ^ FQ((e >> 2) & 3)) << 4)) = wv2;
    }
    __syncthreads();
    float dprod = 1.f;
    const int qoff = QS + tile_off(64, 0, 16 * w + fr, g, (fr >> 2) & 3);
    const int koff = KS + tile_off(64, 0, 8 * (fr >> 2) + (fr & 3), g, fr >> 2);
    const int ktoff = KT + tile_off(64, 0, 16 * w + fr, g, (fr >> 2) & 3);
    const int vtoff = VTO + tile_off(DV, 0, fr, g, (fr >> 2) & 3);
    const int stoff = STO + tile_off(DV, 0, fr, g, (fr >> 2) & 3);
    u32x4 gq[2], gk[2], gv[NV]; float gdt = 1.f;
    auto issue = [&](int c) {
        const int n0 = nbase + c * 64;
        {
            const int row = tid >> 2, cc0 = (tid & 1) | ((tid & 2) << 1);
            const int tl = dir ? (L - 1 - (n0 + row)) : (n0 + row);
#pragma unroll
            for (int i = 0; i < 2; ++i) {
                gq[i] = gld16(Qp + (size_t)tl * ldq + (cc0 + 2 * i) * 8);
                gk[i] = gld16(Kp + (size_t)tl * ldk + (cc0 + 2 * i) * 8);
            }
        }
#pragma unroll
        for (int i = 0; i < NV; ++i) {
            const int q = tid + 256 * i, row = q / (DV / 8), cc = q % (DV / 8);
            const int tl = dir ? (L - 1 - (n0 + row)) : (n0 + row);
            gv[i] = gld16(Vp + (size_t)tl * ldv + cc * 8);
        }
        if (dtp) { const int tl = dir ? (L - 1 - (n0 + lane)) : (n0 + lane); gdt = dtp[(size_t)tl * 16]; }
    };
    issue(0);
    for (int c = 0; c < nch; ++c) {
        const int n0 = nbase + c * 64;
        const float dtv = gdt;
        const float la = dtp ? dtv * acoef : acoef;
        float ac, aend;
        if (dtp) {
            ac = la;
#pragma unroll
            for (int o = 1; o < 64; o <<= 1) { const float t = shu(ac, o); if (lane >= o) ac += t; }
            aend = shf(ac, 63);
        } else { ac = (float)(lane + 1) * la; aend = 64.f * la; }
        if (w == 0) acs[lane] = ac;
        {
            const int row = tid >> 2, cc0 = (tid & 1) | ((tid & 2) << 1);
            const float ksc = shf(dtv, row) * kmul, wend = __expf(aend - shf(ac, row));
            float qa[2][8], ka[2][8];
#pragma unroll
            for (int i = 0; i < 2; ++i) { unpack8(gq[i], qa[i]); unpack8(gk[i], ka[i]); }
            if (rope) {
                const int tlr = dir ? (L - 1 - (n0 + row)) : (n0 + row);
                const int pos = (cc0 >> 2) ? (tlr & 63) : (tlr >> 6);
                const float* rp = ropeL + pos * 16 + (cc0 & 1) * 8;
                f32x4 rc[2], rs[2];
                rc[0] = *(const f32x4*)rp; rc[1] = *(const f32x4*)(rp + 4); rs[0] = *(const f32x4*)(rp + 1024); rs[1] = *(const f32x4*)(rp + 1028);
#pragma unroll
                for (int j = 0; j < 8; ++j) {
                    const float c = rc[j >> 2][j & 3], sn = rs[j >> 2][j & 3];
                    const float q1 = qa[0][j], q2 = qa[1][j], k1 = ka[0][j], k2 = ka[1][j];
                    qa[0][j] = q1 * c - q2 * sn; qa[1][j] = q2 * c + q1 * sn;
                    ka[0][j] = k1 * c - k2 * sn; ka[1][j] = k2 * c + k1 * sn;
                }
            }
#pragma unroll
            for (int i = 0; i < 2; ++i) {
                const int cc = cc0 + 2 * i;
                if (rope) *(u32x4*)(smem + QS + tile_off(64, cc >> 2, row, cc & 3, (row >> 2) & 3)) = pack8(qa[i]);
                else *(u32x4*)(smem + QS + tile_off(64, cc >> 2, row, cc & 3, (row >> 2) & 3)) = gq[i];
#pragma unroll
                for (int j = 0; j < 8; ++j) ka[i][j] *= ksc;
                *(u32x4*)(smem + KS + tile_off(64, cc >> 2, row, cc & 3, (row >> 3) & 3)) = pack8(ka[i]);
#pragma unroll
                for (int j = 0; j < 8; ++j) {
                    const int d = cc * 8 + j;
                    *(bf16_t*)(smem + KT + tile_off(64, row >> 5, d, (row >> 3) & 3, (d >> 2) & 3) + (row & 7) * 2) = f2bf(ka[i][j] * wend);
                }
            }
        }
#pragma unroll
        for (int i = 0; i < NV; ++i) {
            const int q = tid + 256 * i, row = q / (DV / 8), cc = q % (DV / 8);
            const u32x4 vv = gv[i];
#pragma unroll
            for (int j = 0; j < 8; ++j) {
                const int e = cc * 8 + j;
                const unsigned short h = (unsigned short)(vv[j >> 1] >> (16 * (j & 1)));
                *(bf16_t*)(smem + VTO + tile_off(DV, row >> 5, e, (row >> 3) & 3, (e >> 2) & 3) + (row & 7) * 2) = h;
            }
        }
        if (c + 1 < nch) issue(c + 1);
        __builtin_amdgcn_sched_barrier(0);
        __syncthreads();
        {
            const int irow = 16 * w + fr;
            const int ns = (w >> 1) + 1;
            bf16x8 qfr[2], sf[ET][2], kfa[2][2][2], vf[2][ET], kt2[2];
            qfr[0] = *(const bf16x8*)(smem + qoff); qfr[1] = *(const bf16x8*)(smem + qoff + 4096);
#pragma unroll
            for (int et = 0; et < ET; ++et)
#pragma unroll
                for (int ks = 0; ks < 2; ++ks) sf[et][ks] = *(const bf16x8*)(smem + stoff + et * 1024 + ks * DV * 64);
#pragma unroll
            for (int aa = 0; aa < 2; ++aa)
#pragma unroll
                for (int ks = 0; ks < 2; ++ks) kfa[0][aa][ks] = *(const bf16x8*)(smem + koff + (4 * aa) * 64 + ks * 4096);
            const float ai = acs[irow];
            f32x4 ajv[2][2];
#pragma unroll
            for (int aa = 0; aa < 2; ++aa) ajv[0][aa] = *(const f32x4*)(acs + 8 * g + 4 * aa);
            const float cd = __expf(acs[63]);
            __builtin_amdgcn_sched_barrier(0);
            f32x4 o[ET];
            if (!stateonly) {
#pragma unroll
                for (int et = 0; et < ET; ++et) {
                    o[et] = (f32x4){0.f, 0.f, 0.f, 0.f};
#pragma unroll
                    for (int ks = 0; ks < 2; ++ks) o[et] = __builtin_amdgcn_mfma_f32_16x16x32_bf16(sf[et][ks], qfr[ks], o[et], 0, 0, 0);
                }
            }
#pragma unroll
            for (int aa = 0; aa < 2; ++aa)
#pragma unroll
                for (int ks = 0; ks < 2; ++ks) kfa[1][aa][ks] = *(const bf16x8*)(smem + koff + (32 + 4 * aa) * 64 + ks * 4096);
#pragma unroll
            for (int ks = 0; ks < 2; ++ks) {
#pragma unroll
                for (int et = 0; et < ET; ++et) vf[ks][et] = *(const bf16x8*)(smem + vtoff + et * 1024 + ks * DV * 64);
                kt2[ks] = *(const bf16x8*)(smem + ktoff + ks * 4096);
            }
#pragma unroll
            for (int aa = 0; aa < 2; ++aa) ajv[1][aa] = *(const f32x4*)(acs + 32 + 8 * g + 4 * aa);
            __builtin_amdgcn_sched_barrier(0);
            if (!stateonly) {
                const float ei = __expf(ai);
#pragma unroll
                for (int et = 0; et < ET; ++et) o[et] = o[et] * ei;
#pragma unroll
                for (int s2 = 0; s2 < 2; ++s2) {
                    if (s2 < ns) {
                        f32x4 pp[2];
#pragma unroll
                        for (int aa = 0; aa < 2; ++aa) {
                            pp[aa] = (f32x4){0.f, 0.f, 0.f, 0.f};
#pragma unroll
                            for (int ks = 0; ks < 2; ++ks) pp[aa] = __builtin_amdgcn_mfma_f32_16x16x32_bf16(kfa[s2][aa][ks], qfr[ks], pp[aa], 0, 0, 0);
                        }
                        float pv[8];
#pragma unroll
                        for (int aa = 0; aa < 2; ++aa) {
                            const int j0 = 32 * s2 + 8 * g + 4 * aa;
#pragma unroll
                            for (int r = 0; r < 4; ++r) {
                                const float dec = __expf(fminf(ai - ajv[s2][aa][r], 0.f));
                                pv[4 * aa + r] = (j0 + r <= irow) ? pp[aa][r] * dec : 0.f;
                            }
                        }
                        const u32x4 pw = pack8(pv);
                        const bf16x8 pf = __builtin_bit_cast(bf16x8, pw);
#pragma unroll
                        for (int et = 0; et < ET; ++et) o[et] = __builtin_amdgcn_mfma_f32_16x16x32_bf16(vf[s2][et], pf, o[et], 0, 0, 0);
                    }
                }
                const int tl = dir ? (L - 1 - (n0 + irow)) : (n0 + irow);
                bf16_t* orow = Op + (size_t)tl * ldo + 4 * g;
#pragma unroll
                for (int et = 0; et < ET; ++et) {
                    u32x2 wv2; wv2[0] = pk2(o[et][0], o[et][1]); wv2[1] = pk2(o[et][2], o[et][3]);
                    st_wt8(orow + 16 * et, wv2);
                }
            }
            dprod *= cd;
#pragma unroll
            for (int et = 0; et < ET; ++et) sacc[et] = sacc[et] * cd;
#pragma unroll
            for (int ks = 0; ks < 2; ++ks)
#pragma unroll
                for (int et = 0; et < ET; ++et) sacc[et] = __builtin_amdgcn_mfma_f32_16x16x32_bf16(kt2[ks], vf[ks][et], sacc[et], 0, 0, 0);
        }
        __syncthreads();
#pragma unroll
        for (int et = 0; et < ET; ++et) {
            const int e = 16 * et + fr;
            u32x2 wv2; wv2[0] = pk2(sacc[et][0], sacc[et][1]); wv2[1] = pk2(sacc[et][2], sacc[et][3]);
            *(u32x2*)(smem + st_off + e * 64 + ((st_gg ^ FQ((e >> 2) & 3)) << 4)) = wv2;
        }
    }
    if (sout) {
#pragma unroll
        for (int et = 0; et < ET; ++et)
#pragma unroll
            for (int r = 0; r < 4; ++r) sout[(size_t)(16 * w + 4 * g + r) * lds_state + 16 * et + fr] = sacc[et][r];
    }
    if (lout) {
#pragma unroll
        for (int et = 0; et < ET; ++et)
#pragma unroll
            for (int r = 0; r < 4; ++r) st_wt2(lout + (16 * w + 4 * g + r) * DV + 16 * et + fr, f2bf(sacc[et][r]));
        if (tid == 0) st_wt4f(dout, dprod);
    }
    __syncthreads();
}

DI void scan_any_item(const Ctx& p, int l, int ps, int isret, int s, int h, int dir, int half, int mode, int seg, int sid, char* smem, int tid) {
    const Seq q = seq_info(s, ps);
    const bf16_t *Qp, *Kp, *Vp; size_t ld; const float* dtp; float acoef, kmul; const float* rope; bf16_t* O; float* so; int lds;
    if (isret) {
        const bf16_t* PR = (const bf16_t*)(p.ws() + OFF_PROJ) + (size_t)q.tok0 * INWP;
        const float x = p.in(23)[l * 8 + dir * 4 + h];
        acoef = fminf(x, 0.f) - log1pe(__expf(-fabsf(x)));
        Qp = PR + C_RQ + h * 64; Kp = PR + C_RK + h * 64; Vp = PR + C_RV + h * 128 + half * 64; ld = INWP; dtp = nullptr; kmul = 0.125f;
        rope = q.lat ? (const float*)(p.ws() + OFF_T16) : nullptr;
        O = (bf16_t*)(p.ws() + OFF_OR) + ((size_t)dir * NPT + q.tok0) * 512 + h * 128 + half * 64;
        so = p.out() + O_RET + ((size_t)((q.b * 2 + l) * 2 + dir) * 4 + h) * 8192 + half * 64; lds = 128;
    } else {
        const bf16_t* XB = (const bf16_t*)(p.ws() + OFF_XBCA) + (size_t)q.tok0 * 768;
        const int grp = h >> 2;
        Qp = XB + 640 + grp * 64; Kp = XB + 512 + grp * 64; Vp = XB + h * 64; ld = 768; kmul = 1.f; rope = nullptr;
        dtp = (const float*)(p.ws() + OFF_DT) + (size_t)q.tok0 * 16 + dir * 8 + h;
        acoef = -__expf(p.in(20)[l * 16 + dir * 8 + h]);
        O = (bf16_t*)(p.ws() + OFF_OS) + ((size_t)dir * NPT + q.tok0) * 512 + h * 64;
        so = p.out() + O_SSD + ((size_t)((q.b * 2 + l) * 2 + dir) * 8 + h) * 4096; lds = 64;
    }
    bf16_t* segb = (bf16_t*)(p.ws() + OFF_SEG) + (size_t)(sid * NSEG + seg) * 4096;
    float* segd = (float*)(p.ws() + OFF_SEGD) + sid * NSEG + seg;
    scan_item<4>(Qp, ld, Kp, ld, Vp, ld, dtp, acoef, q.L, dir, nullptr, mode == 0 ? so : nullptr, lds, O, 512, rope, kmul,
                 mode == 0 ? 0 : seg * SEGTOK, mode == 0 ? (q.L >> 6) : (SEGTOK >> 6), mode == 3 ? segb : nullptr, mode == 1 ? segb : nullptr, mode == 1 ? segd : nullptr, smem, tid);
}
DI void scan_combine_item(const Ctx& p, int l, int ps, int sid, int tid) {
    const float* s0; int ld;
    if (sid < 32) { const int b = ps * 2 + (sid >> 4), h = (sid >> 1) & 7, dir = sid & 1; s0 = p.in(2) + ((size_t)((b * 2 + l) * 2 + dir) * 8 + h) * 4096; ld = 64; }
    else { const int k = sid - 32, b = ps * 2 + (k >> 4), h = (k >> 2) & 3, dir = (k >> 1) & 1, half = k & 1;
           s0 = p.in(3) + ((size_t)((b * 2 + l) * 2 + dir) * 4 + h) * 8192 + half * 64; ld = 128; }
    bf16_t* segb = (bf16_t*)(p.ws() + OFF_SEG) + (size_t)sid * NSEG * 4096;
    const float* segd = (const float*)(p.ws() + OFF_SEGD) + sid * NSEG;
    const int t2 = launder(tid);
    const float* sp = s0 + (size_t)(t2 >> 2) * ld + (t2 & 3) * 16;
    bf16_t* bp = segb + t2 * 16;
    float S[16];
#pragma unroll
    for (int k = 0; k < 4; ++k) { const f32x4 v = *(const f32x4*)(sp + 4 * k); S[4 * k] = v[0]; S[4 * k + 1] = v[1]; S[4 * k + 2] = v[2]; S[4 * k + 3] = v[3]; }
#pragma unroll 1
    for (int g2 = 0; g2 < NSEG; ++g2) {
        float loc[16]; float d = 0.f;
        if (g2 < NSEG - 1) { d = segd[g2]; unpack8(*(const u32x4*)(bp + g2 * 4096), loc); unpack8(*(const u32x4*)(bp + g2 * 4096 + 8), loc + 8); }
        else {
#pragma unroll
            for (int k = 0; k < 16; ++k) loc[k] = 0.f;
        }
        st_wt16(bp + g2 * 4096, pack8(S)); st_wt16(bp + g2 * 4096 + 8, pack8(S + 8));
#pragma unroll
        for (int k = 0; k < 16; ++k) S[k] = S[k] * d + loc[k];
    }
}

DI void postscan_token(const Ctx& p, int l, int m, int lane) {
    char* ws = p.ws();
    bf16_t* pr = (bf16_t*)(ws + OFF_PROJ) + (size_t)m * INWP;
    const int c0 = lane * 8;
    {
        const bf16_t* OS = (const bf16_t*)(ws + OFF_OS);
        float a[8], b[8], xs[8], z[8];
        unpack8(*(const u32x4*)(OS + (size_t)m * 512 + c0), a);
        unpack8(*(const u32x4*)(OS + ((size_t)NPT + m) * 512 + c0), b);
        unpack8(*(const u32x4*)((const bf16_t*)(ws + OFF_XBCA) + (size_t)m * 768 + c0), xs);
        unpack8(*(const u32x4*)(pr + C_Z + c0), z);
        const float dsk = p.in(21)[l * 8 + (c0 >> 6)];
        float v[8], ss = 0.f;
#pragma unroll
        for (int j = 0; j < 8; ++j) { v[j] = ((a[j] + b[j]) + dsk * xs[j]) * siluf(z[j]); ss += v[j] * v[j]; }
        ss = wsum(ss);
        const float rstd = rsqrtf(ss * (1.f / 512.f) + EPS);
        const float* w = p.in(22) + l * 512 + c0;
#pragma unroll
        for (int j = 0; j < 8; ++j) v[j] = (v[j] * rstd) * w[j];
        *(u32x4*)(pr + C_Z + c0) = pack8(v);
    }
    {
        const bf16_t* ORb = (const bf16_t*)(ws + OFF_OR);
        float a[8], b[8], gt[8];
        unpack8(*(const u32x4*)(ORb + (size_t)m * 512 + c0), a);
        unpack8(*(const u32x4*)(ORb + ((size_t)NPT + m) * 512 + c0), b);
        unpack8(*(const u32x4*)(pr + C_RG + c0), gt);
        float v[8], sm = 0.f;
#pragma unroll
        for (int j = 0; j < 8; ++j) { v[j] = a[j] + b[j]; sm += v[j]; }
        sm += shx(sm, 1); sm += shx(sm, 2); sm += shx(sm, 4); sm += shx(sm, 8);
        const float mean = sm * (1.f / 128.f);
        float sq = 0.f;
#pragma unroll
        for (int j = 0; j < 8; ++j) { v[j] -= mean; sq += v[j] * v[j]; }
        sq += shx(sq, 1); sq += shx(sq, 2); sq += shx(sq, 4); sq += shx(sq, 8);
        const float rstd = rsqrtf(sq * (1.f / 128.f) + EPS);
        const float* w = p.in(24) + l * 512 + c0;
#pragma unroll
        for (int j = 0; j < 8; ++j) v[j] = (v[j] * rstd) * w[j] * siluf(gt[j]);
        *(u32x4*)(pr + C_RG + c0) = pack8(v);
    }
}

DI void phase_act(const Ctx& p, int l, int ps, int tid) {
    tid = launder(tid);
    const int lane = tid & 63, wv = tid >> 6;
    const bf16_t* U = (const bf16_t*)(p.ws() + OFF_U);
    bf16_t* A = (bf16_t*)(p.ws() + OFF_ACT);
    const float* cw = p.in(39) + (size_t)l * 3 * 5632; const float* cb = p.in(40) + (size_t)l * 5632;
    for (int item = BIDX * 4 + wv; item < 512 * 6; item += gridDim.x * 4) {
        const int run = item / 6, cbk = item % 6;
        const int j0 = cbk * 512 + lane * 8;
        if (j0 >= DFF) continue;
        const int m0 = run * 16;
        const Tok k = tok_info(m0, ps);
        float wu[4][8], wg[4][8];
#pragma unroll
        for (int tp = 0; tp < 3; ++tp) {
            const f32x4 a0 = *(const f32x4*)(cw + tp * 5632 + j0), a1 = *(const f32x4*)(cw + tp * 5632 + j0 + 4);
            const f32x4 g0 = *(const f32x4*)(cw + tp * 5632 + DFF + j0), g1 = *(const f32x4*)(cw + tp * 5632 + DFF + j0 + 4);
#pragma unroll
            for (int e = 0; e < 4; ++e) { wu[tp][e] = a0[e]; wu[tp][4 + e] = a1[e]; wg[tp][e] = g0[e]; wg[tp][4 + e] = g1[e]; }
        }
        {
            const f32x4 a0 = *(const f32x4*)(cb + j0), a1 = *(const f32x4*)(cb + j0 + 4);
            const f32x4 g0 = *(const f32x4*)(cb + DFF + j0), g1 = *(const f32x4*)(cb + DFF + j0 + 4);
#pragma unroll
            for (int e = 0; e < 4; ++e) { wu[3][e] = a0[e]; wu[3][4 + e] = a1[e]; wg[3][e] = g0[e]; wg[3][4 + e] = g1[e]; }
        }
        const bf16_t* ub = U + (size_t)m0 * 5632 + j0;
        const u32x4 zero = {0u, 0u, 0u, 0u};
        u32x4 pu = zero, pg = zero, cu, cg;
        if (k.t > 0) { pu = gld16(ub - 5632); pg = gld16(ub - 5632 + DFF); }
        cu = gld16(ub); cg = gld16(ub + DFF);
#pragma unroll 4
        for (int i = 0; i < 16; ++i) {
            u32x4 nu = zero, ng = zero;
            if (k.t + i + 1 < k.L) { nu = gld16(ub + (size_t)(i + 1) * 5632); ng = gld16(ub + (size_t)(i + 1) * 5632 + DFF); }
            float a[8], b[8], c[8], o[8];
            unpack8(pu, a); unpack8(cu, b); unpack8(nu, c);
            float up[8];
#pragma unroll
            for (int e = 0; e < 8; ++e) up[e] = wu[3][e] + wu[0][e] * a[e] + wu[1][e] * b[e] + wu[2][e] * c[e];
            unpack8(pg, a); unpack8(cg, b); unpack8(ng, c);
#pragma unroll
            for (int e = 0; e < 8; ++e) { const float gt = wg[3][e] + wg[0][e] * a[e] + wg[1][e] * b[e] + wg[2][e] * c[e]; o[e] = siluf(gt) * up[e]; }
            *(u32x4*)(A + (size_t)(m0 + i) * DFF + j0) = pack8(o);
            pu = cu; pg = cg; cu = nu; cg = ng;
        }
    }
}

DI int next_item(unsigned* ctr, volatile LAS unsigned* slot, int tid) {
    __syncthreads();
    if (tid == 0) *slot = __hip_atomic_fetch_add(ctr, 1u, __ATOMIC_RELAXED, __HIP_MEMORY_SCOPE_AGENT);
    __syncthreads();
    return (int)*slot;
}

#ifndef ONLY2
#define ONLY2 -1
#endif
#ifndef PROBE_KIND
#define PROBE_KIND -1
#endif
DI void item_publish(unsigned* cnt, int tid) {
    asm volatile("s_waitcnt vmcnt(0)" ::: "memory");
    __syncthreads();
    if (tid == 0) __hip_atomic_fetch_add(cnt, 1u, __ATOMIC_RELAXED, __HIP_MEMORY_SCOPE_AGENT);
}
DI void item_wait(unsigned* cnt, unsigned need, int tid) {
    if (tid == 0) {
        unsigned sp = 0;
        while (__hip_atomic_load(cnt, __ATOMIC_RELAXED, __HIP_MEMORY_SCOPE_AGENT) < need) { __builtin_amdgcn_s_sleep(2); if (++sp > (1u << 24)) break; }
        __builtin_amdgcn_fence(__ATOMIC_ACQUIRE, "agent");
        asm volatile("s_waitcnt vmcnt(0)" ::: "memory");
    }
    __syncthreads();
}
DI void phase_mix(const Ctx& p, int l, int ps, unsigned* ctr, unsigned* c12, volatile LAS unsigned* slot, char* smem, int tid) {
    unsigned* gdone = ctr + 64; unsigned* sdone = ctr + 128;
    unsigned* c1 = c12; unsigned* c2 = c12 + 64;
    constexpr int N1 = 64 * (NSEG - 1), N3 = 64 * NSEG;
    constexpr int A0 = N1, A1 = A0 + 384, A2 = A1 + 544, A3 = A2 + 256, A4 = A3 + 64, A5 = A4 + N3, A6 = A5 + 256, A7 = A6 + 256, A8 = A7 + 256, A9 = A8 + 256, A10 = A9 + 256, A11 = A10 + 256;
    for (;;) {
        tid = launder(tid);
        l = launder_s(l); ps = launder_s(ps);
        int it = next_item(ctr, slot, tid);
        const int nwi = ps == 0 ? T_UP / 4 : 0;
        if (it >= A11 + nwi) break;
        int sc = -1, isret = 0, sq = 0, hd = 0, dr = 0, hf = 0, md = 0, sg = 0, sid = 0; unsigned* pub = sdone;
        if (it < A0) { sid = it / (NSEG - 1); sg = it % (NSEG - 1); md = 1; sc = 1; pub = c1 + sid; }
        else if (it >= A4 && it < A5) { const int k = it - A4; sid = k / NSEG; sg = k % NSEG; md = 3; sc = 1; }
        else if (it >= A6 && it < A7) { const int k = it - A6; sq = k >> 4; hd = (k >> 1) & 7; dr = k & 1; sc = 0; }
        else if (it >= A7 && it < A8) { const int k = it - A7; isret = 1; sq = k >> 4; hd = (k >> 2) & 3; dr = (k >> 1) & 1; hf = k & 1; sc = 0; }
        if (sc == 1) {
            if (sid < 32) { isret = 0; sq = 16 + (sid >> 4); hd = (sid >> 1) & 7; dr = sid & 1; hf = 0; }
            else { const int k = sid - 32; isret = 1; sq = 16 + (k >> 4); hd = (k >> 2) & 3; dr = (k >> 1) & 1; hf = k & 1; }
        }
        if (sc >= 0) {
            if (md == 3) item_wait(c2 + sid, 1u, tid);
            scan_any_item(p, l, ps, isret, sq, hd, dr, hf, md, sg, sid, smem, tid);
            item_publish(pub, tid);
        }
        else if (it < A1) { gemm_uq_tile(p, l, ps, it - A0, smem, tid); item_publish(gdone, tid); }
        else if (it < A2) { gemm_ukv_tile(p, l, it - A1, smem, tid); item_publish(gdone, tid); }
        else if (it < A3) { const int k = it - A2; attn_gqa_item(p, l, 16 + (k >> 7), (k >> 4) & 7, k & 15, ps, smem, tid); }
        else if (it < A4) { const int sd = it - A3; item_wait(c1 + sd, (unsigned)(NSEG - 1), tid); scan_combine_item(p, l, ps, sd, tid); item_publish(c2 + sd, tid); }
        else if (it < A6) { const int k = it - A5; item_wait(gdone, 928u, tid); attn_mla_item(p, 16 + (k >> 7), (k >> 4) & 7, k & 15, ps, smem, tid); }
        else if (it < A9) { const int k = it - A8; attn_gqa_item(p, l, k >> 4, (k >> 1) & 7, k & 1, ps, smem, tid); }
        else if (it < A10) { const int k = it - A9; item_wait(gdone, 928u, tid); attn_mla_item(p, k >> 4, (k >> 1) & 7, k & 1, ps, smem, tid); }
        else if (it < A10 + nwi) { const int w0 = l * T_LAYER + T_MIDEND + (it - A10) * 4; wtile_run(p, w0, w0 + 4, 1, smem, tid); }
        else { item_wait(sdone, (unsigned)(N3 + 512), tid); const int k = it - A10 - nwi; const int t5 = launder(tid); for (int i = 0; i < 8; ++i) postscan_token(p, l, k * 32 + i * 4 + (t5 >> 6), t5 & 63); }
    }
}

constexpr int NPL = 9;
constexpr int NPP = 1 + 2 * NPL;
constexpr int NPHASE = 1 + 2 * NPP;
DI void run_phase(const Ctx& p, int ph, int rep, volatile LAS unsigned* slot, char* smem, int tid) {
#ifndef EXCL
#define EXCL -2
#endif
#ifndef ONLY
#define ONLY -1
#endif
    if (ph == 0) { phase_prep_w(p, smem, tid); return; }
    const int q = ph - 1, ps = q / NPP, r = q % NPP;
    if (r == 0) { phase_h1(p, ps, tid); return; }
    const int l = (r - 1) / NPL, k = (r - 1) % NPL;
    char* ws = p.ws();
    unsigned* ctr = (unsigned*)(p.ws() + OFF_CTR) + ph;
    switch (k) {
    case 0: phase_gemm_in(p, l, ps, smem, tid); break;
    case 1: phase_prep(p, l, ps, tid); break;
    case 2: phase_mix(p, l, ps, ctr, (unsigned*)(p.ws() + OFF_CTR) + 256 + (ps * 2 + l) * 128, slot, smem, tid); break;
    case 3: phase_merge(p, l, smem, tid); break;
    case 4: phase_gemm_plain<true>((const bf16_t*)(ws + OFF_WOUT) + (size_t)l * SZ_WOUT, 1024, (const bf16_t*)(ws + OFF_MERGED), 1024, 64, 8, ws + OFF_MO, 1024, smem, tid); break;
    case 5: phase_res(p, ps, l, 0, tid); break;
    case 6: phase_up_act(p, l, ps, smem, tid); break;
    case 7: phase_down(p, l, smem, tid); break;
    default: phase_res(p, ps, l, 1, tid); if (ps == 0 && l == 1) phase_h1(p, 1, tid); break;
    }
}

constexpr unsigned long long probe_mask(int kind) {
    unsigned long long m = 0;
    for (int ph = 0; ph < NPHASE; ++ph) {
        int k = 11; if (ph > 0) { const int r = (ph - 1) % NPP; k = (r == 0) ? 12 : (r - 1) % NPL; }
        if (k == kind) m |= 1ull << ph;
    }
    return m;
}
__global__ void __launch_bounds__(256, 2) fwd_kernel(Params prm, int ph_lo, int ph_hi, int rep) {
    __shared__ __attribute__((aligned(16))) char smem_all[512 + 65536 + 2048];
    int tid = threadIdx.x;
    volatile LAS unsigned* xw = (volatile LAS unsigned*)(smem_all);
    volatile LAS unsigned* tbl = (volatile LAS unsigned*)(smem_all + 32);
    char* smem = smem_all + 512;
    if (tid == 0) { xw[0] = 0u; xw[1] = 0u; xw[2] = 0u; xw[3] = 0u; }
    if (tid == 0) {
#pragma unroll
        for (int i = 0; i < 44; ++i) {
            const unsigned long long v = (i < 42) ? (unsigned long long)prm.in[i < 42 ? i : 0] : (i == 42 ? (unsigned long long)prm.out : (unsigned long long)prm.ws);
            tbl[2 * i] = (unsigned)v; tbl[2 * i + 1] = (unsigned)(v >> 32);
        }
    }
    __syncthreads();
    Ctx p; p.tbl = tbl;
    XcdBarrier bar;
    if (ph_hi - ph_lo > 1) bar = xcd_barrier_post((unsigned*)(p.ws() + OFF_BAR), xw, tid);
    constexpr unsigned long long PMASK = probe_mask(PROBE_KIND);
    if (PROBE_KIND >= 0 && BIDX == 0 && tid == 0) { xw[3] = 0u; xw[4] = (unsigned)__builtin_amdgcn_s_memrealtime(); }
    for (int ph = ph_lo; ph < ph_hi; ++ph) {
        if (ph == 1 + NPP) continue;
        tid = launder(tid);
        run_phase(p, ph, rep, xw + 2, smem, tid);
        if (PROBE_KIND == 13 && BIDX == 0 && tid == 0) xw[5] = (unsigned)__builtin_amdgcn_s_memrealtime();
        if (launder_s(ph_hi) - launder_s(ph_lo) > 1 && ph + 1 < ph_hi) xcd_barrier(bar, tid);
        if (PROBE_KIND >= 0 && BIDX == 0 && tid == 0) {
            const unsigned tn = (unsigned)__builtin_amdgcn_s_memrealtime();
            if (PROBE_KIND == 13) xw[3] = xw[3] + (tn - xw[5]);
            else if ((PMASK >> ph) & 1ull) xw[3] = xw[3] + (tn - xw[4]);
            xw[4] = tn;
        }
    }
    if (PROBE_KIND >= 0 && BIDX == 0 && tid == 0) {
        const unsigned long long tend = __builtin_amdgcn_s_memrealtime() + 9ull * xw[3];
        while (__builtin_amdgcn_s_memrealtime() < tend) __builtin_amdgcn_s_sleep(8);
    }
}

#ifndef MK_ONE_LAUNCH
#define MK_ONE_LAUNCH 1
#endif

extern "C" void kernel_launch(void* const* d_in, const int* in_sizes, int n_in, void* d_out, int out_size, void* d_ws, size_t ws_size, hipStream_t stream) {
    (void)in_sizes; (void)n_in; (void)out_size;
    if (ws_size < WS_NEED) { fprintf(stderr, "workspace too small: %zu < %zu\n", ws_size, (size_t)WS_NEED); return; }
    Params p{};
    for (int i = 0; i < 42; ++i) p.in[i] = (const float*)d_in[i];
    p.out = (float*)d_out; p.ws = (char*)d_ws;
    static int grid_blocks = 0;
    if (!grid_blocks) {
        int dev = 0, cus = 0, per_cu = 0;
        hipGetDevice(&dev);
        hipDeviceGetAttribute(&cus, hipDeviceAttributeMultiprocessorCount, dev);
        hipOccupancyMaxActiveBlocksPerMultiprocessor(&per_cu, fwd_kernel, 256, 0);
        if (per_cu > 2) per_cu = 2;
        if (per_cu < 1) per_cu = 1;
        grid_blocks = cus * per_cu;
    }
    hipMemsetAsync((char*)d_ws + OFF_BAR, 0, BAR_BYTES + CTR_BYTES, stream);
#if MK_ONE_LAUNCH
    {
        int lo = 0, hi = NPHASE, rep = 0;
        void* args[] = {&p, &lo, &hi, &rep};
        hipError_t e = hipLaunchCooperativeKernel((void*)fwd_kernel, dim3(grid_blocks), dim3(256), args, 0, stream);
        if (e != hipSuccess) fprintf(stderr, "cooperative launch failed: %s (grid %d)\n", hipGetErrorString(e), grid_blocks);
    }
#else
#ifndef PROBE_REP
#define PROBE_REP 0
#endif
    for (int ph = 0; ph < NPHASE; ++ph) {
        fwd_kernel<<<grid_blocks, 256, 0, stream>>>(p, ph, ph + 1, 0);
        int kind = -1;
        if (ph == 0) kind = 11; else { const int r = (ph - 1) % NPP; kind = (r == 0) ? 12 : (r - 1) % NPL; }
        if ((PROBE_REP >> kind) & 1) fwd_kernel<<<grid_blocks, 256, 0, stream>>>(p, ph, ph + 1, 1);
    }
#endif
}
```

```cpp
#include <hip/hip_runtime.h>
#include <cstdio>
#include <cstdint>
#include <cmath>

typedef unsigned short bf16_t;
typedef short bf16x8 __attribute__((ext_vector_type(8)));
typedef float f32x4 __attribute__((ext_vector_type(4)));
typedef unsigned u32x4 __attribute__((ext_vector_type(4)));
typedef unsigned u32x2 __attribute__((ext_vector_type(2)));
#define DI __device__ __forceinline__
#define LAS __attribute__((address_space(3)))

constexpr int DM = 1024, INW = 4272, INWP = 4352, DFF = 2816;
constexpr int NPT = 8192;
constexpr int KROWS = 8704;
constexpr float EPS = 1e-6f;
constexpr int C_Z = 0, C_XBC = 512, C_DT = 1280, C_RQ = 1296, C_RK = 1552, C_RV = 1808, C_RG = 2320, C_AQ = 2832, C_AK = 3344, C_AV = 3472,
              C_MCQ = 3600, C_MCKV = 3984;
constexpr size_t O_YS = 8388608, O_SSD = 16777216, O_RET = 20971520, O_CK = 25165824, O_CV = 27262976, O_CC = 29360128, O_CR = 33554432;

constexpr size_t al256(size_t x) { return (x + 255) & ~(size_t)255; }
constexpr size_t SZ_WIN = (size_t)INWP * 1024, SZ_WM = (size_t)4096 * 1024, SZ_WUQ = (size_t)768 * 384, SZ_WUKV = (size_t)1024 * 256,
                 SZ_WBR = (size_t)4 * 1024 * 512, SZ_WOUT = (size_t)1024 * 1024, SZ_WUP = (size_t)5632 * 1024, SZ_WDN = (size_t)1024 * 2816;
constexpr size_t OFF_WIN = 0;
constexpr size_t OFF_WM = OFF_WIN + 4 * SZ_WIN;
constexpr size_t OFF_WUQ = OFF_WM + 4 * SZ_WM;
constexpr size_t OFF_WUKV = OFF_WUQ + 4 * SZ_WUQ;
constexpr size_t OFF_WBR = OFF_WUKV + 4 * SZ_WUKV;
constexpr size_t OFF_WOUT = OFF_WBR + 4 * SZ_WBR;
constexpr size_t OFF_WUP = OFF_WOUT + 4 * SZ_WOUT;
constexpr size_t OFF_WDN = OFF_WUP + 4 * SZ_WUP;
constexpr size_t OFF_MOD = al256(OFF_WDN + 4 * SZ_WDN);
constexpr size_t OFF_T16 = al256(OFF_MOD + (size_t)2 * 5 * 6144 * 4);
constexpr size_t OFF_T8 = OFF_T16 + 2 * 64 * 16 * 4;
constexpr size_t OFF_BAR = al256(OFF_T8 + 2 * 64 * 8 * 4);
constexpr int CTR_TEAM = 256 + 4 * 128;
constexpr size_t BAR_BYTES = 3456 * 4, CTR_BYTES = (256 + 4 * 128) * 4 + (size_t)4 * 64 * 2 * 256;
constexpr size_t OFF_CTR = OFF_BAR + BAR_BYTES;
constexpr size_t OFF_DTRAW = al256(OFF_CTR + CTR_BYTES);
constexpr size_t OFF_DT = OFF_DTRAW + (size_t)NPT * 16 * 4;
constexpr size_t OFF_H = al256(OFF_DT + (size_t)NPT * 16 * 4);
constexpr size_t OFF_PROJ = OFF_H + (size_t)NPT * 1024 * 2;
constexpr size_t OFF_XBCA = OFF_PROJ + (size_t)NPT * INWP * 2;
constexpr size_t OFF_KA = OFF_XBCA + (size_t)NPT * 768 * 2;
constexpr size_t OFF_VAT = OFF_KA + (size_t)KROWS * 128 * 2;
constexpr size_t OFF_CKV = OFF_VAT + (size_t)KROWS * 128 * 2;
constexpr size_t OFF_KRP = OFF_CKV + (size_t)KROWS * 256 * 2;
constexpr size_t OFF_QM = OFF_KRP + (size_t)KROWS * 32 * 2;
constexpr size_t OFF_KN = OFF_QM + (size_t)NPT * 768 * 2;
constexpr size_t OFF_VMT = OFF_KN + (size_t)KROWS * 512 * 2;
constexpr size_t OFF_OS = OFF_VMT + (size_t)KROWS * 512 * 2;
constexpr size_t OFF_OR = OFF_OS + (size_t)2 * NPT * 512 * 2;
constexpr size_t OFF_OM = OFF_OR + (size_t)2 * NPT * 512 * 2;
constexpr size_t OFF_OA = OFF_OM + (size_t)NPT * 512 * 2;
constexpr int NSEG = 4, SEGTOK = 2048 / NSEG;
constexpr size_t OFF_SEG = OFF_OA + (size_t)NPT * 512 * 2;
constexpr size_t OFF_SEGD = OFF_SEG + (size_t)64 * NSEG * 4096 * 2;
constexpr size_t WS_END1 = OFF_SEGD + 64 * NSEG * 4;
constexpr size_t OFF_MERGED = OFF_OS;
constexpr size_t OFF_FO = OFF_XBCA;
static_assert(OFF_FO + (size_t)NPT * 1024 * 4 <= OFF_KN, "FO beyond QM");
constexpr size_t WS_NEED = WS_END1;

struct Params {
    const float* in[42];
    float* out;
    char* ws;
};
struct Ctx {
    volatile LAS unsigned* tbl;
    __device__ __forceinline__ unsigned long long ld(int i) const {
        const unsigned lo = tbl[2 * i], hi = tbl[2 * i + 1];
        return ((unsigned long long)(unsigned)__builtin_amdgcn_readfirstlane((int)hi) << 32) | (unsigned)__builtin_amdgcn_readfirstlane((int)lo);
    }
    __device__ __forceinline__ const float* in(int i) const { return (const float*)ld(i); }
    __device__ __forceinline__ float* out() const { return (float*)ld(42); }
    __device__ __forceinline__ char* ws() const { return (char*)ld(43); }
};

DI float bf2f(unsigned short h) { return __uint_as_float((unsigned)h << 16); }
DI unsigned short f2bf(float f) { return __builtin_bit_cast(unsigned short, (__bf16)f); }
typedef __bf16 bf16x2_t __attribute__((ext_vector_type(2)));
DI unsigned pk2(float lo, float hi) { bf16x2_t v; v[0] = (__bf16)lo; v[1] = (__bf16)hi; return __builtin_bit_cast(unsigned, v); }
DI void unpack8(const u32x4& w, float* v) {
#pragma unroll
    for (int i = 0; i < 4; ++i) { v[2 * i] = __uint_as_float(w[i] << 16); v[2 * i + 1] = __uint_as_float(w[i] & 0xffff0000u); }
}
DI u32x4 pack8(const float* v) { u32x4 w; w[0] = pk2(v[0], v[1]); w[1] = pk2(v[2], v[3]); w[2] = pk2(v[4], v[5]); w[3] = pk2(v[6], v[7]); return w; }
DI float log1pe(float e) { return e < 1e-4f ? e - 0.5f * e * e : __builtin_amdgcn_logf(1.f + e) * 0.6931471805599453f; }
DI float siluf(float x) { return x / (1.f + __expf(-x)); }
DI float sigmoidf(float x) { return 1.f / (1.f + __expf(-x)); }
DI int lanel() { int l = (int)__lane_id(); asm volatile("" : "+v"(l)); return l; }
DI float shx(float v, int m) { const int l = lanel(); return __int_as_float(__builtin_amdgcn_ds_bpermute((l ^ m) << 2, __float_as_int(v))); }
DI float shf(float v, int src) { return __int_as_float(__builtin_amdgcn_ds_bpermute(src << 2, __float_as_int(v))); }
DI float shu(float v, int d) { const int l = lanel(); const int sidx = (l - d) < 0 ? l : (l - d); return __int_as_float(__builtin_amdgcn_ds_bpermute(sidx << 2, __float_as_int(v))); }
DI float gmax4(float v) {
    auto a = __builtin_amdgcn_permlane16_swap(__float_as_uint(v), __float_as_uint(v), false, false);
    v = fmaxf(__uint_as_float(a[0]), __uint_as_float(a[1]));
    auto b = __builtin_amdgcn_permlane32_swap(__float_as_uint(v), __float_as_uint(v), false, false);
    return fmaxf(__uint_as_float(b[0]), __uint_as_float(b[1]));
}
DI float gsum4(float v) {
    auto a = __builtin_amdgcn_permlane16_swap(__float_as_uint(v), __float_as_uint(v), false, false);
    v = __uint_as_float(a[0]) + __uint_as_float(a[1]);
    auto b = __builtin_amdgcn_permlane32_swap(__float_as_uint(v), __float_as_uint(v), false, false);
    return __uint_as_float(b[0]) + __uint_as_float(b[1]);
}
DI float wsum(float v) {
#pragma unroll
    for (int o = 32; o >= 1; o >>= 1) v += shx(v, o);
    return v;
}
typedef const __attribute__((address_space(1))) u32x4* gp128;
DI u32x4 gld16(const void* p) { return *(gp128)(unsigned long long)p; }
DI void st_wt8(void* p, u32x2 v) { __hip_atomic_store((unsigned long long*)p, ((unsigned long long)v[1] << 32) | v[0], __ATOMIC_RELAXED, __HIP_MEMORY_SCOPE_AGENT); }
DI void st_wt16(void* p, u32x4 v) { st_wt8(p, (u32x2){v[0], v[1]}); st_wt8((char*)p + 8, (u32x2){v[2], v[3]}); }
DI void st_wt2(bf16_t* p, bf16_t v) { __hip_atomic_store(p, v, __ATOMIC_RELAXED, __HIP_MEMORY_SCOPE_AGENT); }
DI void st_wtf4(float* p, f32x4 v) { st_wt16(p, __builtin_bit_cast(u32x4, v)); }
DI void st_wt4f(float* p, float v) { __hip_atomic_store(p, v, __ATOMIC_RELAXED, __HIP_MEMORY_SCOPE_AGENT); }
DI int launder(int x) { asm volatile("" : "+v"(x)); return x; }
DI int launder_s(int x) { asm volatile("" : "+s"(x)); return x; }
#define BIDX launder_s((int)blockIdx.x)
DI int FQ(int q) { return (4 - q) & 3; }
DI int tile_off(int rows, int ks, int row, int g, int q) { return (ks * rows + row) * 64 + ((g ^ FQ(q)) << 4); }

#define XB_TMO      128
#define XB_XCNT(j)  (256  + 64 * (j))
#define XB_XSUB(j)  (1280 + 64 * (j))
#define XB_XGEN(j)  (2304 + 64 * (j))
#define XB_TOP      3328
#define XB_TOPGEN   3392
#define XB_SPIN_CAP (1u << 22)
DI unsigned xb_ld(unsigned* p) { return __hip_atomic_load(p, __ATOMIC_RELAXED, __HIP_MEMORY_SCOPE_AGENT); }
DI unsigned xb_add(unsigned* p, unsigned v) { return __hip_atomic_fetch_add(p, v, __ATOMIC_RELAXED, __HIP_MEMORY_SCOPE_AGENT); }
DI unsigned xb_xcc_id() { return (unsigned)__builtin_amdgcn_s_getreg((3 << 11) | 20) & 0xFu; }
#define XB_SPIN(cond, bar) do { unsigned _sp = 0; while (cond) { __builtin_amdgcn_s_sleep(1); \
    if ((++_sp & 255u) == 0u) { if (xb_ld(&(bar)[XB_TMO])) break; if (_sp > XB_SPIN_CAP) { atomicAdd(&(bar)[XB_TMO], 1u); break; } } } } while (0)
struct XcdBarrier { unsigned* bar; unsigned x; volatile LAS unsigned* st; };
DI XcdBarrier xcd_barrier_post(unsigned* bar, volatile LAS unsigned* st, int tid) {
    XcdBarrier b; b.bar = bar; b.x = xb_xcc_id(); b.st = st;
    if (tid == 0) st[7] = xb_add(&bar[XB_XCNT(b.x)], 1u);
    return b;
}
DI void xcd_barrier_complete(unsigned* bar, unsigned x, unsigned& nloc, unsigned& nx, unsigned& rank) {
    const unsigned G = gridDim.x * gridDim.y * gridDim.z;
    unsigned sum, cnt, mine, sp = 0u;
    for (;;) {
        sum = 0u; cnt = 0u; mine = 0u; rank = 0u;
#pragma unroll
        for (unsigned j = 0; j < 16; ++j) { const unsigned c = xb_ld(&bar[XB_XCNT(j)]); sum += c; cnt += (c > 0u) ? 1u : 0u; mine = (j == x) ? c : mine; rank += (j < x && c > 0u) ? 1u : 0u; }
        if (sum == G) break;
        __builtin_amdgcn_s_sleep(1);
        if ((++sp & 255u) == 0u) { if (xb_ld(&bar[XB_TMO])) break; if (sp > XB_SPIN_CAP) { atomicAdd(&bar[XB_TMO], 1u); break; } }
    }
    nloc = mine > 0u ? mine : 1u; nx = cnt > 0u ? cnt : 1u;
}
DI void xcd_barrier(const XcdBarrier& b, int tid) {
    asm volatile("s_waitcnt vmcnt(0)" ::: "memory");
    __syncthreads();
    if (tid == 0) {
        unsigned* bar = b.bar;
        __builtin_amdgcn_s_waitcnt(0);
        unsigned nloc = b.st[0], nx = b.st[1];
        if (nloc == 0u) { unsigned rank; xcd_barrier_complete(bar, b.x, nloc, nx, rank); b.st[0] = nloc; b.st[1] = nx; b.st[6] = rank; }
        const unsigned old = xb_add(&bar[XB_XSUB(b.x)], 1u);
        const unsigned gen = old / nloc;
        if (old + 1u == (gen + 1u) * nloc) {
            __builtin_amdgcn_fence(__ATOMIC_RELEASE, "agent");
            asm volatile("s_waitcnt vmcnt(0)" ::: "memory");
            const unsigned og = xb_add(&bar[XB_TOP], 1u);
            const unsigned tg = og / nx;
            if (og + 1u == (tg + 1u) * nx) xb_add(&bar[XB_TOPGEN], 1u);
            else XB_SPIN(xb_ld(&bar[XB_TOPGEN]) == tg, bar);
            __builtin_amdgcn_fence(__ATOMIC_ACQUIRE, "agent");
            xb_add(&bar[XB_XGEN(b.x)], 1u);
            asm volatile("s_waitcnt vmcnt(0)" ::: "memory");
        } else {
            XB_SPIN(xb_ld(&bar[XB_XGEN(b.x)]) == gen, bar);
            __builtin_amdgcn_fence(__ATOMIC_ACQUIRE, "agent");
            asm volatile("s_waitcnt vmcnt(0)" ::: "memory");
        }
    }
    __syncthreads();
}

DI int next_item(unsigned* ctr, volatile LAS unsigned* slot, int tid) {
    __syncthreads();
    if (tid == 0) *slot = __hip_atomic_fetch_add(ctr, 1u, __ATOMIC_RELAXED, __HIP_MEMORY_SCOPE_AGENT);
    __syncthreads();
    return (int)*slot;
}

struct Tok { int lat, b, t, L, cond, krow, seq0; size_t gx; };
DI Tok tok_info(int m, int ps) {
    Tok k;
    if (m < 4096) { k.lat = 0; k.b = ps * 16 + (m >> 8); k.t = m & 255; k.L = 256; k.cond = 0; k.krow = m; k.seq0 = m & ~255; k.gx = (size_t)ps * 4096 + m; }
    else { const int mm = m - 4096, j = mm >> 11; k.lat = 1; k.b = ps * 2 + j; k.t = mm & 2047; k.L = 2048; k.cond = 1 + k.b; k.krow = 4096 + j * 2304 + 256 + k.t;
           k.seq0 = 4096 + j * 2048; k.gx = (size_t)8192 + (size_t)ps * 4096 + mm; }
    return k;
}

template <int NTA, int NTB, bool LOWREG = false, int WMAP = 0>
DI void gemm_kloop(f32x4 (&acc)[NTA][NTB], const bf16_t* __restrict__ W, size_t ldw, const bf16_t* __restrict__ X, size_t ldx, int K, char* smem, int tid) {
    constexpr int BF = 32 * NTA, BT = 32 * NTB;
    constexpr int WB = BF * 128, STG = (BF + BT) * 128;
    constexpr int NPW = BF / 8, NPX = BT / 8, NPIECE = NPW + NPX, PPW = NPIECE / 4;
    static_assert(NPIECE % 4 == 0, "pieces must divide over 4 waves");
    tid = launder(tid);
    const int lane = tid & 63, wv = tid >> 6, wn = wv >> 1, wt = wv & 1, fr = lane & 15, g = lane >> 4;
    constexpr int PWW = NPW / 4, PXX = PPW - PWW;
    const int wvu = __builtin_amdgcn_readfirstlane(wv);
    auto lane_off = [&](int j, int ln) -> unsigned {
        const bool isw = j < PWW;
        const int pp = isw ? wvu * PWW + j : wvu * PXX + (j - PWW);
        const int rows = isw ? BF : BT;
        const int rb = pp % (rows / 16);
        const int rl = ln >> 2;
        const int q = isw ? (((rb * 16 + rl) / (4 * NTA)) & 3) : ((rl >> 2) & 3);
        const int gl = (ln & 3) ^ FQ(q);
        if (WMAP && isw) return (unsigned)((rl & 7) + (rl >> 3) * DFF) * (unsigned)ldw + (unsigned)(gl * 8);
        return (unsigned)rl * (unsigned)(isw ? ldw : ldx) + (unsigned)(gl * 8);
    };
    unsigned poff[PPW];
    if (!LOWREG) {
#pragma unroll
        for (int j = 0; j < PPW; ++j) poff[j] = lane_off(j, lane);
    }
    auto issue = [&](int k0, char* sdst) {
        const int ln = LOWREG ? launder(lane) : lane;
#pragma unroll
        for (int j = 0; j < PPW; ++j) {
            const bool isw = j < PWW;
            const int pp = isw ? wvu * PWW + j : wvu * PXX + (j - PWW);
            const int rows = isw ? BF : BT;
            const int ks = pp / (rows / 16), rb = pp % (rows / 16);
            const int wrow = WMAP ? 32 * (rb >> 2) + 8 * (rb & 3) : rb * 16;
            const bf16_t* base = (isw ? W + (size_t)wrow * ldw : X + (size_t)(rb * 16) * ldx) + k0 + ks * 32;
            const unsigned off = LOWREG ? lane_off(j, ln) : poff[j];
            __builtin_amdgcn_global_load_lds((const unsigned*)(base + off), (unsigned*)(sdst + (isw ? 0 : WB) + (ks * rows + rb * 16) * 64), 16, 0, 0);
        }
    };
    const int aoff = tile_off(BF, 0, wn * 16 * NTA + 4 * NTA * (fr >> 2) + (fr & 3), g, fr >> 2);
    const int boff = WB + tile_off(BT, 0, wt * 16 * NTB + fr, g, (fr >> 2) & 3);
    const int nk = K >> 6;
    issue(0, smem);
    asm volatile("s_waitcnt vmcnt(0)" ::: "memory");
    __syncthreads();
    for (int kt = 0; kt < nk; ++kt) {
        if (kt + 1 < nk) issue((kt + 1) << 6, smem + ((kt + 1) & 1) * STG);
        const char* sb = smem + (kt & 1) * STG;
        __builtin_amdgcn_s_setprio(1);
#pragma unroll
        for (int kk = 0; kk < 2; ++kk) {
            if (LOWREG) {
                bf16x8 bfr[NTB];
#pragma unroll
                for (int mt = 0; mt < NTB; ++mt) bfr[mt] = *(const bf16x8*)(sb + boff + mt * 1024 + kk * BT * 64);
#pragma unroll
                for (int a = 0; a < NTA; ++a) {
                    const bf16x8 af1 = *(const bf16x8*)(sb + aoff + a * 256 + kk * BF * 64);
#pragma unroll
                    for (int mt = 0; mt < NTB; ++mt) acc[a][mt] = __builtin_amdgcn_mfma_f32_16x16x32_bf16(af1, bfr[mt], acc[a][mt], 0, 0, 0);
                    __builtin_amdgcn_sched_barrier(0);
                }
            } else {
                bf16x8 af[NTA], bfr[NTB];
#pragma unroll
                for (int a = 0; a < NTA; ++a) af[a] = *(const bf16x8*)(sb + aoff + a * 256 + kk * BF * 64);
#pragma unroll
                for (int mt = 0; mt < NTB; ++mt) bfr[mt] = *(const bf16x8*)(sb + boff + mt * 1024 + kk * BT * 64);
#pragma unroll
                for (int a = 0; a < NTA; ++a)
#pragma unroll
                    for (int mt = 0; mt < NTB; ++mt) acc[a][mt] = __builtin_amdgcn_mfma_f32_16x16x32_bf16(af[a], bfr[mt], acc[a][mt], 0, 0, 0);
            }
        }
        __builtin_amdgcn_s_setprio(0);
        asm volatile("s_waitcnt vmcnt(0)" ::: "memory");
        __syncthreads();
    }
}

struct WTile { const float* src; bf16_t* dst; int K, N, k0, n0; };
constexpr int T_IN = 16 * 68, T_M = 16 * 64, T_UQ = 6 * 12, T_UKV = 4 * 16, T_BR = 8 * 16, T_OUT = 16 * 16, T_UP = 16 * 88, T_DN = 44 * 16;
constexpr int T_LAYER = T_IN + T_M + T_UQ + T_UKV + 4 * T_BR + T_OUT + T_UP + T_DN;
constexpr int T_MIDEND = T_IN + T_M + T_UQ + T_UKV + 4 * T_BR + T_OUT, T_UPEND = T_MIDEND + T_UP;
DI WTile wtile_decode(const Ctx& p, int it) {
    char* ws = p.ws();
    const int l = it / T_LAYER; int k = it % T_LAYER;
    WTile t; int ntn;
    if (k < T_IN) { t.src = p.in(16) + (size_t)l * 1024 * INW; t.dst = (bf16_t*)(ws + OFF_WIN) + (size_t)l * SZ_WIN; t.K = 1024; t.N = INW; ntn = 68; }
    else if ((k -= T_IN) < T_M) { t.src = p.in(35) + (size_t)l * 1024 * 4096; t.dst = (bf16_t*)(ws + OFF_WM) + (size_t)l * SZ_WM; t.K = 1024; t.N = 4096; ntn = 64; }
    else if ((k -= T_M) < T_UQ) { t.src = p.in(28) + (size_t)l * 384 * 768; t.dst = (bf16_t*)(ws + OFF_WUQ) + (size_t)l * SZ_WUQ; t.K = 384; t.N = 768; ntn = 12; }
    else if ((k -= T_UQ) < T_UKV) { t.src = p.in(30) + (size_t)l * 256 * 1024; t.dst = (bf16_t*)(ws + OFF_WUKV) + (size_t)l * SZ_WUKV; t.K = 256; t.N = 1024; ntn = 16; }
    else if ((k -= T_UKV) < 4 * T_BR) { const int j = k / T_BR; k -= j * T_BR; t.src = (j == 0 ? p.in(31) : j == 1 ? p.in(32) : j == 2 ? p.in(33) : p.in(34)) + (size_t)l * 512 * 1024;
                                        t.dst = (bf16_t*)(ws + OFF_WBR) + (size_t)(l * 4 + j) * 1024 * 512; t.K = 512; t.N = 1024; ntn = 16; }
    else if ((k -= 4 * T_BR) < T_OUT) { t.src = p.in(37) + (size_t)l * 1024 * 1024; t.dst = (bf16_t*)(ws + OFF_WOUT) + (size_t)l * SZ_WOUT; t.K = 1024; t.N = 1024; ntn = 16; }
    else if ((k -= T_OUT) < T_UP) { t.src = p.in(38) + (size_t)l * 1024 * 5632; t.dst = (bf16_t*)(ws + OFF_WUP) + (size_t)l * SZ_WUP; t.K = 1024; t.N = 5632; ntn = 88; }
    else { k -= T_UP; t.src = p.in(41) + (size_t)l * 2816 * 1024; t.dst = (bf16_t*)(ws + OFF_WDN) + (size_t)l * SZ_WDN; t.K = 2816; t.N = 1024; ntn = 16; }
    t.k0 = (k / ntn) * 64; t.n0 = (k % ntn) * 64;
    return t;
}
DI void wtile_load(const WTile& t, int tid, f32x4 (&v)[4]) {
    const int r = tid >> 4, c4 = tid & 15;
#pragma unroll
    for (int i = 0; i < 4; ++i) {
        v[i] = (f32x4){0.f, 0.f, 0.f, 0.f};
        if (t.n0 + 4 * c4 < t.N) v[i] = *(const f32x4*)(t.src + (size_t)(t.k0 + r + 16 * i) * t.N + t.n0 + 4 * c4);
    }
}
DI void wtile_finish(const WTile& t, const f32x4 (&v)[4], char* smem, int tid) {
    float* tl = (float*)smem;
    const int r = tid >> 4, c4 = tid & 15;
#pragma unroll
    for (int i = 0; i < 4; ++i) {
        const int row = r + 16 * i;
        tl[row * 65 + 4 * c4 + 0] = v[i][0]; tl[row * 65 + 4 * c4 + 1] = v[i][1]; tl[row * 65 + 4 * c4 + 2] = v[i][2]; tl[row * 65 + 4 * c4 + 3] = v[i][3];
    }
    __syncthreads();
#pragma unroll
    for (int i = 0; i < 2; ++i) {
        const int q = tid + 256 * i, n = q >> 3, c = q & 7;
        float o[8];
#pragma unroll
        for (int j = 0; j < 8; ++j) o[j] = tl[(8 * c + j) * 65 + n];
        *(u32x4*)(t.dst + (size_t)(t.n0 + n) * t.K + t.k0 + 8 * c) = pack8(o);
    }
    __syncthreads();
}
DI void wtile_run(const Ctx& p, int lo, int hi, int step, char* smem, int tid) {
    int it = lo;
    f32x4 va[4];
    if (it < hi) { const WTile c0 = wtile_decode(p, it); wtile_load(c0, tid, va); }
    while (it < hi) {
        const int nx = it + step;
        f32x4 vb[4];
        if (nx < hi) { const WTile nt = wtile_decode(p, nx); wtile_load(nt, tid, vb); }
        { const WTile cur = wtile_decode(p, launder(it)); wtile_finish(cur, va, smem, tid); }
#pragma unroll
        for (int i = 0; i < 4; ++i) va[i] = vb[i];
        it = nx;
    }
}
DI void wtile_tail(const Ctx& p, int tiles_per_xcd, int lo, int hi, char* smem, int tid) {
    const int x = BIDX & 7, loc = BIDX >> 3, nloc = gridDim.x >> 3;
    const int rem = tiles_per_xcd % nloc;
    const int j = rem ? loc - rem : loc, nidle = rem ? nloc - rem : nloc;
    if (j >= 0) wtile_run(p, lo + j * 8 + x, hi, nidle * 8, smem, tid);
}

DI void phase_prep_w(const Ctx& p, char* smem, int tid) {
    char* ws = p.ws();
    constexpr int N_MODI = 2 * 192;
    for (int it = BIDX; it < N_MODI + 1; it += gridDim.x) {
        if (it < N_MODI) {
            const int l = it / 192, cb = it % 192;
            float* sc = (float*)smem;
            float* red = sc + 5 * 1024;
            __syncthreads();
            for (int e = tid; e < 5 * 1024; e += 256) {
                const int c = e >> 10, kk = e & 1023;
                const float v = (c == 0) ? p.in(9)[kk] : p.in(8)[(c - 1) * 1024 + kk];
                sc[e] = siluf(v);
            }
            __syncthreads();
            const int col = tid & 31, kg = tid >> 5;
            float a[5] = {0.f, 0.f, 0.f, 0.f, 0.f};
            const float* w = p.in(10) + ((size_t)l * 1024 + kg * 128) * 6144 + cb * 32 + col;
#pragma unroll 1
            for (int k0 = 0; k0 < 128; k0 += 16) {
                float wv[16];
#pragma unroll
                for (int j = 0; j < 16; ++j) wv[j] = w[(size_t)(k0 + j) * 6144];
#pragma unroll
                for (int j = 0; j < 16; ++j)
#pragma unroll
                    for (int c = 0; c < 5; ++c) a[c] += wv[j] * sc[c * 1024 + kg * 128 + k0 + j];
            }
#pragma unroll
            for (int c = 0; c < 5; ++c) red[(kg * 5 + c) * 32 + col] = a[c];
            __syncthreads();
            if (tid < 160) {
                const int c = tid >> 5, cl = tid & 31;
                float sm = 0.f;
#pragma unroll
                for (int k8 = 0; k8 < 8; ++k8) sm += red[(k8 * 5 + c) * 32 + cl];
                float* mod = (float*)(ws + OFF_MOD);
                mod[((size_t)l * 5 + c) * 6144 + cb * 32 + cl] = sm + p.in(11)[(size_t)l * 6144 + cb * 32 + cl];
            }
            __syncthreads();
        } else {
            float* t16 = (float*)(ws + OFF_T16); float* t8 = (float*)(ws + OFF_T8);
            for (int e = tid; e < 64 * 16 + 64 * 8; e += 256) {
                const bool small = e >= 1024;
                const int ee = small ? e - 1024 : e;
                const int pos = small ? (ee >> 3) : (ee >> 4), i = small ? (ee & 7) : (ee & 15);
                const double r = small ? 0.31622776601683794 : 0.5623413251903491;
                double th = 1.0;
                for (int j = 0; j < i; ++j) th *= r;
                const double t2 = th * th;
                double c1 = 1.0, s1 = th;
                double tc = 1.0, tsn = th;
                for (int k = 1; k < 14; ++k) {
                    tc = -tc * t2 / (double)((2 * k - 1) * (2 * k));
                    tsn = -tsn * t2 / (double)((2 * k) * (2 * k + 1));
                    c1 += tc; s1 += tsn;
                }
                double c = 1.0, sn = 0.0;
                for (int j = 0; j < pos; ++j) { const double cn = c * c1 - sn * s1, snn = sn * c1 + c * s1; c = cn; sn = snn; }
                if (small) { t8[ee] = (float)c; t8[512 + ee] = (float)sn; } else { t16[ee] = (float)c; t16[1024 + ee] = (float)sn; }
            }
        }
    }
    __syncthreads();
    wtile_run(p, BIDX, T_IN, gridDim.x, smem, tid);
}

DI void row_load(const float* r, int lane, f32x4 (&v)[4]) {
#pragma unroll
    for (int i = 0; i < 4; ++i) v[i] = *(const f32x4*)(r + 4 * lane + 256 * i);
}
DI float row_ss(const f32x4 (&v)[4]) {
    float s = 0.f;
#pragma unroll
    for (int i = 0; i < 4; ++i) s += v[i][0] * v[i][0] + v[i][1] * v[i][1] + v[i][2] * v[i][2] + v[i][3] * v[i][3];
    return wsum(s);
}
DI void row_modnorm_store(const f32x4 (&x)[4], const float* gw, const float* sh, const float* sc, bf16_t* dst, int lane) {
    const float rstd = rsqrtf(row_ss(x) * (1.f / 1024.f) + EPS);
#pragma unroll
    for (int i = 0; i < 4; ++i) {
        const int c = 4 * lane + 256 * i;
        const f32x4 g = *(const f32x4*)(gw + c), s = *(const f32x4*)(sh + c), q = *(const f32x4*)(sc + c);
        float o[4];
#pragma unroll
        for (int j = 0; j < 4; ++j) o[j] = (x[i][j] * rstd) * g[j] * (1.f + q[j]) + s[j];
        u32x2 w; w[0] = pk2(o[0], o[1]); w[1] = pk2(o[2], o[3]);
        *(u32x2*)(dst + c) = w;
    }
}
DI const float* x_in_row(const Ctx& p, int m, int ps) {
    return (m < 4096) ? p.in(0) + ((size_t)ps * 4096 + m) * 1024 : p.in(1) + ((size_t)ps * 4096 + (m - 4096)) * 1024;
}
DI void phase_h1(const Ctx& p, int ps, int tid) {
    const int lane = tid & 63, wv = tid >> 6;
    const float* mod = (const float*)(p.ws() + OFF_MOD);
    bf16_t* H = (bf16_t*)(p.ws() + OFF_H);
    for (int m = BIDX * 4 + wv; m < NPT; m += gridDim.x * 4) {
        const Tok k = tok_info(m, ps);
        f32x4 x[4]; row_load(x_in_row(p, m, ps), lane, x);
        const float* md = mod + (size_t)(0 * 5 + k.cond) * 6144;
        row_modnorm_store(x, p.in(12), md + 0, md + 1024, H + (size_t)m * 1024, lane);
    }
}
DI void res_rows(const Ctx& p, int ps, int l, int which, const float* Yp, int panel, int j, int size, int tid) {
    const int lane = tid & 63, wv = tid >> 6;
    const float* mod = (const float*)(p.ws() + OFF_MOD);
    bf16_t* H = (bf16_t*)(p.ws() + OFF_H);
    const float* gpost = (which ? p.in(15) : p.in(13)) + (size_t)l * 1024;
    for (int i = j * 4 + wv; i < 128; i += size * 4) {
        const int m = panel * 128 + i;
        const Tok k = tok_info(m, ps);
        const float* md = mod + (size_t)(l * 5 + k.cond) * 6144;
        const float* gate = md + (which ? 5 * 1024 : 2 * 1024);
        f32x4 x[4], y[4];
        if (l == 0 && which == 0) row_load(x_in_row(p, m, ps), lane, x); else row_load(p.out() + k.gx * 1024, lane, x);
        row_load(Yp + (size_t)i * 1024, lane, y);
        const float rstd = rsqrtf(row_ss(y) * (1.f / 1024.f) + EPS);
#pragma unroll
        for (int q = 0; q < 4; ++q) {
            const int c = 4 * lane + 256 * q;
            const f32x4 g = *(const f32x4*)(gate + c), w = *(const f32x4*)(gpost + c);
#pragma unroll
            for (int e = 0; e < 4; ++e) x[q][e] = x[q][e] + g[e] * ((y[q][e] * rstd) * w[e]);
            *(f32x4*)(p.out() + k.gx * 1024 + c) = x[q];
        }
        if (which == 0) row_modnorm_store(x, p.in(14) + (size_t)l * 1024, md + 3 * 1024, md + 4 * 1024, H + (size_t)m * 1024, lane);
        else if (l + 1 < 2) { const float* md2 = mod + (size_t)((l + 1) * 5 + k.cond) * 6144;
                              row_modnorm_store(x, p.in(12) + (size_t)(l + 1) * 1024, md2, md2 + 1024, H + (size_t)m * 1024, lane); }
        else if (ps == 0) {
            const Tok k1 = tok_info(m, 1);
            f32x4 x1[4]; row_load(x_in_row(p, m, 1), lane, x1);
            const float* md1 = mod + (size_t)(0 * 5 + k1.cond) * 6144;
            row_modnorm_store(x1, p.in(12), md1 + 0, md1 + 1024, H + (size_t)m * 1024, lane);
        }
    }
}

DI bool xcd_tile(int it, int Mt, int Nt, int B, int& mt, int& nt) {
    const int x = BIDX & 7, loc = BIDX >> 3, nloc = gridDim.x >> 3;
    const int MP = Mt >> 3;
    const int idx = it * nloc + loc;
    if (idx >= MP * Nt) return false;
    const int ng = idx / (MP * B);
    const int bw = min(B, Nt - ng * B);
    const int r = idx - ng * MP * B;
    mt = x * MP + r / bw; nt = ng * B + r % bw;
    return true;
}
DI void phase_gemm_in(const Ctx& p, int l, int ps, char* smem, int tid) {
    const bf16_t* W = (const bf16_t*)(p.ws() + OFF_WIN) + (size_t)l * SZ_WIN;
    const bf16_t* X = (const bf16_t*)(p.ws() + OFF_H);
    bf16_t* PROJ = (bf16_t*)(p.ws() + OFF_PROJ);
    float* DTRAW = (float*)(p.ws() + OFF_DTRAW);
    const int lane = tid & 63, wv = tid >> 6, wn = wv >> 1, wt = wv & 1, fr = lane & 15, g = lane >> 4;
    for (int it = 0;; ++it) {
        int mt0, nt0; if (!xcd_tile(it, 64, 34, 8, mt0, nt0)) break;
        const int m0 = mt0 * 128, n0 = nt0 * 128;
        f32x4 acc[4][4];
#pragma unroll
        for (int a = 0; a < 4; ++a)
#pragma unroll
            for (int b = 0; b < 4; ++b) acc[a][b] = (f32x4){0.f, 0.f, 0.f, 0.f};
        gemm_kloop<4, 4>(acc, W + (size_t)n0 * 1024, 1024, X + (size_t)m0 * 1024, 1024, 1024, smem, tid);
        const int fb = n0 + wn * 64 + 16 * g;
#pragma unroll
        for (int mt = 0; mt < 4; ++mt) {
            const int m = m0 + wt * 64 + 16 * mt + fr;
            float v[16];
#pragma unroll
            for (int a = 0; a < 4; ++a)
#pragma unroll
                for (int r = 0; r < 4; ++r) v[4 * a + r] = acc[a][mt][r];
            bf16_t* d = PROJ + (size_t)m * INWP + fb;
            *(u32x4*)d = pack8(v); *(u32x4*)(d + 8) = pack8(v + 8);
            if (fb == C_DT) {
                float* dd = DTRAW + (size_t)m * 16;
#pragma unroll
                for (int a = 0; a < 4; ++a) *(f32x4*)(dd + 4 * a) = acc[a][mt];
            }
        }
    }
    if (launder_s(ps) == 0) wtile_tail(p, 8 * 34, l * T_LAYER + T_IN, l * T_LAYER + T_MIDEND, smem, launder(tid));
}

template <bool F32OUT>
DI void phase_gemm_plain(const bf16_t* W, int K, const bf16_t* X, size_t ldx, int Mtiles, int Ntiles, void* out, size_t ldo, char* smem, int tid) {
    const int lane = tid & 63, wv = tid >> 6, wn = wv >> 1, wt = wv & 1, fr = lane & 15, g = lane >> 4;
    for (int it = 0;; ++it) {
        int mt0, nt0; if (!xcd_tile(it, Mtiles, Ntiles, 8, mt0, nt0)) break;
        const int m0 = mt0 * 128, n0 = nt0 * 128;
        f32x4 acc[4][4];
#pragma unroll
        for (int a = 0; a < 4; ++a)
#pragma unroll
            for (int b = 0; b < 4; ++b) acc[a][b] = (f32x4){0.f, 0.f, 0.f, 0.f};
        gemm_kloop<4, 4>(acc, W + (size_t)n0 * K, K, X + (size_t)m0 * ldx, ldx, K, smem, tid);
        const int fb = n0 + wn * 64 + 16 * g;
#pragma unroll
        for (int mt = 0; mt < 4; ++mt) {
            const int m = m0 + wt * 64 + 16 * mt + fr;
            if (F32OUT) {
                float* d = (float*)out + (size_t)m * ldo + fb;
#pragma unroll
                for (int a = 0; a < 4; ++a) *(f32x4*)(d + 4 * a) = acc[a][mt];
            } else {
                float v[16];
#pragma unroll
                for (int a = 0; a < 4; ++a)
#pragma unroll
                    for (int r = 0; r < 4; ++r) v[4 * a + r] = acc[a][mt][r];
                bf16_t* d = (bf16_t*)out + (size_t)m * ldo + fb;
                *(u32x4*)d = pack8(v); *(u32x4*)(d + 8) = pack8(v + 8);
            }
        }
    }
}


template <int CTRL> DI float dpp0(float v) { return __builtin_bit_cast(float, __builtin_amdgcn_update_dpp(0, __builtin_bit_cast(int, v), CTRL, 0xf, 0xf, true)); }
constexpr int BND_OFF = 65536;
constexpr size_t PPB = (size_t)128 * INWP * 2;
constexpr size_t PP_EDGE = (size_t)128 * DFF * 2;
DI void up_tile(const Ctx& p, int l, int mt0, int nt0, char* smem, int tid) {
    const bf16_t* W = (const bf16_t*)(p.ws() + OFF_WUP) + (size_t)l * SZ_WUP;
    const bf16_t* X = (const bf16_t*)(p.ws() + OFF_H);
    bf16_t* A = (bf16_t*)(p.ws() + OFF_PROJ + (size_t)mt0 * PPB) - (size_t)mt0 * 128 * DFF;
    float* EDGE = (float*)(p.ws() + OFF_PROJ + (size_t)mt0 * PPB + PP_EDGE) - (size_t)mt0 * 4 * 5632;
    const float* cw = p.in(39) + (size_t)l * 3 * 5632; const float* cb = p.in(40) + (size_t)l * 5632;
    float* bnd = (float*)(smem + BND_OFF);
    {
        const int m0 = mt0 * 128, cb0 = nt0 * 64;
        f32x4 acc[4][4];
#pragma unroll
        for (int a = 0; a < 4; ++a)
#pragma unroll
            for (int b = 0; b < 4; ++b) acc[a][b] = (f32x4){0.f, 0.f, 0.f, 0.f};
        gemm_kloop<4, 4, false, 1>(acc, W + (size_t)cb0 * 1024, 1024, X + (size_t)m0 * 1024, 1024, 1024, smem, tid);
        const int t2 = launder(tid);
        const int lane = t2 & 63, wv = t2 >> 6, wn = wv >> 1, wt = wv & 1, fr = lane & 15, g = lane >> 4;
        const int c0 = cb0 + 32 * wn + 8 * g;
        if (fr == 0) {
            float* d = bnd + (((wn * 2 + wt) * 2 + 0) * 4 + g) * 16;
#pragma unroll
            for (int a = 0; a < 4; ++a) *(f32x4*)(d + 4 * a) = acc[a][0];
        }
        if (fr == 15) {
            float* d = bnd + (((wn * 2 + wt) * 2 + 1) * 4 + g) * 16;
#pragma unroll
            for (int a = 0; a < 4; ++a) *(f32x4*)(d + 4 * a) = acc[a][3];
        }
        __syncthreads();
        const bool e0 = (wt == 0 && fr == 0), e127 = (wt == 1 && fr == 15);
        u32x2 keep[4];
#pragma unroll
        for (int eh = 0; eh < 2; ++eh) {
            const int c = c0 + 4 * eh;
            const f32x4 w0u = *(const f32x4*)(cw + c), w1u = *(const f32x4*)(cw + 5632 + c), w2u = *(const f32x4*)(cw + 2 * 5632 + c), bu = *(const f32x4*)(cb + c);
            const f32x4 w0g = *(const f32x4*)(cw + DFF + c), w1g = *(const f32x4*)(cw + 5632 + DFF + c), w2g = *(const f32x4*)(cw + 2 * 5632 + DFF + c), bg = *(const f32x4*)(cb + DFF + c);
            const float* bo = bnd + (((wn * 2 + (wt ^ 1)) * 2 + (wt ? 1 : 0)) * 4 + g) * 16;
            const f32x4 bxu = *(const f32x4*)(bo + 4 * eh), bxg = *(const f32x4*)(bo + 8 + 4 * eh);
#pragma unroll
            for (int mt = 0; mt < 4; ++mt) {
                float up[4], gt[4], o[4];
#pragma unroll
                for (int r = 0; r < 4; ++r) {
                    const float cu = acc[eh][mt][r], cg = acc[2 + eh][mt][r];
                    float pu = dpp0<0x111>(cu), pg = dpp0<0x111>(cg), nu = dpp0<0x101>(cu), ng = dpp0<0x101>(cg);
                    if (mt > 0) { pu += dpp0<0x10F>(acc[eh][mt > 0 ? mt - 1 : 0][r]); pg += dpp0<0x10F>(acc[2 + eh][mt > 0 ? mt - 1 : 0][r]); }
                    else if (wt == 1 && fr == 0) { pu = bxu[r]; pg = bxg[r]; }
                    if (mt < 3) { nu += dpp0<0x11F>(acc[eh][mt < 3 ? mt + 1 : 3][r]); ng += dpp0<0x11F>(acc[2 + eh][mt < 3 ? mt + 1 : 3][r]); }
                    else if (wt == 0 && fr == 15) { nu = bxu[r]; ng = bxg[r]; }
                    up[r] = bu[r] + w0u[r] * pu + w1u[r] * cu + w2u[r] * nu;
                    gt[r] = bg[r] + w0g[r] * pg + w1g[r] * cg + w2g[r] * ng;
                    o[r] = siluf(gt[r]) * up[r];
                }
                if (mt == 0 && e0) {
                    float* e = EDGE + ((size_t)mt0 * 4 + 0) * 5632 + c;
                    st_wtf4(e, (f32x4){up[0], up[1], up[2], up[3]}); st_wtf4(e + DFF, (f32x4){gt[0], gt[1], gt[2], gt[3]});
                    float* e3 = EDGE + ((size_t)mt0 * 4 + 3) * 5632 + c;
                    st_wtf4(e3, (f32x4){w2u[0] * acc[eh][0][0], w2u[1] * acc[eh][0][1], w2u[2] * acc[eh][0][2], w2u[3] * acc[eh][0][3]});
                    st_wtf4(e3 + DFF, (f32x4){w2g[0] * acc[2 + eh][0][0], w2g[1] * acc[2 + eh][0][1], w2g[2] * acc[2 + eh][0][2], w2g[3] * acc[2 + eh][0][3]});
                }
                if (mt == 3 && e127) {
                    float* e = EDGE + ((size_t)mt0 * 4 + 2) * 5632 + c;
                    st_wtf4(e, (f32x4){up[0], up[1], up[2], up[3]}); st_wtf4(e + DFF, (f32x4){gt[0], gt[1], gt[2], gt[3]});
                    float* e1 = EDGE + ((size_t)mt0 * 4 + 1) * 5632 + c;
                    st_wtf4(e1, (f32x4){w0u[0] * acc[eh][3][0], w0u[1] * acc[eh][3][1], w0u[2] * acc[eh][3][2], w0u[3] * acc[eh][3][3]});
                    st_wtf4(e1 + DFF, (f32x4){w0g[0] * acc[2 + eh][3][0], w0g[1] * acc[2 + eh][3][1], w0g[2] * acc[2 + eh][3][2], w0g[3] * acc[2 + eh][3][3]});
                }
                const u32x2 pk = {pk2(o[0], o[1]), pk2(o[2], o[3])};
                if (eh == 0) keep[mt] = pk;
                else {
                    const int m = m0 + wt * 64 + 16 * mt + fr;
                    *(u32x4*)(A + (size_t)m * DFF + c0) = (u32x4){keep[mt][0], keep[mt][1], pk[0], pk[1]};
                }
            }
        }
    }
}

DI void down_tile(const Ctx& p, int l, int mt0, int nt0, char* smem, int tid) {
    const bf16_t* W = (const bf16_t*)(p.ws() + OFF_WDN) + (size_t)l * SZ_WDN;
    bf16_t* A = (bf16_t*)(p.ws() + OFF_PROJ + (size_t)mt0 * PPB) - (size_t)mt0 * 128 * DFF;
    const bf16_t* X = A;
    float* out = (float*)(p.ws() + OFF_FO);
    {
        const int m0 = mt0 * 128, n0 = nt0 * 128;
        {
            const int t3 = launder(tid);
            const Tok k0 = tok_info(m0, 0);
            const bool hasp = k0.t > 0, hasn = k0.t + 128 < k0.L;
            for (int i = t3; i < 2 * 704; i += 256) {
                const int row = i >= 704 ? 1 : 0, c = (i - row * 704) * 4;
                const float* P = (const float*)(p.ws() + OFF_PROJ + (size_t)mt0 * PPB + PP_EDGE) + (size_t)(row ? 2 : 0) * 5632 + c;
                f32x4 u = *(const f32x4*)P, gt = *(const f32x4*)(P + DFF);
                if (row ? hasn : hasp) {
                    const float* C = (const float*)(p.ws() + OFF_PROJ + (size_t)(row ? mt0 + 1 : mt0 - 1) * PPB + PP_EDGE) + (size_t)(row ? 3 : 1) * 5632 + c;
                    const f32x4 cu = *(const f32x4*)C, cg = *(const f32x4*)(C + DFF);
                    u += cu; gt += cg;
                }
                const u32x2 pk = {pk2(siluf(gt[0]) * u[0], siluf(gt[1]) * u[1]), pk2(siluf(gt[2]) * u[2], siluf(gt[3]) * u[3])};
                *(u32x2*)(A + (size_t)(m0 + (row ? 127 : 0)) * DFF + c) = pk;
            }
            asm volatile("s_waitcnt vmcnt(0)" ::: "memory");
            __syncthreads();
        }
        f32x4 acc[4][4];
#pragma unroll
        for (int a = 0; a < 4; ++a)
#pragma unroll
            for (int b = 0; b < 4; ++b) acc[a][b] = (f32x4){0.f, 0.f, 0.f, 0.f};
        gemm_kloop<4, 4>(acc, W + (size_t)n0 * DFF, DFF, X + (size_t)m0 * DFF, DFF, DFF, smem, tid);
        const int t2 = launder(tid);
        const int lane = t2 & 63, wv = t2 >> 6, wn = wv >> 1, wt = wv & 1, fr = lane & 15, g = lane >> 4;
        const int fb = n0 + wn * 64 + 16 * g;
#pragma unroll
        for (int mt = 0; mt < 4; ++mt) {
            const int m = m0 + wt * 64 + 16 * mt + fr;
            float* d = out + (size_t)m * 1024 + fb;
#pragma unroll
            for (int a = 0; a < 4; ++a) *(f32x4*)(d + 4 * a) = acc[a][mt];
        }
    }
}


DI void out_tile(const Ctx& p, int l, int mt0, int nt0, char* smem, int tid) {
    const bf16_t* W = (const bf16_t*)(p.ws() + OFF_WOUT) + (size_t)l * SZ_WOUT;
    const bf16_t* X = (const bf16_t*)(p.ws() + OFF_MERGED);
    float* out = (float*)(p.ws() + OFF_PROJ + (size_t)mt0 * PPB);
    const int m0 = mt0 * 128, n0 = nt0 * 128;
    f32x4 acc[4][4];
#pragma unroll
    for (int a = 0; a < 4; ++a)
#pragma unroll
        for (int b = 0; b < 4; ++b) acc[a][b] = (f32x4){0.f, 0.f, 0.f, 0.f};
    gemm_kloop<4, 4>(acc, W + (size_t)n0 * 1024, 1024, X + (size_t)m0 * 1024, 1024, 1024, smem, tid);
    const int t2 = launder(tid);
    const int lane = t2 & 63, wv = t2 >> 6, wn = wv >> 1, wt = wv & 1, fr = lane & 15, g = lane >> 4;
    const int fb = n0 + wn * 64 + 16 * g;
#pragma unroll
    for (int mt = 0; mt < 4; ++mt) {
        float* d = out + (size_t)(wt * 64 + 16 * mt + fr) * 1024 + fb;
#pragma unroll
        for (int a = 0; a < 4; ++a) *(f32x4*)(d + 4 * a) = acc[a][mt];
    }
}

DI void gemm_uq_tile(const Ctx& p, int l, int ps, int tile, char* smem, int tid) {
    const bf16_t* W = (const bf16_t*)(p.ws() + OFF_WUQ) + (size_t)l * SZ_WUQ;
    const bf16_t* X = (const bf16_t*)(p.ws() + OFF_PROJ) + C_MCQ;
    bf16_t* QM = (bf16_t*)(p.ws() + OFF_QM);
    const float* t8 = (const float*)(p.ws() + OFF_T8);
    const int lane = tid & 63, wv = tid >> 6, wn = wv >> 1, wt = wv & 1, fr = lane & 15, g = lane >> 4;
    const int mt0 = tile / 6, nt0 = tile % 6, m0 = mt0 * 128, n0 = nt0 * 128;
    f32x4 acc[4][4];
#pragma unroll
    for (int a = 0; a < 4; ++a)
#pragma unroll
        for (int b = 0; b < 4; ++b) acc[a][b] = (f32x4){0.f, 0.f, 0.f, 0.f};
    gemm_kloop<4, 4>(acc, W + (size_t)n0 * 384, 384, X + (size_t)m0 * INWP, INWP, 384, smem, tid);
    const int fb = n0 + wn * 64 + 16 * g;
    const int o = fb % 96;
#pragma unroll
    for (int mt = 0; mt < 4; ++mt) {
        const int m = m0 + wt * 64 + 16 * mt + fr;
        float v[16];
#pragma unroll
        for (int a = 0; a < 4; ++a)
#pragma unroll
            for (int r = 0; r < 4; ++r) v[4 * a + r] = acc[a][mt][r];
        if (m >= 4096 && o >= 64) {
            const int t = (m - 4096) & 2047;
            const int pos = (o == 64) ? (t >> 6) : (t & 63);
#pragma unroll
            for (int j = 0; j < 8; ++j) {
                const float c = t8[pos * 8 + j], s = t8[512 + pos * 8 + j];
                const float x1 = v[j], x2 = v[j + 8];
                v[j] = x1 * c - x2 * s; v[j + 8] = x2 * c + x1 * s;
            }
        }
        bf16_t* d = QM + (size_t)m * 768 + fb;
        st_wt16(d, pack8(v)); st_wt16(d + 8, pack8(v + 8));
    }
}

DI void gemm_ukv_tile(const Ctx& p, int l, int tile, char* smem, int tid) {
    const bf16_t* W = (const bf16_t*)(p.ws() + OFF_WUKV) + (size_t)l * SZ_WUKV;
    const bf16_t* X = (const bf16_t*)(p.ws() + OFF_CKV);
    bf16_t* KN = (bf16_t*)(p.ws() + OFF_KN);
    bf16_t* VMT = (bf16_t*)(p.ws() + OFF_VMT);
    const int lane = tid & 63, wv = tid >> 6, wn = wv >> 1, wt = wv & 1, fr = lane & 15, g = lane >> 4;
    const int mt0 = tile / 8, nt0 = tile % 8, m0 = mt0 * 128, n0 = nt0 * 128;
    f32x4 acc[4][4];
#pragma unroll
    for (int a = 0; a < 4; ++a)
#pragma unroll
        for (int b = 0; b < 4; ++b) acc[a][b] = (f32x4){0.f, 0.f, 0.f, 0.f};
    gemm_kloop<4, 4>(acc, W + (size_t)n0 * 256, 256, X + (size_t)m0 * 256, 256, 256, smem, tid);
    const int fb = n0 + wn * 64 + 16 * g;
    const int head = fb >> 7, o = fb & 127;
    int key0, Lk;
    if (m0 < 4096) { key0 = m0 & ~255; Lk = 256; } else { const int j = (m0 - 4096) / 2304; key0 = 4096 + j * 2304; Lk = 2304; }
#pragma unroll
    for (int mt = 0; mt < 4; ++mt) {
        const int m = m0 + wt * 64 + 16 * mt + fr;
        float v[16];
#pragma unroll
        for (int a = 0; a < 4; ++a)
#pragma unroll
            for (int r = 0; r < 4; ++r) v[4 * a + r] = acc[a][mt][r];
        if (o < 64) {
            bf16_t* d = KN + (size_t)m * 512 + head * 64 + o;
            st_wt16(d, pack8(v)); st_wt16(d + 8, pack8(v + 8));
        } else {
            bf16_t* d = VMT + (size_t)key0 * 512 + (size_t)(head * 64 + (o - 64)) * Lk + (m - key0);
#pragma unroll
            for (int i = 0; i < 16; ++i) st_wt2(d + (size_t)i * Lk, f2bf(v[i]));
        }
    }
}

DI void merge_tile(const Ctx& p, int l, int mt0, int nt0, char* smem, int tid) {
    {
        const int m0 = mt0 * 128, n0 = nt0 * 128;
        u32x2 mgp[4][4];
#pragma unroll
        for (int a = 0; a < 4; ++a)
#pragma unroll
            for (int b = 0; b < 4; ++b) mgp[a][b] = (u32x2){0u, 0u};
#pragma unroll 1
        for (int br = 0; br < 4; ++br) {
            u32x2 gpk[4][4];
            {
                f32x4 ga[4][4];
#pragma unroll
                for (int a = 0; a < 4; ++a)
#pragma unroll
                    for (int b = 0; b < 4; ++b) ga[a][b] = (f32x4){0.f, 0.f, 0.f, 0.f};
                gemm_kloop<4, 4, false>(ga, (const bf16_t*)(p.ws() + OFF_WM) + (size_t)l * SZ_WM + (size_t)(br * 1024 + n0) * 1024, 1024,
                                       (const bf16_t*)(p.ws() + OFF_H) + (size_t)m0 * 1024, 1024, 1024, smem, tid);
                const int t2 = launder(tid);
                const int fb = n0 + (t2 >> 7) * 64 + 16 * ((t2 & 63) >> 4);
                const float* bm = p.in(36) + (size_t)l * 4096;
#pragma unroll
                for (int a = 0; a < 4; ++a) {
                    const f32x4 bv = *(const f32x4*)(bm + br * 1024 + fb + 4 * a);
#pragma unroll
                    for (int mt = 0; mt < 4; ++mt) {
                        gpk[a][mt][0] = pk2(sigmoidf(ga[a][mt][0] + bv[0]), sigmoidf(ga[a][mt][1] + bv[1]));
                        gpk[a][mt][1] = pk2(sigmoidf(ga[a][mt][2] + bv[2]), sigmoidf(ga[a][mt][3] + bv[3]));
                    }
                }
            }
            f32x4 pa[4][4];
#pragma unroll
            for (int a = 0; a < 4; ++a)
#pragma unroll
                for (int b = 0; b < 4; ++b) pa[a][b] = (f32x4){0.f, 0.f, 0.f, 0.f};
            const bf16_t* xb; size_t ldb;
            const bf16_t* PROJ = (const bf16_t*)(p.ws() + OFF_PROJ);
            if (br == 0) { xb = PROJ + (size_t)m0 * INWP + C_Z; ldb = INWP; }
            else if (br == 1) { xb = PROJ + (size_t)m0 * INWP + C_RG; ldb = INWP; }
            else if (br == 2) { xb = (const bf16_t*)(p.ws() + OFF_OA) + (size_t)m0 * 512; ldb = 512; }
            else { xb = (const bf16_t*)(p.ws() + OFF_OM) + (size_t)m0 * 512; ldb = 512; }
            gemm_kloop<4, 4, false>(pa, (const bf16_t*)(p.ws() + OFF_WBR) + (size_t)l * SZ_WBR + (size_t)br * 1024 * 512 + (size_t)n0 * 512, 512, xb, ldb, 512, smem, tid);
#pragma unroll
            for (int a = 0; a < 4; ++a)
#pragma unroll
                for (int mt = 0; mt < 4; ++mt) {
                    const float m0 = __uint_as_float(mgp[a][mt][0] << 16) + __uint_as_float(gpk[a][mt][0] << 16) * pa[a][mt][0];
                    const float m1 = __uint_as_float(mgp[a][mt][0] & 0xffff0000u) + __uint_as_float(gpk[a][mt][0] & 0xffff0000u) * pa[a][mt][1];
                    const float m2 = __uint_as_float(mgp[a][mt][1] << 16) + __uint_as_float(gpk[a][mt][1] << 16) * pa[a][mt][2];
                    const float m3 = __uint_as_float(mgp[a][mt][1] & 0xffff0000u) + __uint_as_float(gpk[a][mt][1] & 0xffff0000u) * pa[a][mt][3];
                    mgp[a][mt][0] = pk2(m0, m1); mgp[a][mt][1] = pk2(m2, m3);
                }
        }
        const int t3 = launder(tid);
        const int fr = t3 & 15, g = (t3 & 63) >> 4, wn = t3 >> 7, wt = (t3 >> 6) & 1;
        const int fb = n0 + wn * 64 + 16 * g;
        bf16_t* MG = (bf16_t*)(p.ws() + OFF_MERGED);
#pragma unroll
        for (int mt = 0; mt < 4; ++mt) {
            const int m = m0 + wt * 64 + 16 * mt + fr;
            bf16_t* d = MG + (size_t)m * 1024 + fb;
            *(u32x4*)d = (u32x4){mgp[0][mt][0], mgp[0][mt][1], mgp[1][mt][0], mgp[1][mt][1]};
            *(u32x4*)(d + 8) = (u32x4){mgp[2][mt][0], mgp[2][mt][1], mgp[3][mt][0], mgp[3][mt][1]};
        }
    }
}

struct Team { int panel, j, size; };
DI Team team_info(volatile LAS unsigned* xw) {
    const int nloc = __builtin_amdgcn_readfirstlane((int)xw[0]), nx = __builtin_amdgcn_readfirstlane((int)xw[1]);
    const int r = __builtin_amdgcn_readfirstlane((int)xw[6]), vloc = __builtin_amdgcn_readfirstlane((int)xw[7]);
    const int p0 = (64 * r) / nx, np = (64 * (r + 1)) / nx - p0;
    Team t; const int ti = vloc % np;
    t.panel = p0 + ti; t.j = vloc / np; t.size = nloc / np + (ti < nloc % np ? 1 : 0);
    return t;
}
DI unsigned ctr_ld(unsigned* c) { return __hip_atomic_load(c, __ATOMIC_RELAXED, __HIP_MEMORY_SCOPE_AGENT); }
DI void team_sync(unsigned* cnt, unsigned need, unsigned* upself, unsigned nup, unsigned* nb0, unsigned* nb1, int tid) {
    asm volatile("s_waitcnt vmcnt(0)" ::: "memory");
    __syncthreads();
    if (tid == 0) {
        if (upself) __hip_atomic_fetch_add(upself, nup, __ATOMIC_RELAXED, __HIP_MEMORY_SCOPE_AGENT);
        __hip_atomic_fetch_add(cnt, 1u, __ATOMIC_RELAXED, __HIP_MEMORY_SCOPE_AGENT);
        unsigned sp = 0;
        while (ctr_ld(cnt) < need || (nb0 && ctr_ld(nb0) < 44u) || (nb1 && ctr_ld(nb1) < 44u)) { __builtin_amdgcn_s_sleep(4); if (++sp > (1u << 24)) break; }
        __builtin_amdgcn_fence(__ATOMIC_ACQUIRE, "agent");
        asm volatile("s_waitcnt vmcnt(0)" ::: "memory");
    }
    __syncthreads();
}
#ifndef CHAIN_GRID
#define CHAIN_GRID 0
#endif
DI void phase_chain(const Ctx& p, int l, int ps, unsigned* wq, volatile LAS unsigned* xw, const XcdBarrier& bar, char* smem, int tid) {
    const Team tm = team_info(xw);
    unsigned* tcnt = (unsigned*)(p.ws() + OFF_CTR) + CTR_TEAM + ((ps * 2 + l) * 64 + tm.panel) * 128;
    unsigned* upc = tcnt + 64;
    const unsigned sz = (unsigned)tm.size;
    unsigned ep = 0u;
    for (int nt = tm.j; nt < 8; nt += tm.size) merge_tile(p, l, tm.panel, nt, smem, tid);
    if (CHAIN_GRID & 1) xcd_barrier(bar, tid); else { ep += sz; team_sync(tcnt, ep, nullptr, 0u, nullptr, nullptr, tid); }
    for (int nt = tm.j; nt < 8; nt += tm.size) out_tile(p, l, tm.panel, nt, smem, tid);
    if (CHAIN_GRID & 2) xcd_barrier(bar, tid); else { ep += sz; team_sync(tcnt, ep, nullptr, 0u, nullptr, nullptr, tid); }
    res_rows(p, ps, l, 0, (const float*)(p.ws() + OFF_PROJ + (size_t)tm.panel * PPB), tm.panel, tm.j, tm.size, launder(tid));
    if (CHAIN_GRID & 4) xcd_barrier(bar, tid); else { ep += sz; team_sync(tcnt, ep, nullptr, 0u, nullptr, nullptr, tid); }
    unsigned nup = 0u;
    for (int nt = tm.j; nt < 44; nt += tm.size) { up_tile(p, l, tm.panel, nt, smem, tid); ++nup; }
    if (launder_s(ps) == 0) {
        const int lo = l * T_LAYER + T_UPEND, hi = l == 0 ? T_LAYER + T_IN : 2 * T_LAYER;
        for (;;) {
            const int k = next_item(wq, xw + 2, tid);
            const int w0 = lo + 4 * k;
            if (w0 >= hi) break;
            wtile_run(p, w0, min(w0 + 4, hi), 1, smem, tid);
        }
    }
    if (CHAIN_GRID & 8) xcd_barrier(bar, tid);
    else {
        const Tok k0 = tok_info(tm.panel * 128, 0);
        unsigned* nb0 = k0.t > 0 ? upc - 128 : nullptr;
        unsigned* nb1 = k0.t + 128 < k0.L ? upc + 128 : nullptr;
        ep += sz; team_sync(tcnt, ep, upc, nup, nb0, nb1, tid);
    }
    for (int nt = tm.j; nt < 8; nt += tm.size) down_tile(p, l, tm.panel, nt, smem, tid);
    if (CHAIN_GRID & 16) xcd_barrier(bar, tid); else { ep += sz; team_sync(tcnt, ep, nullptr, 0u, nullptr, nullptr, tid); }
    res_rows(p, ps, l, 1, (const float*)(p.ws() + OFF_FO) + (size_t)tm.panel * 128 * 1024, tm.panel, tm.j, tm.size, launder(tid));
}
DI void prep_token(const Ctx& p, int l, int ps, int m, int lane) {
    char* ws = p.ws();
    bf16_t* PROJ = (bf16_t*)(ws + OFF_PROJ);
    const float* t16 = (const float*)(ws + OFF_T16);
    const float* t8 = (const float*)(ws + OFF_T8);
    const Tok k = tok_info(m, ps);
    bf16_t* pr = PROJ + (size_t)m * INWP;
    if (lane < 16) {
        const float v = ((const float*)(ws + OFF_DTRAW))[(size_t)m * 16 + lane] + p.in(19)[l * 16 + lane];
        const float sp = v > 20.f ? v : log1pe(__expf(v));
        ((float*)(ws + OFF_DT))[(size_t)m * 16 + lane] = sp;
    }
    {
        const int seqkey0 = k.lat ? (k.krow - 256 - k.t) : (k.krow - k.t);
        const int Lk = k.lat ? 2304 : 256;
        const int keyidx = k.krow - seqkey0;
        float v[8];
        if (lane < 32) unpack8(*(const u32x4*)(pr + C_AK + lane * 8), v);
        else {
#pragma unroll
            for (int j = 0; j < 8; ++j) v[j] = 0.f;
        }
        float ss = 0.f;
#pragma unroll
        for (int j = 0; j < 8; ++j) ss += v[j] * v[j];
        ss += shx(ss, 1); ss += shx(ss, 2); ss += shx(ss, 4);
        const float rstd = rsqrtf(ss * (1.f / 64.f) + EPS);
        const int u = lane & 7, axis = u >> 2, pos = axis ? (k.t & 63) : (k.t >> 6);
        float kv[8];
        const float* w = p.in(26) + l * 64 + u * 8;
#pragma unroll
        for (int j = 0; j < 8; ++j) kv[j] = (v[j] * rstd) * w[j];
        float kr[8];
#pragma unroll
        for (int j = 0; j < 8; ++j) {
            const float other = shx(kv[j], 2);
            const int fi = (u & 1) * 8 + j;
            const float c = t16[pos * 16 + fi], s = t16[1024 + pos * 16 + fi];
            kr[j] = (u & 2) ? (kv[j] * c + other * s) : (kv[j] * c - other * s);
        }
        if (lane < 16) {
            if (!k.lat) {
                float* o = p.out() + O_CK + ((size_t)(k.b * 2 + l) * 256 + k.t) * 128 + lane * 8;
                *(f32x4*)o = (f32x4){kv[0], kv[1], kv[2], kv[3]}; *(f32x4*)(o + 4) = (f32x4){kv[4], kv[5], kv[6], kv[7]};
            }
            bf16_t* ka = (bf16_t*)(ws + OFF_KA) + (size_t)k.krow * 128 + lane * 8;
            *(u32x4*)ka = k.lat ? pack8(kr) : pack8(kv);
        } else if (lane < 32) {
            const int d0 = (lane - 16) * 8;
            if (!k.lat) {
                float* o = p.out() + O_CV + ((size_t)(k.b * 2 + l) * 256 + k.t) * 128 + d0;
                *(f32x4*)o = (f32x4){v[0], v[1], v[2], v[3]}; *(f32x4*)(o + 4) = (f32x4){v[4], v[5], v[6], v[7]};
            }
            bf16_t* vt = (bf16_t*)(ws + OFF_VAT) + (size_t)seqkey0 * 128 + (size_t)d0 * Lk + keyidx;
#pragma unroll
            for (int j = 0; j < 8; ++j) vt[(size_t)j * Lk] = f2bf(v[j]);
        }
    }
    {
        float v[8];
        if (lane < 48) unpack8(*(const u32x4*)(pr + C_MCQ + lane * 8), v);
        else {
#pragma unroll
            for (int j = 0; j < 8; ++j) v[j] = 0.f;
        }
        float ss = 0.f;
#pragma unroll
        for (int j = 0; j < 8; ++j) ss += v[j] * v[j];
        ss = wsum(ss);
        const float rstd = rsqrtf(ss * (1.f / 384.f) + EPS);
        if (lane < 48) {
            const float* w = p.in(27) + l * 384 + lane * 8;
#pragma unroll
            for (int j = 0; j < 8; ++j) v[j] = (v[j] * rstd) * w[j];
            *(u32x4*)(pr + C_MCQ + lane * 8) = pack8(v);
        }
    }
    {
        float v[8];
        if (lane < 36) unpack8(*(const u32x4*)(pr + C_MCKV + lane * 8), v);
        else {
#pragma unroll
            for (int j = 0; j < 8; ++j) v[j] = 0.f;
        }
        float ss = 0.f;
        if (lane < 32) {
#pragma unroll
            for (int j = 0; j < 8; ++j) ss += v[j] * v[j];
        }
        ss = wsum(ss);
        const float rstd = rsqrtf(ss * (1.f / 256.f) + EPS);
        const int u = (lane - 32) & 3, axis = u >> 1, pos = axis ? (k.t & 63) : (k.t >> 6);
        float kr[8];
#pragma unroll
        for (int j = 0; j < 8; ++j) {
            const float other = shx(v[j], 1);
            const float c = t8[pos * 8 + j], s = t8[512 + pos * 8 + j];
            kr[j] = (u & 1) ? (v[j] * c + other * s) : (v[j] * c - other * s);
        }
        if (lane < 32) {
            const float* w = p.in(29) + l * 256 + lane * 8;
            float c[8];
#pragma unroll
            for (int j = 0; j < 8; ++j) c[j] = (v[j] * rstd) * w[j];
            if (!k.lat) {
                float* o = p.out() + O_CC + ((size_t)(k.b * 2 + l) * 256 + k.t) * 256 + lane * 8;
                *(f32x4*)o = (f32x4){c[0], c[1], c[2], c[3]}; *(f32x4*)(o + 4) = (f32x4){c[4], c[5], c[6], c[7]};
            }
            *(u32x4*)((bf16_t*)(ws + OFF_CKV) + (size_t)k.krow * 256 + lane * 8) = pack8(c);
        } else if (lane < 36) {
            const int d0 = (lane - 32) * 8;
            if (!k.lat) {
                float* o = p.out() + O_CR + ((size_t)(k.b * 2 + l) * 256 + k.t) * 32 + d0;
                *(f32x4*)o = (f32x4){v[0], v[1], v[2], v[3]}; *(f32x4*)(o + 4) = (f32x4){v[4], v[5], v[6], v[7]};
            }
            *(u32x4*)((bf16_t*)(ws + OFF_KRP) + (size_t)k.krow * 32 + d0) = k.lat ? pack8(kr) : pack8(v);
        }
    }
}
DI void prep_conv_item(const Ctx& p, int l, int ps, int item, int lane) {
    const int run = item >> 1, cbk = item & 1;
    const int c0 = cbk * 512 + lane * 8;
    if (c0 >= 768) return;
    const int m0 = run * 16;
    const Tok k = tok_info(m0, ps);
    const float* cw = p.in(17) + (size_t)l * 3 * 768; const float* cb = p.in(18) + (size_t)l * 768;
    float w[4][8];
#pragma unroll
    for (int tp = 0; tp < 4; ++tp) {
        const float* src = (tp < 3) ? cw + tp * 768 + c0 : cb + c0;
        const f32x4 a0 = *(const f32x4*)src, a1 = *(const f32x4*)(src + 4);
#pragma unroll
        for (int e = 0; e < 4; ++e) { w[tp][e] = a0[e]; w[tp][4 + e] = a1[e]; }
    }
    const bf16_t* xb = (const bf16_t*)(p.ws() + OFF_PROJ) + (size_t)m0 * INWP + C_XBC + c0;
    bf16_t* xo = (bf16_t*)(p.ws() + OFF_XBCA) + (size_t)m0 * 768 + c0;
    const u32x4 zero = {0u, 0u, 0u, 0u};
    u32x4 pv = zero, cv;
    if (k.t > 0) pv = gld16(xb - INWP);
    cv = gld16(xb);
#pragma unroll 4
    for (int i = 0; i < 16; ++i) {
        u32x4 nv = zero;
        if (k.t + i + 1 < k.L) nv = gld16(xb + (size_t)(i + 1) * INWP);
        float a[8], b[8], c[8], o[8];
        unpack8(pv, a); unpack8(cv, b); unpack8(nv, c);
#pragma unroll
        for (int e = 0; e < 8; ++e) o[e] = siluf(w[3][e] + w[0][e] * a[e] + w[1][e] * b[e] + w[2][e] * c[e]);
        *(u32x4*)(xo + (size_t)i * 768) = pack8(o);
        pv = cv; cv = nv;
    }
}
DI void prep_cache_row(const Ctx& p, int l, int ps, int r, int lane) {
    char* ws = p.ws();
    const int j = r >> 8, c = r & 255, b = ps * 2 + j;
    const int key0 = 4096 + j * 2304, krow = key0 + c, Lk = 2304;
    const size_t src = (size_t)(b * 2 + l) * 256 + c;
    if (lane < 16) {
        const float* s = p.in(4) + src * 128 + lane * 8; float v[8];
#pragma unroll
        for (int i = 0; i < 8; ++i) v[i] = s[i];
        *(u32x4*)((bf16_t*)(ws + OFF_KA) + (size_t)krow * 128 + lane * 8) = pack8(v);
    } else if (lane < 32) {
        const int d0 = (lane - 16) * 8;
        const float* s = p.in(5) + src * 128 + d0;
        bf16_t* vt = (bf16_t*)(ws + OFF_VAT) + (size_t)key0 * 128 + (size_t)d0 * Lk + c;
#pragma unroll
        for (int i = 0; i < 8; ++i) vt[(size_t)i * Lk] = f2bf(s[i]);
    } else if (lane < 36) {
        const int d0 = (lane - 32) * 8;
        const float* s = p.in(7) + src * 32 + d0; float v[8];
#pragma unroll
        for (int i = 0; i < 8; ++i) v[i] = s[i];
        *(u32x4*)((bf16_t*)(ws + OFF_KRP) + (size_t)krow * 32 + d0) = pack8(v);
    }
    if (lane < 32) {
        const float* s = p.in(6) + src * 256 + lane * 8; float v[8];
#pragma unroll
        for (int i = 0; i < 8; ++i) v[i] = s[i];
        *(u32x4*)((bf16_t*)(ws + OFF_CKV) + (size_t)krow * 256 + lane * 8) = pack8(v);
    }
}
DI void phase_prep(const Ctx& p, int l, int ps, int tid) {
    const int lane = tid & 63, wv = tid >> 6;
    for (int m = BIDX * 4 + wv; m < NPT + 512 + 1024; m += gridDim.x * 4) {
        if (m < NPT) prep_token(p, l, ps, m, lane); else if (m < NPT + 512) prep_cache_row(p, l, ps, m - NPT, lane); else prep_conv_item(p, l, ps, m - NPT - 512, lane);
    }
}

template <int KC, int NQT>
DI void attn_tile(const bf16_t* __restrict__ Q, size_t ldq, const bf16_t* __restrict__ K1, size_t ldk1, const bf16_t* __restrict__ K2, size_t ldk2,
                  const bf16_t* __restrict__ VT, size_t ldvt, int nkt, float c2, bf16_t* __restrict__ O, size_t ldo,
                  const float* __restrict__ qnw  , const float* __restrict__ rope, int t0  , char* smem, int tid) {
    constexpr int KB = KC * 4096, STG = KB + 8192;
    tid = launder(tid);
    const int lane = tid & 63, w = tid >> 6, fr = lane & 15, g = lane >> 4;
    bf16x8 qf[NQT][KC];
#pragma unroll
    for (int qt = 0; qt < NQT; ++qt)
#pragma unroll
        for (int ks = 0; ks < KC; ++ks) { const u32x4 t4 = gld16(Q + (size_t)(16 * NQT * w + 16 * qt + fr) * ldq + ks * 32 + 8 * g); qf[qt][ks] = __builtin_bit_cast(bf16x8, t4); }
    if (KC == 2 && qnw) {
#pragma unroll
        for (int qt = 0; qt < NQT; ++qt) {
            float v[2][8]; float ss = 0.f;
#pragma unroll
            for (int ks = 0; ks < 2; ++ks) {
                const u32x4 t4 = __builtin_bit_cast(u32x4, qf[qt][ks]); unpack8(t4, v[ks]);
#pragma unroll
                for (int j = 0; j < 8; ++j) ss += v[ks][j] * v[ks][j];
            }
            ss += shx(ss, 16); ss += shx(ss, 32);
            const float rstd = rsqrtf(ss * (1.f / 64.f) + EPS);
            const int t = t0 + 16 * NQT * w + 16 * qt + fr;
#pragma unroll
            for (int ks = 0; ks < 2; ++ks) {
                const int pos = ks ? (t & 63) : (t >> 6);
#pragma unroll
                for (int j = 0; j < 8; ++j) {
                    float x = (v[ks][j] * rstd) * qnw[32 * ks + 8 * g + j];
                    if (rope) {
                        const float other = shx(x, 32);
                        const int fi = (g & 1) * 8 + j;
                        const float c = rope[pos * 16 + fi], sn = rope[1024 + pos * 16 + fi];
                        x = (g & 2) ? (x * c + other * sn) : (x * c - other * sn);
                    }
                    v[ks][j] = x;
                }
                const u32x4 t4 = pack8(v[ks]); qf[qt][ks] = __builtin_bit_cast(bf16x8, t4);
            }
        }
    }
    constexpr int NPK = KC * 4, PPW = (NPK + 8) / 4;
    static_assert((NPK + 8) % 4 == 0, "pieces must divide over 4 waves");
    const int wvu = __builtin_amdgcn_readfirstlane(w);
    unsigned poff[PPW];
#pragma unroll
    for (int j = 0; j < PPW; ++j) {
        const int pc = wvu * PPW + j;
        const bool isk = pc < NPK;
        const int pp = isk ? pc : pc - NPK;
        const int ks = pp >> 2, rb = pp & 3;
        const int rl = lane >> 2, row = rb * 16 + rl;
        const int q = isk ? ((row >> 3) & 3) : ((rl >> 2) & 3);
        const int gl = (lane & 3) ^ FQ(q);
        const unsigned ld = isk ? ((KC == 2 || ks < 2) ? (unsigned)ldk1 : (unsigned)ldk2) : (unsigned)ldvt;
        poff[j] = (unsigned)rl * ld + (unsigned)(gl * 8);
    }
    auto issue = [&](int kt, char* stage) {
#pragma unroll
        for (int j = 0; j < PPW; ++j) {
            const int pc = wvu * PPW + j;
            const bool isk = pc < NPK;
            const int pp = isk ? pc : pc - NPK;
            const int ks = pp >> 2, rb = pp & 3;
            const bf16_t* base;
            if (isk) { if (KC == 2 || ks < 2) base = K1 + ks * 32 + (size_t)(kt * 64 + rb * 16) * ldk1; else base = K2 + (size_t)(kt * 64 + rb * 16) * ldk2; }
            else base = VT + ks * 32 + (size_t)kt * 64 + (size_t)(rb * 16) * ldvt;
            __builtin_amdgcn_global_load_lds((const unsigned*)(base + poff[j]), (unsigned*)(stage + (isk ? 0 : KB) + (ks * 64 + rb * 16) * 64), 16, 0, 0);
        }
    };
    const int koff = tile_off(64, 0, 8 * (fr >> 2) + (fr & 3), g, fr >> 2);
    const int voff = KB + tile_off(64, 0, fr, g, (fr >> 2) & 3);
    f32x4 o[4][NQT];
#pragma unroll
    for (int a = 0; a < 4; ++a)
#pragma unroll
        for (int qt = 0; qt < NQT; ++qt) o[a][qt] = (f32x4){0.f, 0.f, 0.f, 0.f};
    float mrun[NQT], lrun[NQT];
#pragma unroll
    for (int qt = 0; qt < NQT; ++qt) { mrun[qt] = -1e30f; lrun[qt] = 0.f; }
    __syncthreads();
    issue(0, smem);
    if (nkt > 1) {
        issue(1, smem + STG);
        if (PPW == 4) asm volatile("s_waitcnt vmcnt(4)" ::: "memory"); else asm volatile("s_waitcnt vmcnt(5)" ::: "memory");
    } else asm volatile("s_waitcnt vmcnt(0)" ::: "memory");
    __syncthreads();
    int so_cur = 0, so_nn = 2 * STG;
    for (int kt = 0; kt < nkt; ++kt) {
        if (kt + 2 < nkt) issue(kt + 2, smem + so_nn);
        __builtin_amdgcn_sched_barrier(0);
        const char* sb = smem + so_cur;
        f32x4 s[4][NQT];
#pragma unroll
        for (int a = 0; a < 4; ++a)
#pragma unroll
            for (int qt = 0; qt < NQT; ++qt) s[a][qt] = (f32x4){0.f, 0.f, 0.f, 0.f};
        bf16x8 kf[KC][4];
#pragma unroll
        for (int ks = 0; ks < KC; ++ks)
#pragma unroll
            for (int a = 0; a < 4; ++a) kf[ks][a] = *(const bf16x8*)(sb + koff + ((a >> 1) * 32 + (a & 1) * 4) * 64 + ks * 4096);
        __builtin_amdgcn_sched_barrier(0);
#pragma unroll
        for (int ks = 0; ks < KC; ++ks)
#pragma unroll
            for (int a = 0; a < 4; ++a) {
#pragma unroll
                for (int qt = 0; qt < NQT; ++qt) s[a][qt] = __builtin_amdgcn_mfma_f32_16x16x32_bf16(kf[ks][a], qf[qt][ks], s[a][qt], 0, 0, 0);
            }
        bf16x8 vfr[2][4];
#pragma unroll
        for (int s2 = 0; s2 < 2; ++s2)
#pragma unroll
            for (int dt = 0; dt < 4; ++dt) vfr[s2][dt] = *(const bf16x8*)(sb + voff + dt * 1024 + s2 * 4096);
        __builtin_amdgcn_sched_barrier(0);
        bf16x8 pf[NQT][2];
#pragma unroll
        for (int qt = 0; qt < NQT; ++qt) {
            float mx = s[0][qt][0];
#pragma unroll
            for (int a = 0; a < 4; ++a)
#pragma unroll
                for (int r = 0; r < 4; ++r) mx = fmaxf(mx, s[a][qt][r]);
            mx = gmax4(mx);
            const float mnew = fmaxf(mrun[qt], mx);
            const float alpha = __builtin_amdgcn_exp2f((mrun[qt] - mnew) * c2);
            mrun[qt] = mnew;
            const float mc = mnew * c2;
            float ls = 0.f; float pv[16];
#pragma unroll
            for (int a = 0; a < 4; ++a)
#pragma unroll
                for (int r = 0; r < 4; ++r) { const float e = __builtin_amdgcn_exp2f(s[a][qt][r] * c2 - mc); pv[4 * a + r] = e; ls += e; }
            lrun[qt] = lrun[qt] * alpha + ls;
#pragma unroll
            for (int a = 0; a < 4; ++a) o[a][qt] = o[a][qt] * alpha;
            u32x4 w0 = pack8(pv), w1 = pack8(pv + 8);
            pf[qt][0] = __builtin_bit_cast(bf16x8, w0); pf[qt][1] = __builtin_bit_cast(bf16x8, w1);
        }
        __builtin_amdgcn_sched_barrier(0);
#pragma unroll
        for (int s2 = 0; s2 < 2; ++s2)
#pragma unroll
            for (int dt = 0; dt < 4; ++dt) {
#pragma unroll
                for (int qt = 0; qt < NQT; ++qt) o[dt][qt] = __builtin_amdgcn_mfma_f32_16x16x32_bf16(vfr[s2][dt], pf[qt][s2], o[dt][qt], 0, 0, 0);
            }
        __builtin_amdgcn_sched_barrier(0);
        if (kt + 2 < nkt) { if (PPW == 4) asm volatile("s_waitcnt vmcnt(4)" ::: "memory"); else asm volatile("s_waitcnt vmcnt(5)" ::: "memory"); }
        else asm volatile("s_waitcnt vmcnt(0)" ::: "memory");
        asm volatile("s_waitcnt lgkmcnt(0)" ::: "memory");
        __builtin_amdgcn_s_barrier();
        so_cur = (so_cur == 2 * STG) ? 0 : so_cur + STG;
        so_nn = (so_nn == 2 * STG) ? 0 : so_nn + STG;
    }
#pragma unroll
    for (int qt = 0; qt < NQT; ++qt) {
        float l = gsum4(lrun[qt]);
        const float inv = 1.f / l;
        bf16_t* orow = O + (size_t)(16 * NQT * w + 16 * qt + fr) * ldo + 4 * g;
#pragma unroll
        for (int dt = 0; dt < 4; ++dt) {
            u32x2 wv2; wv2[0] = pk2(o[dt][qt][0] * inv, o[dt][qt][1] * inv); wv2[1] = pk2(o[dt][qt][2] * inv, o[dt][qt][3] * inv);
            *(u32x2*)(orow + 16 * dt) = wv2;
        }
    }
}

struct Seq { int lat, tok0, L, key0, Lk, b; };
DI Seq seq_info(int s, int ps) {
    Seq q;
    if (s < 16) { q.lat = 0; q.tok0 = s * 256; q.L = 256; q.key0 = s * 256; q.Lk = 256; q.b = ps * 16 + s; }
    else { const int j = s - 16; q.lat = 1; q.tok0 = 4096 + j * 2048; q.L = 2048; q.key0 = 4096 + j * 2304; q.Lk = 2304; q.b = ps * 2 + j; }
    return q;
}
DI void attn_gqa_item(const Ctx& p, int l, int s, int head, int qb, int ps, char* smem, int tid) {
    const Seq q = seq_info(s, ps);
    const int rows = 128;
    const bf16_t* PROJ = (const bf16_t*)(p.ws() + OFF_PROJ);
    const bf16_t* Q = PROJ + (size_t)(q.tok0 + qb * rows) * INWP + C_AQ + head * 64;
    const int kh = head >> 2;
    const bf16_t* K = (const bf16_t*)(p.ws() + OFF_KA) + (size_t)q.key0 * 128 + kh * 64;
    const bf16_t* VT = (const bf16_t*)(p.ws() + OFF_VAT) + (size_t)q.key0 * 128 + (size_t)kh * 64 * q.Lk;
    bf16_t* O = (bf16_t*)(p.ws() + OFF_OA) + (size_t)(q.tok0 + qb * rows) * 512 + head * 64;
    const float c2 = 0.125f * 1.4426950408889634f;
    attn_tile<2, 2>(Q, INWP, K, 128, K, 128, VT, q.Lk, q.Lk / 64, c2, O, 512, p.in(25) + l * 64, q.lat ? (const float*)(p.ws() + OFF_T16) : nullptr, qb * 128, smem, tid);
}
DI void attn_mla_item(const Ctx& p, int s, int head, int qb, int ps, char* smem, int tid) {
    const Seq q = seq_info(s, ps);
    const int rows = 128;
    const bf16_t* Q = (const bf16_t*)(p.ws() + OFF_QM) + (size_t)(q.tok0 + qb * rows) * 768 + head * 96;
    const bf16_t* K1 = (const bf16_t*)(p.ws() + OFF_KN) + (size_t)q.key0 * 512 + head * 64;
    const bf16_t* K2 = (const bf16_t*)(p.ws() + OFF_KRP) + (size_t)q.key0 * 32;
    const bf16_t* VT = (const bf16_t*)(p.ws() + OFF_VMT) + (size_t)q.key0 * 512 + (size_t)head * 64 * q.Lk;
    bf16_t* O = (bf16_t*)(p.ws() + OFF_OM) + (size_t)(q.tok0 + qb * rows) * 512 + head * 64;
    const float c2 = 0.10206207261596577f * 1.4426950408889634f;
    attn_tile<3, 2>(Q, 768, K1, 512, K2, 32, VT, q.Lk, q.Lk / 64, c2, O, 512, nullptr, nullptr, 0, smem, tid);
}

template <int ET>
DI void scan_item(const bf16_t* __restrict__ Qp, size_t ldq, const bf16_t* __restrict__ Kp, size_t ldk, const bf16_t* __restrict__ Vp, size_t ldv,
                  const float* __restrict__ dtp  , float acoef  ,
                  int L, int dir, const float* __restrict__ s0, float* __restrict__ sout, int lds_state  , bf16_t* __restrict__ Op, size_t ldo,
                  const float* __restrict__ rope  , float kmul,
                  int nbase  , int nch  , const bf16_t* __restrict__ s0b  ,
                  bf16_t* __restrict__ lout  , float* __restrict__ dout  , char* smem, int tid) {
    constexpr int DV = 16 * ET;
    const bool stateonly = (lout != nullptr);
    constexpr int QS = 0, KS = 8192, KT = 16384, VTO = 24576, STO = VTO + DV * 128, ACO = STO + DV * 128;
    constexpr int NV = DV / 32;
    tid = launder(tid);
    const int lane = tid & 63, w = tid >> 6, fr = lane & 15, g = lane >> 4;
    float* acs = (float*)(smem + ACO);
    f32x4 sacc[ET];
#pragma unroll
    for (int et = 0; et < ET; ++et) {
        if (s0) {
#pragma unroll
            for (int r = 0; r < 4; ++r) sacc[et][r] = s0[(size_t)(16 * w + 4 * g + r) * lds_state + 16 * et + fr];
        } else if (s0b) {
#pragma unroll
            for (int r = 0; r < 4; ++r) sacc[et][r] = bf2f(s0b[(16 * w + 4 * g + r) * DV + 16 * et + fr]);
        } else sacc[et] = (f32x4){0.f, 0.f, 0.f, 0.f};
    }
    const int st_off = STO + ((w >> 1) * DV) * 64 + (g & 1) * 8;
    const int st_gg = (2 * w + (g >> 1)) & 3;
    __syncthreads();
    float* ropeL = (float*)(smem + ACO + 256);
    if (rope) {
#pragma unroll
        for (int i = 0; i < 2; ++i) *(f32x4*)(ropeL + (tid + 256 * i) * 4) = *(const f32x4*)(rope + (tid + 256 * i) * 4);
    }
#pragma unroll
    for (int et = 0; et < ET; ++et) {
        const int e = 16 * et + fr;
        u32x2 wv2; wv2[0] = pk2(sacc[et][0], sacc[et][1]); wv2[1] = pk2(sacc[et][2], sacc[et][3]);
        *(u32x2*)(smem + st_off + e * 64 + ((st_gg ^ FQ((e >> 2) & 3)) << 4)) = wv2;
    }
    __syncthreads();
    float dprod = 1.f;
    const int qoff = QS + tile_off(64, 0, 16 * w + fr, g, (fr >> 2) & 3);
    const int koff = KS + tile_off(64, 0, 8 * (fr >> 2) + (fr & 3), g, fr >> 2);
    const int ktoff = KT + tile_off(64, 0, 16 * w + fr, g, (fr >> 2) & 3);
    const int vtoff = VTO + tile_off(DV, 0, fr, g, (fr >> 2) & 3);
    const int stoff = STO + tile_off(DV, 0, fr, g, (fr >> 2) & 3);
    u32x4 gq[2], gk[2], gv[NV]; float gdt = 1.f;
    auto issue = [&](int c) {
        const int n0 = nbase + c * 64;
        {
            const int row = tid >> 2, cc0 = (tid & 1) | ((tid & 2) << 1);
            const int tl = dir ? (L - 1 - (n0 + row)) : (n0 + row);
#pragma unroll
            for (int i = 0; i < 2; ++i) {
                gq[i] = gld16(Qp + (size_t)tl * ldq + (cc0 + 2 * i) * 8);
                gk[i] = gld16(Kp + (size_t)tl * ldk + (cc0 + 2 * i) * 8);
            }
        }
#pragma unroll
        for (int i = 0; i < NV; ++i) {
            const int q = tid + 256 * i, row = q / (DV / 8), cc = q % (DV / 8);
            const int tl = dir ? (L - 1 - (n0 + row)) : (n0 + row);
            gv[i] = gld16(Vp + (size_t)tl * ldv + cc * 8);
        }
        if (dtp) { const int tl = dir ? (L - 1 - (n0 + lane)) : (n0 + lane); gdt = dtp[(size_t)tl * 16]; }
    };
    issue(0);
    for (int c = 0; c < nch; ++c) {
        const int n0 = nbase + c * 64;
        const float dtv = gdt;
        const float la = dtp ? dtv * acoef : acoef;
        float ac, aend;
        if (dtp) {
            ac = la;
#pragma unroll
            for (int o = 1; o < 64; o <<= 1) { const float t = shu(ac, o); if (lane >= o) ac += t; }
            aend = shf(ac, 63);
        } else { ac = (float)(lane + 1) * la; aend = 64.f * la; }
        if (w == 0) acs[lane] = ac;
        {
            const int row = tid >> 2, cc0 = (tid & 1) | ((tid & 2) << 1);
            const float ksc = shf(dtv, row) * kmul, wend = __expf(aend - shf(ac, row));
            float qa[2][8], ka[2][8];
#pragma unroll
            for (int i = 0; i < 2; ++i) { unpack8(gq[i], qa[i]); unpack8(gk[i], ka[i]); }
            if (rope) {
                const int tlr = dir ? (L - 1 - (n0 + row)) : (n0 + row);
                const int pos = (cc0 >> 2) ? (tlr & 63) : (tlr >> 6);
                const float* rp = ropeL + pos * 16 + (cc0 & 1) * 8;
                f32x4 rc[2], rs[2];
                rc[0] = *(const f32x4*)rp; rc[1] = *(const f32x4*)(rp + 4); rs[0] = *(const f32x4*)(rp + 1024); rs[1] = *(const f32x4*)(rp + 1028);
#pragma unroll
                for (int j = 0; j < 8; ++j) {
                    const float c = rc[j >> 2][j & 3], sn = rs[j >> 2][j & 3];
                    const float q1 = qa[0][j], q2 = qa[1][j], k1 = ka[0][j], k2 = ka[1][j];
                    qa[0][j] = q1 * c - q2 * sn; qa[1][j] = q2 * c + q1 * sn;
                    ka[0][j] = k1 * c - k2 * sn; ka[1][j] = k2 * c + k1 * sn;
                }
            }
#pragma unroll
            for (int i = 0; i < 2; ++i) {
                const int cc = cc0 + 2 * i;
                if (rope) *(u32x4*)(smem + QS + tile_off(64, cc >> 2, row, cc & 3, (row >> 2) & 3)) = pack8(qa[i]);
                else *(u32x4*)(smem + QS + tile_off(64, cc >> 2, row, cc & 3, (row >> 2) & 3)) = gq[i];
#pragma unroll
                for (int j = 0; j < 8; ++j) ka[i][j] *= ksc;
                *(u32x4*)(smem + KS + tile_off(64, cc >> 2, row, cc & 3, (row >> 3) & 3)) = pack8(ka[i]);
#pragma unroll
                for (int j = 0; j < 8; ++j) {
                    const int d = cc * 8 + j;
                    *(bf16_t*)(smem + KT + tile_off(64, row >> 5, d, (row >> 3) & 3, (d >> 2) & 3) + (row & 7) * 2) = f2bf(ka[i][j] * wend);
                }
            }
        }
#pragma unroll
        for (int i = 0; i < NV; ++i) {
            const int q = tid + 256 * i, row = q / (DV / 8), cc = q % (DV / 8);
            const u32x4 vv = gv[i];
#pragma unroll
            for (int j = 0; j < 8; ++j) {
                const int e = cc * 8 + j;
                const unsigned short h = (unsigned short)(vv[j >> 1] >> (16 * (j & 1)));
                *(bf16_t*)(smem + VTO + tile_off(DV, row >> 5, e, (row >> 3) & 3, (e >> 2) & 3) + (row & 7) * 2) = h;
            }
        }
        if (c + 1 < nch) issue(c + 1);
        __builtin_amdgcn_sched_barrier(0);
        __syncthreads();
        {
            const int irow = 16 * w + fr;
            const int ns = (w >> 1) + 1;
            bf16x8 qfr[2], sf[ET][2], kfa[2][2][2], vf[2][ET], kt2[2];
            qfr[0] = *(const bf16x8*)(smem + qoff); qfr[1] = *(const bf16x8*)(smem + qoff + 4096);
#pragma unroll
            for (int et = 0; et < ET; ++et)
#pragma unroll
                for (int ks = 0; ks < 2; ++ks) sf[et][ks] = *(const bf16x8*)(smem + stoff + et * 1024 + ks * DV * 64);
#pragma unroll
            for (int aa = 0; aa < 2; ++aa)
#pragma unroll
                for (int ks = 0; ks < 2; ++ks) kfa[0][aa][ks] = *(const bf16x8*)(smem + koff + (4 * aa) * 64 + ks * 4096);
            const float ai = acs[irow];
            f32x4 ajv[2][2];
#pragma unroll
            for (int aa = 0; aa < 2; ++aa) ajv[0][aa] = *(const f32x4*)(acs + 8 * g + 4 * aa);
            const float cd = __expf(acs[63]);
            __builtin_amdgcn_sched_barrier(0);
            f32x4 o[ET];
            if (!stateonly) {
#pragma unroll
                for (int et = 0; et < ET; ++et) {
                    o[et] = (f32x4){0.f, 0.f, 0.f, 0.f};
#pragma unroll
                    for (int ks = 0; ks < 2; ++ks) o[et] = __builtin_amdgcn_mfma_f32_16x16x32_bf16(sf[et][ks], qfr[ks], o[et], 0, 0, 0);
                }
            }
#pragma unroll
            for (int aa = 0; aa < 2; ++aa)
#pragma unroll
                for (int ks = 0; ks < 2; ++ks) kfa[1][aa][ks] = *(const bf16x8*)(smem + koff + (32 + 4 * aa) * 64 + ks * 4096);
#pragma unroll
            for (int ks = 0; ks < 2; ++ks) {
#pragma unroll
                for (int et = 0; et < ET; ++et) vf[ks][et] = *(const bf16x8*)(smem + vtoff + et * 1024 + ks * DV * 64);
                kt2[ks] = *(const bf16x8*)(smem + ktoff + ks * 4096);
            }
#pragma unroll
            for (int aa = 0; aa < 2; ++aa) ajv[1][aa] = *(const f32x4*)(acs + 32 + 8 * g + 4 * aa);
            __builtin_amdgcn_sched_barrier(0);
            if (!stateonly) {
                const float ei = __expf(ai);
#pragma unroll
                for (int et = 0; et < ET; ++et) o[et] = o[et] * ei;
#pragma unroll
                for (int s2 = 0; s2 < 2; ++s2) {
                    if (s2 < ns) {
                        f32x4 pp[2];
#pragma unroll
                        for (int aa = 0; aa < 2; ++aa) {
                            pp[aa] = (f32x4){0.f, 0.f, 0.f, 0.f};
#pragma unroll
                            for (int ks = 0; ks < 2; ++ks) pp[aa] = __builtin_amdgcn_mfma_f32_16x16x32_bf16(kfa[s2][aa][ks], qfr[ks], pp[aa], 0, 0, 0);
                        }
                        float pv[8];
#pragma unroll
                        for (int aa = 0; aa < 2; ++aa) {
                            const int j0 = 32 * s2 + 8 * g + 4 * aa;
#pragma unroll
                            for (int r = 0; r < 4; ++r) {
                                const float dec = __expf(fminf(ai - ajv[s2][aa][r], 0.f));
                                pv[4 * aa + r] = (j0 + r <= irow) ? pp[aa][r] * dec : 0.f;
                            }
                        }
                        const u32x4 pw = pack8(pv);
                        const bf16x8 pf = __builtin_bit_cast(bf16x8, pw);
#pragma unroll
                        for (int et = 0; et < ET; ++et) o[et] = __builtin_amdgcn_mfma_f32_16x16x32_bf16(vf[s2][et], pf, o[et], 0, 0, 0);
                    }
                }
                const int tl = dir ? (L - 1 - (n0 + irow)) : (n0 + irow);
                bf16_t* orow = Op + (size_t)tl * ldo + 4 * g;
#pragma unroll
                for (int et = 0; et < ET; ++et) {
                    u32x2 wv2; wv2[0] = pk2(o[et][0], o[et][1]); wv2[1] = pk2(o[et][2], o[et][3]);
                    st_wt8(orow + 16 * et, wv2);
                }
            }
            dprod *= cd;
#pragma unroll
            for (int et = 0; et < ET; ++et) sacc[et] = sacc[et] * cd;
#pragma unroll
            for (int ks = 0; ks < 2; ++ks)
#pragma unroll
                for (int et = 0; et < ET; ++et) sacc[et] = __builtin_amdgcn_mfma_f32_16x16x32_bf16(kt2[ks], vf[ks][et], sacc[et], 0, 0, 0);
        }
        __syncthreads();
#pragma unroll
        for (int et = 0; et < ET; ++et) {
            const int e = 16 * et + fr;
            u32x2 wv2; wv2[0] = pk2(sacc[et][0], sacc[et][1]); wv2[1] = pk2(sacc[et][2], sacc[et][3]);
            *(u32x2*)(smem + st_off + e * 64 + ((st_gg ^ FQ((e >> 2) & 3)) << 4)) = wv2;
        }
    }
    if (sout) {
#pragma unroll
        for (int et = 0; et < ET; ++et)
#pragma unroll
            for (int r = 0; r < 4; ++r) sout[(size_t)(16 * w + 4 * g + r) * lds_state + 16 * et + fr] = sacc[et][r];
    }
    if (lout) {
#pragma unroll
        for (int et = 0; et < ET; ++et)
#pragma unroll
            for (int r = 0; r < 4; ++r) st_wt2(lout + (16 * w + 4 * g + r) * DV + 16 * et + fr, f2bf(sacc[et][r]));
        if (tid == 0) st_wt4f(dout, dprod);
    }
    __syncthreads();
}

DI void scan_any_item(const Ctx& p, int l, int ps, int isret, int s, int h, int dir, int half, int mode, int seg, int sid, char* smem, int tid) {
    const Seq q = seq_info(s, ps);
    const bf16_t *Qp, *Kp, *Vp; size_t ld; const float* dtp; float acoef, kmul; const float* rope; bf16_t* O; float* so; int lds;
    if (isret) {
        const bf16_t* PR = (const bf16_t*)(p.ws() + OFF_PROJ) + (size_t)q.tok0 * INWP;
        const float x = p.in(23)[l * 8 + dir * 4 + h];
        acoef = fminf(x, 0.f) - log1pe(__expf(-fabsf(x)));
        Qp = PR + C_RQ + h * 64; Kp = PR + C_RK + h * 64; Vp = PR + C_RV + h * 128 + half * 64; ld = INWP; dtp = nullptr; kmul = 0.125f;
        rope = q.lat ? (const float*)(p.ws() + OFF_T16) : nullptr;
        O = (bf16_t*)(p.ws() + OFF_OR) + ((size_t)dir * NPT + q.tok0) * 512 + h * 128 + half * 64;
        so = p.out() + O_RET + ((size_t)((q.b * 2 + l) * 2 + dir) * 4 + h) * 8192 + half * 64; lds = 128;
    } else {
        const bf16_t* XB = (const bf16_t*)(p.ws() + OFF_XBCA) + (size_t)q.tok0 * 768;
        const int grp = h >> 2;
        Qp = XB + 640 + grp * 64; Kp = XB + 512 + grp * 64; Vp = XB + h * 64; ld = 768; kmul = 1.f; rope = nullptr;
        dtp = (const float*)(p.ws() + OFF_DT) + (size_t)q.tok0 * 16 + dir * 8 + h;
        acoef = -__expf(p.in(20)[l * 16 + dir * 8 + h]);
        O = (bf16_t*)(p.ws() + OFF_OS) + ((size_t)dir * NPT + q.tok0) * 512 + h * 64;
        so = p.out() + O_SSD + ((size_t)((q.b * 2 + l) * 2 + dir) * 8 + h) * 4096; lds = 64;
    }
    bf16_t* segb = (bf16_t*)(p.ws() + OFF_SEG) + (size_t)(sid * NSEG + seg) * 4096;
    float* segd = (float*)(p.ws() + OFF_SEGD) + sid * NSEG + seg;
    scan_item<4>(Qp, ld, Kp, ld, Vp, ld, dtp, acoef, q.L, dir, nullptr, mode == 0 ? so : nullptr, lds, O, 512, rope, kmul,
                 mode == 0 ? 0 : seg * SEGTOK, mode == 0 ? (q.L >> 6) : (SEGTOK >> 6), mode == 3 ? segb : nullptr, mode == 1 ? segb : nullptr, mode == 1 ? segd : nullptr, smem, tid);
}
DI void scan_combine_item(const Ctx& p, int l, int ps, int sid, int tid) {
    const float* s0; int ld;
    if (sid < 32) { const int b = ps * 2 + (sid >> 4), h = (sid >> 1) & 7, dir = sid & 1; s0 = p.in(2) + ((size_t)((b * 2 + l) * 2 + dir) * 8 + h) * 4096; ld = 64; }
    else { const int k = sid - 32, b = ps * 2 + (k >> 4), h = (k >> 2) & 3, dir = (k >> 1) & 1, half = k & 1;
           s0 = p.in(3) + ((size_t)((b * 2 + l) * 2 + dir) * 4 + h) * 8192 + half * 64; ld = 128; }
    bf16_t* segb = (bf16_t*)(p.ws() + OFF_SEG) + (size_t)sid * NSEG * 4096;
    const float* segd = (const float*)(p.ws() + OFF_SEGD) + sid * NSEG;
    const int t2 = launder(tid);
    const float* sp = s0 + (size_t)(t2 >> 2) * ld + (t2 & 3) * 16;
    bf16_t* bp = segb + t2 * 16;
    float S[16];
#pragma unroll
    for (int k = 0; k < 4; ++k) { const f32x4 v = *(const f32x4*)(sp + 4 * k); S[4 * k] = v[0]; S[4 * k + 1] = v[1]; S[4 * k + 2] = v[2]; S[4 * k + 3] = v[3]; }
#pragma unroll 1
    for (int g2 = 0; g2 < NSEG; ++g2) {
        float loc[16]; float d = 0.f;
        if (g2 < NSEG - 1) { d = segd[g2]; unpack8(*(const u32x4*)(bp + g2 * 4096), loc); unpack8(*(const u32x4*)(bp + g2 * 4096 + 8), loc + 8); }
        else {
#pragma unroll
            for (int k = 0; k < 16; ++k) loc[k] = 0.f;
        }
        st_wt16(bp + g2 * 4096, pack8(S)); st_wt16(bp + g2 * 4096 + 8, pack8(S + 8));
#pragma unroll
        for (int k = 0; k < 16; ++k) S[k] = S[k] * d + loc[k];
    }
}

DI void postscan_token(const Ctx& p, int l, int m, int lane) {
    char* ws = p.ws();
    bf16_t* pr = (bf16_t*)(ws + OFF_PROJ) + (size_t)m * INWP;
    const int c0 = lane * 8;
    {
        const bf16_t* OS = (const bf16_t*)(ws + OFF_OS);
        float a[8], b[8], xs[8], z[8];
        unpack8(*(const u32x4*)(OS + (size_t)m * 512 + c0), a);
        unpack8(*(const u32x4*)(OS + ((size_t)NPT + m) * 512 + c0), b);
        unpack8(*(const u32x4*)((const bf16_t*)(ws + OFF_XBCA) + (size_t)m * 768 + c0), xs);
        unpack8(*(const u32x4*)(pr + C_Z + c0), z);
        const float dsk = p.in(21)[l * 8 + (c0 >> 6)];
        float v[8], ss = 0.f;
#pragma unroll
        for (int j = 0; j < 8; ++j) { v[j] = ((a[j] + b[j]) + dsk * xs[j]) * siluf(z[j]); ss += v[j] * v[j]; }
        ss = wsum(ss);
        const float rstd = rsqrtf(ss * (1.f / 512.f) + EPS);
        const float* w = p.in(22) + l * 512 + c0;
#pragma unroll
        for (int j = 0; j < 8; ++j) v[j] = (v[j] * rstd) * w[j];
        *(u32x4*)(pr + C_Z + c0) = pack8(v);
    }
    {
        const bf16_t* ORb = (const bf16_t*)(ws + OFF_OR);
        float a[8], b[8], gt[8];
        unpack8(*(const u32x4*)(ORb + (size_t)m * 512 + c0), a);
        unpack8(*(const u32x4*)(ORb + ((size_t)NPT + m) * 512 + c0), b);
        unpack8(*(const u32x4*)(pr + C_RG + c0), gt);
        float v[8], sm = 0.f;
#pragma unroll
        for (int j = 0; j < 8; ++j) { v[j] = a[j] + b[j]; sm += v[j]; }
        sm += shx(sm, 1); sm += shx(sm, 2); sm += shx(sm, 4); sm += shx(sm, 8);
        const float mean = sm * (1.f / 128.f);
        float sq = 0.f;
#pragma unroll
        for (int j = 0; j < 8; ++j) { v[j] -= mean; sq += v[j] * v[j]; }
        sq += shx(sq, 1); sq += shx(sq, 2); sq += shx(sq, 4); sq += shx(sq, 8);
        const float rstd = rsqrtf(sq * (1.f / 128.f) + EPS);
        const float* w = p.in(24) + l * 512 + c0;
#pragma unroll
        for (int j = 0; j < 8; ++j) v[j] = (v[j] * rstd) * w[j] * siluf(gt[j]);
        *(u32x4*)(pr + C_RG + c0) = pack8(v);
    }
}


#ifndef ONLY2
#define ONLY2 -1
#endif
#ifndef PROBE_KIND
#define PROBE_KIND -1
#endif
DI void item_publish(unsigned* cnt, int tid) {
    asm volatile("s_waitcnt vmcnt(0)" ::: "memory");
    __syncthreads();
    if (tid == 0) __hip_atomic_fetch_add(cnt, 1u, __ATOMIC_RELAXED, __HIP_MEMORY_SCOPE_AGENT);
}
DI void item_wait(unsigned* cnt, unsigned need, int tid) {
    if (tid == 0) {
        unsigned sp = 0;
        while (__hip_atomic_load(cnt, __ATOMIC_RELAXED, __HIP_MEMORY_SCOPE_AGENT) < need) { __builtin_amdgcn_s_sleep(2); if (++sp > (1u << 24)) break; }
        __builtin_amdgcn_fence(__ATOMIC_ACQUIRE, "agent");
        asm volatile("s_waitcnt vmcnt(0)" ::: "memory");
    }
    __syncthreads();
}
DI void phase_mix(const Ctx& p, int l, int ps, unsigned* ctr, unsigned* c12, volatile LAS unsigned* slot, char* smem, int tid) {
    unsigned* gdone = ctr + 64; unsigned* sdone = ctr + 128;
    unsigned* c1 = c12; unsigned* c2 = c12 + 64;
    constexpr int N1 = 64 * (NSEG - 1), N3 = 64 * NSEG;
    constexpr int A0 = N1, A1 = A0 + 384, A2 = A1 + 544, A3 = A2 + 256, A4 = A3 + 64, A5 = A4 + N3, A6 = A5 + 256, A7 = A6 + 256, A8 = A7 + 256, A9 = A8 + 256, A10 = A9 + 256, A11 = A10 + 256;
    for (;;) {
        tid = launder(tid);
        l = launder_s(l); ps = launder_s(ps);
        int it = next_item(ctr, slot, tid);
        const int nwi = ps == 0 ? T_UP / 4 : 0;
        if (it >= A11 + nwi) break;
        int sc = -1, isret = 0, sq = 0, hd = 0, dr = 0, hf = 0, md = 0, sg = 0, sid = 0; unsigned* pub = sdone;
        if (it < A0) { sid = it / (NSEG - 1); sg = it % (NSEG - 1); md = 1; sc = 1; pub = c1 + sid; }
        else if (it >= A4 && it < A5) { const int k = it - A4; sid = k / NSEG; sg = k % NSEG; md = 3; sc = 1; }
        else if (it >= A6 && it < A7) { const int k = it - A6; sq = k >> 4; hd = (k >> 1) & 7; dr = k & 1; sc = 0; }
        else if (it >= A7 && it < A8) { const int k = it - A7; isret = 1; sq = k >> 4; hd = (k >> 2) & 3; dr = (k >> 1) & 1; hf = k & 1; sc = 0; }
        if (sc == 1) {
            if (sid < 32) { isret = 0; sq = 16 + (sid >> 4); hd = (sid >> 1) & 7; dr = sid & 1; hf = 0; }
            else { const int k = sid - 32; isret = 1; sq = 16 + (k >> 4); hd = (k >> 2) & 3; dr = (k >> 1) & 1; hf = k & 1; }
        }
        if (sc >= 0) {
            if (md == 3) item_wait(c2 + sid, 1u, tid);
            scan_any_item(p, l, ps, isret, sq, hd, dr, hf, md, sg, sid, smem, tid);
            item_publish(pub, tid);
        }
        else if (it < A1) { gemm_uq_tile(p, l, ps, it - A0, smem, tid); item_publish(gdone, tid); }
        else if (it < A2) { gemm_ukv_tile(p, l, it - A1, smem, tid); item_publish(gdone, tid); }
        else if (it < A3) { const int k = it - A2; attn_gqa_item(p, l, 16 + (k >> 7), (k >> 4) & 7, k & 15, ps, smem, tid); }
        else if (it < A4) { const int sd = it - A3; item_wait(c1 + sd, (unsigned)(NSEG - 1), tid); scan_combine_item(p, l, ps, sd, tid); item_publish(c2 + sd, tid); }
        else if (it < A6) { const int k = it - A5; item_wait(gdone, 928u, tid); attn_mla_item(p, 16 + (k >> 7), (k >> 4) & 7, k & 15, ps, smem, tid); }
        else if (it < A9) { const int k = it - A8; attn_gqa_item(p, l, k >> 4, (k >> 1) & 7, k & 1, ps, smem, tid); }
        else if (it < A10) { const int k = it - A9; item_wait(gdone, 928u, tid); attn_mla_item(p, k >> 4, (k >> 1) & 7, k & 1, ps, smem, tid); }
        else if (it < A10 + nwi) { const int w0 = l * T_LAYER + T_MIDEND + (it - A10) * 4; wtile_run(p, w0, w0 + 4, 1, smem, tid); }
        else { item_wait(sdone, (unsigned)(N3 + 512), tid); const int k = it - A10 - nwi; const int t5 = launder(tid); for (int i = 0; i < 8; ++i) postscan_token(p, l, k * 32 + i * 4 + (t5 >> 6), t5 & 63); }
    }
}

constexpr int NPL = 4;
constexpr int NPP = 1 + 2 * NPL;
constexpr int NPHASE = 1 + 2 * NPP;
DI void run_phase(const Ctx& p, int ph, int rep, volatile LAS unsigned* slot, const XcdBarrier& bar, char* smem, int tid) {
#ifndef EXCL
#define EXCL -2
#endif
#ifndef ONLY
#define ONLY -1
#endif
    if (ph == 0) { phase_prep_w(p, smem, tid); return; }
    const int q = ph - 1, ps = q / NPP, r = q % NPP;
    if (r == 0) { phase_h1(p, ps, tid); return; }
    const int l = (r - 1) / NPL, k = (r - 1) % NPL;
    char* ws = p.ws();
    unsigned* ctr = (unsigned*)(p.ws() + OFF_CTR) + ph;
    switch (k) {
    case 0: phase_gemm_in(p, l, ps, smem, tid); break;
    case 1: phase_prep(p, l, ps, tid); break;
    case 2: phase_mix(p, l, ps, ctr, (unsigned*)(p.ws() + OFF_CTR) + 256 + (ps * 2 + l) * 128, slot, smem, tid); break;
    default: phase_chain(p, l, ps, ctr, slot - 2, bar, smem, tid); break;
    }
}

constexpr unsigned long long probe_mask(int kind) {
    unsigned long long m = 0;
    for (int ph = 0; ph < NPHASE; ++ph) {
        int k = 11; if (ph > 0) { const int r = (ph - 1) % NPP; k = (r == 0) ? 12 : (r - 1) % NPL; }
        if (k == kind) m |= 1ull << ph;
    }
    return m;
}
__global__ void __launch_bounds__(256, 2) fwd_kernel(Params prm, int ph_lo, int ph_hi, int rep) {
    __shared__ __attribute__((aligned(16))) char smem_all[512 + 65536 + 2048];
    int tid = threadIdx.x;
    volatile LAS unsigned* xw = (volatile LAS unsigned*)(smem_all);
    volatile LAS unsigned* tbl = (volatile LAS unsigned*)(smem_all + 32);
    char* smem = smem_all + 512;
    if (tid == 0) { xw[0] = 0u; xw[1] = 0u; xw[2] = 0u; xw[3] = 0u; }
    if (tid == 0) {
#pragma unroll
        for (int i = 0; i < 44; ++i) {
            const unsigned long long v = (i < 42) ? (unsigned long long)prm.in[i < 42 ? i : 0] : (i == 42 ? (unsigned long long)prm.out : (unsigned long long)prm.ws);
            tbl[2 * i] = (unsigned)v; tbl[2 * i + 1] = (unsigned)(v >> 32);
        }
    }
    __syncthreads();
    Ctx p; p.tbl = tbl;
    XcdBarrier bar;
    if (ph_hi - ph_lo > 1) bar = xcd_barrier_post((unsigned*)(p.ws() + OFF_BAR), xw, tid);
    constexpr unsigned long long PMASK = probe_mask(PROBE_KIND);
    if (PROBE_KIND >= 0 && BIDX == 0 && tid == 0) { xw[3] = 0u; xw[4] = (unsigned)__builtin_amdgcn_s_memrealtime(); }
    for (int ph = ph_lo; ph < ph_hi; ++ph) {
        if (ph == 1 + NPP) continue;
        tid = launder(tid);
        run_phase(p, ph, rep, xw + 2, bar, smem, tid);
        if (PROBE_KIND == 13 && BIDX == 0 && tid == 0) xw[5] = (unsigned)__builtin_amdgcn_s_memrealtime();
        if (launder_s(ph_hi) - launder_s(ph_lo) > 1 && ph + 1 < ph_hi) xcd_barrier(bar, tid);
        if (PROBE_KIND >= 0 && BIDX == 0 && tid == 0) {
            const unsigned tn = (unsigned)__builtin_amdgcn_s_memrealtime();
            if (PROBE_KIND == 13) xw[3] = xw[3] + (tn - xw[5]);
            else if ((PMASK >> ph) & 1ull) xw[3] = xw[3] + (tn - xw[4]);
            xw[4] = tn;
        }
    }
    if (PROBE_KIND >= 0 && BIDX == 0 && tid == 0) {
        const unsigned long long tend = __builtin_amdgcn_s_memrealtime() + 9ull * xw[3];
        while (__builtin_amdgcn_s_memrealtime() < tend) __builtin_amdgcn_s_sleep(8);
    }
}

#ifndef MK_ONE_LAUNCH
#define MK_ONE_LAUNCH 1
#endif

extern "C" void kernel_launch(void* const* d_in, const int* in_sizes, int n_in, void* d_out, int out_size, void* d_ws, size_t ws_size, hipStream_t stream) {
    (void)in_sizes; (void)n_in; (void)out_size;
    if (ws_size < WS_NEED) { fprintf(stderr, "workspace too small: %zu < %zu\n", ws_size, (size_t)WS_NEED); return; }
    Params p{};
    for (int i = 0; i < 42; ++i) p.in[i] = (const float*)d_in[i];
    p.out = (float*)d_out; p.ws = (char*)d_ws;
    static int grid_blocks = 0;
    if (!grid_blocks) {
        int dev = 0, cus = 0, per_cu = 0;
        hipGetDevice(&dev);
        hipDeviceGetAttribute(&cus, hipDeviceAttributeMultiprocessorCount, dev);
        hipOccupancyMaxActiveBlocksPerMultiprocessor(&per_cu, fwd_kernel, 256, 0);
        if (per_cu > 2) per_cu = 2;
        if (per_cu < 1) per_cu = 1;
        grid_blocks = cus * per_cu;
    }
    hipMemsetAsync((char*)d_ws + OFF_BAR, 0, BAR_BYTES + CTR_BYTES, stream);
#if MK_ONE_LAUNCH
    {
        int lo = 0, hi = NPHASE, rep = 0;
        void* args[] = {&p, &lo, &hi, &rep};
        hipError_t e = hipLaunchCooperativeKernel((void*)fwd_kernel, dim3(grid_blocks), dim3(256), args, 0, stream);
        if (e != hipSuccess) fprintf(stderr, "cooperative launch failed: %s (grid %d)\n", hipGetErrorString(e), grid_blocks);
    }
#else
#ifndef PROBE_REP
#define PROBE_REP 0
#endif
    for (int ph = 0; ph < NPHASE; ++ph) {
        fwd_kernel<<<grid_blocks, 256, 0, stream>>>(p, ph, ph + 1, 0);
        int kind = -1;
        if (ph == 0) kind = 11; else { const int r = (ph - 1) % NPP; kind = (r == 0) ? 12 : (r - 1) % NPL; }
        if ((PROBE_REP >> kind) & 1) fwd_kernel<<<grid_blocks, 256, 0, stream>>>(p, ph, ph + 1, 1);
    }
#endif
}
```

```cpp
#include <hip/hip_runtime.h>
#include <cstdio>
#include <cstdint>
#include <cmath>

typedef unsigned short bf16_t;
typedef short bf16x8 __attribute__((ext_vector_type(8)));
typedef float f32x4 __attribute__((ext_vector_type(4)));
typedef unsigned u32x4 __attribute__((ext_vector_type(4)));
typedef unsigned u32x2 __attribute__((ext_vector_type(2)));
#define DI __device__ __forceinline__
#define LAS __attribute__((address_space(3)))

constexpr int DM = 1024, INW = 4272, INWP = 4352, DFF = 2816;
constexpr int NPT = 8192;
constexpr int KROWS = 8704;
constexpr float EPS = 1e-6f;
constexpr int C_Z = 0, C_XBC = 512, C_DT = 1280, C_RQ = 1296, C_RK = 1552, C_RV = 1808, C_RG = 2320, C_AQ = 2832, C_AK = 3344, C_AV = 3472,
              C_MCQ = 3600, C_MCKV = 3984;
constexpr size_t O_YS = 8388608, O_SSD = 16777216, O_RET = 20971520, O_CK = 25165824, O_CV = 27262976, O_CC = 29360128, O_CR = 33554432;

constexpr size_t al256(size_t x) { return (x + 255) & ~(size_t)255; }
constexpr size_t SZ_WIN = (size_t)INWP * 1024, SZ_WM = (size_t)4096 * 1024, SZ_WUQ = (size_t)768 * 384, SZ_WUKV = (size_t)1024 * 256,
                 SZ_WBR = (size_t)4 * 1024 * 512, SZ_WOUT = (size_t)1024 * 1024, SZ_WUP = (size_t)5632 * 1024, SZ_WDN = (size_t)1024 * 2816;
constexpr size_t OFF_WIN = 0;
constexpr size_t OFF_WM = OFF_WIN + 4 * SZ_WIN;
constexpr size_t OFF_WUQ = OFF_WM + 4 * SZ_WM;
constexpr size_t OFF_WUKV = OFF_WUQ + 4 * SZ_WUQ;
constexpr size_t OFF_WBR = OFF_WUKV + 4 * SZ_WUKV;
constexpr size_t OFF_WOUT = OFF_WBR + 4 * SZ_WBR;
constexpr size_t OFF_WUP = OFF_WOUT + 4 * SZ_WOUT;
constexpr size_t OFF_WDN = OFF_WUP + 4 * SZ_WUP;
constexpr size_t OFF_MOD = al256(OFF_WDN + 4 * SZ_WDN);
constexpr size_t OFF_T16 = al256(OFF_MOD + (size_t)2 * 5 * 6144 * 4);
constexpr size_t OFF_T8 = OFF_T16 + 2 * 64 * 16 * 4;
constexpr size_t OFF_BAR = al256(OFF_T8 + 2 * 64 * 8 * 4);
constexpr int CTR_TEAM = 256 + 4 * 128;
constexpr int CTR_STREAM = CTR_TEAM + 5 * 64 * 4 * 64;
constexpr size_t BAR_BYTES = 3456 * 4, CTR_BYTES = (256 + 4 * 128) * 4 + (size_t)5 * 64 * 4 * 256 + (size_t)4 * 64 * 2 * 256;
constexpr size_t OFF_CTR = OFF_BAR + BAR_BYTES;
constexpr size_t OFF_DTRAW = al256(OFF_CTR + CTR_BYTES);
constexpr size_t OFF_DT = OFF_DTRAW + (size_t)NPT * 16 * 4;
constexpr size_t OFF_H = al256(OFF_DT + (size_t)NPT * 16 * 4);
constexpr size_t OFF_PROJ = OFF_H + (size_t)NPT * 1024 * 2;
constexpr size_t OFF_XBCA = OFF_PROJ + (size_t)NPT * INWP * 2;
constexpr size_t OFF_KA = OFF_XBCA + (size_t)NPT * 768 * 2;
constexpr size_t OFF_VAT = OFF_KA + (size_t)KROWS * 128 * 2;
constexpr size_t OFF_CKV = OFF_VAT + (size_t)KROWS * 128 * 2;
constexpr size_t OFF_KRP = OFF_CKV + (size_t)KROWS * 256 * 2;
constexpr size_t OFF_QM = OFF_KRP + (size_t)KROWS * 32 * 2;
constexpr size_t OFF_KN = OFF_QM + (size_t)NPT * 768 * 2;
constexpr size_t OFF_VMT = OFF_KN + (size_t)KROWS * 512 * 2;
constexpr size_t OFF_OS = OFF_VMT + (size_t)KROWS * 512 * 2;
constexpr size_t OFF_OR = OFF_OS + (size_t)2 * NPT * 512 * 2;
constexpr size_t OFF_OM = OFF_OR + (size_t)2 * NPT * 512 * 2;
constexpr size_t OFF_OA = OFF_OM + (size_t)NPT * 512 * 2;
constexpr int NSEG = 4, SEGTOK = 2048 / NSEG;
constexpr size_t OFF_SEG = OFF_OA + (size_t)NPT * 512 * 2;
constexpr size_t OFF_SEGD = OFF_SEG + (size_t)64 * NSEG * 4096 * 2;
constexpr size_t WS_END1 = OFF_SEGD + 64 * NSEG * 4;
constexpr size_t OFF_MERGED = OFF_QM;
static_assert(OFF_MERGED + (size_t)NPT * 1024 * 2 <= OFF_VMT, "MERGED beyond KN");
constexpr size_t OFF_FO = OFF_OS;
static_assert(OFF_FO + (size_t)NPT * 1024 * 4 <= OFF_OM, "FO beyond OR");
constexpr size_t OFF_EDGE = al256(WS_END1);
constexpr size_t OFF_XEDGE = OFF_EDGE + (size_t)64 * 4 * 5632 * 4;
constexpr size_t WS_NEED = OFF_XEDGE + (size_t)64 * 2 * 768 * 2;
static_assert(WS_NEED <= (size_t)293824896, "workspace");

struct Params {
    const float* in[42];
    float* out;
    char* ws;
};
struct Ctx {
    volatile LAS unsigned* tbl;
    __device__ __forceinline__ unsigned long long ld(int i) const {
        const unsigned lo = tbl[2 * i], hi = tbl[2 * i + 1];
        return ((unsigned long long)(unsigned)__builtin_amdgcn_readfirstlane((int)hi) << 32) | (unsigned)__builtin_amdgcn_readfirstlane((int)lo);
    }
    __device__ __forceinline__ const float* in(int i) const { return (const float*)ld(i); }
    __device__ __forceinline__ float* out() const { return (float*)ld(42); }
    __device__ __forceinline__ char* ws() const { return (char*)ld(43); }
};

DI float bf2f(unsigned short h) { return __uint_as_float((unsigned)h << 16); }
DI unsigned short f2bf(float f) { return __builtin_bit_cast(unsigned short, (__bf16)f); }
typedef __bf16 bf16x2_t __attribute__((ext_vector_type(2)));
DI unsigned pk2(float lo, float hi) { bf16x2_t v; v[0] = (__bf16)lo; v[1] = (__bf16)hi; return __builtin_bit_cast(unsigned, v); }
DI void unpack8(const u32x4& w, float* v) {
#pragma unroll
    for (int i = 0; i < 4; ++i) { v[2 * i] = __uint_as_float(w[i] << 16); v[2 * i + 1] = __uint_as_float(w[i] & 0xffff0000u); }
}
DI u32x4 pack8(const float* v) { u32x4 w; w[0] = pk2(v[0], v[1]); w[1] = pk2(v[2], v[3]); w[2] = pk2(v[4], v[5]); w[3] = pk2(v[6], v[7]); return w; }
DI float log1pe(float e) { return e < 1e-4f ? e - 0.5f * e * e : __builtin_amdgcn_logf(1.f + e) * 0.6931471805599453f; }
DI float siluf(float x) { return x / (1.f + __expf(-x)); }
DI float sigmoidf(float x) { return 1.f / (1.f + __expf(-x)); }
DI int lanel() { int l = (int)__lane_id(); asm volatile("" : "+v"(l)); return l; }
DI float shx(float v, int m) { const int l = lanel(); return __int_as_float(__builtin_amdgcn_ds_bpermute((l ^ m) << 2, __float_as_int(v))); }
DI float shf(float v, int src) { return __int_as_float(__builtin_amdgcn_ds_bpermute(src << 2, __float_as_int(v))); }
DI float shu(float v, int d) { const int l = lanel(); const int sidx = (l - d) < 0 ? l : (l - d); return __int_as_float(__builtin_amdgcn_ds_bpermute(sidx << 2, __float_as_int(v))); }
DI float gmax4(float v) {
    auto a = __builtin_amdgcn_permlane16_swap(__float_as_uint(v), __float_as_uint(v), false, false);
    v = fmaxf(__uint_as_float(a[0]), __uint_as_float(a[1]));
    auto b = __builtin_amdgcn_permlane32_swap(__float_as_uint(v), __float_as_uint(v), false, false);
    return fmaxf(__uint_as_float(b[0]), __uint_as_float(b[1]));
}
DI float gsum4(float v) {
    auto a = __builtin_amdgcn_permlane16_swap(__float_as_uint(v), __float_as_uint(v), false, false);
    v = __uint_as_float(a[0]) + __uint_as_float(a[1]);
    auto b = __builtin_amdgcn_permlane32_swap(__float_as_uint(v), __float_as_uint(v), false, false);
    return __uint_as_float(b[0]) + __uint_as_float(b[1]);
}
DI float wsum(float v) {
#pragma unroll
    for (int o = 32; o >= 1; o >>= 1) v += shx(v, o);
    return v;
}
typedef const __attribute__((address_space(1))) u32x4* gp128;
DI u32x4 gld16(const void* p) { return *(gp128)(unsigned long long)p; }
DI void st_wt8(void* p, u32x2 v) { __hip_atomic_store((unsigned long long*)p, ((unsigned long long)v[1] << 32) | v[0], __ATOMIC_RELAXED, __HIP_MEMORY_SCOPE_AGENT); }
DI void st_wt16(void* p, u32x4 v) { st_wt8(p, (u32x2){v[0], v[1]}); st_wt8((char*)p + 8, (u32x2){v[2], v[3]}); }
DI void st_wt2(bf16_t* p, bf16_t v) { __hip_atomic_store(p, v, __ATOMIC_RELAXED, __HIP_MEMORY_SCOPE_AGENT); }
DI void st_wtf4(float* p, f32x4 v) { st_wt16(p, __builtin_bit_cast(u32x4, v)); }
DI void st_wt4f(float* p, float v) { __hip_atomic_store(p, v, __ATOMIC_RELAXED, __HIP_MEMORY_SCOPE_AGENT); }
DI int launder(int x) { asm volatile("" : "+v"(x)); return x; }
DI int launder_s(int x) { asm volatile("" : "+s"(x)); return x; }
#define BIDX launder_s((int)blockIdx.x)
DI int FQ(int q) { return (4 - q) & 3; }
DI int tile_off(int rows, int ks, int row, int g, int q) { return (ks * rows + row) * 64 + ((g ^ FQ(q)) << 4); }

#define XB_TMO      128
#define XB_XCNT(j)  (256  + 64 * (j))
#define XB_XSUB(j)  (1280 + 64 * (j))
#define XB_XGEN(j)  (2304 + 64 * (j))
#define XB_TOP      3328
#define XB_TOPGEN   3392
#define XB_SPIN_CAP (1u << 22)
DI unsigned xb_ld(unsigned* p) { return __hip_atomic_load(p, __ATOMIC_RELAXED, __HIP_MEMORY_SCOPE_AGENT); }
DI unsigned xb_add(unsigned* p, unsigned v) { return __hip_atomic_fetch_add(p, v, __ATOMIC_RELAXED, __HIP_MEMORY_SCOPE_AGENT); }
DI unsigned xb_xcc_id() { return (unsigned)__builtin_amdgcn_s_getreg((3 << 11) | 20) & 0xFu; }
#define XB_SPIN(cond, bar) do { unsigned _sp = 0; while (cond) { __builtin_amdgcn_s_sleep(1); \
    if ((++_sp & 255u) == 0u) { if (xb_ld(&(bar)[XB_TMO])) break; if (_sp > XB_SPIN_CAP) { atomicAdd(&(bar)[XB_TMO], 1u); break; } } } } while (0)
struct XcdBarrier { unsigned* bar; unsigned x; volatile LAS unsigned* st; };
DI XcdBarrier xcd_barrier_post(unsigned* bar, volatile LAS unsigned* st, int tid) {
    XcdBarrier b; b.bar = bar; b.x = xb_xcc_id(); b.st = st;
    if (tid == 0) st[7] = xb_add(&bar[XB_XCNT(b.x)], 1u);
    return b;
}
DI void xcd_barrier_complete(unsigned* bar, unsigned x, unsigned& nloc, unsigned& nx, unsigned& rank) {
    const unsigned G = gridDim.x * gridDim.y * gridDim.z;
    unsigned sum, cnt, mine, sp = 0u;
    for (;;) {
        sum = 0u; cnt = 0u; mine = 0u; rank = 0u;
#pragma unroll
        for (unsigned j = 0; j < 16; ++j) { const unsigned c = xb_ld(&bar[XB_XCNT(j)]); sum += c; cnt += (c > 0u) ? 1u : 0u; mine = (j == x) ? c : mine; rank += (j < x && c > 0u) ? 1u : 0u; }
        if (sum == G) break;
        __builtin_amdgcn_s_sleep(1);
        if ((++sp & 255u) == 0u) { if (xb_ld(&bar[XB_TMO])) break; if (sp > XB_SPIN_CAP) { atomicAdd(&bar[XB_TMO], 1u); break; } }
    }
    nloc = mine > 0u ? mine : 1u; nx = cnt > 0u ? cnt : 1u;
}
DI void xcd_barrier(const XcdBarrier& b, int tid) {
    asm volatile("s_waitcnt vmcnt(0)" ::: "memory");
    __syncthreads();
    if (tid == 0) {
        unsigned* bar = b.bar;
        __builtin_amdgcn_s_waitcnt(0);
        unsigned nloc = b.st[0], nx = b.st[1];
        if (nloc == 0u) { unsigned rank; xcd_barrier_complete(bar, b.x, nloc, nx, rank); b.st[0] = nloc; b.st[1] = nx; b.st[6] = rank; }
        const unsigned old = xb_add(&bar[XB_XSUB(b.x)], 1u);
        const unsigned gen = old / nloc;
        if (old + 1u == (gen + 1u) * nloc) {
            __builtin_amdgcn_fence(__ATOMIC_RELEASE, "agent");
            asm volatile("s_waitcnt vmcnt(0)" ::: "memory");
            const unsigned og = xb_add(&bar[XB_TOP], 1u);
            const unsigned tg = og / nx;
            if (og + 1u == (tg + 1u) * nx) xb_add(&bar[XB_TOPGEN], 1u);
            else XB_SPIN(xb_ld(&bar[XB_TOPGEN]) == tg, bar);
            __builtin_amdgcn_fence(__ATOMIC_ACQUIRE, "agent");
            xb_add(&bar[XB_XGEN(b.x)], 1u);
            asm volatile("s_waitcnt vmcnt(0)" ::: "memory");
        } else {
            XB_SPIN(xb_ld(&bar[XB_XGEN(b.x)]) == gen, bar);
            __builtin_amdgcn_fence(__ATOMIC_ACQUIRE, "agent");
            asm volatile("s_waitcnt vmcnt(0)" ::: "memory");
        }
    }
    __syncthreads();
}

DI int next_item(unsigned* ctr, volatile LAS unsigned* slot, int tid) {
    __syncthreads();
    if (tid == 0) *slot = __hip_atomic_fetch_add(ctr, 1u, __ATOMIC_RELAXED, __HIP_MEMORY_SCOPE_AGENT);
    __syncthreads();
    return (int)*slot;
}

struct Tok { int lat, b, t, L, cond, krow, seq0; size_t gx; };
DI Tok tok_info(int m, int ps) {
    Tok k;
    if (m < 4096) { k.lat = 0; k.b = ps * 16 + (m >> 8); k.t = m & 255; k.L = 256; k.cond = 0; k.krow = m; k.seq0 = m & ~255; k.gx = (size_t)ps * 4096 + m; }
    else { const int mm = m - 4096, j = mm >> 11; k.lat = 1; k.b = ps * 2 + j; k.t = mm & 2047; k.L = 2048; k.cond = 1 + k.b; k.krow = 4096 + j * 2304 + 256 + k.t;
           k.seq0 = 4096 + j * 2048; k.gx = (size_t)8192 + (size_t)ps * 4096 + mm; }
    return k;
}

template <int NTA, int NTB, bool LOWREG = false, int WMAP = 0>
DI void gemm_kloop(f32x4 (&acc)[NTA][NTB], const bf16_t* __restrict__ W, size_t ldw, const bf16_t* __restrict__ X, size_t ldx, int K, char* smem, int tid) {
    constexpr int BF = 32 * NTA, BT = 32 * NTB;
    constexpr int WB = BF * 128, STG = (BF + BT) * 128;
    constexpr int NPW = BF / 8, NPX = BT / 8, NPIECE = NPW + NPX, PPW = NPIECE / 4;
    static_assert(NPIECE % 4 == 0, "pieces must divide over 4 waves");
    tid = launder(tid);
    const int lane = tid & 63, wv = tid >> 6, wn = wv >> 1, wt = wv & 1, fr = lane & 15, g = lane >> 4;
    constexpr int PWW = NPW / 4, PXX = PPW - PWW;
    const int wvu = __builtin_amdgcn_readfirstlane(wv);
    auto lane_off = [&](int j, int ln) -> unsigned {
        const bool isw = j < PWW;
        const int pp = isw ? wvu * PWW + j : wvu * PXX + (j - PWW);
        const int rows = isw ? BF : BT;
        const int rb = pp % (rows / 16);
        const int rl = ln >> 2;
        const int q = isw ? (((rb * 16 + rl) / (4 * NTA)) & 3) : ((rl >> 2) & 3);
        const int gl = (ln & 3) ^ FQ(q);
        if (WMAP && isw) return (unsigned)((rl & 7) + (rl >> 3) * DFF) * (unsigned)ldw + (unsigned)(gl * 8);
        return (unsigned)rl * (unsigned)(isw ? ldw : ldx) + (unsigned)(gl * 8);
    };
    unsigned poff[PPW];
    if (!LOWREG) {
#pragma unroll
        for (int j = 0; j < PPW; ++j) poff[j] = lane_off(j, lane);
    }
    auto issue = [&](int k0, char* sdst) {
        const int ln = LOWREG ? launder(lane) : lane;
#pragma unroll
        for (int j = 0; j < PPW; ++j) {
            const bool isw = j < PWW;
            const int pp = isw ? wvu * PWW + j : wvu * PXX + (j - PWW);
            const int rows = isw ? BF : BT;
            const int ks = pp / (rows / 16), rb = pp % (rows / 16);
            const int wrow = WMAP ? 32 * (rb >> 2) + 8 * (rb & 3) : rb * 16;
            const bf16_t* base = (isw ? W + (size_t)wrow * ldw : X + (size_t)(rb * 16) * ldx) + k0 + ks * 32;
            const unsigned off = LOWREG ? lane_off(j, ln) : poff[j];
            __builtin_amdgcn_global_load_lds((const unsigned*)(base + off), (unsigned*)(sdst + (isw ? 0 : WB) + (ks * rows + rb * 16) * 64), 16, 0, 0);
        }
    };
    const int aoff = tile_off(BF, 0, wn * 16 * NTA + 4 * NTA * (fr >> 2) + (fr & 3), g, fr >> 2);
    const int boff = WB + tile_off(BT, 0, wt * 16 * NTB + fr, g, (fr >> 2) & 3);
    const int nk = K >> 6;
    issue(0, smem);
    asm volatile("s_waitcnt vmcnt(0)" ::: "memory");
    __syncthreads();
    for (int kt = 0; kt < nk; ++kt) {
        if (kt + 1 < nk) issue((kt + 1) << 6, smem + ((kt + 1) & 1) * STG);
        const char* sb = smem + (kt & 1) * STG;
        __builtin_amdgcn_s_setprio(1);
#pragma unroll
        for (int kk = 0; kk < 2; ++kk) {
            if (LOWREG) {
                bf16x8 bfr[NTB];
#pragma unroll
                for (int mt = 0; mt < NTB; ++mt) bfr[mt] = *(const bf16x8*)(sb + boff + mt * 1024 + kk * BT * 64);
#pragma unroll
                for (int a = 0; a < NTA; ++a) {
                    const bf16x8 af1 = *(const bf16x8*)(sb + aoff + a * 256 + kk * BF * 64);
#pragma unroll
                    for (int mt = 0; mt < NTB; ++mt) acc[a][mt] = __builtin_amdgcn_mfma_f32_16x16x32_bf16(af1, bfr[mt], acc[a][mt], 0, 0, 0);
                    __builtin_amdgcn_sched_barrier(0);
                }
            } else {
                bf16x8 af[NTA], bfr[NTB];
#pragma unroll
                for (int a = 0; a < NTA; ++a) af[a] = *(const bf16x8*)(sb + aoff + a * 256 + kk * BF * 64);
#pragma unroll
                for (int mt = 0; mt < NTB; ++mt) bfr[mt] = *(const bf16x8*)(sb + boff + mt * 1024 + kk * BT * 64);
#pragma unroll
                for (int a = 0; a < NTA; ++a)
#pragma unroll
                    for (int mt = 0; mt < NTB; ++mt) acc[a][mt] = __builtin_amdgcn_mfma_f32_16x16x32_bf16(af[a], bfr[mt], acc[a][mt], 0, 0, 0);
            }
        }
        __builtin_amdgcn_s_setprio(0);
        asm volatile("s_waitcnt vmcnt(0)" ::: "memory");
        __syncthreads();
    }
}

struct WTile { const float* src; bf16_t* dst; int K, N, k0, n0; };
constexpr int T_IN = 16 * 68, T_M = 16 * 64, T_UQ = 6 * 12, T_UKV = 4 * 16, T_BR = 8 * 16, T_OUT = 16 * 16, T_UP = 16 * 88, T_DN = 44 * 16;
constexpr int T_LAYER = T_IN + T_M + T_UQ + T_UKV + 4 * T_BR + T_OUT + T_UP + T_DN;
constexpr int T_MIDEND = T_IN + T_M + T_UQ + T_UKV + 4 * T_BR + T_OUT, T_UPEND = T_MIDEND + T_UP;
DI WTile wtile_decode(const Ctx& p, int it) {
    char* ws = p.ws();
    const int l = it / T_LAYER; int k = it % T_LAYER;
    WTile t; int ntn;
    if (k < T_IN) { t.src = p.in(16) + (size_t)l * 1024 * INW; t.dst = (bf16_t*)(ws + OFF_WIN) + (size_t)l * SZ_WIN; t.K = 1024; t.N = INW; ntn = 68; }
    else if ((k -= T_IN) < T_M) { t.src = p.in(35) + (size_t)l * 1024 * 4096; t.dst = (bf16_t*)(ws + OFF_WM) + (size_t)l * SZ_WM; t.K = 1024; t.N = 4096; ntn = 64; }
    else if ((k -= T_M) < T_UQ) { t.src = p.in(28) + (size_t)l * 384 * 768; t.dst = (bf16_t*)(ws + OFF_WUQ) + (size_t)l * SZ_WUQ; t.K = 384; t.N = 768; ntn = 12; }
    else if ((k -= T_UQ) < T_UKV) { t.src = p.in(30) + (size_t)l * 256 * 1024; t.dst = (bf16_t*)(ws + OFF_WUKV) + (size_t)l * SZ_WUKV; t.K = 256; t.N = 1024; ntn = 16; }
    else if ((k -= T_UKV) < 4 * T_BR) { const int j = k / T_BR; k -= j * T_BR; t.src = (j == 0 ? p.in(31) : j == 1 ? p.in(32) : j == 2 ? p.in(33) : p.in(34)) + (size_t)l * 512 * 1024;
                                        t.dst = (bf16_t*)(ws + OFF_WBR) + (size_t)(l * 4 + j) * 1024 * 512; t.K = 512; t.N = 1024; ntn = 16; }
    else if ((k -= 4 * T_BR) < T_OUT) { t.src = p.in(37) + (size_t)l * 1024 * 1024; t.dst = (bf16_t*)(ws + OFF_WOUT) + (size_t)l * SZ_WOUT; t.K = 1024; t.N = 1024; ntn = 16; }
    else if ((k -= T_OUT) < T_UP) { t.src = p.in(38) + (size_t)l * 1024 * 5632; t.dst = (bf16_t*)(ws + OFF_WUP) + (size_t)l * SZ_WUP; t.K = 1024; t.N = 5632; ntn = 88; }
    else { k -= T_UP; t.src = p.in(41) + (size_t)l * 2816 * 1024; t.dst = (bf16_t*)(ws + OFF_WDN) + (size_t)l * SZ_WDN; t.K = 2816; t.N = 1024; ntn = 16; }
    t.k0 = (k / ntn) * 64; t.n0 = (k % ntn) * 64;
    return t;
}
DI void wtile_load(const WTile& t, int tid, f32x4 (&v)[4]) {
    const int r = tid >> 4, c4 = tid & 15;
#pragma unroll
    for (int i = 0; i < 4; ++i) {
        v[i] = (f32x4){0.f, 0.f, 0.f, 0.f};
        if (t.n0 + 4 * c4 < t.N) v[i] = *(const f32x4*)(t.src + (size_t)(t.k0 + r + 16 * i) * t.N + t.n0 + 4 * c4);
    }
}
DI void wtile_finish(const WTile& t, const f32x4 (&v)[4], char* smem, int tid) {
    float* tl = (float*)smem;
    const int r = tid >> 4, c4 = tid & 15;
#pragma unroll
    for (int i = 0; i < 4; ++i) {
        const int row = r + 16 * i;
        tl[row * 65 + 4 * c4 + 0] = v[i][0]; tl[row * 65 + 4 * c4 + 1] = v[i][1]; tl[row * 65 + 4 * c4 + 2] = v[i][2]; tl[row * 65 + 4 * c4 + 3] = v[i][3];
    }
    __syncthreads();
#pragma unroll
    for (int i = 0; i < 2; ++i) {
        const int q = tid + 256 * i, n = q >> 3, c = q & 7;
        float o[8];
#pragma unroll
        for (int j = 0; j < 8; ++j) o[j] = tl[(8 * c + j) * 65 + n];
        *(u32x4*)(t.dst + (size_t)(t.n0 + n) * t.K + t.k0 + 8 * c) = pack8(o);
    }
    __syncthreads();
}
DI void wtile_run(const Ctx& p, int lo, int hi, int step, char* smem, int tid) {
    int it = lo;
    f32x4 va[4];
    if (it < hi) { const WTile c0 = wtile_decode(p, it); wtile_load(c0, tid, va); }
    while (it < hi) {
        const int nx = it + step;
        f32x4 vb[4];
        if (nx < hi) { const WTile nt = wtile_decode(p, nx); wtile_load(nt, tid, vb); }
        { const WTile cur = wtile_decode(p, launder(it)); wtile_finish(cur, va, smem, tid); }
#pragma unroll
        for (int i = 0; i < 4; ++i) va[i] = vb[i];
        it = nx;
    }
}
DI void wtile_tail(const Ctx& p, int tiles_per_xcd, int lo, int hi, char* smem, int tid) {
    const int x = BIDX & 7, loc = BIDX >> 3, nloc = gridDim.x >> 3;
    const int rem = tiles_per_xcd % nloc;
    const int j = rem ? loc - rem : loc, nidle = rem ? nloc - rem : nloc;
    if (j >= 0) wtile_run(p, lo + j * 8 + x, hi, nidle * 8, smem, tid);
}

DI void phase_prep_w(const Ctx& p, char* smem, int tid) {
    char* ws = p.ws();
    constexpr int N_MODI = 2 * 192;
    for (int it = BIDX; it < N_MODI + 1; it += gridDim.x) {
        if (it < N_MODI) {
            const int l = it / 192, cb = it % 192;
            float* sc = (float*)smem;
            float* red = sc + 5 * 1024;
            __syncthreads();
            for (int e = tid; e < 5 * 1024; e += 256) {
                const int c = e >> 10, kk = e & 1023;
                const float v = (c == 0) ? p.in(9)[kk] : p.in(8)[(c - 1) * 1024 + kk];
                sc[e] = siluf(v);
            }
            __syncthreads();
            const int col = tid & 31, kg = tid >> 5;
            float a[5] = {0.f, 0.f, 0.f, 0.f, 0.f};
            const float* w = p.in(10) + ((size_t)l * 1024 + kg * 128) * 6144 + cb * 32 + col;
#pragma unroll 1
            for (int k0 = 0; k0 < 128; k0 += 16) {
                float wv[16];
#pragma unroll
                for (int j = 0; j < 16; ++j) wv[j] = w[(size_t)(k0 + j) * 6144];
#pragma unroll
                for (int j = 0; j < 16; ++j)
#pragma unroll
                    for (int c = 0; c < 5; ++c) a[c] += wv[j] * sc[c * 1024 + kg * 128 + k0 + j];
            }
#pragma unroll
            for (int c = 0; c < 5; ++c) red[(kg * 5 + c) * 32 + col] = a[c];
            __syncthreads();
            if (tid < 160) {
                const int c = tid >> 5, cl = tid & 31;
                float sm = 0.f;
#pragma unroll
                for (int k8 = 0; k8 < 8; ++k8) sm += red[(k8 * 5 + c) * 32 + cl];
                float* mod = (float*)(ws + OFF_MOD);
                mod[((size_t)l * 5 + c) * 6144 + cb * 32 + cl] = sm + p.in(11)[(size_t)l * 6144 + cb * 32 + cl];
            }
            __syncthreads();
        } else {
            float* t16 = (float*)(ws + OFF_T16); float* t8 = (float*)(ws + OFF_T8);
            for (int e = tid; e < 64 * 16 + 64 * 8; e += 256) {
                const bool small = e >= 1024;
                const int ee = small ? e - 1024 : e;
                const int pos = small ? (ee >> 3) : (ee >> 4), i = small ? (ee & 7) : (ee & 15);
                const double r = small ? 0.31622776601683794 : 0.5623413251903491;
                double th = 1.0;
                for (int j = 0; j < i; ++j) th *= r;
                const double t2 = th * th;
                double c1 = 1.0, s1 = th;
                double tc = 1.0, tsn = th;
                for (int k = 1; k < 14; ++k) {
                    tc = -tc * t2 / (double)((2 * k - 1) * (2 * k));
                    tsn = -tsn * t2 / (double)((2 * k) * (2 * k + 1));
                    c1 += tc; s1 += tsn;
                }
                double c = 1.0, sn = 0.0;
                for (int j = 0; j < pos; ++j) { const double cn = c * c1 - sn * s1, snn = sn * c1 + c * s1; c = cn; sn = snn; }
                if (small) { t8[ee] = (float)c; t8[512 + ee] = (float)sn; } else { t16[ee] = (float)c; t16[1024 + ee] = (float)sn; }
            }
        }
    }
    __syncthreads();
    wtile_run(p, BIDX, T_IN, gridDim.x, smem, tid);
}

DI void row_load(const float* r, int lane, f32x4 (&v)[4]) {
#pragma unroll
    for (int i = 0; i < 4; ++i) v[i] = *(const f32x4*)(r + 4 * lane + 256 * i);
}
DI float row_ss(const f32x4 (&v)[4]) {
    float s = 0.f;
#pragma unroll
    for (int i = 0; i < 4; ++i) s += v[i][0] * v[i][0] + v[i][1] * v[i][1] + v[i][2] * v[i][2] + v[i][3] * v[i][3];
    return wsum(s);
}
DI void row_modnorm_store(const f32x4 (&x)[4], const float* gw, const float* sh, const float* sc, bf16_t* dst, int lane) {
    const float rstd = rsqrtf(row_ss(x) * (1.f / 1024.f) + EPS);
#pragma unroll
    for (int i = 0; i < 4; ++i) {
        const int c = 4 * lane + 256 * i;
        const f32x4 g = *(const f32x4*)(gw + c), s = *(const f32x4*)(sh + c), q = *(const f32x4*)(sc + c);
        float o[4];
#pragma unroll
        for (int j = 0; j < 4; ++j) o[j] = (x[i][j] * rstd) * g[j] * (1.f + q[j]) + s[j];
        u32x2 w; w[0] = pk2(o[0], o[1]); w[1] = pk2(o[2], o[3]);
        *(u32x2*)(dst + c) = w;
    }
}
DI const float* x_in_row(const Ctx& p, int m, int ps) {
    return (m < 4096) ? p.in(0) + ((size_t)ps * 4096 + m) * 1024 : p.in(1) + ((size_t)ps * 4096 + (m - 4096)) * 1024;
}
DI void phase_h1(const Ctx& p, int ps, int tid) {
    const int lane = tid & 63, wv = tid >> 6;
    const float* mod = (const float*)(p.ws() + OFF_MOD);
    bf16_t* H = (bf16_t*)(p.ws() + OFF_H);
    for (int m = BIDX * 4 + wv; m < NPT; m += gridDim.x * 4) {
        const Tok k = tok_info(m, ps);
        f32x4 x[4]; row_load(x_in_row(p, m, ps), lane, x);
        const float* md = mod + (size_t)(0 * 5 + k.cond) * 6144;
        row_modnorm_store(x, p.in(12), md + 0, md + 1024, H + (size_t)m * 1024, lane);
    }
}
DI void wsum2(float& a, float& b) {
#pragma unroll
    for (int o = 32; o >= 1; o >>= 1) { const float ta = shx(a, o), tb = shx(b, o); a += ta; b += tb; }
}
DI void res_rows(const Ctx& p, int ps, int l, int which, const float* Yp, int panel, int j, int size, int tid) {
    const int lane = tid & 63, wv = tid >> 6;
    const float* mod = (const float*)(p.ws() + OFF_MOD);
    bf16_t* H = (bf16_t*)(p.ws() + OFF_H);
    const float* gpost = (which ? p.in(15) : p.in(13)) + (size_t)l * 1024;
    const int step = size * 4;
    for (int i0 = j * 4 + wv; i0 < 128; i0 += 2 * step) {
        const bool vb = i0 + step < 128;
        int mm[2]; mm[0] = panel * 128 + i0; mm[1] = vb ? mm[0] + step : mm[0];
        f32x4 x[2][4], y[2][4];
        size_t gx[2]; int cond[2];
#pragma unroll
        for (int u = 0; u < 2; ++u) {
            const Tok k = tok_info(mm[u], ps);
            gx[u] = k.gx; cond[u] = k.cond;
            if (l == 0 && which == 0) row_load(x_in_row(p, mm[u], ps), lane, x[u]); else row_load(p.out() + k.gx * 1024, lane, x[u]);
            row_load(Yp + (size_t)(mm[u] - panel * 128) * 1024, lane, y[u]);
        }
        float ss[2];
#pragma unroll
        for (int u = 0; u < 2; ++u) {
            float t = 0.f;
#pragma unroll
            for (int q = 0; q < 4; ++q) t += y[u][q][0] * y[u][q][0] + y[u][q][1] * y[u][q][1] + y[u][q][2] * y[u][q][2] + y[u][q][3] * y[u][q][3];
            ss[u] = t;
        }
        wsum2(ss[0], ss[1]);
        float s2[2];
#pragma unroll
        for (int u = 0; u < 2; ++u) {
            const float rstd = rsqrtf(ss[u] * (1.f / 1024.f) + EPS);
            const float* gate = mod + (size_t)(l * 5 + cond[u]) * 6144 + (which ? 5 * 1024 : 2 * 1024);
            float t = 0.f;
#pragma unroll
            for (int q = 0; q < 4; ++q) {
                const int c = 4 * lane + 256 * q;
                const f32x4 g = *(const f32x4*)(gate + c), w = *(const f32x4*)(gpost + c);
#pragma unroll
                for (int e = 0; e < 4; ++e) { x[u][q][e] = x[u][q][e] + g[e] * ((y[u][q][e] * rstd) * w[e]); t += x[u][q][e] * x[u][q][e]; }
                if (u == 0 || vb) *(f32x4*)(p.out() + gx[u] * 1024 + c) = x[u][q];
            }
            s2[u] = t;
        }
        const bool nextnorm = which == 0 || l + 1 < 2;
        if (nextnorm) {
            wsum2(s2[0], s2[1]);
#pragma unroll
            for (int u = 0; u < 2; ++u) {
                if (u == 1 && !vb) continue;
                const int ln = which == 0 ? l : l + 1;
                const float* md = mod + (size_t)(ln * 5 + cond[u]) * 6144 + (which == 0 ? 3 * 1024 : 0);
                const float* gw = (which == 0 ? p.in(14) : p.in(12)) + (size_t)ln * 1024;
                const float rstd = rsqrtf(s2[u] * (1.f / 1024.f) + EPS);
                bf16_t* dst = H + (size_t)mm[u] * 1024;
#pragma unroll
                for (int q = 0; q < 4; ++q) {
                    const int c = 4 * lane + 256 * q;
                    const f32x4 g = *(const f32x4*)(gw + c), sh = *(const f32x4*)(md + c), sc = *(const f32x4*)(md + 1024 + c);
                    float o[4];
#pragma unroll
                    for (int e = 0; e < 4; ++e) o[e] = (x[u][q][e] * rstd) * g[e] * (1.f + sc[e]) + sh[e];
                    u32x2 w; w[0] = pk2(o[0], o[1]); w[1] = pk2(o[2], o[3]);
                    *(u32x2*)(dst + c) = w;
                }
            }
        } else if (ps == 0) {
#pragma unroll
            for (int u = 0; u < 2; ++u) {
                if (u == 1 && !vb) continue;
                const Tok k1 = tok_info(mm[u], 1);
                f32x4 x1[4]; row_load(x_in_row(p, mm[u], 1), lane, x1);
                const float* md1 = mod + (size_t)(0 * 5 + k1.cond) * 6144;
                row_modnorm_store(x1, p.in(12), md1 + 0, md1 + 1024, H + (size_t)mm[u] * 1024, lane);
            }
        }
    }
}

DI bool xcd_tile(int it, int Mt, int Nt, int B, int& mt, int& nt) {
    const int x = BIDX & 7, loc = BIDX >> 3, nloc = gridDim.x >> 3;
    const int MP = Mt >> 3;
    const int idx = it * nloc + loc;
    if (idx >= MP * Nt) return false;
    const int ng = idx / (MP * B);
    const int bw = min(B, Nt - ng * B);
    const int r = idx - ng * MP * B;
    mt = x * MP + r / bw; nt = ng * B + r % bw;
    return true;
}
DI void gemm_in_tile(const Ctx& p, int l, int mt0, int nt0, char* smem, int tid) {
    const bf16_t* W = (const bf16_t*)(p.ws() + OFF_WIN) + (size_t)l * SZ_WIN;
    const bf16_t* X = (const bf16_t*)(p.ws() + OFF_H);
    bf16_t* PROJ = (bf16_t*)(p.ws() + OFF_PROJ);
    float* DTRAW = (float*)(p.ws() + OFF_DTRAW);
    const int m0 = mt0 * 128, n0 = nt0 * 128;
    f32x4 acc[4][4];
#pragma unroll
    for (int a = 0; a < 4; ++a)
#pragma unroll
        for (int b = 0; b < 4; ++b) acc[a][b] = (f32x4){0.f, 0.f, 0.f, 0.f};
    gemm_kloop<4, 4>(acc, W + (size_t)n0 * 1024, 1024, X + (size_t)m0 * 1024, 1024, 1024, smem, tid);
    const int t2 = launder(tid);
    const int lane = t2 & 63, wv = t2 >> 6, wn = wv >> 1, wt = wv & 1, fr = lane & 15, g = lane >> 4;
    const int fb = n0 + wn * 64 + 16 * g;
#pragma unroll
    for (int mt = 0; mt < 4; ++mt) {
        const int m = m0 + wt * 64 + 16 * mt + fr;
        float v[16];
#pragma unroll
        for (int a = 0; a < 4; ++a)
#pragma unroll
            for (int r = 0; r < 4; ++r) v[4 * a + r] = acc[a][mt][r];
        bf16_t* d = PROJ + (size_t)m * INWP + fb;
        const u32x4 w0 = pack8(v), w1 = pack8(v + 8);
        *(u32x4*)d = w0; *(u32x4*)(d + 8) = w1;
        if (fb == C_DT) {
            float* dd = DTRAW + (size_t)m * 16;
#pragma unroll
            for (int a = 0; a < 4; ++a) *(f32x4*)(dd + 4 * a) = acc[a][mt];
        }
        if (fb >= C_XBC && fb < C_DT && ((mt == 0 && wt == 0 && fr == 0) || (mt == 3 && wt == 1 && fr == 15))) {
            bf16_t* e = (bf16_t*)(p.ws() + OFF_XEDGE) + ((size_t)mt0 * 2 + (mt == 3 ? 1 : 0)) * 768 + (fb - C_XBC);
            st_wt16(e, w0); st_wt16(e + 8, w1);
        }
    }
}

template <bool F32OUT>
DI void phase_gemm_plain(const bf16_t* W, int K, const bf16_t* X, size_t ldx, int Mtiles, int Ntiles, void* out, size_t ldo, char* smem, int tid) {
    const int lane = tid & 63, wv = tid >> 6, wn = wv >> 1, wt = wv & 1, fr = lane & 15, g = lane >> 4;
    for (int it = 0;; ++it) {
        int mt0, nt0; if (!xcd_tile(it, Mtiles, Ntiles, 8, mt0, nt0)) break;
        const int m0 = mt0 * 128, n0 = nt0 * 128;
        f32x4 acc[4][4];
#pragma unroll
        for (int a = 0; a < 4; ++a)
#pragma unroll
            for (int b = 0; b < 4; ++b) acc[a][b] = (f32x4){0.f, 0.f, 0.f, 0.f};
        gemm_kloop<4, 4>(acc, W + (size_t)n0 * K, K, X + (size_t)m0 * ldx, ldx, K, smem, tid);
        const int fb = n0 + wn * 64 + 16 * g;
#pragma unroll
        for (int mt = 0; mt < 4; ++mt) {
            const int m = m0 + wt * 64 + 16 * mt + fr;
            if (F32OUT) {
                float* d = (float*)out + (size_t)m * ldo + fb;
#pragma unroll
                for (int a = 0; a < 4; ++a) *(f32x4*)(d + 4 * a) = acc[a][mt];
            } else {
                float v[16];
#pragma unroll
                for (int a = 0; a < 4; ++a)
#pragma unroll
                    for (int r = 0; r < 4; ++r) v[4 * a + r] = acc[a][mt][r];
                bf16_t* d = (bf16_t*)out + (size_t)m * ldo + fb;
                *(u32x4*)d = pack8(v); *(u32x4*)(d + 8) = pack8(v + 8);
            }
        }
    }
}


template <int CTRL> DI float dpp0(float v) { return __builtin_bit_cast(float, __builtin_amdgcn_update_dpp(0, __builtin_bit_cast(int, v), CTRL, 0xf, 0xf, true)); }
constexpr int BND_OFF = 65536;
constexpr size_t PPB = (size_t)128 * INWP * 2;
DI void up_tile(const Ctx& p, int l, int mt0, int nt0, char* smem, int tid) {
    const bf16_t* W = (const bf16_t*)(p.ws() + OFF_WUP) + (size_t)l * SZ_WUP;
    const bf16_t* X = (const bf16_t*)(p.ws() + OFF_H);
    bf16_t* A = (bf16_t*)(p.ws() + OFF_PROJ + (size_t)mt0 * PPB) - (size_t)mt0 * 128 * DFF;
    float* EDGE = (float*)(p.ws() + OFF_EDGE);
    const float* cw = p.in(39) + (size_t)l * 3 * 5632; const float* cb = p.in(40) + (size_t)l * 5632;
    float* bnd = (float*)(smem + BND_OFF);
    {
        const int m0 = mt0 * 128, cb0 = nt0 * 64;
        f32x4 acc[4][4];
#pragma unroll
        for (int a = 0; a < 4; ++a)
#pragma unroll
            for (int b = 0; b < 4; ++b) acc[a][b] = (f32x4){0.f, 0.f, 0.f, 0.f};
        gemm_kloop<4, 4, false, 1>(acc, W + (size_t)cb0 * 1024, 1024, X + (size_t)m0 * 1024, 1024, 1024, smem, tid);
        const int t2 = launder(tid);
        const int lane = t2 & 63, wv = t2 >> 6, wn = wv >> 1, wt = wv & 1, fr = lane & 15, g = lane >> 4;
        const int c0 = cb0 + 32 * wn + 8 * g;
        if (fr == 0) {
            float* d = bnd + (((wn * 2 + wt) * 2 + 0) * 4 + g) * 16;
#pragma unroll
            for (int a = 0; a < 4; ++a) *(f32x4*)(d + 4 * a) = acc[a][0];
        }
        if (fr == 15) {
            float* d = bnd + (((wn * 2 + wt) * 2 + 1) * 4 + g) * 16;
#pragma unroll
            for (int a = 0; a < 4; ++a) *(f32x4*)(d + 4 * a) = acc[a][3];
        }
        __syncthreads();
        const bool e0 = (wt == 0 && fr == 0), e127 = (wt == 1 && fr == 15);
        u32x2 keep[4];
#pragma unroll
        for (int eh = 0; eh < 2; ++eh) {
            const int c = c0 + 4 * eh;
            const f32x4 w0u = *(const f32x4*)(cw + c), w1u = *(const f32x4*)(cw + 5632 + c), w2u = *(const f32x4*)(cw + 2 * 5632 + c), bu = *(const f32x4*)(cb + c);
            const f32x4 w0g = *(const f32x4*)(cw + DFF + c), w1g = *(const f32x4*)(cw + 5632 + DFF + c), w2g = *(const f32x4*)(cw + 2 * 5632 + DFF + c), bg = *(const f32x4*)(cb + DFF + c);
            const float* bo = bnd + (((wn * 2 + (wt ^ 1)) * 2 + (wt ? 1 : 0)) * 4 + g) * 16;
            const f32x4 bxu = *(const f32x4*)(bo + 4 * eh), bxg = *(const f32x4*)(bo + 8 + 4 * eh);
#pragma unroll
            for (int mt = 0; mt < 4; ++mt) {
                float up[4], gt[4], o[4];
#pragma unroll
                for (int r = 0; r < 4; ++r) {
                    const float cu = acc[eh][mt][r], cg = acc[2 + eh][mt][r];
                    float pu = dpp0<0x111>(cu), pg = dpp0<0x111>(cg), nu = dpp0<0x101>(cu), ng = dpp0<0x101>(cg);
                    if (mt > 0) { pu += dpp0<0x10F>(acc[eh][mt > 0 ? mt - 1 : 0][r]); pg += dpp0<0x10F>(acc[2 + eh][mt > 0 ? mt - 1 : 0][r]); }
                    else if (wt == 1 && fr == 0) { pu = bxu[r]; pg = bxg[r]; }
                    if (mt < 3) { nu += dpp0<0x11F>(acc[eh][mt < 3 ? mt + 1 : 3][r]); ng += dpp0<0x11F>(acc[2 + eh][mt < 3 ? mt + 1 : 3][r]); }
                    else if (wt == 0 && fr == 15) { nu = bxu[r]; ng = bxg[r]; }
                    up[r] = bu[r] + w0u[r] * pu + w1u[r] * cu + w2u[r] * nu;
                    gt[r] = bg[r] + w0g[r] * pg + w1g[r] * cg + w2g[r] * ng;
                    o[r] = siluf(gt[r]) * up[r];
                }
                if (mt == 0 && e0) {
                    float* e = EDGE + ((size_t)mt0 * 4 + 0) * 5632 + c;
                    st_wtf4(e, (f32x4){up[0], up[1], up[2], up[3]}); st_wtf4(e + DFF, (f32x4){gt[0], gt[1], gt[2], gt[3]});
                    float* e3 = EDGE + ((size_t)mt0 * 4 + 3) * 5632 + c;
                    st_wtf4(e3, (f32x4){w2u[0] * acc[eh][0][0], w2u[1] * acc[eh][0][1], w2u[2] * acc[eh][0][2], w2u[3] * acc[eh][0][3]});
                    st_wtf4(e3 + DFF, (f32x4){w2g[0] * acc[2 + eh][0][0], w2g[1] * acc[2 + eh][0][1], w2g[2] * acc[2 + eh][0][2], w2g[3] * acc[2 + eh][0][3]});
                }
                if (mt == 3 && e127) {
                    float* e = EDGE + ((size_t)mt0 * 4 + 2) * 5632 + c;
                    st_wtf4(e, (f32x4){up[0], up[1], up[2], up[3]}); st_wtf4(e + DFF, (f32x4){gt[0], gt[1], gt[2], gt[3]});
                    float* e1 = EDGE + ((size_t)mt0 * 4 + 1) * 5632 + c;
                    st_wtf4(e1, (f32x4){w0u[0] * acc[eh][3][0], w0u[1] * acc[eh][3][1], w0u[2] * acc[eh][3][2], w0u[3] * acc[eh][3][3]});
                    st_wtf4(e1 + DFF, (f32x4){w0g[0] * acc[2 + eh][3][0], w0g[1] * acc[2 + eh][3][1], w0g[2] * acc[2 + eh][3][2], w0g[3] * acc[2 + eh][3][3]});
                }
                const u32x2 pk = {pk2(o[0], o[1]), pk2(o[2], o[3])};
                if (eh == 0) keep[mt] = pk;
                else {
                    const int m = m0 + wt * 64 + 16 * mt + fr;
                    *(u32x4*)(A + (size_t)m * DFF + c0) = (u32x4){keep[mt][0], keep[mt][1], pk[0], pk[1]};
                }
            }
        }
    }
}

DI void down_tile(const Ctx& p, int l, int mt0, int nt0, char* smem, int tid) {
    const bf16_t* W = (const bf16_t*)(p.ws() + OFF_WDN) + (size_t)l * SZ_WDN;
    bf16_t* A = (bf16_t*)(p.ws() + OFF_PROJ + (size_t)mt0 * PPB) - (size_t)mt0 * 128 * DFF;
    const bf16_t* X = A;
    float* out = (float*)(p.ws() + OFF_FO);
    {
        const int m0 = mt0 * 128, n0 = nt0 * 128;
        {
            const int t3 = launder(tid);
            const Tok k0 = tok_info(m0, 0);
            const bool hasp = k0.t > 0, hasn = k0.t + 128 < k0.L;
            for (int i = t3; i < 2 * 704; i += 256) {
                const int row = i >= 704 ? 1 : 0, c = (i - row * 704) * 4;
                const float* P = (const float*)(p.ws() + OFF_EDGE) + ((size_t)mt0 * 4 + (row ? 2 : 0)) * 5632 + c;
                f32x4 u = *(const f32x4*)P, gt = *(const f32x4*)(P + DFF);
                if (row ? hasn : hasp) {
                    const float* C = (const float*)(p.ws() + OFF_EDGE) + ((size_t)(row ? mt0 + 1 : mt0 - 1) * 4 + (row ? 3 : 1)) * 5632 + c;
                    const f32x4 cu = *(const f32x4*)C, cg = *(const f32x4*)(C + DFF);
                    u += cu; gt += cg;
                }
                const u32x2 pk = {pk2(siluf(gt[0]) * u[0], siluf(gt[1]) * u[1]), pk2(siluf(gt[2]) * u[2], siluf(gt[3]) * u[3])};
                *(u32x2*)(A + (size_t)(m0 + (row ? 127 : 0)) * DFF + c) = pk;
            }
            asm volatile("s_waitcnt vmcnt(0)" ::: "memory");
            __syncthreads();
        }
        f32x4 acc[4][4];
#pragma unroll
        for (int a = 0; a < 4; ++a)
#pragma unroll
            for (int b = 0; b < 4; ++b) acc[a][b] = (f32x4){0.f, 0.f, 0.f, 0.f};
        gemm_kloop<4, 4>(acc, W + (size_t)n0 * DFF, DFF, X + (size_t)m0 * DFF, DFF, DFF, smem, tid);
        const int t2 = launder(tid);
        const int lane = t2 & 63, wv = t2 >> 6, wn = wv >> 1, wt = wv & 1, fr = lane & 15, g = lane >> 4;
        const int fb = n0 + wn * 64 + 16 * g;
#pragma unroll
        for (int mt = 0; mt < 4; ++mt) {
            const int m = m0 + wt * 64 + 16 * mt + fr;
            float* d = out + (size_t)m * 1024 + fb;
#pragma unroll
            for (int a = 0; a < 4; ++a) *(f32x4*)(d + 4 * a) = acc[a][mt];
        }
    }
}


DI void out_tile(const Ctx& p, int l, int mt0, int nt0, char* smem, int tid) {
    const bf16_t* W = (const bf16_t*)(p.ws() + OFF_WOUT) + (size_t)l * SZ_WOUT;
    const bf16_t* X = (const bf16_t*)(p.ws() + OFF_MERGED);
    float* out = (float*)(p.ws() + OFF_PROJ + (size_t)mt0 * PPB);
    const int m0 = mt0 * 128, n0 = nt0 * 128;
    f32x4 acc[4][4];
#pragma unroll
    for (int a = 0; a < 4; ++a)
#pragma unroll
        for (int b = 0; b < 4; ++b) acc[a][b] = (f32x4){0.f, 0.f, 0.f, 0.f};
    gemm_kloop<4, 4>(acc, W + (size_t)n0 * 1024, 1024, X + (size_t)m0 * 1024, 1024, 1024, smem, tid);
    const int t2 = launder(tid);
    const int lane = t2 & 63, wv = t2 >> 6, wn = wv >> 1, wt = wv & 1, fr = lane & 15, g = lane >> 4;
    const int fb = n0 + wn * 64 + 16 * g;
#pragma unroll
    for (int mt = 0; mt < 4; ++mt) {
        float* d = out + (size_t)(wt * 64 + 16 * mt + fr) * 1024 + fb;
#pragma unroll
        for (int a = 0; a < 4; ++a) *(f32x4*)(d + 4 * a) = acc[a][mt];
    }
}

DI void gemm_uq_tile(const Ctx& p, int l, int ps, int tile, char* smem, int tid) {
    const bf16_t* W = (const bf16_t*)(p.ws() + OFF_WUQ) + (size_t)l * SZ_WUQ;
    const bf16_t* X = (const bf16_t*)(p.ws() + OFF_PROJ) + C_MCQ;
    bf16_t* QM = (bf16_t*)(p.ws() + OFF_QM);
    const float* t8 = (const float*)(p.ws() + OFF_T8);
    const int lane = tid & 63, wv = tid >> 6, wn = wv >> 1, wt = wv & 1, fr = lane & 15, g = lane >> 4;
    const int mt0 = tile / 6, nt0 = tile % 6, m0 = mt0 * 128, n0 = nt0 * 128;
    f32x4 acc[4][4];
#pragma unroll
    for (int a = 0; a < 4; ++a)
#pragma unroll
        for (int b = 0; b < 4; ++b) acc[a][b] = (f32x4){0.f, 0.f, 0.f, 0.f};
    gemm_kloop<4, 4>(acc, W + (size_t)n0 * 384, 384, X + (size_t)m0 * INWP, INWP, 384, smem, tid);
    const int fb = n0 + wn * 64 + 16 * g;
    const int o = fb % 96;
#pragma unroll
    for (int mt = 0; mt < 4; ++mt) {
        const int m = m0 + wt * 64 + 16 * mt + fr;
        float v[16];
#pragma unroll
        for (int a = 0; a < 4; ++a)
#pragma unroll
            for (int r = 0; r < 4; ++r) v[4 * a + r] = acc[a][mt][r];
        if (m >= 4096 && o >= 64) {
            const int t = (m - 4096) & 2047;
            const int pos = (o == 64) ? (t >> 6) : (t & 63);
#pragma unroll
            for (int j = 0; j < 8; ++j) {
                const float c = t8[pos * 8 + j], s = t8[512 + pos * 8 + j];
                const float x1 = v[j], x2 = v[j + 8];
                v[j] = x1 * c - x2 * s; v[j + 8] = x2 * c + x1 * s;
            }
        }
        bf16_t* d = QM + (size_t)m * 768 + fb;
        st_wt16(d, pack8(v)); st_wt16(d + 8, pack8(v + 8));
    }
}

DI void gemm_ukv_tile(const Ctx& p, int l, int tile, char* smem, int tid) {
    const bf16_t* W = (const bf16_t*)(p.ws() + OFF_WUKV) + (size_t)l * SZ_WUKV;
    const bf16_t* X = (const bf16_t*)(p.ws() + OFF_CKV);
    bf16_t* KN = (bf16_t*)(p.ws() + OFF_KN);
    bf16_t* VMT = (bf16_t*)(p.ws() + OFF_VMT);
    const int lane = tid & 63, wv = tid >> 6, wn = wv >> 1, wt = wv & 1, fr = lane & 15, g = lane >> 4;
    const int mt0 = tile / 8, nt0 = tile % 8, m0 = mt0 * 128, n0 = nt0 * 128;
    f32x4 acc[4][4];
#pragma unroll
    for (int a = 0; a < 4; ++a)
#pragma unroll
        for (int b = 0; b < 4; ++b) acc[a][b] = (f32x4){0.f, 0.f, 0.f, 0.f};
    gemm_kloop<4, 4>(acc, W + (size_t)n0 * 256, 256, X + (size_t)m0 * 256, 256, 256, smem, tid);
    const int fb = n0 + wn * 64 + 16 * g;
    const int head = fb >> 7, o = fb & 127;
    int key0, Lk;
    if (m0 < 4096) { key0 = m0 & ~255; Lk = 256; } else { const int j = (m0 - 4096) / 2304; key0 = 4096 + j * 2304; Lk = 2304; }
#pragma unroll
    for (int mt = 0; mt < 4; ++mt) {
        const int m = m0 + wt * 64 + 16 * mt + fr;
        float v[16];
#pragma unroll
        for (int a = 0; a < 4; ++a)
#pragma unroll
            for (int r = 0; r < 4; ++r) v[4 * a + r] = acc[a][mt][r];
        if (o < 64) {
            bf16_t* d = KN + (size_t)m * 512 + head * 64 + o;
            st_wt16(d, pack8(v)); st_wt16(d + 8, pack8(v + 8));
        } else {
            bf16_t* d = VMT + (size_t)key0 * 512 + (size_t)(head * 64 + (o - 64)) * Lk + (m - key0);
#pragma unroll
            for (int i = 0; i < 16; ++i) st_wt2(d + (size_t)i * Lk, f2bf(v[i]));
        }
    }
}

DI void merge_tile(const Ctx& p, int l, int mt0, int nt0, char* smem, int tid) {
    {
        const int m0 = mt0 * 128, n0 = nt0 * 128;
        u32x2 mgp[4][4];
#pragma unroll
        for (int a = 0; a < 4; ++a)
#pragma unroll
            for (int b = 0; b < 4; ++b) mgp[a][b] = (u32x2){0u, 0u};
#pragma unroll 1
        for (int br = 0; br < 4; ++br) {
            u32x2 gpk[4][4];
            {
                f32x4 ga[4][4];
#pragma unroll
                for (int a = 0; a < 4; ++a)
#pragma unroll
                    for (int b = 0; b < 4; ++b) ga[a][b] = (f32x4){0.f, 0.f, 0.f, 0.f};
                gemm_kloop<4, 4, false>(ga, (const bf16_t*)(p.ws() + OFF_WM) + (size_t)l * SZ_WM + (size_t)(br * 1024 + n0) * 1024, 1024,
                                       (const bf16_t*)(p.ws() + OFF_H) + (size_t)m0 * 1024, 1024, 1024, smem, tid);
                const int t2 = launder(tid);
                const int fb = n0 + (t2 >> 7) * 64 + 16 * ((t2 & 63) >> 4);
                const float* bm = p.in(36) + (size_t)l * 4096;
#pragma unroll
                for (int a = 0; a < 4; ++a) {
                    const f32x4 bv = *(const f32x4*)(bm + br * 1024 + fb + 4 * a);
#pragma unroll
                    for (int mt = 0; mt < 4; ++mt) {
                        gpk[a][mt][0] = pk2(sigmoidf(ga[a][mt][0] + bv[0]), sigmoidf(ga[a][mt][1] + bv[1]));
                        gpk[a][mt][1] = pk2(sigmoidf(ga[a][mt][2] + bv[2]), sigmoidf(ga[a][mt][3] + bv[3]));
                    }
                }
            }
            f32x4 pa[4][4];
#pragma unroll
            for (int a = 0; a < 4; ++a)
#pragma unroll
                for (int b = 0; b < 4; ++b) pa[a][b] = (f32x4){0.f, 0.f, 0.f, 0.f};
            const bf16_t* xb; size_t ldb;
            const bf16_t* PROJ = (const bf16_t*)(p.ws() + OFF_PROJ);
            if (br == 0) { xb = PROJ + (size_t)m0 * INWP + C_Z; ldb = INWP; }
            else if (br == 1) { xb = PROJ + (size_t)m0 * INWP + C_RG; ldb = INWP; }
            else if (br == 2) { xb = (const bf16_t*)(p.ws() + OFF_OA) + (size_t)m0 * 512; ldb = 512; }
            else { xb = (const bf16_t*)(p.ws() + OFF_OM) + (size_t)m0 * 512; ldb = 512; }
            gemm_kloop<4, 4, false>(pa, (const bf16_t*)(p.ws() + OFF_WBR) + (size_t)l * SZ_WBR + (size_t)br * 1024 * 512 + (size_t)n0 * 512, 512, xb, ldb, 512, smem, tid);
#pragma unroll
            for (int a = 0; a < 4; ++a)
#pragma unroll
                for (int mt = 0; mt < 4; ++mt) {
                    const float m0 = __uint_as_float(mgp[a][mt][0] << 16) + __uint_as_float(gpk[a][mt][0] << 16) * pa[a][mt][0];
                    const float m1 = __uint_as_float(mgp[a][mt][0] & 0xffff0000u) + __uint_as_float(gpk[a][mt][0] & 0xffff0000u) * pa[a][mt][1];
                    const float m2 = __uint_as_float(mgp[a][mt][1] << 16) + __uint_as_float(gpk[a][mt][1] << 16) * pa[a][mt][2];
                    const float m3 = __uint_as_float(mgp[a][mt][1] & 0xffff0000u) + __uint_as_float(gpk[a][mt][1] & 0xffff0000u) * pa[a][mt][3];
                    mgp[a][mt][0] = pk2(m0, m1); mgp[a][mt][1] = pk2(m2, m3);
                }
        }
        const int t3 = launder(tid);
        const int fr = t3 & 15, g = (t3 & 63) >> 4, wn = t3 >> 7, wt = (t3 >> 6) & 1;
        const int fb = n0 + wn * 64 + 16 * g;
        bf16_t* MG = (bf16_t*)(p.ws() + OFF_MERGED);
#pragma unroll
        for (int mt = 0; mt < 4; ++mt) {
            const int m = m0 + wt * 64 + 16 * mt + fr;
            bf16_t* d = MG + (size_t)m * 1024 + fb;
            *(u32x4*)d = (u32x4){mgp[0][mt][0], mgp[0][mt][1], mgp[1][mt][0], mgp[1][mt][1]};
            *(u32x4*)(d + 8) = (u32x4){mgp[2][mt][0], mgp[2][mt][1], mgp[3][mt][0], mgp[3][mt][1]};
        }
    }
}

DI void prep_token(const Ctx& p, int l, int ps, int m, int lane) {
    char* ws = p.ws();
    bf16_t* PROJ = (bf16_t*)(ws + OFF_PROJ);
    const float* t16 = (const float*)(ws + OFF_T16);
    const float* t8 = (const float*)(ws + OFF_T8);
    const Tok k = tok_info(m, ps);
    bf16_t* pr = PROJ + (size_t)m * INWP;
    if (lane < 16) {
        const float v = ((const float*)(ws + OFF_DTRAW))[(size_t)m * 16 + lane] + p.in(19)[l * 16 + lane];
        const float sp = v > 20.f ? v : log1pe(__expf(v));
        ((float*)(ws + OFF_DT))[(size_t)m * 16 + lane] = sp;
    }
    {
        const int seqkey0 = k.lat ? (k.krow - 256 - k.t) : (k.krow - k.t);
        const int Lk = k.lat ? 2304 : 256;
        const int keyidx = k.krow - seqkey0;
        float v[8];
        if (lane < 32) unpack8(*(const u32x4*)(pr + C_AK + lane * 8), v);
        else {
#pragma unroll
            for (int j = 0; j < 8; ++j) v[j] = 0.f;
        }
        float ss = 0.f;
#pragma unroll
        for (int j = 0; j < 8; ++j) ss += v[j] * v[j];
        ss += shx(ss, 1); ss += shx(ss, 2); ss += shx(ss, 4);
        const float rstd = rsqrtf(ss * (1.f / 64.f) + EPS);
        const int u = lane & 7, axis = u >> 2, pos = axis ? (k.t & 63) : (k.t >> 6);
        float kv[8];
        const float* w = p.in(26) + l * 64 + u * 8;
#pragma unroll
        for (int j = 0; j < 8; ++j) kv[j] = (v[j] * rstd) * w[j];
        float kr[8];
#pragma unroll
        for (int j = 0; j < 8; ++j) {
            const float other = shx(kv[j], 2);
            const int fi = (u & 1) * 8 + j;
            const float c = t16[pos * 16 + fi], s = t16[1024 + pos * 16 + fi];
            kr[j] = (u & 2) ? (kv[j] * c + other * s) : (kv[j] * c - other * s);
        }
        if (lane < 16) {
            if (!k.lat) {
                float* o = p.out() + O_CK + ((size_t)(k.b * 2 + l) * 256 + k.t) * 128 + lane * 8;
                *(f32x4*)o = (f32x4){kv[0], kv[1], kv[2], kv[3]}; *(f32x4*)(o + 4) = (f32x4){kv[4], kv[5], kv[6], kv[7]};
            }
            bf16_t* ka = (bf16_t*)(ws + OFF_KA) + (size_t)k.krow * 128 + lane * 8;
            *(u32x4*)ka = k.lat ? pack8(kr) : pack8(kv);
        } else if (lane < 32) {
            const int d0 = (lane - 16) * 8;
            if (!k.lat) {
                float* o = p.out() + O_CV + ((size_t)(k.b * 2 + l) * 256 + k.t) * 128 + d0;
                *(f32x4*)o = (f32x4){v[0], v[1], v[2], v[3]}; *(f32x4*)(o + 4) = (f32x4){v[4], v[5], v[6], v[7]};
            }
            bf16_t* vt = (bf16_t*)(ws + OFF_VAT) + (size_t)seqkey0 * 128 + (size_t)d0 * Lk + keyidx;
#pragma unroll
            for (int j = 0; j < 8; ++j) vt[(size_t)j * Lk] = f2bf(v[j]);
        }
    }
    {
        float v[8];
        if (lane < 48) unpack8(*(const u32x4*)(pr + C_MCQ + lane * 8), v);
        else {
#pragma unroll
            for (int j = 0; j < 8; ++j) v[j] = 0.f;
        }
        float ss = 0.f;
#pragma unroll
        for (int j = 0; j < 8; ++j) ss += v[j] * v[j];
        ss = wsum(ss);
        const float rstd = rsqrtf(ss * (1.f / 384.f) + EPS);
        if (lane < 48) {
            const float* w = p.in(27) + l * 384 + lane * 8;
#pragma unroll
            for (int j = 0; j < 8; ++j) v[j] = (v[j] * rstd) * w[j];
            *(u32x4*)(pr + C_MCQ + lane * 8) = pack8(v);
        }
    }
    {
        float v[8];
        if (lane < 36) unpack8(*(const u32x4*)(pr + C_MCKV + lane * 8), v);
        else {
#pragma unroll
            for (int j = 0; j < 8; ++j) v[j] = 0.f;
        }
        float ss = 0.f;
        if (lane < 32) {
#pragma unroll
            for (int j = 0; j < 8; ++j) ss += v[j] * v[j];
        }
        ss = wsum(ss);
        const float rstd = rsqrtf(ss * (1.f / 256.f) + EPS);
        const int u = (lane - 32) & 3, axis = u >> 1, pos = axis ? (k.t & 63) : (k.t >> 6);
        float kr[8];
#pragma unroll
        for (int j = 0; j < 8; ++j) {
            const float other = shx(v[j], 1);
            const float c = t8[pos * 8 + j], s = t8[512 + pos * 8 + j];
            kr[j] = (u & 1) ? (v[j] * c + other * s) : (v[j] * c - other * s);
        }
        if (lane < 32) {
            const float* w = p.in(29) + l * 256 + lane * 8;
            float c[8];
#pragma unroll
            for (int j = 0; j < 8; ++j) c[j] = (v[j] * rstd) * w[j];
            if (!k.lat) {
                float* o = p.out() + O_CC + ((size_t)(k.b * 2 + l) * 256 + k.t) * 256 + lane * 8;
                *(f32x4*)o = (f32x4){c[0], c[1], c[2], c[3]}; *(f32x4*)(o + 4) = (f32x4){c[4], c[5], c[6], c[7]};
            }
            *(u32x4*)((bf16_t*)(ws + OFF_CKV) + (size_t)k.krow * 256 + lane * 8) = pack8(c);
        } else if (lane < 36) {
            const int d0 = (lane - 32) * 8;
            if (!k.lat) {
                float* o = p.out() + O_CR + ((size_t)(k.b * 2 + l) * 256 + k.t) * 32 + d0;
                *(f32x4*)o = (f32x4){v[0], v[1], v[2], v[3]}; *(f32x4*)(o + 4) = (f32x4){v[4], v[5], v[6], v[7]};
            }
            *(u32x4*)((bf16_t*)(ws + OFF_KRP) + (size_t)k.krow * 32 + d0) = k.lat ? pack8(kr) : pack8(v);
        }
    }
}
DI void prep_conv_item(const Ctx& p, int l, int ps, int item, int lane) {
    const int run = item >> 1, cbk = item & 1;
    const int c0 = cbk * 512 + lane * 8;
    if (c0 >= 768) return;
    const int m0 = run * 16;
    const Tok k = tok_info(m0, ps);
    const float* cw = p.in(17) + (size_t)l * 3 * 768; const float* cb = p.in(18) + (size_t)l * 768;
    float w[4][8];
#pragma unroll
    for (int tp = 0; tp < 4; ++tp) {
        const float* src = (tp < 3) ? cw + tp * 768 + c0 : cb + c0;
        const f32x4 a0 = *(const f32x4*)src, a1 = *(const f32x4*)(src + 4);
#pragma unroll
        for (int e = 0; e < 4; ++e) { w[tp][e] = a0[e]; w[tp][4 + e] = a1[e]; }
    }
    const bf16_t* xb = (const bf16_t*)(p.ws() + OFF_PROJ) + (size_t)m0 * INWP + C_XBC + c0;
    bf16_t* xo = (bf16_t*)(p.ws() + OFF_XBCA) + (size_t)m0 * 768 + c0;
    const u32x4 zero = {0u, 0u, 0u, 0u};
    u32x4 pv = zero, cv;
    const bf16_t* xe = (const bf16_t*)(p.ws() + OFF_XEDGE) + c0;
    if (k.t > 0) pv = (m0 & 127) ? gld16(xb - INWP) : gld16(xe + ((size_t)((m0 >> 7) - 1) * 2 + 1) * 768);
    cv = gld16(xb);
#pragma unroll 4
    for (int i = 0; i < 16; ++i) {
        u32x4 nv = zero;
        if (k.t + i + 1 < k.L) nv = ((m0 + i + 1) & 127) ? gld16(xb + (size_t)(i + 1) * INWP) : gld16(xe + ((size_t)((m0 >> 7) + 1) * 2 + 0) * 768);
        float a[8], b[8], c[8], o[8];
        unpack8(pv, a); unpack8(cv, b); unpack8(nv, c);
#pragma unroll
        for (int e = 0; e < 8; ++e) o[e] = siluf(w[3][e] + w[0][e] * a[e] + w[1][e] * b[e] + w[2][e] * c[e]);
        *(u32x4*)(xo + (size_t)i * 768) = pack8(o);
        pv = cv; cv = nv;
    }
}
DI void prep_cache_row(const Ctx& p, int l, int ps, int r, int lane) {
    char* ws = p.ws();
    const int j = r >> 8, c = r & 255, b = ps * 2 + j;
    const int key0 = 4096 + j * 2304, krow = key0 + c, Lk = 2304;
    const size_t src = (size_t)(b * 2 + l) * 256 + c;
    if (lane < 16) {
        const float* s = p.in(4) + src * 128 + lane * 8; float v[8];
#pragma unroll
        for (int i = 0; i < 8; ++i) v[i] = s[i];
        *(u32x4*)((bf16_t*)(ws + OFF_KA) + (size_t)krow * 128 + lane * 8) = pack8(v);
    } else if (lane < 32) {
        const int d0 = (lane - 16) * 8;
        const float* s = p.in(5) + src * 128 + d0;
        bf16_t* vt = (bf16_t*)(ws + OFF_VAT) + (size_t)key0 * 128 + (size_t)d0 * Lk + c;
#pragma unroll
        for (int i = 0; i < 8; ++i) vt[(size_t)i * Lk] = f2bf(s[i]);
    } else if (lane < 36) {
        const int d0 = (lane - 32) * 8;
        const float* s = p.in(7) + src * 32 + d0; float v[8];
#pragma unroll
        for (int i = 0; i < 8; ++i) v[i] = s[i];
        *(u32x4*)((bf16_t*)(ws + OFF_KRP) + (size_t)krow * 32 + d0) = pack8(v);
    }
    if (lane < 32) {
        const float* s = p.in(6) + src * 256 + lane * 8; float v[8];
#pragma unroll
        for (int i = 0; i < 8; ++i) v[i] = s[i];
        *(u32x4*)((bf16_t*)(ws + OFF_CKV) + (size_t)krow * 256 + lane * 8) = pack8(v);
    }
}

struct Team { int panel, j, size; };
DI Team team_info(volatile LAS unsigned* xw) {
    const int nloc = __builtin_amdgcn_readfirstlane((int)xw[0]), nx = __builtin_amdgcn_readfirstlane((int)xw[1]);
    const int r = __builtin_amdgcn_readfirstlane((int)xw[6]), vloc = __builtin_amdgcn_readfirstlane((int)xw[7]);
    const int p0 = (64 * r) / nx, np = (64 * (r + 1)) / nx - p0;
    Team t; const int ti = vloc % np;
    t.panel = p0 + ti; t.j = vloc / np; t.size = nloc / np + (ti < nloc % np ? 1 : 0);
    return t;
}
DI unsigned ctr_ld(unsigned* c) { return __hip_atomic_load(c, __ATOMIC_RELAXED, __HIP_MEMORY_SCOPE_AGENT); }
DI void team_sync(unsigned* cnt, unsigned need, unsigned* upself, unsigned nup, unsigned* nb0, unsigned* nb1, unsigned nbneed, int tid) {
    asm volatile("s_waitcnt vmcnt(0)" ::: "memory");
    __syncthreads();
    if (tid == 0) {
        if (upself) __hip_atomic_fetch_add(upself, nup, __ATOMIC_RELAXED, __HIP_MEMORY_SCOPE_AGENT);
        __hip_atomic_fetch_add(cnt, 1u, __ATOMIC_RELAXED, __HIP_MEMORY_SCOPE_AGENT);
        unsigned sp = 0;
        while (ctr_ld(cnt) < need || (nb0 && ctr_ld(nb0) < nbneed) || (nb1 && ctr_ld(nb1) < nbneed)) { __builtin_amdgcn_s_sleep(4); if (++sp > (1u << 24)) break; }
        __builtin_amdgcn_fence(__ATOMIC_ACQUIRE, "agent");
        asm volatile("s_waitcnt vmcnt(0)" ::: "memory");
    }
    __syncthreads();
}
DI void phase_chain(const Ctx& p, int ci, bool head, int bl, int bps, int tl, int tps, unsigned* wq, volatile LAS unsigned* xw, char* smem, int tid) {
    const Team tm = team_info(xw);
    unsigned* tcnt = (unsigned*)(p.ws() + OFF_CTR) + CTR_TEAM + (ci * 64 + tm.panel) * 256;
    unsigned* upc = tcnt + 64; unsigned* xbc = tcnt + 128;
    const unsigned sz = (unsigned)tm.size;
    unsigned ep = 0u;
    const Tok k0 = tok_info(tm.panel * 128, 0);
    const bool hasp = k0.t > 0, hasn = k0.t + 128 < k0.L;
    if (head) {
        const int t2 = launder(tid);
        const float* mod = (const float*)(p.ws() + OFF_MOD);
        bf16_t* H = (bf16_t*)(p.ws() + OFF_H);
        for (int i = tm.j * 4 + (t2 >> 6); i < 128; i += tm.size * 4) {
            const int m = tm.panel * 128 + i;
            const Tok k = tok_info(m, 0);
            f32x4 x[4]; row_load(x_in_row(p, m, 0), t2 & 63, x);
            const float* md = mod + (size_t)(0 * 5 + k.cond) * 6144;
            row_modnorm_store(x, p.in(12), md + 0, md + 1024, H + (size_t)m * 1024, t2 & 63);
        }
    }
    if (bl >= 0) {
        const int l = bl, ps = bps;
        for (int nt = tm.j; nt < 8; nt += tm.size) merge_tile(p, l, tm.panel, nt, smem, tid);
        ep += sz; team_sync(tcnt, ep, nullptr, 0u, nullptr, nullptr, 0u, tid);
        for (int nt = tm.j; nt < 8; nt += tm.size) out_tile(p, l, tm.panel, nt, smem, tid);
        ep += sz; team_sync(tcnt, ep, nullptr, 0u, nullptr, nullptr, 0u, tid);
        res_rows(p, ps, l, 0, (const float*)(p.ws() + OFF_PROJ + (size_t)tm.panel * PPB), tm.panel, tm.j, tm.size, launder(tid));
        ep += sz; team_sync(tcnt, ep, nullptr, 0u, nullptr, nullptr, 0u, tid);
        unsigned nup = 0u;
        for (int nt = tm.j; nt < 44; nt += tm.size) { up_tile(p, l, tm.panel, nt, smem, tid); ++nup; }
        ep += sz; team_sync(tcnt, ep, upc, nup, hasp ? upc - 256 : nullptr, hasn ? upc + 256 : nullptr, 44u, tid);
        for (int nt = tm.j; nt < 8; nt += tm.size) down_tile(p, l, tm.panel, nt, smem, tid);
        ep += sz; team_sync(tcnt, ep, nullptr, 0u, nullptr, nullptr, 0u, tid);
        res_rows(p, ps, l, 1, (const float*)(p.ws() + OFF_FO) + (size_t)tm.panel * 128 * 1024, tm.panel, tm.j, tm.size, launder(tid));
    }
    if (tl >= 0) {
        const int l = tl, ps = tps;
        ep += sz; team_sync(tcnt, ep, nullptr, 0u, nullptr, nullptr, 0u, tid);
        unsigned nxb = 0u;
        for (int nt = tm.j; nt < 34; nt += tm.size) { gemm_in_tile(p, l, tm.panel, nt, smem, tid); if (nt >= 4 && nt < 10) ++nxb; }
        if (launder_s(ps) == 0) {
            const int lo = l * T_LAYER + T_IN, hi = l * T_LAYER + T_MIDEND;
            for (;;) {
                const int k = next_item(wq, xw + 2, tid);
                const int w0 = lo + 4 * k;
                if (w0 >= hi) break;
                wtile_run(p, w0, min(w0 + 4, hi), 1, smem, tid);
            }
        }
        ep += sz; team_sync(tcnt, ep, xbc, nxb, hasp ? xbc - 256 : nullptr, hasn ? xbc + 256 : nullptr, 6u, tid);
        const int t2 = launder(tid);
        for (int i = tm.j * 4 + (t2 >> 6); i < 128 + 16 + 8; i += tm.size * 4) {
            if (i < 128) prep_token(p, l, ps, tm.panel * 128 + i, t2 & 63);
            else if (i < 144) prep_conv_item(p, l, ps, tm.panel * 16 + (i - 128), t2 & 63);
            else prep_cache_row(p, l, ps, tm.panel * 8 + (i - 144), t2 & 63);
        }
    }
}
template <int KC, int NQT>
DI void attn_tile(const bf16_t* __restrict__ Q, size_t ldq, const bf16_t* __restrict__ K1, size_t ldk1, const bf16_t* __restrict__ K2, size_t ldk2,
                  const bf16_t* __restrict__ VT, size_t ldvt, int nkt, float c2, bf16_t* __restrict__ O, size_t ldo,
                  const float* __restrict__ qnw  , const float* __restrict__ rope, int t0  , char* smem, int tid) {
    constexpr int KB = KC * 4096, STG = KB + 8192;
    tid = launder(tid);
    const int lane = tid & 63, w = tid >> 6, fr = lane & 15, g = lane >> 4;
    bf16x8 qf[NQT][KC];
#pragma unroll
    for (int qt = 0; qt < NQT; ++qt)
#pragma unroll
        for (int ks = 0; ks < KC; ++ks) { const u32x4 t4 = gld16(Q + (size_t)(16 * NQT * w + 16 * qt + fr) * ldq + ks * 32 + 8 * g); qf[qt][ks] = __builtin_bit_cast(bf16x8, t4); }
    if (KC == 2 && qnw) {
#pragma unroll
        for (int qt = 0; qt < NQT; ++qt) {
            float v[2][8]; float ss = 0.f;
#pragma unroll
            for (int ks = 0; ks < 2; ++ks) {
                const u32x4 t4 = __builtin_bit_cast(u32x4, qf[qt][ks]); unpack8(t4, v[ks]);
#pragma unroll
                for (int j = 0; j < 8; ++j) ss += v[ks][j] * v[ks][j];
            }
            ss += shx(ss, 16); ss += shx(ss, 32);
            const float rstd = rsqrtf(ss * (1.f / 64.f) + EPS);
            const int t = t0 + 16 * NQT * w + 16 * qt + fr;
#pragma unroll
            for (int ks = 0; ks < 2; ++ks) {
                const int pos = ks ? (t & 63) : (t >> 6);
#pragma unroll
                for (int j = 0; j < 8; ++j) {
                    float x = (v[ks][j] * rstd) * qnw[32 * ks + 8 * g + j];
                    if (rope) {
                        const float other = shx(x, 32);
                        const int fi = (g & 1) * 8 + j;
                        const float c = rope[pos * 16 + fi], sn = rope[1024 + pos * 16 + fi];
                        x = (g & 2) ? (x * c + other * sn) : (x * c - other * sn);
                    }
                    v[ks][j] = x;
                }
                const u32x4 t4 = pack8(v[ks]); qf[qt][ks] = __builtin_bit_cast(bf16x8, t4);
            }
        }
    }
    constexpr int NPK = KC * 4, PPW = (NPK + 8) / 4;
    static_assert((NPK + 8) % 4 == 0, "pieces must divide over 4 waves");
    const int wvu = __builtin_amdgcn_readfirstlane(w);
    unsigned poff[PPW];
#pragma unroll
    for (int j = 0; j < PPW; ++j) {
        const int pc = wvu * PPW + j;
        const bool isk = pc < NPK;
        const int pp = isk ? pc : pc - NPK;
        const int ks = pp >> 2, rb = pp & 3;
        const int rl = lane >> 2, row = rb * 16 + rl;
        const int q = isk ? ((row >> 3) & 3) : ((rl >> 2) & 3);
        const int gl = (lane & 3) ^ FQ(q);
        const unsigned ld = isk ? ((KC == 2 || ks < 2) ? (unsigned)ldk1 : (unsigned)ldk2) : (unsigned)ldvt;
        poff[j] = (unsigned)rl * ld + (unsigned)(gl * 8);
    }
    auto issue = [&](int kt, char* stage) {
#pragma unroll
        for (int j = 0; j < PPW; ++j) {
            const int pc = wvu * PPW + j;
            const bool isk = pc < NPK;
            const int pp = isk ? pc : pc - NPK;
            const int ks = pp >> 2, rb = pp & 3;
            const bf16_t* base;
            if (isk) { if (KC == 2 || ks < 2) base = K1 + ks * 32 + (size_t)(kt * 64 + rb * 16) * ldk1; else base = K2 + (size_t)(kt * 64 + rb * 16) * ldk2; }
            else base = VT + ks * 32 + (size_t)kt * 64 + (size_t)(rb * 16) * ldvt;
            __builtin_amdgcn_global_load_lds((const unsigned*)(base + poff[j]), (unsigned*)(stage + (isk ? 0 : KB) + (ks * 64 + rb * 16) * 64), 16, 0, 0);
        }
    };
    const int koff = tile_off(64, 0, 8 * (fr >> 2) + (fr & 3), g, fr >> 2);
    const int voff = KB + tile_off(64, 0, fr, g, (fr >> 2) & 3);
    f32x4 o[4][NQT];
#pragma unroll
    for (int a = 0; a < 4; ++a)
#pragma unroll
        for (int qt = 0; qt < NQT; ++qt) o[a][qt] = (f32x4){0.f, 0.f, 0.f, 0.f};
    float mrun[NQT], lrun[NQT];
#pragma unroll
    for (int qt = 0; qt < NQT; ++qt) { mrun[qt] = -1e30f; lrun[qt] = 0.f; }
    __syncthreads();
    issue(0, smem);
    if (nkt > 1) {
        issue(1, smem + STG);
        if (PPW == 4) asm volatile("s_waitcnt vmcnt(4)" ::: "memory"); else asm volatile("s_waitcnt vmcnt(5)" ::: "memory");
    } else asm volatile("s_waitcnt vmcnt(0)" ::: "memory");
    __syncthreads();
    int so_cur = 0, so_nn = 2 * STG;
    for (int kt = 0; kt < nkt; ++kt) {
        if (kt + 2 < nkt) issue(kt + 2, smem + so_nn);
        __builtin_amdgcn_sched_barrier(0);
        const char* sb = smem + so_cur;
        f32x4 s[4][NQT];
#pragma unroll
        for (int a = 0; a < 4; ++a)
#pragma unroll
            for (int qt = 0; qt < NQT; ++qt) s[a][qt] = (f32x4){0.f, 0.f, 0.f, 0.f};
        bf16x8 kf[KC][4];
#pragma unroll
        for (int ks = 0; ks < KC; ++ks)
#pragma unroll
            for (int a = 0; a < 4; ++a) kf[ks][a] = *(const bf16x8*)(sb + koff + ((a >> 1) * 32 + (a & 1) * 4) * 64 + ks * 4096);
        __builtin_amdgcn_sched_barrier(0);
#pragma unroll
        for (int ks = 0; ks < KC; ++ks)
#pragma unroll
            for (int a = 0; a < 4; ++a) {
#pragma unroll
                for (int qt = 0; qt < NQT; ++qt) s[a][qt] = __builtin_amdgcn_mfma_f32_16x16x32_bf16(kf[ks][a], qf[qt][ks], s[a][qt], 0, 0, 0);
            }
        bf16x8 vfr[2][4];
#pragma unroll
        for (int s2 = 0; s2 < 2; ++s2)
#pragma unroll
            for (int dt = 0; dt < 4; ++dt) vfr[s2][dt] = *(const bf16x8*)(sb + voff + dt * 1024 + s2 * 4096);
        __builtin_amdgcn_sched_barrier(0);
        bf16x8 pf[NQT][2];
#pragma unroll
        for (int qt = 0; qt < NQT; ++qt) {
            float mx = s[0][qt][0];
#pragma unroll
            for (int a = 0; a < 4; ++a)
#pragma unroll
                for (int r = 0; r < 4; ++r) mx = fmaxf(mx, s[a][qt][r]);
            mx = gmax4(mx);
            const float mnew = fmaxf(mrun[qt], mx);
            const float alpha = __builtin_amdgcn_exp2f((mrun[qt] - mnew) * c2);
            mrun[qt] = mnew;
            const float mc = mnew * c2;
            float ls = 0.f; float pv[16];
#pragma unroll
            for (int a = 0; a < 4; ++a)
#pragma unroll
                for (int r = 0; r < 4; ++r) { const float e = __builtin_amdgcn_exp2f(s[a][qt][r] * c2 - mc); pv[4 * a + r] = e; ls += e; }
            lrun[qt] = lrun[qt] * alpha + ls;
#pragma unroll
            for (int a = 0; a < 4; ++a) o[a][qt] = o[a][qt] * alpha;
            u32x4 w0 = pack8(pv), w1 = pack8(pv + 8);
            pf[qt][0] = __builtin_bit_cast(bf16x8, w0); pf[qt][1] = __builtin_bit_cast(bf16x8, w1);
        }
        __builtin_amdgcn_sched_barrier(0);
#pragma unroll
        for (int s2 = 0; s2 < 2; ++s2)
#pragma unroll
            for (int dt = 0; dt < 4; ++dt) {
#pragma unroll
                for (int qt = 0; qt < NQT; ++qt) o[dt][qt] = __builtin_amdgcn_mfma_f32_16x16x32_bf16(vfr[s2][dt], pf[qt][s2], o[dt][qt], 0, 0, 0);
            }
        __builtin_amdgcn_sched_barrier(0);
        if (kt + 2 < nkt) { if (PPW == 4) asm volatile("s_waitcnt vmcnt(4)" ::: "memory"); else asm volatile("s_waitcnt vmcnt(5)" ::: "memory"); }
        else asm volatile("s_waitcnt vmcnt(0)" ::: "memory");
        asm volatile("s_waitcnt lgkmcnt(0)" ::: "memory");
        __builtin_amdgcn_s_barrier();
        so_cur = (so_cur == 2 * STG) ? 0 : so_cur + STG;
        so_nn = (so_nn == 2 * STG) ? 0 : so_nn + STG;
    }
#pragma unroll
    for (int qt = 0; qt < NQT; ++qt) {
        float l = gsum4(lrun[qt]);
        const float inv = 1.f / l;
        bf16_t* orow = O + (size_t)(16 * NQT * w + 16 * qt + fr) * ldo + 4 * g;
#pragma unroll
        for (int dt = 0; dt < 4; ++dt) {
            u32x2 wv2; wv2[0] = pk2(o[dt][qt][0] * inv, o[dt][qt][1] * inv); wv2[1] = pk2(o[dt][qt][2] * inv, o[dt][qt][3] * inv);
            *(u32x2*)(orow + 16 * dt) = wv2;
        }
    }
}

struct Seq { int lat, tok0, L, key0, Lk, b; };
DI Seq seq_info(int s, int ps) {
    Seq q;
    if (s < 16) { q.lat = 0; q.tok0 = s * 256; q.L = 256; q.key0 = s * 256; q.Lk = 256; q.b = ps * 16 + s; }
    else { const int j = s - 16; q.lat = 1; q.tok0 = 4096 + j * 2048; q.L = 2048; q.key0 = 4096 + j * 2304; q.Lk = 2304; q.b = ps * 2 + j; }
    return q;
}
DI void attn_gqa_item(const Ctx& p, int l, int s, int head, int qb, int ps, char* smem, int tid) {
    const Seq q = seq_info(s, ps);
    const int rows = 128;
    const bf16_t* PROJ = (const bf16_t*)(p.ws() + OFF_PROJ);
    const bf16_t* Q = PROJ + (size_t)(q.tok0 + qb * rows) * INWP + C_AQ + head * 64;
    const int kh = head >> 2;
    const bf16_t* K = (const bf16_t*)(p.ws() + OFF_KA) + (size_t)q.key0 * 128 + kh * 64;
    const bf16_t* VT = (const bf16_t*)(p.ws() + OFF_VAT) + (size_t)q.key0 * 128 + (size_t)kh * 64 * q.Lk;
    bf16_t* O = (bf16_t*)(p.ws() + OFF_OA) + (size_t)(q.tok0 + qb * rows) * 512 + head * 64;
    const float c2 = 0.125f * 1.4426950408889634f;
    attn_tile<2, 2>(Q, INWP, K, 128, K, 128, VT, q.Lk, q.Lk / 64, c2, O, 512, p.in(25) + l * 64, q.lat ? (const float*)(p.ws() + OFF_T16) : nullptr, qb * 128, smem, tid);
}
DI void attn_mla_item(const Ctx& p, int s, int head, int qb, int ps, char* smem, int tid) {
    const Seq q = seq_info(s, ps);
    const int rows = 128;
    const bf16_t* Q = (const bf16_t*)(p.ws() + OFF_QM) + (size_t)(q.tok0 + qb * rows) * 768 + head * 96;
    const bf16_t* K1 = (const bf16_t*)(p.ws() + OFF_KN) + (size_t)q.key0 * 512 + head * 64;
    const bf16_t* K2 = (const bf16_t*)(p.ws() + OFF_KRP) + (size_t)q.key0 * 32;
    const bf16_t* VT = (const bf16_t*)(p.ws() + OFF_VMT) + (size_t)q.key0 * 512 + (size_t)head * 64 * q.Lk;
    bf16_t* O = (bf16_t*)(p.ws() + OFF_OM) + (size_t)(q.tok0 + qb * rows) * 512 + head * 64;
    const float c2 = 0.10206207261596577f * 1.4426950408889634f;
    attn_tile<3, 2>(Q, 768, K1, 512, K2, 32, VT, q.Lk, q.Lk / 64, c2, O, 512, nullptr, nullptr, 0, smem, tid);
}

template <int ET>
DI void scan_item(const bf16_t* __restrict__ Qp, size_t ldq, const bf16_t* __restrict__ Kp, size_t ldk, const bf16_t* __restrict__ Vp, size_t ldv,
                  const float* __restrict__ dtp  , float acoef  ,
                  int L, int dir, const float* __restrict__ s0, float* __restrict__ sout, int lds_state  , bf16_t* __restrict__ Op, size_t ldo,
                  const float* __restrict__ rope  , float kmul,
                  int nbase  , int nch  , const bf16_t* __restrict__ s0b  ,
                  bf16_t* __restrict__ lout  , float* __restrict__ dout  , char* smem, int tid) {
    constexpr int DV = 16 * ET;
    const bool stateonly = (lout != nullptr);
    constexpr int QS = 0, KS = 8192, KT = 16384, VTO = 24576, STO = VTO + DV * 128, ACO = STO + DV * 128;
    constexpr int NV = DV / 32;
    tid = launder(tid);
    const int lane = tid & 63, w = tid >> 6, fr = lane & 15, g = lane >> 4;
    float* acs = (float*)(smem + ACO);
    f32x4 sacc[ET];
#pragma unroll
    for (int et = 0; et < ET; ++et) {
        if (s0) {
#pragma unroll
            for (int r = 0; r < 4; ++r) sacc[et][r] = s0[(size_t)(16 * w + 4 * g + r) * lds_state + 16 * et + fr];
        } else if (s0b) {
#pragma unroll
            for (int r = 0; r < 4; ++r) sacc[et][r] = bf2f(s0b[(16 * w + 4 * g + r) * DV + 16 * et + fr]);
        } else sacc[et] = (f32x4){0.f, 0.f, 0.f, 0.f};
    }
    const int st_off = STO + ((w >> 1) * DV) * 64 + (g & 1) * 8;
    const int st_gg = (2 * w + (g >> 1)) & 3;
    __syncthreads();
    float* ropeL = (float*)(smem + ACO + 256);
    if (rope) {
#pragma unroll
        for (int i = 0; i < 2; ++i) *(f32x4*)(ropeL + (tid + 256 * i) * 4) = *(const f32x4*)(rope + (tid + 256 * i) * 4);
    }
#pragma unroll
    for (int et = 0; et < ET; ++et) {
        const int e = 16 * et + fr;
        u32x2 wv2; wv2[0] = pk2(sacc[et][0], sacc[et][1]); wv2[1] = pk2(sacc[et][2], sacc[et][3]);
        *(u32x2*)(smem + st_off + e * 64 + ((st_gg ^ FQ((e >> 2) & 3)) << 4)) = wv2;
    }
    __syncthreads();
    float dprod = 1.f;
    const int qoff = QS + tile_off(64, 0, 16 * w + fr, g, (fr >> 2) & 3);
    const int koff = KS + tile_off(64, 0, 8 * (fr >> 2) + (fr & 3), g, fr >> 2);
    const int ktoff = KT + tile_off(64, 0, 16 * w + fr, g, (fr >> 2) & 3);
    const int vtoff = VTO + tile_off(DV, 0, fr, g, (fr >> 2) & 3);
    const int stoff = STO + tile_off(DV, 0, fr, g, (fr >> 2) & 3);
    u32x4 gq[2], gk[2], gv[NV]; float gdt = 1.f;
    auto issue = [&](int c) {
        const int n0 = nbase + c * 64;
        {
            const int row = tid >> 2, cc0 = (tid & 1) | ((tid & 2) << 1);
            const int tl = dir ? (L - 1 - (n0 + row)) : (n0 + row);
#pragma unroll
            for (int i = 0; i < 2; ++i) {
                gq[i] = gld16(Qp + (size_t)tl * ldq + (cc0 + 2 * i) * 8);
                gk[i] = gld16(Kp + (size_t)tl * ldk + (cc0 + 2 * i) * 8);
            }
        }
#pragma unroll
        for (int i = 0; i < NV; ++i) {
            const int q = tid + 256 * i, row = q / (DV / 8), cc = q % (DV / 8);
            const int tl = dir ? (L - 1 - (n0 + row)) : (n0 + row);
            gv[i] = gld16(Vp + (size_t)tl * ldv + cc * 8);
        }
        if (dtp) { const int tl = dir ? (L - 1 - (n0 + lane)) : (n0 + lane); gdt = dtp[(size_t)tl * 16]; }
    };
    issue(0);
    for (int c = 0; c < nch; ++c) {
        const int n0 = nbase + c * 64;
        const float dtv = gdt;
        const float la = dtp ? dtv * acoef : acoef;
        float ac, aend;
        if (dtp) {
            ac = la;
#pragma unroll
            for (int o = 1; o < 64; o <<= 1) { const float t = shu(ac, o); if (lane >= o) ac += t; }
            aend = shf(ac, 63);
        } else { ac = (float)(lane + 1) * la; aend = 64.f * la; }
        if (w == 0) acs[lane] = ac;
        {
            const int row = tid >> 2, cc0 = (tid & 1) | ((tid & 2) << 1);
            const float ksc = shf(dtv, row) * kmul, wend = __expf(aend - shf(ac, row));
            float qa[2][8], ka[2][8];
#pragma unroll
            for (int i = 0; i < 2; ++i) { unpack8(gq[i], qa[i]); unpack8(gk[i], ka[i]); }
            if (rope) {
                const int tlr = dir ? (L - 1 - (n0 + row)) : (n0 + row);
                const int pos = (cc0 >> 2) ? (tlr & 63) : (tlr >> 6);
                const float* rp = ropeL + pos * 16 + (cc0 & 1) * 8;
                f32x4 rc[2], rs[2];
                rc[0] = *(const f32x4*)rp; rc[1] = *(const f32x4*)(rp + 4); rs[0] = *(const f32x4*)(rp + 1024); rs[1] = *(const f32x4*)(rp + 1028);
#pragma unroll
                for (int j = 0; j < 8; ++j) {
                    const float c = rc[j >> 2][j & 3], sn = rs[j >> 2][j & 3];
                    const float q1 = qa[0][j], q2 = qa[1][j], k1 = ka[0][j], k2 = ka[1][j];
                    qa[0][j] = q1 * c - q2 * sn; qa[1][j] = q2 * c + q1 * sn;
                    ka[0][j] = k1 * c - k2 * sn; ka[1][j] = k2 * c + k1 * sn;
                }
            }
#pragma unroll
            for (int i = 0; i < 2; ++i) {
                const int cc = cc0 + 2 * i;
                if (rope) *(u32x4*)(smem + QS + tile_off(64, cc >> 2, row, cc & 3, (row >> 2) & 3)) = pack8(qa[i]);
                else *(u32x4*)(smem + QS + tile_off(64, cc >> 2, row, cc & 3, (row >> 2) & 3)) = gq[i];
#pragma unroll
                for (int j = 0; j < 8; ++j) ka[i][j] *= ksc;
                *(u32x4*)(smem + KS + tile_off(64, cc >> 2, row, cc & 3, (row >> 3) & 3)) = pack8(ka[i]);
#pragma unroll
                for (int j = 0; j < 8; ++j) {
                    const int d = cc * 8 + j;
                    *(bf16_t*)(smem + KT + tile_off(64, row >> 5, d, (row >> 3) & 3, (d >> 2) & 3) + (row & 7) * 2) = f2bf(ka[i][j] * wend);
                }
            }
        }
#pragma unroll
        for (int i = 0; i < NV; ++i) {
            const int q = tid + 256 * i, row = q / (DV / 8), cc = q % (DV / 8);
            const u32x4 vv = gv[i];
#pragma unroll
            for (int j = 0; j < 8; ++j) {
                const int e = cc * 8 + j;
                const unsigned short h = (unsigned short)(vv[j >> 1] >> (16 * (j & 1)));
                *(bf16_t*)(smem + VTO + tile_off(DV, row >> 5, e, (row >> 3) & 3, (e >> 2) & 3) + (row & 7) * 2) = h;
            }
        }
        if (c + 1 < nch) issue(c + 1);
        __builtin_amdgcn_sched_barrier(0);
        __syncthreads();
        {
            const int irow = 16 * w + fr;
            const int ns = (w >> 1) + 1;
            bf16x8 qfr[2], sf[ET][2], kfa[2][2][2], vf[2][ET], kt2[2];
            qfr[0] = *(const bf16x8*)(smem + qoff); qfr[1] = *(const bf16x8*)(smem + qoff + 4096);
#pragma unroll
            for (int et = 0; et < ET; ++et)
#pragma unroll
                for (int ks = 0; ks < 2; ++ks) sf[et][ks] = *(const bf16x8*)(smem + stoff + et * 1024 + ks * DV * 64);
#pragma unroll
            for (int aa = 0; aa < 2; ++aa)
#pragma unroll
                for (int ks = 0; ks < 2; ++ks) kfa[0][aa][ks] = *(const bf16x8*)(smem + koff + (4 * aa) * 64 + ks * 4096);
            const float ai = acs[irow];
            f32x4 ajv[2][2];
#pragma unroll
            for (int aa = 0; aa < 2; ++aa) ajv[0][aa] = *(const f32x4*)(acs + 8 * g + 4 * aa);
            const float cd = __expf(acs[63]);
            __builtin_amdgcn_sched_barrier(0);
            f32x4 o[ET];
            if (!stateonly) {
#pragma unroll
                for (int et = 0; et < ET; ++et) {
                    o[et] = (f32x4){0.f, 0.f, 0.f, 0.f};
#pragma unroll
                    for (int ks = 0; ks < 2; ++ks) o[et] = __builtin_amdgcn_mfma_f32_16x16x32_bf16(sf[et][ks], qfr[ks], o[et], 0, 0, 0);
                }
            }
#pragma unroll
            for (int aa = 0; aa < 2; ++aa)
#pragma unroll
                for (int ks = 0; ks < 2; ++ks) kfa[1][aa][ks] = *(const bf16x8*)(smem + koff + (32 + 4 * aa) * 64 + ks * 4096);
#pragma unroll
            for (int ks = 0; ks < 2; ++ks) {
#pragma unroll
                for (int et = 0; et < ET; ++et) vf[ks][et] = *(const bf16x8*)(smem + vtoff + et * 1024 + ks * DV * 64);
                kt2[ks] = *(const bf16x8*)(smem + ktoff + ks * 4096);
            }
#pragma unroll
            for (int aa = 0; aa < 2; ++aa) ajv[1][aa] = *(const f32x4*)(acs + 32 + 8 * g + 4 * aa);
            __builtin_amdgcn_sched_barrier(0);
            if (!stateonly) {
                const float ei = __expf(ai);
#pragma unroll
                for (int et = 0; et < ET; ++et) o[et] = o[et] * ei;
#pragma unroll
                for (int s2 = 0; s2 < 2; ++s2) {
                    if (s2 < ns) {
                        f32x4 pp[2];
#pragma unroll
                        for (int aa = 0; aa < 2; ++aa) {
                            pp[aa] = (f32x4){0.f, 0.f, 0.f, 0.f};
#pragma unroll
                            for (int ks = 0; ks < 2; ++ks) pp[aa] = __builtin_amdgcn_mfma_f32_16x16x32_bf16(kfa[s2][aa][ks], qfr[ks], pp[aa], 0, 0, 0);
                        }
                        float pv[8];
#pragma unroll
                        for (int aa = 0; aa < 2; ++aa) {
                            const int j0 = 32 * s2 + 8 * g + 4 * aa;
#pragma unroll
                            for (int r = 0; r < 4; ++r) {
                                const float dec = __expf(fminf(ai - ajv[s2][aa][r], 0.f));
                                pv[4 * aa + r] = (j0 + r <= irow) ? pp[aa][r] * dec : 0.f;
                            }
                        }
                        const u32x4 pw = pack8(pv);
                        const bf16x8 pf = __builtin_bit_cast(bf16x8, pw);
#pragma unroll
                        for (int et = 0; et < ET; ++et) o[et] = __builtin_amdgcn_mfma_f32_16x16x32_bf16(vf[s2][et], pf, o[et], 0, 0, 0);
                    }
                }
                const int tl = dir ? (L - 1 - (n0 + irow)) : (n0 + irow);
                bf16_t* orow = Op + (size_t)tl * ldo + 4 * g;
#pragma unroll
                for (int et = 0; et < ET; ++et) {
                    u32x2 wv2; wv2[0] = pk2(o[et][0], o[et][1]); wv2[1] = pk2(o[et][2], o[et][3]);
                    st_wt8(orow + 16 * et, wv2);
                }
            }
            dprod *= cd;
#pragma unroll
            for (int et = 0; et < ET; ++et) sacc[et] = sacc[et] * cd;
#pragma unroll
            for (int ks = 0; ks < 2; ++ks)
#pragma unroll
                for (int et = 0; et < ET; ++et) sacc[et] = __builtin_amdgcn_mfma_f32_16x16x32_bf16(kt2[ks], vf[ks][et], sacc[et], 0, 0, 0);
        }
        __syncthreads();
#pragma unroll
        for (int et = 0; et < ET; ++et) {
            const int e = 16 * et + fr;
            u32x2 wv2; wv2[0] = pk2(sacc[et][0], sacc[et][1]); wv2[1] = pk2(sacc[et][2], sacc[et][3]);
            *(u32x2*)(smem + st_off + e * 64 + ((st_gg ^ FQ((e >> 2) & 3)) << 4)) = wv2;
        }
    }
    if (sout) {
#pragma unroll
        for (int et = 0; et < ET; ++et)
#pragma unroll
            for (int r = 0; r < 4; ++r) sout[(size_t)(16 * w + 4 * g + r) * lds_state + 16 * et + fr] = sacc[et][r];
    }
    if (lout) {
#pragma unroll
        for (int et = 0; et < ET; ++et)
#pragma unroll
            for (int r = 0; r < 4; ++r) st_wt2(lout + (16 * w + 4 * g + r) * DV + 16 * et + fr, f2bf(sacc[et][r]));
        if (tid == 0) st_wt4f(dout, dprod);
    }
    __syncthreads();
}

DI void scan_any_item(const Ctx& p, int l, int ps, int isret, int s, int h, int dir, int half, int mode, int seg, int sid, char* smem, int tid) {
    const Seq q = seq_info(s, ps);
    const bf16_t *Qp, *Kp, *Vp; size_t ld; const float* dtp; float acoef, kmul; const float* rope; bf16_t* O; float* so; int lds;
    if (isret) {
        const bf16_t* PR = (const bf16_t*)(p.ws() + OFF_PROJ) + (size_t)q.tok0 * INWP;
        const float x = p.in(23)[l * 8 + dir * 4 + h];
        acoef = fminf(x, 0.f) - log1pe(__expf(-fabsf(x)));
        Qp = PR + C_RQ + h * 64; Kp = PR + C_RK + h * 64; Vp = PR + C_RV + h * 128 + half * 64; ld = INWP; dtp = nullptr; kmul = 0.125f;
        rope = q.lat ? (const float*)(p.ws() + OFF_T16) : nullptr;
        O = (bf16_t*)(p.ws() + OFF_OR) + ((size_t)dir * NPT + q.tok0) * 512 + h * 128 + half * 64;
        so = p.out() + O_RET + ((size_t)((q.b * 2 + l) * 2 + dir) * 4 + h) * 8192 + half * 64; lds = 128;
    } else {
        const bf16_t* XB = (const bf16_t*)(p.ws() + OFF_XBCA) + (size_t)q.tok0 * 768;
        const int grp = h >> 2;
        Qp = XB + 640 + grp * 64; Kp = XB + 512 + grp * 64; Vp = XB + h * 64; ld = 768; kmul = 1.f; rope = nullptr;
        dtp = (const float*)(p.ws() + OFF_DT) + (size_t)q.tok0 * 16 + dir * 8 + h;
        acoef = -__expf(p.in(20)[l * 16 + dir * 8 + h]);
        O = (bf16_t*)(p.ws() + OFF_OS) + ((size_t)dir * NPT + q.tok0) * 512 + h * 64;
        so = p.out() + O_SSD + ((size_t)((q.b * 2 + l) * 2 + dir) * 8 + h) * 4096; lds = 64;
    }
    bf16_t* segb = (bf16_t*)(p.ws() + OFF_SEG) + (size_t)(sid * NSEG + seg) * 4096;
    float* segd = (float*)(p.ws() + OFF_SEGD) + sid * NSEG + seg;
    scan_item<4>(Qp, ld, Kp, ld, Vp, ld, dtp, acoef, q.L, dir, nullptr, mode == 0 ? so : nullptr, lds, O, 512, rope, kmul,
                 mode == 0 ? 0 : seg * SEGTOK, mode == 0 ? (q.L >> 6) : (SEGTOK >> 6), mode == 3 ? segb : nullptr, mode == 1 ? segb : nullptr, mode == 1 ? segd : nullptr, smem, tid);
}
DI void scan_combine_item(const Ctx& p, int l, int ps, int sid, int tid) {
    const float* s0; int ld;
    if (sid < 32) { const int b = ps * 2 + (sid >> 4), h = (sid >> 1) & 7, dir = sid & 1; s0 = p.in(2) + ((size_t)((b * 2 + l) * 2 + dir) * 8 + h) * 4096; ld = 64; }
    else { const int k = sid - 32, b = ps * 2 + (k >> 4), h = (k >> 2) & 3, dir = (k >> 1) & 1, half = k & 1;
           s0 = p.in(3) + ((size_t)((b * 2 + l) * 2 + dir) * 4 + h) * 8192 + half * 64; ld = 128; }
    bf16_t* segb = (bf16_t*)(p.ws() + OFF_SEG) + (size_t)sid * NSEG * 4096;
    const float* segd = (const float*)(p.ws() + OFF_SEGD) + sid * NSEG;
    const int t2 = launder(tid);
    const float* sp = s0 + (size_t)(t2 >> 2) * ld + (t2 & 3) * 16;
    bf16_t* bp = segb + t2 * 16;
    float S[16];
#pragma unroll
    for (int k = 0; k < 4; ++k) { const f32x4 v = *(const f32x4*)(sp + 4 * k); S[4 * k] = v[0]; S[4 * k + 1] = v[1]; S[4 * k + 2] = v[2]; S[4 * k + 3] = v[3]; }
#pragma unroll 1
    for (int g2 = 0; g2 < NSEG; ++g2) {
        float loc[16]; float d = 0.f;
        if (g2 < NSEG - 1) { d = segd[g2]; unpack8(*(const u32x4*)(bp + g2 * 4096), loc); unpack8(*(const u32x4*)(bp + g2 * 4096 + 8), loc + 8); }
        else {
#pragma unroll
            for (int k = 0; k < 16; ++k) loc[k] = 0.f;
        }
        st_wt16(bp + g2 * 4096, pack8(S)); st_wt16(bp + g2 * 4096 + 8, pack8(S + 8));
#pragma unroll
        for (int k = 0; k < 16; ++k) S[k] = S[k] * d + loc[k];
    }
}

DI void postscan_token(const Ctx& p, int l, int m, int lane) {
    char* ws = p.ws();
    bf16_t* pr = (bf16_t*)(ws + OFF_PROJ) + (size_t)m * INWP;
    const int c0 = lane * 8;
    {
        const bf16_t* OS = (const bf16_t*)(ws + OFF_OS);
        float a[8], b[8], xs[8], z[8];
        unpack8(*(const u32x4*)(OS + (size_t)m * 512 + c0), a);
        unpack8(*(const u32x4*)(OS + ((size_t)NPT + m) * 512 + c0), b);
        unpack8(*(const u32x4*)((const bf16_t*)(ws + OFF_XBCA) + (size_t)m * 768 + c0), xs);
        unpack8(*(const u32x4*)(pr + C_Z + c0), z);
        const float dsk = p.in(21)[l * 8 + (c0 >> 6)];
        float v[8], ss = 0.f;
#pragma unroll
        for (int j = 0; j < 8; ++j) { v[j] = ((a[j] + b[j]) + dsk * xs[j]) * siluf(z[j]); ss += v[j] * v[j]; }
        ss = wsum(ss);
        const float rstd = rsqrtf(ss * (1.f / 512.f) + EPS);
        const float* w = p.in(22) + l * 512 + c0;
#pragma unroll
        for (int j = 0; j < 8; ++j) v[j] = (v[j] * rstd) * w[j];
        *(u32x4*)(pr + C_Z + c0) = pack8(v);
    }
    {
        const bf16_t* ORb = (const bf16_t*)(ws + OFF_OR);
        float a[8], b[8], gt[8];
        unpack8(*(const u32x4*)(ORb + (size_t)m * 512 + c0), a);
        unpack8(*(const u32x4*)(ORb + ((size_t)NPT + m) * 512 + c0), b);
        unpack8(*(const u32x4*)(pr + C_RG + c0), gt);
        float v[8], sm = 0.f;
#pragma unroll
        for (int j = 0; j < 8; ++j) { v[j] = a[j] + b[j]; sm += v[j]; }
        sm += shx(sm, 1); sm += shx(sm, 2); sm += shx(sm, 4); sm += shx(sm, 8);
        const float mean = sm * (1.f / 128.f);
        float sq = 0.f;
#pragma unroll
        for (int j = 0; j < 8; ++j) { v[j] -= mean; sq += v[j] * v[j]; }
        sq += shx(sq, 1); sq += shx(sq, 2); sq += shx(sq, 4); sq += shx(sq, 8);
        const float rstd = rsqrtf(sq * (1.f / 128.f) + EPS);
        const float* w = p.in(24) + l * 512 + c0;
#pragma unroll
        for (int j = 0; j < 8; ++j) v[j] = (v[j] * rstd) * w[j] * siluf(gt[j]);
        *(u32x4*)(pr + C_RG + c0) = pack8(v);
    }
}


#ifndef ONLY2
#define ONLY2 -1
#endif
#ifndef PROBE_KIND
#define PROBE_KIND -1
#endif
DI void item_publish(unsigned* cnt, int tid) {
    asm volatile("s_waitcnt vmcnt(0)" ::: "memory");
    __syncthreads();
    if (tid == 0) __hip_atomic_fetch_add(cnt, 1u, __ATOMIC_RELAXED, __HIP_MEMORY_SCOPE_AGENT);
}
DI void item_wait(unsigned* cnt, unsigned need, int tid) {
    if (tid == 0) {
        unsigned sp = 0;
        while (__hip_atomic_load(cnt, __ATOMIC_RELAXED, __HIP_MEMORY_SCOPE_AGENT) < need) { __builtin_amdgcn_s_sleep(4); if (++sp > (1u << 24)) break; }
        __builtin_amdgcn_fence(__ATOMIC_ACQUIRE, "agent");
        asm volatile("s_waitcnt vmcnt(0)" ::: "memory");
    }
    __syncthreads();
}
DI void phase_mix(const Ctx& p, int l, int ps, unsigned* ctr, unsigned* c12, volatile LAS unsigned* slot, char* smem, int tid) {
    unsigned* gdone = ctr + 64; unsigned* sdone = ctr + 128;
    unsigned* c1 = c12; unsigned* c2 = c12 + 64;
    constexpr int N1 = 64 * (NSEG - 1), N3 = 64 * NSEG;
    constexpr int A0 = N1, A1 = A0 + 384, A2 = A1 + 544, A3 = A2 + 256, A4 = A3 + 64, A5 = A4 + N3, A6 = A5 + 256, A7 = A6 + 256, A8 = A7 + 256, A9 = A8 + 256, A10 = A9 + 256, A11 = A10 + 256;
    for (;;) {
        tid = launder(tid);
        l = launder_s(l); ps = launder_s(ps);
        int it = next_item(ctr, slot, tid);
        const int nwi = ps == 0 ? (l == 0 ? (T_UP + T_DN + T_IN) / 4 : (T_UP + T_DN) / 4) : 0;
        if (it >= A11 + nwi) break;
        int sc = -1, isret = 0, sq = 0, hd = 0, dr = 0, hf = 0, md = 0, sg = 0, sid = 0; unsigned* pub = sdone;
        if (it < A0) { sid = it / (NSEG - 1); sg = it % (NSEG - 1); md = 1; sc = 1; pub = c1 + sid * 128; }
        else if (it >= A4 && it < A5) { const int k = it - A4; sid = k / NSEG; sg = k % NSEG; md = 3; sc = 1; }
        else if (it >= A6 && it < A7) { const int k = it - A6; sq = k >> 4; hd = (k >> 1) & 7; dr = k & 1; sc = 0; }
        else if (it >= A7 && it < A8) { const int k = it - A7; isret = 1; sq = k >> 4; hd = (k >> 2) & 3; dr = (k >> 1) & 1; hf = k & 1; sc = 0; }
        if (sc == 1) {
            if (sid < 32) { isret = 0; sq = 16 + (sid >> 4); hd = (sid >> 1) & 7; dr = sid & 1; hf = 0; }
            else { const int k = sid - 32; isret = 1; sq = 16 + (k >> 4); hd = (k >> 2) & 3; dr = (k >> 1) & 1; hf = k & 1; }
        }
        if (sc >= 0) {
            if (md == 3) item_wait(c2 + sid * 128, 1u, tid);
            scan_any_item(p, l, ps, isret, sq, hd, dr, hf, md, sg, sid, smem, tid);
            item_publish(pub, tid);
        }
        else if (it < A1) { gemm_uq_tile(p, l, ps, it - A0, smem, tid); item_publish(gdone, tid); }
        else if (it < A2) { gemm_ukv_tile(p, l, it - A1, smem, tid); item_publish(gdone, tid); }
        else if (it < A3) { const int k = it - A2; attn_gqa_item(p, l, 16 + (k >> 7), (k >> 4) & 7, k & 15, ps, smem, tid); }
        else if (it < A4) { const int sd = it - A3; item_wait(c1 + sd * 128, (unsigned)(NSEG - 1), tid); scan_combine_item(p, l, ps, sd, tid); item_publish(c2 + sd * 128, tid); }
        else if (it < A6) { const int k = it - A5; item_wait(gdone, 928u, tid); attn_mla_item(p, 16 + (k >> 7), (k >> 4) & 7, k & 15, ps, smem, tid); }
        else if (it < A9) { const int k = it - A8; attn_gqa_item(p, l, k >> 4, (k >> 1) & 7, k & 1, ps, smem, tid); }
        else if (it < A10) { const int k = it - A9; item_wait(gdone, 928u, tid); attn_mla_item(p, k >> 4, (k >> 1) & 7, k & 1, ps, smem, tid); }
        else if (it < A10 + nwi) { const int w0 = l * T_LAYER + T_MIDEND + (it - A10) * 4; wtile_run(p, w0, w0 + 4, 1, smem, tid); }
        else { item_wait(sdone, (unsigned)(N3 + 512), tid); const int k = it - A10 - nwi; const int t5 = launder(tid); for (int i = 0; i < 8; ++i) postscan_token(p, l, k * 32 + i * 4 + (t5 >> 6), t5 & 63); }
    }
}

constexpr int NPHASE = 10;
DI void run_phase(const Ctx& p, int ph, volatile LAS unsigned* xw, char* smem, int tid) {
    if (ph == 0) { phase_prep_w(p, smem, tid); return; }
    const int q = ph - 1;
    unsigned* ctr = (unsigned*)(p.ws() + OFF_CTR) + ph;
    if (q & 1) {
        const int inst = q >> 1, ps = inst >> 1, l = inst & 1;
        phase_mix(p, l, ps, ctr, (unsigned*)(p.ws() + OFF_CTR) + CTR_STREAM + inst * 64 * 128, xw + 2, smem, tid);
    } else {
        const int ci = q >> 1;
        const int bi = ci - 1;
        phase_chain(p, ci, ci == 0, ci >= 1 ? (bi & 1) : -1, ci >= 1 ? (bi >> 1) : 0, ci <= 3 ? (ci & 1) : -1, ci <= 3 ? (ci >> 1) : 0, ctr, xw, smem, tid);
    }
}

__global__ void __launch_bounds__(256, 2) fwd_kernel(Params prm, int ph_lo, int ph_hi, int rep) {
    __shared__ __attribute__((aligned(16))) char smem_all[512 + 65536 + 2048];
    int tid = threadIdx.x;
    volatile LAS unsigned* xw = (volatile LAS unsigned*)(smem_all);
    volatile LAS unsigned* tbl = (volatile LAS unsigned*)(smem_all + 32);
    char* smem = smem_all + 512;
    if (tid == 0) { xw[0] = 0u; xw[1] = 0u; xw[2] = 0u; xw[3] = 0u; }
    if (tid == 0) {
#pragma unroll
        for (int i = 0; i < 44; ++i) {
            const unsigned long long v = (i < 42) ? (unsigned long long)prm.in[i < 42 ? i : 0] : (i == 42 ? (unsigned long long)prm.out : (unsigned long long)prm.ws);
            tbl[2 * i] = (unsigned)v; tbl[2 * i + 1] = (unsigned)(v >> 32);
        }
    }
    __syncthreads();
    Ctx p; p.tbl = tbl;
    XcdBarrier bar = xcd_barrier_post((unsigned*)(p.ws() + OFF_BAR), xw, tid);
    for (int ph = ph_lo; ph < ph_hi; ++ph) {
        tid = launder(tid);
        run_phase(p, launder_s(ph), xw, smem, tid);
        if (ph + 1 < ph_hi) xcd_barrier(bar, tid);
    }
}

extern "C" void kernel_launch(void* const* d_in, const int* in_sizes, int n_in, void* d_out, int out_size, void* d_ws, size_t ws_size, hipStream_t stream) {
    (void)in_sizes; (void)n_in; (void)out_size;
    if (ws_size < WS_NEED) { fprintf(stderr, "workspace too small: %zu < %zu\n", ws_size, (size_t)WS_NEED); return; }
    Params p{};
    for (int i = 0; i < 42; ++i) p.in[i] = (const float*)d_in[i];
    p.out = (float*)d_out; p.ws = (char*)d_ws;
    static int grid_blocks = 0;
    if (!grid_blocks) {
        int dev = 0, cus = 0, per_cu = 0;
        hipGetDevice(&dev);
        hipDeviceGetAttribute(&cus, hipDeviceAttributeMultiprocessorCount, dev);
        hipOccupancyMaxActiveBlocksPerMultiprocessor(&per_cu, fwd_kernel, 256, 0);
        if (per_cu > 2) per_cu = 2;
        if (per_cu < 1) per_cu = 1;
        grid_blocks = cus * per_cu;
    }
    hipMemsetAsync((char*)d_ws + OFF_BAR, 0, BAR_BYTES + CTR_BYTES, stream);
    {
        int lo = 0, hi = NPHASE, rep = 0;
        void* args[] = {&p, &lo, &hi, &rep};
        hipError_t e = hipLaunchCooperativeKernel((void*)fwd_kernel, dim3(grid_blocks), dim3(256), args, 0, stream);
        if (e != hipSuccess) fprintf(stderr, "cooperative launch failed: %s (grid %d)\n", hipGetErrorString(e), grid_blocks);
    }

}
```

```cpp
#include <hip/hip_runtime.h>
#include <cstdio>
#include <cstdint>
#include <cmath>

typedef unsigned short bf16_t;
typedef short bf16x8 __attribute__((ext_vector_type(8)));
typedef float f32x4 __attribute__((ext_vector_type(4)));
typedef unsigned u32x4 __attribute__((ext_vector_type(4)));
typedef unsigned u32x2 __attribute__((ext_vector_type(2)));
#define DI __device__ __forceinline__
#define LAS __attribute__((address_space(3)))

constexpr int DM = 1024, INW = 4272, INWP = 4352, DFF = 2816;
constexpr int NPT = 8192;
constexpr int KROWS = 8704;
constexpr float EPS = 1e-6f;
constexpr int C_Z = 0, C_XBC = 512, C_DT = 1280, C_RQ = 1296, C_RK = 1552, C_RV = 1808, C_RG = 2320, C_AQ = 2832, C_AK = 3344, C_AV = 3472,
              C_MCQ = 3600, C_MCKV = 3984;
constexpr size_t O_YS = 8388608, O_SSD = 16777216, O_RET = 20971520, O_CK = 25165824, O_CV = 27262976, O_CC = 29360128, O_CR = 33554432;

constexpr size_t al256(size_t x) { return (x + 255) & ~(size_t)255; }
constexpr size_t SZ_WIN = (size_t)INWP * 1024, SZ_WM = (size_t)4096 * 1024, SZ_WUQ = (size_t)768 * 384, SZ_WUKV = (size_t)1024 * 256,
                 SZ_WBR = (size_t)4 * 1024 * 512, SZ_WOUT = (size_t)1024 * 1024, SZ_WUP = (size_t)5632 * 1024, SZ_WDN = (size_t)1024 * 2816;
constexpr size_t OFF_WIN = 0;
constexpr size_t OFF_WM = OFF_WIN + 4 * SZ_WIN;
constexpr size_t OFF_WUQ = OFF_WM + 4 * SZ_WM;
constexpr size_t OFF_WUKV = OFF_WUQ + 4 * SZ_WUQ;
constexpr size_t OFF_WBR = OFF_WUKV + 4 * SZ_WUKV;
constexpr size_t OFF_WOUT = OFF_WBR + 4 * SZ_WBR;
constexpr size_t OFF_WUP = OFF_WOUT + 4 * SZ_WOUT;
constexpr size_t OFF_WDN = OFF_WUP + 4 * SZ_WUP;
constexpr size_t OFF_MOD = al256(OFF_WDN + 4 * SZ_WDN);
constexpr size_t OFF_T16 = al256(OFF_MOD + (size_t)2 * 5 * 6144 * 4);
constexpr size_t OFF_T8 = OFF_T16 + 2 * 64 * 16 * 4;
constexpr size_t OFF_BAR = al256(OFF_T8 + 2 * 64 * 8 * 4);
constexpr int CTR_TEAM = 256 + 4 * 128;
constexpr int CTR_STREAM = CTR_TEAM + 5 * 64 * 4 * 64;
constexpr size_t BAR_BYTES = 3456 * 4, CTR_BYTES = (256 + 4 * 128) * 4 + (size_t)5 * 64 * 4 * 256 + (size_t)4 * 64 * 2 * 256;
constexpr size_t OFF_CTR = OFF_BAR + BAR_BYTES;
constexpr size_t OFF_DTRAW = al256(OFF_CTR + CTR_BYTES);
constexpr size_t OFF_DT = OFF_DTRAW + (size_t)NPT * 16 * 4;
constexpr size_t OFF_H = al256(OFF_DT + (size_t)NPT * 16 * 4);
constexpr size_t OFF_PROJ = OFF_H + (size_t)NPT * 1024 * 2;
constexpr size_t OFF_XBCA = OFF_PROJ + (size_t)NPT * INWP * 2;
constexpr size_t OFF_KA = OFF_XBCA + (size_t)NPT * 768 * 2;
constexpr size_t OFF_VAT = OFF_KA + (size_t)KROWS * 128 * 2;
constexpr size_t OFF_CKV = OFF_VAT + (size_t)KROWS * 128 * 2;
constexpr size_t OFF_KRP = OFF_CKV + (size_t)KROWS * 256 * 2;
constexpr size_t OFF_QM = OFF_KRP + (size_t)KROWS * 32 * 2;
constexpr size_t OFF_KN = OFF_QM + (size_t)NPT * 768 * 2;
constexpr size_t OFF_VMT = OFF_KN + (size_t)KROWS * 512 * 2;
constexpr size_t OFF_OS = OFF_VMT + (size_t)KROWS * 512 * 2;
constexpr size_t OFF_OR = OFF_OS + (size_t)2 * NPT * 512 * 2;
constexpr size_t OFF_OM = OFF_OR + (size_t)2 * NPT * 512 * 2;
constexpr size_t OFF_OA = OFF_OM + (size_t)NPT * 512 * 2;
constexpr int NSEG = 4, SEGTOK = 2048 / NSEG;
constexpr size_t OFF_SEG = OFF_OA + (size_t)NPT * 512 * 2;
constexpr size_t OFF_SEGD = OFF_SEG + (size_t)64 * NSEG * 4096 * 2;
constexpr size_t WS_END1 = OFF_SEGD + 64 * NSEG * 4;
constexpr size_t OFF_MERGED = OFF_QM;
static_assert(OFF_MERGED + (size_t)NPT * 1024 * 2 <= OFF_VMT, "MERGED beyond KN");
constexpr size_t OFF_FO = OFF_OS;
static_assert(OFF_FO + (size_t)NPT * 1024 * 4 <= OFF_OM, "FO beyond OR");
constexpr size_t OFF_EDGE = al256(WS_END1);
constexpr size_t OFF_XEDGE = OFF_EDGE + (size_t)64 * 4 * 5632 * 4;
constexpr size_t WS_NEED = OFF_XEDGE + (size_t)64 * 2 * 768 * 2;
static_assert(WS_NEED <= (size_t)293824896, "workspace");

struct Params {
    const float* in[42];
    float* out;
    char* ws;
};
struct Ctx {
    volatile LAS unsigned* tbl;
    __device__ __forceinline__ unsigned long long ld(int i) const {
        const unsigned lo = tbl[2 * i], hi = tbl[2 * i + 1];
        return ((unsigned long long)(unsigned)__builtin_amdgcn_readfirstlane((int)hi) << 32) | (unsigned)__builtin_amdgcn_readfirstlane((int)lo);
    }
    __device__ __forceinline__ const float* in(int i) const { return (const float*)ld(i); }
    __device__ __forceinline__ float* out() const { return (float*)ld(42); }
    __device__ __forceinline__ char* ws() const { return (char*)ld(43); }
};

DI float bf2f(unsigned short h) { return __uint_as_float((unsigned)h << 16); }
DI unsigned short f2bf(float f) { return __builtin_bit_cast(unsigned short, (__bf16)f); }
typedef __bf16 bf16x2_t __attribute__((ext_vector_type(2)));
typedef float f32x2 __attribute__((ext_vector_type(2)));
DI unsigned pk2(float lo, float hi) { bf16x2_t v; v[0] = (__bf16)lo; v[1] = (__bf16)hi; return __builtin_bit_cast(unsigned, v); }
DI void unpack8(const u32x4& w, float* v) {
#pragma unroll
    for (int i = 0; i < 4; ++i) { v[2 * i] = __uint_as_float(w[i] << 16); v[2 * i + 1] = __uint_as_float(w[i] & 0xffff0000u); }
}
DI u32x4 pack8(const float* v) { u32x4 w; w[0] = pk2(v[0], v[1]); w[1] = pk2(v[2], v[3]); w[2] = pk2(v[4], v[5]); w[3] = pk2(v[6], v[7]); return w; }
DI float log1pe(float e) { return e < 1e-4f ? e - 0.5f * e * e : __builtin_amdgcn_logf(1.f + e) * 0.6931471805599453f; }
DI float siluf(float x) { return x / (1.f + __expf(-x)); }
DI float sigmoidf(float x) { return 1.f / (1.f + __expf(-x)); }
DI int lanel() { int l = (int)__lane_id(); asm volatile("" : "+v"(l)); return l; }
DI float shx(float v, int m) { const int l = lanel(); return __int_as_float(__builtin_amdgcn_ds_bpermute((l ^ m) << 2, __float_as_int(v))); }
DI float shf(float v, int src) { return __int_as_float(__builtin_amdgcn_ds_bpermute(src << 2, __float_as_int(v))); }
DI float shu(float v, int d) { const int l = lanel(); const int sidx = (l - d) < 0 ? l : (l - d); return __int_as_float(__builtin_amdgcn_ds_bpermute(sidx << 2, __float_as_int(v))); }
DI float gmax4(float v) {
    auto a = __builtin_amdgcn_permlane16_swap(__float_as_uint(v), __float_as_uint(v), false, false);
    v = fmaxf(__uint_as_float(a[0]), __uint_as_float(a[1]));
    auto b = __builtin_amdgcn_permlane32_swap(__float_as_uint(v), __float_as_uint(v), false, false);
    return fmaxf(__uint_as_float(b[0]), __uint_as_float(b[1]));
}
DI float gsum4(float v) {
    auto a = __builtin_amdgcn_permlane16_swap(__float_as_uint(v), __float_as_uint(v), false, false);
    v = __uint_as_float(a[0]) + __uint_as_float(a[1]);
    auto b = __builtin_amdgcn_permlane32_swap(__float_as_uint(v), __float_as_uint(v), false, false);
    return __uint_as_float(b[0]) + __uint_as_float(b[1]);
}
DI float wsum(float v) {
#pragma unroll
    for (int o = 32; o >= 1; o >>= 1) v += shx(v, o);
    return v;
}
typedef const __attribute__((address_space(1))) u32x4* gp128;
DI u32x4 gld16(const void* p) { return *(gp128)(unsigned long long)p; }
DI void st_wt8(void* p, u32x2 v) { __hip_atomic_store((unsigned long long*)p, ((unsigned long long)v[1] << 32) | v[0], __ATOMIC_RELAXED, __HIP_MEMORY_SCOPE_AGENT); }
DI void st_wt16(void* p, u32x4 v) { st_wt8(p, (u32x2){v[0], v[1]}); st_wt8((char*)p + 8, (u32x2){v[2], v[3]}); }
DI void st_wt2(bf16_t* p, bf16_t v) { __hip_atomic_store(p, v, __ATOMIC_RELAXED, __HIP_MEMORY_SCOPE_AGENT); }
DI void st_wtf4(float* p, f32x4 v) { st_wt16(p, __builtin_bit_cast(u32x4, v)); }
DI void st_wt4f(float* p, float v) { __hip_atomic_store(p, v, __ATOMIC_RELAXED, __HIP_MEMORY_SCOPE_AGENT); }
DI int launder(int x) { asm volatile("" : "+v"(x)); return x; }
DI int launder_s(int x) { asm volatile("" : "+s"(x)); return x; }
#define BIDX launder_s((int)blockIdx.x)
DI int FQ(int q) { return (4 - q) & 3; }
DI int tile_off(int rows, int ks, int row, int g, int q) { return (ks * rows + row) * 64 + ((g ^ FQ(q)) << 4); }

#define XB_TMO      128
#define XB_MIS      192
#define XB_XCNT(j)  (256  + 64 * (j))
#define XB_XSUB(j)  (1280 + 64 * (j))
#define XB_XGEN(j)  (2304 + 64 * (j))
#define XB_TOP      3328
#define XB_TOPGEN   3392
#define XB_SPIN_CAP (1u << 22)
DI unsigned xb_ld(unsigned* p) { return __hip_atomic_load(p, __ATOMIC_RELAXED, __HIP_MEMORY_SCOPE_AGENT); }
DI unsigned xb_add(unsigned* p, unsigned v) { return __hip_atomic_fetch_add(p, v, __ATOMIC_RELAXED, __HIP_MEMORY_SCOPE_AGENT); }
DI unsigned xb_xcc_id() { return (unsigned)__builtin_amdgcn_s_getreg((3 << 11) | 20) & 0xFu; }
#define XB_SPIN(cond, bar) do { unsigned _sp = 0; while (cond) { __builtin_amdgcn_s_sleep(1); \
    if ((++_sp & 255u) == 0u) { if (xb_ld(&(bar)[XB_TMO])) break; if (_sp > XB_SPIN_CAP) { atomicAdd(&(bar)[XB_TMO], 1u); break; } } } } while (0)
struct XcdBarrier { unsigned* bar; unsigned x; volatile LAS unsigned* st; };
DI XcdBarrier xcd_barrier_post(unsigned* bar, volatile LAS unsigned* st, int tid) {
    XcdBarrier b; b.bar = bar; b.x = xb_xcc_id(); b.st = st;
    if (tid == 0) st[7] = xb_add(&bar[XB_XCNT(b.x)], 1u);
    return b;
}
DI void xcd_barrier_complete(unsigned* bar, unsigned x, unsigned& nloc, unsigned& nx, unsigned& rank) {
    const unsigned G = gridDim.x * gridDim.y * gridDim.z;
    unsigned sum, cnt, mine, sp = 0u;
    for (;;) {
        sum = 0u; cnt = 0u; mine = 0u; rank = 0u;
#pragma unroll
        for (unsigned j = 0; j < 16; ++j) { const unsigned c = xb_ld(&bar[XB_XCNT(j)]); sum += c; cnt += (c > 0u) ? 1u : 0u; mine = (j == x) ? c : mine; rank += (j < x && c > 0u) ? 1u : 0u; }
        if (sum == G) break;
        __builtin_amdgcn_s_sleep(1);
        if ((++sp & 255u) == 0u) { if (xb_ld(&bar[XB_TMO])) break; if (sp > XB_SPIN_CAP) { atomicAdd(&bar[XB_TMO], 1u); break; } }
    }
    nloc = mine > 0u ? mine : 1u; nx = cnt > 0u ? cnt : 1u;
}
DI void xcd_barrier(const XcdBarrier& b, int tid) {
    asm volatile("s_waitcnt vmcnt(0)" ::: "memory");
    __syncthreads();
    if (tid == 0) {
        unsigned* bar = b.bar;
        __builtin_amdgcn_s_waitcnt(0);
        unsigned nloc = b.st[0], nx = b.st[1];
        bool first = false;
        if (nloc == 0u) {
            unsigned rank; xcd_barrier_complete(bar, b.x, nloc, nx, rank); b.st[0] = nloc; b.st[1] = nx; b.st[6] = rank; first = true;
            if (rank != (blockIdx.x & 7u) || nx != 8u || nloc * 8u != gridDim.x) { (void)xb_add(&bar[XB_MIS], 1u); asm volatile("s_waitcnt vmcnt(0)" ::: "memory"); }
        }
        const unsigned old = xb_add(&bar[XB_XSUB(b.x)], 1u);
        const unsigned gen = old / nloc;
        if (old + 1u == (gen + 1u) * nloc) {
            __builtin_amdgcn_fence(__ATOMIC_RELEASE, "agent");
            asm volatile("s_waitcnt vmcnt(0)" ::: "memory");
            const unsigned og = xb_add(&bar[XB_TOP], 1u);
            const unsigned tg = og / nx;
            if (og + 1u == (tg + 1u) * nx) xb_add(&bar[XB_TOPGEN], 1u);
            else XB_SPIN(xb_ld(&bar[XB_TOPGEN]) == tg, bar);
            __builtin_amdgcn_fence(__ATOMIC_ACQUIRE, "agent");
            xb_add(&bar[XB_XGEN(b.x)], 1u);
            asm volatile("s_waitcnt vmcnt(0)" ::: "memory");
        } else {
            XB_SPIN(xb_ld(&bar[XB_XGEN(b.x)]) == gen, bar);
            __builtin_amdgcn_fence(__ATOMIC_ACQUIRE, "agent");
            asm volatile("s_waitcnt vmcnt(0)" ::: "memory");
        }
        if (first) b.st[5] = xb_ld(&bar[XB_MIS]);
    }
    __syncthreads();
}

DI int next_item(unsigned* ctr, volatile LAS unsigned* slot, int tid) {
    __syncthreads();
    if (tid == 0) *slot = __hip_atomic_fetch_add(ctr, 1u, __ATOMIC_RELAXED, __HIP_MEMORY_SCOPE_AGENT);
    __syncthreads();
    return (int)*slot;
}

struct Tok { int lat, b, t, L, cond, krow, seq0; size_t gx; };
DI Tok tok_info(int m, int ps) {
    Tok k;
    if (m < 4096) { k.lat = 0; k.b = ps * 16 + (m >> 8); k.t = m & 255; k.L = 256; k.cond = 0; k.krow = m; k.seq0 = m & ~255; k.gx = (size_t)ps * 4096 + m; }
    else { const int mm = m - 4096, j = mm >> 11; k.lat = 1; k.b = ps * 2 + j; k.t = mm & 2047; k.L = 2048; k.cond = 1 + k.b; k.krow = 4096 + j * 2304 + 256 + k.t;
           k.seq0 = 4096 + j * 2048; k.gx = (size_t)8192 + (size_t)ps * 4096 + mm; }
    return k;
}

template <int NTA, int NTB, bool LOWREG = false, int WMAP = 0>
DI void gemm_kloop(f32x4 (&acc)[NTA][NTB], const bf16_t* __restrict__ W, size_t ldw, const bf16_t* __restrict__ X, size_t ldx, int K, char* smem, int tid) {
    constexpr int BF = 32 * NTA, BT = 32 * NTB;
    constexpr int WB = BF * 128, STG = (BF + BT) * 128;
    constexpr int NPW = BF / 8, NPX = BT / 8, NPIECE = NPW + NPX, PPW = NPIECE / 4;
    static_assert(NPIECE % 4 == 0, "pieces must divide over 4 waves");
    tid = launder(tid);
    const int lane = tid & 63, wv = tid >> 6, wn = wv >> 1, wt = wv & 1, fr = lane & 15, g = lane >> 4;
    constexpr int PWW = NPW / 4, PXX = PPW - PWW;
    const int wvu = __builtin_amdgcn_readfirstlane(wv);
    auto lane_off = [&](int j, int ln) -> unsigned {
        const bool isw = j < PWW;
        const int pp = isw ? wvu * PWW + j : wvu * PXX + (j - PWW);
        const int rows = isw ? BF : BT;
        const int rb = pp % (rows / 16);
        const int rl = ln >> 2;
        const int q = isw ? (((rb * 16 + rl) / (4 * NTA)) & 3) : ((rl >> 2) & 3);
        const int gl = (ln & 3) ^ FQ(q);
        if (WMAP && isw) return (unsigned)((rl & 7) + (rl >> 3) * DFF) * (unsigned)ldw + (unsigned)(gl * 8);
        return (unsigned)rl * (unsigned)(isw ? ldw : ldx) + (unsigned)(gl * 8);
    };
    unsigned poff[PPW];
    if (!LOWREG) {
#pragma unroll
        for (int j = 0; j < PPW; ++j) poff[j] = lane_off(j, lane);
    }
    auto issue = [&](int k0, char* sdst) {
        const int ln = LOWREG ? launder(lane) : lane;
#pragma unroll
        for (int j = 0; j < PPW; ++j) {
            const bool isw = j < PWW;
            const int pp = isw ? wvu * PWW + j : wvu * PXX + (j - PWW);
            const int rows = isw ? BF : BT;
            const int ks = pp / (rows / 16), rb = pp % (rows / 16);
            const int wrow = WMAP ? 32 * (rb >> 2) + 8 * (rb & 3) : rb * 16;
            const bf16_t* base = (isw ? W + (size_t)wrow * ldw : X + (size_t)(rb * 16) * ldx) + k0 + ks * 32;
            const unsigned off = LOWREG ? lane_off(j, ln) : poff[j];
            __builtin_amdgcn_global_load_lds((const unsigned*)(base + off), (unsigned*)(sdst + (isw ? 0 : WB) + (ks * rows + rb * 16) * 64), 16, 0, 0);
        }
    };
    const int aoff = tile_off(BF, 0, wn * 16 * NTA + 4 * NTA * (fr >> 2) + (fr & 3), g, fr >> 2);
    const int boff = WB + tile_off(BT, 0, wt * 16 * NTB + fr, g, (fr >> 2) & 3);
    const int nk = K >> 6;
    issue(0, smem);
    asm volatile("s_waitcnt vmcnt(0)" ::: "memory");
    __syncthreads();
    for (int kt = 0; kt < nk; ++kt) {
        if (kt + 1 < nk) issue((kt + 1) << 6, smem + ((kt + 1) & 1) * STG);
        const char* sb = smem + (kt & 1) * STG;
        __builtin_amdgcn_s_setprio(1);
#pragma unroll
        for (int kk = 0; kk < 2; ++kk) {
            if (LOWREG) {
                bf16x8 bfr[NTB];
#pragma unroll
                for (int mt = 0; mt < NTB; ++mt) bfr[mt] = *(const bf16x8*)(sb + boff + mt * 1024 + kk * BT * 64);
#pragma unroll
                for (int a = 0; a < NTA; ++a) {
                    const bf16x8 af1 = *(const bf16x8*)(sb + aoff + a * 256 + kk * BF * 64);
#pragma unroll
                    for (int mt = 0; mt < NTB; ++mt) acc[a][mt] = __builtin_amdgcn_mfma_f32_16x16x32_bf16(af1, bfr[mt], acc[a][mt], 0, 0, 0);
                    __builtin_amdgcn_sched_barrier(0);
                }
            } else {
                bf16x8 af[NTA], bfr[NTB];
#pragma unroll
                for (int a = 0; a < NTA; ++a) af[a] = *(const bf16x8*)(sb + aoff + a * 256 + kk * BF * 64);
#pragma unroll
                for (int mt = 0; mt < NTB; ++mt) bfr[mt] = *(const bf16x8*)(sb + boff + mt * 1024 + kk * BT * 64);
#pragma unroll
                for (int a = 0; a < NTA; ++a)
#pragma unroll
                    for (int mt = 0; mt < NTB; ++mt) acc[a][mt] = __builtin_amdgcn_mfma_f32_16x16x32_bf16(af[a], bfr[mt], acc[a][mt], 0, 0, 0);
            }
        }
        __builtin_amdgcn_s_setprio(0);
        asm volatile("s_waitcnt vmcnt(0)" ::: "memory");
        __syncthreads();
    }
}

struct WTile { const float* src; bf16_t* dst; int K, N, k0, n0; };
constexpr int T_IN = 16 * 68, T_M = 16 * 64, T_UQ = 6 * 12, T_UKV = 4 * 16, T_BR = 8 * 16, T_OUT = 16 * 16, T_UP = 16 * 88, T_DN = 44 * 16;
constexpr int T_LAYER = T_IN + T_M + T_UQ + T_UKV + 4 * T_BR + T_OUT + T_UP + T_DN;
constexpr int T_MIDEND = T_IN + T_M + T_UQ + T_UKV + 4 * T_BR + T_OUT, T_UPEND = T_MIDEND + T_UP;
DI WTile wtile_decode(const Ctx& p, int it) {
    char* ws = p.ws();
    const int l = it / T_LAYER; int k = it % T_LAYER;
    WTile t; int ntn;
    if (k < T_IN) { t.src = p.in(16) + (size_t)l * 1024 * INW; t.dst = (bf16_t*)(ws + OFF_WIN) + (size_t)l * SZ_WIN; t.K = 1024; t.N = INW; ntn = 68; }
    else if ((k -= T_IN) < T_M) { t.src = p.in(35) + (size_t)l * 1024 * 4096; t.dst = (bf16_t*)(ws + OFF_WM) + (size_t)l * SZ_WM; t.K = 1024; t.N = 4096; ntn = 64; }
    else if ((k -= T_M) < T_UQ) { t.src = p.in(28) + (size_t)l * 384 * 768; t.dst = (bf16_t*)(ws + OFF_WUQ) + (size_t)l * SZ_WUQ; t.K = 384; t.N = 768; ntn = 12; }
    else if ((k -= T_UQ) < T_UKV) { t.src = p.in(30) + (size_t)l * 256 * 1024; t.dst = (bf16_t*)(ws + OFF_WUKV) + (size_t)l * SZ_WUKV; t.K = 256; t.N = 1024; ntn = 16; }
    else if ((k -= T_UKV) < 4 * T_BR) { const int j = k / T_BR; k -= j * T_BR; t.src = (j == 0 ? p.in(31) : j == 1 ? p.in(32) : j == 2 ? p.in(33) : p.in(34)) + (size_t)l * 512 * 1024;
                                        t.dst = (bf16_t*)(ws + OFF_WBR) + (size_t)(l * 4 + j) * 1024 * 512; t.K = 512; t.N = 1024; ntn = 16; }
    else if ((k -= 4 * T_BR) < T_OUT) { t.src = p.in(37) + (size_t)l * 1024 * 1024; t.dst = (bf16_t*)(ws + OFF_WOUT) + (size_t)l * SZ_WOUT; t.K = 1024; t.N = 1024; ntn = 16; }
    else if ((k -= T_OUT) < T_UP) { t.src = p.in(38) + (size_t)l * 1024 * 5632; t.dst = (bf16_t*)(ws + OFF_WUP) + (size_t)l * SZ_WUP; t.K = 1024; t.N = 5632; ntn = 88; }
    else { k -= T_UP; t.src = p.in(41) + (size_t)l * 2816 * 1024; t.dst = (bf16_t*)(ws + OFF_WDN) + (size_t)l * SZ_WDN; t.K = 2816; t.N = 1024; ntn = 16; }
    t.k0 = (k / ntn) * 64; t.n0 = (k % ntn) * 64;
    return t;
}
DI void wtile_load(const WTile& t, int tid, f32x4 (&v)[4]) {
    const int r = tid >> 4, c4 = tid & 15;
#pragma unroll
    for (int i = 0; i < 4; ++i) {
        v[i] = (f32x4){0.f, 0.f, 0.f, 0.f};
        if (t.n0 + 4 * c4 < t.N) v[i] = *(const f32x4*)(t.src + (size_t)(t.k0 + r + 16 * i) * t.N + t.n0 + 4 * c4);
    }
}
DI void wtile_finish(const WTile& t, const f32x4 (&v)[4], char* smem, int tid) {
    float* tl = (float*)smem;
    const int r = tid >> 4, c4 = tid & 15;
#pragma unroll
    for (int i = 0; i < 4; ++i) {
        const int row = r + 16 * i;
        tl[row * 65 + 4 * c4 + 0] = v[i][0]; tl[row * 65 + 4 * c4 + 1] = v[i][1]; tl[row * 65 + 4 * c4 + 2] = v[i][2]; tl[row * 65 + 4 * c4 + 3] = v[i][3];
    }
    __syncthreads();
#pragma unroll
    for (int i = 0; i < 2; ++i) {
        const int q = tid + 256 * i, n = q >> 3, c = q & 7;
        float o[8];
#pragma unroll
        for (int j = 0; j < 8; ++j) o[j] = tl[(8 * c + j) * 65 + n];
        *(u32x4*)(t.dst + (size_t)(t.n0 + n) * t.K + t.k0 + 8 * c) = pack8(o);
    }
    __syncthreads();
}
DI void wtile_run(const Ctx& p, int lo, int hi, int step, char* smem, int tid) {
    int it = lo;
    f32x4 va[4];
    if (it < hi) { const WTile c0 = wtile_decode(p, it); wtile_load(c0, tid, va); }
    while (it < hi) {
        const int nx = it + step;
        f32x4 vb[4];
        if (nx < hi) { const WTile nt = wtile_decode(p, nx); wtile_load(nt, tid, vb); }
        { const WTile cur = wtile_decode(p, launder(it)); wtile_finish(cur, va, smem, tid); }
#pragma unroll
        for (int i = 0; i < 4; ++i) va[i] = vb[i];
        it = nx;
    }
}
DI void wtile_tail(const Ctx& p, int tiles_per_xcd, int lo, int hi, char* smem, int tid) {
    const int x = BIDX & 7, loc = BIDX >> 3, nloc = gridDim.x >> 3;
    const int rem = tiles_per_xcd % nloc;
    const int j = rem ? loc - rem : loc, nidle = rem ? nloc - rem : nloc;
    if (j >= 0) wtile_run(p, lo + j * 8 + x, hi, nidle * 8, smem, tid);
}

DI void phase_prep_w(const Ctx& p, char* smem, int tid) {
    char* ws = p.ws();
    constexpr int N_MODI = 2 * 192;
    for (int it = BIDX; it < N_MODI + 1; it += gridDim.x) {
        if (it < N_MODI) {
            const int l = it / 192, cb = it % 192;
            float* sc = (float*)smem;
            float* red = sc + 5 * 1024;
            __syncthreads();
            for (int e = tid; e < 5 * 1024; e += 256) {
                const int c = e >> 10, kk = e & 1023;
                const float v = (c == 0) ? p.in(9)[kk] : p.in(8)[(c - 1) * 1024 + kk];
                sc[e] = siluf(v);
            }
            __syncthreads();
            const int col = tid & 31, kg = tid >> 5;
            float a[5] = {0.f, 0.f, 0.f, 0.f, 0.f};
            const float* w = p.in(10) + ((size_t)l * 1024 + kg * 128) * 6144 + cb * 32 + col;
#pragma unroll 1
            for (int k0 = 0; k0 < 128; k0 += 16) {
                float wv[16];
#pragma unroll
                for (int j = 0; j < 16; ++j) wv[j] = w[(size_t)(k0 + j) * 6144];
#pragma unroll
                for (int j = 0; j < 16; ++j)
#pragma unroll
                    for (int c = 0; c < 5; ++c) a[c] += wv[j] * sc[c * 1024 + kg * 128 + k0 + j];
            }
#pragma unroll
            for (int c = 0; c < 5; ++c) red[(kg * 5 + c) * 32 + col] = a[c];
            __syncthreads();
            if (tid < 160) {
                const int c = tid >> 5, cl = tid & 31;
                float sm = 0.f;
#pragma unroll
                for (int k8 = 0; k8 < 8; ++k8) sm += red[(k8 * 5 + c) * 32 + cl];
                float* mod = (float*)(ws + OFF_MOD);
                mod[((size_t)l * 5 + c) * 6144 + cb * 32 + cl] = sm + p.in(11)[(size_t)l * 6144 + cb * 32 + cl];
            }
            __syncthreads();
        } else {
            float* t16 = (float*)(ws + OFF_T16); float* t8 = (float*)(ws + OFF_T8);
            for (int e = tid; e < 64 * 16 + 64 * 8; e += 256) {
                const bool small = e >= 1024;
                const int ee = small ? e - 1024 : e;
                const int pos = small ? (ee >> 3) : (ee >> 4), i = small ? (ee & 7) : (ee & 15);
                const double r = small ? 0.31622776601683794 : 0.5623413251903491;
                double th = 1.0;
                for (int j = 0; j < i; ++j) th *= r;
                const double t2 = th * th;
                double c1 = 1.0, s1 = th;
                double tc = 1.0, tsn = th;
                for (int k = 1; k < 14; ++k) {
                    tc = -tc * t2 / (double)((2 * k - 1) * (2 * k));
                    tsn = -tsn * t2 / (double)((2 * k) * (2 * k + 1));
                    c1 += tc; s1 += tsn;
                }
                double c = 1.0, sn = 0.0;
                for (int j = 0; j < pos; ++j) { const double cn = c * c1 - sn * s1, snn = sn * c1 + c * s1; c = cn; sn = snn; }
                if (small) { t8[ee] = (float)c; t8[512 + ee] = (float)sn; } else { t16[ee] = (float)c; t16[1024 + ee] = (float)sn; }
            }
        }
    }
    __syncthreads();
    wtile_run(p, BIDX, T_IN, gridDim.x, smem, tid);
}

DI void row_load(const float* r, int lane, f32x4 (&v)[4]) {
#pragma unroll
    for (int i = 0; i < 4; ++i) v[i] = *(const f32x4*)(r + 4 * lane + 256 * i);
}
DI float row_ss(const f32x4 (&v)[4]) {
    float s = 0.f;
#pragma unroll
    for (int i = 0; i < 4; ++i) s += v[i][0] * v[i][0] + v[i][1] * v[i][1] + v[i][2] * v[i][2] + v[i][3] * v[i][3];
    return wsum(s);
}
DI void row_modnorm_store(const f32x4 (&x)[4], const float* gw, const float* sh, const float* sc, bf16_t* dst, int lane) {
    const float rstd = rsqrtf(row_ss(x) * (1.f / 1024.f) + EPS);
#pragma unroll
    for (int i = 0; i < 4; ++i) {
        const int c = 4 * lane + 256 * i;
        const f32x4 g = *(const f32x4*)(gw + c), s = *(const f32x4*)(sh + c), q = *(const f32x4*)(sc + c);
        float o[4];
#pragma unroll
        for (int j = 0; j < 4; ++j) o[j] = (x[i][j] * rstd) * g[j] * (1.f + q[j]) + s[j];
        u32x2 w; w[0] = pk2(o[0], o[1]); w[1] = pk2(o[2], o[3]);
        *(u32x2*)(dst + c) = w;
    }
}
DI const float* x_in_row(const Ctx& p, int m, int ps) {
    return (m < 4096) ? p.in(0) + ((size_t)ps * 4096 + m) * 1024 : p.in(1) + ((size_t)ps * 4096 + (m - 4096)) * 1024;
}
DI void phase_h1(const Ctx& p, int ps, int tid) {
    const int lane = tid & 63, wv = tid >> 6;
    const float* mod = (const float*)(p.ws() + OFF_MOD);
    bf16_t* H = (bf16_t*)(p.ws() + OFF_H);
    for (int m = BIDX * 4 + wv; m < NPT; m += gridDim.x * 4) {
        const Tok k = tok_info(m, ps);
        f32x4 x[4]; row_load(x_in_row(p, m, ps), lane, x);
        const float* md = mod + (size_t)(0 * 5 + k.cond) * 6144;
        row_modnorm_store(x, p.in(12), md + 0, md + 1024, H + (size_t)m * 1024, lane);
    }
}
DI void wsum2(float& a, float& b) {
#pragma unroll
    for (int o = 32; o >= 1; o >>= 1) { const float ta = shx(a, o), tb = shx(b, o); a += ta; b += tb; }
}
DI void res_rows(const Ctx& p, int ps, int l, int which, const float* Yp, int panel, int j, int size, int tid) {
    const int lane = tid & 63, wv = tid >> 6;
    const float* mod = (const float*)(p.ws() + OFF_MOD);
    bf16_t* H = (bf16_t*)(p.ws() + OFF_H);
    const float* gpost = (which ? p.in(15) : p.in(13)) + (size_t)l * 1024;
    const int step = size * 4;
    const bool nextnorm = which == 0 || l + 1 < 2;
    f32x4 pg[4], pw[4], pgw[4], psh[4], psc[4];
    {
        const int cond0 = tok_info(panel * 128, ps).cond;
        const float* gate = mod + (size_t)(l * 5 + cond0) * 6144 + (which ? 5 * 1024 : 2 * 1024);
        const int ln = which == 0 ? l : (l + 1 < 2 ? l + 1 : l);
        const float* md = mod + (size_t)(ln * 5 + cond0) * 6144 + (which == 0 ? 3 * 1024 : 0);
        const float* gw = (which == 0 ? p.in(14) : p.in(12)) + (size_t)ln * 1024;
#pragma unroll
        for (int q = 0; q < 4; ++q) {
            const int c = 4 * lane + 256 * q;
            pg[q] = *(const f32x4*)(gate + c); pw[q] = *(const f32x4*)(gpost + c);
            pgw[q] = *(const f32x4*)(gw + c); psh[q] = *(const f32x4*)(md + c); psc[q] = *(const f32x4*)(md + 1024 + c);
        }
    }
    for (int i0 = j * 4 + wv; i0 < 128; i0 += 2 * step) {
        const bool vb = i0 + step < 128;
        int mm[2]; mm[0] = panel * 128 + i0; mm[1] = vb ? mm[0] + step : mm[0];
        f32x4 x[2][4], y[2][4];
        size_t gx[2]; int cond[2];
#pragma unroll
        for (int u = 0; u < 2; ++u) {
            const Tok k = tok_info(mm[u], ps);
            gx[u] = k.gx; cond[u] = k.cond;
            if (l == 0 && which == 0) row_load(x_in_row(p, mm[u], ps), lane, x[u]); else row_load(p.out() + k.gx * 1024, lane, x[u]);
            row_load(Yp + (size_t)(mm[u] - panel * 128) * 1024, lane, y[u]);
        }
        float ss[2];
#pragma unroll
        for (int u = 0; u < 2; ++u) {
            float t = 0.f;
#pragma unroll
            for (int q = 0; q < 4; ++q) t += y[u][q][0] * y[u][q][0] + y[u][q][1] * y[u][q][1] + y[u][q][2] * y[u][q][2] + y[u][q][3] * y[u][q][3];
            ss[u] = t;
        }
        wsum2(ss[0], ss[1]);
        float s2[2];
#pragma unroll
        for (int u = 0; u < 2; ++u) {
            const float rstd = rsqrtf(ss[u] * (1.f / 1024.f) + EPS);
            float t = 0.f;
#pragma unroll
            for (int q = 0; q < 4; ++q) {
                const int c = 4 * lane + 256 * q;
                const f32x4 g = pg[q], w = pw[q];
#pragma unroll
                for (int e = 0; e < 4; ++e) { x[u][q][e] = x[u][q][e] + g[e] * ((y[u][q][e] * rstd) * w[e]); t += x[u][q][e] * x[u][q][e]; }
                if (u == 0 || vb) *(f32x4*)(p.out() + gx[u] * 1024 + c) = x[u][q];
            }
            s2[u] = t;
        }
        if (nextnorm) {
            wsum2(s2[0], s2[1]);
#pragma unroll
            for (int u = 0; u < 2; ++u) {
                if (u == 1 && !vb) continue;
                const float rstd = rsqrtf(s2[u] * (1.f / 1024.f) + EPS);
                bf16_t* dst = H + (size_t)mm[u] * 1024;
#pragma unroll
                for (int q = 0; q < 4; ++q) {
                    const int c = 4 * lane + 256 * q;
                    const f32x4 g = pgw[q], sh = psh[q], sc = psc[q];
                    float o[4];
#pragma unroll
                    for (int e = 0; e < 4; ++e) o[e] = (x[u][q][e] * rstd) * g[e] * (1.f + sc[e]) + sh[e];
                    u32x2 w; w[0] = pk2(o[0], o[1]); w[1] = pk2(o[2], o[3]);
                    *(u32x2*)(dst + c) = w;
                }
            }
        } else if (ps == 0) {
#pragma unroll
            for (int u = 0; u < 2; ++u) {
                if (u == 1 && !vb) continue;
                const Tok k1 = tok_info(mm[u], 1);
                f32x4 x1[4]; row_load(x_in_row(p, mm[u], 1), lane, x1);
                const float* md1 = mod + (size_t)(0 * 5 + k1.cond) * 6144;
                row_modnorm_store(x1, p.in(12), md1 + 0, md1 + 1024, H + (size_t)mm[u] * 1024, lane);
            }
        }
    }
}

DI bool xcd_tile(int it, int Mt, int Nt, int B, int& mt, int& nt) {
    const int x = BIDX & 7, loc = BIDX >> 3, nloc = gridDim.x >> 3;
    const int MP = Mt >> 3;
    const int idx = it * nloc + loc;
    if (idx >= MP * Nt) return false;
    const int ng = idx / (MP * B);
    const int bw = min(B, Nt - ng * B);
    const int r = idx - ng * MP * B;
    mt = x * MP + r / bw; nt = ng * B + r % bw;
    return true;
}
DI void gemm_in_qtile(const Ctx& p, int l, int mt0, int q, char* smem, int tid) {
    const bf16_t* W = (const bf16_t*)(p.ws() + OFF_WIN) + (size_t)l * SZ_WIN;
    const bf16_t* X = (const bf16_t*)(p.ws() + OFF_H);
    bf16_t* PROJ = (bf16_t*)(p.ws() + OFF_PROJ);
    const int m0 = mt0 * 128, n0 = 4096 + 32 * q;
    f32x4 acc[1][4];
#pragma unroll
    for (int b = 0; b < 4; ++b) acc[0][b] = (f32x4){0.f, 0.f, 0.f, 0.f};
    gemm_kloop<1, 4>(acc, W + (size_t)n0 * 1024, 1024, X + (size_t)m0 * 1024, 1024, 1024, smem, tid);
    const int t2 = launder(tid);
    const int lane = t2 & 63, wv = t2 >> 6, wn = wv >> 1, wt = wv & 1, fr = lane & 15, g = lane >> 4;
    const int fb = n0 + wn * 16 + 4 * g;
#pragma unroll
    for (int mt = 0; mt < 4; ++mt) {
        const int m = m0 + wt * 64 + 16 * mt + fr;
        const u32x2 w = {pk2(acc[0][mt][0], acc[0][mt][1]), pk2(acc[0][mt][2], acc[0][mt][3])};
        *(u32x2*)(PROJ + (size_t)m * INWP + fb) = w;
    }
}
DI void gemm_in_tile(const Ctx& p, int l, int mt0, int nt0, char* smem, int tid) {
    const bf16_t* W = (const bf16_t*)(p.ws() + OFF_WIN) + (size_t)l * SZ_WIN;
    const bf16_t* X = (const bf16_t*)(p.ws() + OFF_H);
    bf16_t* PROJ = (bf16_t*)(p.ws() + OFF_PROJ);
    float* DTRAW = (float*)(p.ws() + OFF_DTRAW);
    const int m0 = mt0 * 128, n0 = nt0 * 128;
    f32x4 acc[4][4];
#pragma unroll
    for (int a = 0; a < 4; ++a)
#pragma unroll
        for (int b = 0; b < 4; ++b) acc[a][b] = (f32x4){0.f, 0.f, 0.f, 0.f};
    gemm_kloop<4, 4>(acc, W + (size_t)n0 * 1024, 1024, X + (size_t)m0 * 1024, 1024, 1024, smem, tid);
    const int t2 = launder(tid);
    const int lane = t2 & 63, wv = t2 >> 6, wn = wv >> 1, wt = wv & 1, fr = lane & 15, g = lane >> 4;
    const int fb = n0 + wn * 64 + 16 * g;
#pragma unroll
    for (int mt = 0; mt < 4; ++mt) {
        const int m = m0 + wt * 64 + 16 * mt + fr;
        float v[16];
#pragma unroll
        for (int a = 0; a < 4; ++a)
#pragma unroll
            for (int r = 0; r < 4; ++r) v[4 * a + r] = acc[a][mt][r];
        bf16_t* d = PROJ + (size_t)m * INWP + fb;
        const u32x4 w0 = pack8(v), w1 = pack8(v + 8);
        *(u32x4*)d = w0; *(u32x4*)(d + 8) = w1;
        if (fb == C_DT) {
            float* dd = DTRAW + (size_t)m * 16;
#pragma unroll
            for (int a = 0; a < 4; ++a) *(f32x4*)(dd + 4 * a) = acc[a][mt];
        }
        if (fb >= C_XBC && fb < C_DT && ((mt == 0 && wt == 0 && fr == 0) || (mt == 3 && wt == 1 && fr == 15))) {
            bf16_t* e = (bf16_t*)(p.ws() + OFF_XEDGE) + ((size_t)mt0 * 2 + (mt == 3 ? 1 : 0)) * 768 + (fb - C_XBC);
            st_wt16(e, w0); st_wt16(e + 8, w1);
        }
    }
}

template <bool F32OUT>
DI void phase_gemm_plain(const bf16_t* W, int K, const bf16_t* X, size_t ldx, int Mtiles, int Ntiles, void* out, size_t ldo, char* smem, int tid) {
    const int lane = tid & 63, wv = tid >> 6, wn = wv >> 1, wt = wv & 1, fr = lane & 15, g = lane >> 4;
    for (int it = 0;; ++it) {
        int mt0, nt0; if (!xcd_tile(it, Mtiles, Ntiles, 8, mt0, nt0)) break;
        const int m0 = mt0 * 128, n0 = nt0 * 128;
        f32x4 acc[4][4];
#pragma unroll
        for (int a = 0; a < 4; ++a)
#pragma unroll
            for (int b = 0; b < 4; ++b) acc[a][b] = (f32x4){0.f, 0.f, 0.f, 0.f};
        gemm_kloop<4, 4>(acc, W + (size_t)n0 * K, K, X + (size_t)m0 * ldx, ldx, K, smem, tid);
        const int fb = n0 + wn * 64 + 16 * g;
#pragma unroll
        for (int mt = 0; mt < 4; ++mt) {
            const int m = m0 + wt * 64 + 16 * mt + fr;
            if (F32OUT) {
                float* d = (float*)out + (size_t)m * ldo + fb;
#pragma unroll
                for (int a = 0; a < 4; ++a) *(f32x4*)(d + 4 * a) = acc[a][mt];
            } else {
                float v[16];
#pragma unroll
                for (int a = 0; a < 4; ++a)
#pragma unroll
                    for (int r = 0; r < 4; ++r) v[4 * a + r] = acc[a][mt][r];
                bf16_t* d = (bf16_t*)out + (size_t)m * ldo + fb;
                *(u32x4*)d = pack8(v); *(u32x4*)(d + 8) = pack8(v + 8);
            }
        }
    }
}


template <int CTRL> DI float dpp0(float v) { return __builtin_bit_cast(float, __builtin_amdgcn_update_dpp(0, __builtin_bit_cast(int, v), CTRL, 0xf, 0xf, true)); }
constexpr int BND_OFF = 65536;
constexpr size_t PPB = (size_t)128 * INWP * 2;
DI void up_tile(const Ctx& p, int l, int mt0, int nt0, char* smem, int tid) {
    const bf16_t* W = (const bf16_t*)(p.ws() + OFF_WUP) + (size_t)l * SZ_WUP;
    const bf16_t* X = (const bf16_t*)(p.ws() + OFF_H);
    bf16_t* A = (bf16_t*)(p.ws() + OFF_PROJ + (size_t)mt0 * PPB) - (size_t)mt0 * 128 * DFF;
    float* EDGE = (float*)(p.ws() + OFF_EDGE);
    const float* cw = p.in(39) + (size_t)l * 3 * 5632; const float* cb = p.in(40) + (size_t)l * 5632;
    float* bnd = (float*)(smem + BND_OFF);
    {
        const int m0 = mt0 * 128, cb0 = nt0 * 64;
        f32x4 acc[4][4];
#pragma unroll
        for (int a = 0; a < 4; ++a)
#pragma unroll
            for (int b = 0; b < 4; ++b) acc[a][b] = (f32x4){0.f, 0.f, 0.f, 0.f};
        gemm_kloop<4, 4, false, 1>(acc, W + (size_t)cb0 * 1024, 1024, X + (size_t)m0 * 1024, 1024, 1024, smem, tid);
        const int t2 = launder(tid);
        const int lane = t2 & 63, wv = t2 >> 6, wn = wv >> 1, wt = wv & 1, fr = lane & 15, g = lane >> 4;
        const int c0 = cb0 + 32 * wn + 8 * g;
        f32x4 cwv[2][8];
#pragma unroll
        for (int eh = 0; eh < 2; ++eh) {
            const int c = c0 + 4 * eh;
            cwv[eh][0] = *(const f32x4*)(cw + c); cwv[eh][1] = *(const f32x4*)(cw + 5632 + c); cwv[eh][2] = *(const f32x4*)(cw + 2 * 5632 + c); cwv[eh][3] = *(const f32x4*)(cb + c);
            cwv[eh][4] = *(const f32x4*)(cw + DFF + c); cwv[eh][5] = *(const f32x4*)(cw + 5632 + DFF + c); cwv[eh][6] = *(const f32x4*)(cw + 2 * 5632 + DFF + c); cwv[eh][7] = *(const f32x4*)(cb + DFF + c);
        }
        __builtin_amdgcn_sched_barrier(0);
        if (fr == 0) {
            float* d = bnd + (((wn * 2 + wt) * 2 + 0) * 4 + g) * 16;
#pragma unroll
            for (int a = 0; a < 4; ++a) *(f32x4*)(d + 4 * a) = acc[a][0];
        }
        if (fr == 15) {
            float* d = bnd + (((wn * 2 + wt) * 2 + 1) * 4 + g) * 16;
#pragma unroll
            for (int a = 0; a < 4; ++a) *(f32x4*)(d + 4 * a) = acc[a][3];
        }
        __syncthreads();
        const bool e0 = (wt == 0 && fr == 0), e127 = (wt == 1 && fr == 15);
        u32x2 keep[4];
#pragma unroll
        for (int eh = 0; eh < 2; ++eh) {
            const int c = c0 + 4 * eh;
            const f32x4 w0u = cwv[eh][0], w1u = cwv[eh][1], w2u = cwv[eh][2], bu = cwv[eh][3];
            const f32x4 w0g = cwv[eh][4], w1g = cwv[eh][5], w2g = cwv[eh][6], bg = cwv[eh][7];
            const float* bo = bnd + (((wn * 2 + (wt ^ 1)) * 2 + (wt ? 1 : 0)) * 4 + g) * 16;
            const f32x4 bxu = *(const f32x4*)(bo + 4 * eh), bxg = *(const f32x4*)(bo + 8 + 4 * eh);
#pragma unroll
            for (int mt = 0; mt < 4; ++mt) {
                float up[4], gt[4], o[4];
#pragma unroll
                for (int r = 0; r < 4; ++r) {
                    const float cu = acc[eh][mt][r], cg = acc[2 + eh][mt][r];
                    float pu = dpp0<0x111>(cu), pg = dpp0<0x111>(cg), nu = dpp0<0x101>(cu), ng = dpp0<0x101>(cg);
                    if (mt > 0) { pu += dpp0<0x10F>(acc[eh][mt > 0 ? mt - 1 : 0][r]); pg += dpp0<0x10F>(acc[2 + eh][mt > 0 ? mt - 1 : 0][r]); }
                    else if (wt == 1 && fr == 0) { pu = bxu[r]; pg = bxg[r]; }
                    if (mt < 3) { nu += dpp0<0x11F>(acc[eh][mt < 3 ? mt + 1 : 3][r]); ng += dpp0<0x11F>(acc[2 + eh][mt < 3 ? mt + 1 : 3][r]); }
                    else if (wt == 0 && fr == 15) { nu = bxu[r]; ng = bxg[r]; }
                    up[r] = bu[r] + w0u[r] * pu + w1u[r] * cu + w2u[r] * nu;
                    gt[r] = bg[r] + w0g[r] * pg + w1g[r] * cg + w2g[r] * ng;
                    o[r] = siluf(gt[r]) * up[r];
                }
                if (mt == 0 && e0) {
                    float* e = EDGE + ((size_t)mt0 * 4 + 0) * 5632 + c;
                    st_wtf4(e, (f32x4){up[0], up[1], up[2], up[3]}); st_wtf4(e + DFF, (f32x4){gt[0], gt[1], gt[2], gt[3]});
                    float* e3 = EDGE + ((size_t)mt0 * 4 + 3) * 5632 + c;
                    st_wtf4(e3, (f32x4){w2u[0] * acc[eh][0][0], w2u[1] * acc[eh][0][1], w2u[2] * acc[eh][0][2], w2u[3] * acc[eh][0][3]});
                    st_wtf4(e3 + DFF, (f32x4){w2g[0] * acc[2 + eh][0][0], w2g[1] * acc[2 + eh][0][1], w2g[2] * acc[2 + eh][0][2], w2g[3] * acc[2 + eh][0][3]});
                }
                if (mt == 3 && e127) {
                    float* e = EDGE + ((size_t)mt0 * 4 + 2) * 5632 + c;
                    st_wtf4(e, (f32x4){up[0], up[1], up[2], up[3]}); st_wtf4(e + DFF, (f32x4){gt[0], gt[1], gt[2], gt[3]});
                    float* e1 = EDGE + ((size_t)mt0 * 4 + 1) * 5632 + c;
                    st_wtf4(e1, (f32x4){w0u[0] * acc[eh][3][0], w0u[1] * acc[eh][3][1], w0u[2] * acc[eh][3][2], w0u[3] * acc[eh][3][3]});
                    st_wtf4(e1 + DFF, (f32x4){w0g[0] * acc[2 + eh][3][0], w0g[1] * acc[2 + eh][3][1], w0g[2] * acc[2 + eh][3][2], w0g[3] * acc[2 + eh][3][3]});
                }
                const u32x2 pk = {pk2(o[0], o[1]), pk2(o[2], o[3])};
                if (eh == 0) keep[mt] = pk;
                else {
                    const int m = m0 + wt * 64 + 16 * mt + fr;
                    *(u32x4*)(A + (size_t)m * DFF + c0) = (u32x4){keep[mt][0], keep[mt][1], pk[0], pk[1]};
                }
            }
        }
    }
}

DI void down_tile(const Ctx& p, int l, int mt0, int nt0, char* smem, int tid) {
    const bf16_t* W = (const bf16_t*)(p.ws() + OFF_WDN) + (size_t)l * SZ_WDN;
    bf16_t* A = (bf16_t*)(p.ws() + OFF_PROJ + (size_t)mt0 * PPB) - (size_t)mt0 * 128 * DFF;
    const bf16_t* X = A;
    float* out = (float*)(p.ws() + OFF_FO);
    {
        const int m0 = mt0 * 128, n0 = nt0 * 128;
        {
            const int t3 = launder(tid);
            const Tok k0 = tok_info(m0, 0);
            const bool hasp = k0.t > 0, hasn = k0.t + 128 < k0.L;
            f32x4 eu[6], eg[6];
#pragma unroll
            for (int r6 = 0; r6 < 6; ++r6) {
                const int i = t3 + 256 * r6;
                eu[r6] = (f32x4){0.f, 0.f, 0.f, 0.f}; eg[r6] = eu[r6];
                if (i < 2 * 704) {
                    const int row = i >= 704 ? 1 : 0, c = (i - row * 704) * 4;
                    const float* P = (const float*)(p.ws() + OFF_EDGE) + ((size_t)mt0 * 4 + (row ? 2 : 0)) * 5632 + c;
                    eu[r6] = *(const f32x4*)P; eg[r6] = *(const f32x4*)(P + DFF);
                    if (row ? hasn : hasp) {
                        const float* C = (const float*)(p.ws() + OFF_EDGE) + ((size_t)(row ? mt0 + 1 : mt0 - 1) * 4 + (row ? 3 : 1)) * 5632 + c;
                        eu[r6] += *(const f32x4*)C; eg[r6] += *(const f32x4*)(C + DFF);
                    }
                }
            }
#pragma unroll
            for (int r6 = 0; r6 < 6; ++r6) {
                const int i = t3 + 256 * r6;
                if (i < 2 * 704) {
                    const int row = i >= 704 ? 1 : 0, c = (i - row * 704) * 4;
                    const f32x4 u = eu[r6], gt = eg[r6];
                    const u32x2 pk = {pk2(siluf(gt[0]) * u[0], siluf(gt[1]) * u[1]), pk2(siluf(gt[2]) * u[2], siluf(gt[3]) * u[3])};
                    *(u32x2*)(A + (size_t)(m0 + (row ? 127 : 0)) * DFF + c) = pk;
                }
            }
            asm volatile("s_waitcnt vmcnt(0)" ::: "memory");
            __syncthreads();
        }
        f32x4 acc[4][4];
#pragma unroll
        for (int a = 0; a < 4; ++a)
#pragma unroll
            for (int b = 0; b < 4; ++b) acc[a][b] = (f32x4){0.f, 0.f, 0.f, 0.f};
        gemm_kloop<4, 4>(acc, W + (size_t)n0 * DFF, DFF, X + (size_t)m0 * DFF, DFF, DFF, smem, tid);
        const int t2 = launder(tid);
        const int lane = t2 & 63, wv = t2 >> 6, wn = wv >> 1, wt = wv & 1, fr = lane & 15, g = lane >> 4;
        const int fb = n0 + wn * 64 + 16 * g;
#pragma unroll
        for (int mt = 0; mt < 4; ++mt) {
            const int m = m0 + wt * 64 + 16 * mt + fr;
            float* d = out + (size_t)m * 1024 + fb;
#pragma unroll
            for (int a = 0; a < 4; ++a) *(f32x4*)(d + 4 * a) = acc[a][mt];
        }
    }
}


DI void out_tile(const Ctx& p, int l, int mt0, int nt0, char* smem, int tid) {
    const bf16_t* W = (const bf16_t*)(p.ws() + OFF_WOUT) + (size_t)l * SZ_WOUT;
    const bf16_t* X = (const bf16_t*)(p.ws() + OFF_MERGED);
    float* out = (float*)(p.ws() + OFF_PROJ + (size_t)mt0 * PPB);
    const int m0 = mt0 * 128, n0 = nt0 * 128;
    f32x4 acc[4][4];
#pragma unroll
    for (int a = 0; a < 4; ++a)
#pragma unroll
        for (int b = 0; b < 4; ++b) acc[a][b] = (f32x4){0.f, 0.f, 0.f, 0.f};
    gemm_kloop<4, 4>(acc, W + (size_t)n0 * 1024, 1024, X + (size_t)m0 * 1024, 1024, 1024, smem, tid);
    const int t2 = launder(tid);
    const int lane = t2 & 63, wv = t2 >> 6, wn = wv >> 1, wt = wv & 1, fr = lane & 15, g = lane >> 4;
    const int fb = n0 + wn * 64 + 16 * g;
#pragma unroll
    for (int mt = 0; mt < 4; ++mt) {
        float* d = out + (size_t)(wt * 64 + 16 * mt + fr) * 1024 + fb;
#pragma unroll
        for (int a = 0; a < 4; ++a) *(f32x4*)(d + 4 * a) = acc[a][mt];
    }
}

DI void gemm_uq_tile(const Ctx& p, int l, int ps, int tile, char* smem, int tid) {
    const bf16_t* W = (const bf16_t*)(p.ws() + OFF_WUQ) + (size_t)l * SZ_WUQ;
    const bf16_t* X = (const bf16_t*)(p.ws() + OFF_PROJ) + C_MCQ;
    bf16_t* QM = (bf16_t*)(p.ws() + OFF_QM);
    const float* t8 = (const float*)(p.ws() + OFF_T8);
    const int lane = tid & 63, wv = tid >> 6, wn = wv >> 1, wt = wv & 1, fr = lane & 15, g = lane >> 4;
    const int mt0 = tile / 6, nt0 = tile % 6, m0 = mt0 * 128, n0 = nt0 * 128;
    f32x4 acc[4][4];
#pragma unroll
    for (int a = 0; a < 4; ++a)
#pragma unroll
        for (int b = 0; b < 4; ++b) acc[a][b] = (f32x4){0.f, 0.f, 0.f, 0.f};
    gemm_kloop<4, 4>(acc, W + (size_t)n0 * 384, 384, X + (size_t)m0 * INWP, INWP, 384, smem, tid);
    const int fb = n0 + wn * 64 + 16 * g;
    const int o = fb % 96;
#pragma unroll
    for (int mt = 0; mt < 4; ++mt) {
        const int m = m0 + wt * 64 + 16 * mt + fr;
        float v[16];
#pragma unroll
        for (int a = 0; a < 4; ++a)
#pragma unroll
            for (int r = 0; r < 4; ++r) v[4 * a + r] = acc[a][mt][r];
        if (m >= 4096 && o >= 64) {
            const int t = (m - 4096) & 2047;
            const int pos = (o == 64) ? (t >> 6) : (t & 63);
#pragma unroll
            for (int j = 0; j < 8; ++j) {
                const float c = t8[pos * 8 + j], s = t8[512 + pos * 8 + j];
                const float x1 = v[j], x2 = v[j + 8];
                v[j] = x1 * c - x2 * s; v[j + 8] = x2 * c + x1 * s;
            }
        }
        bf16_t* d = QM + (size_t)m * 768 + fb;
        st_wt16(d, pack8(v)); st_wt16(d + 8, pack8(v + 8));
    }
}

DI void gemm_ukv_tile(const Ctx& p, int l, int tile, char* smem, int tid) {
    const bf16_t* W = (const bf16_t*)(p.ws() + OFF_WUKV) + (size_t)l * SZ_WUKV;
    const bf16_t* X = (const bf16_t*)(p.ws() + OFF_CKV);
    bf16_t* KN = (bf16_t*)(p.ws() + OFF_KN);
    bf16_t* VMT = (bf16_t*)(p.ws() + OFF_VMT);
    const int lane = tid & 63, wv = tid >> 6, wn = wv >> 1, wt = wv & 1, fr = lane & 15, g = lane >> 4;
    const int mt0 = tile / 8, nt0 = tile % 8, m0 = mt0 * 128, n0 = nt0 * 128;
    f32x4 acc[4][4];
#pragma unroll
    for (int a = 0; a < 4; ++a)
#pragma unroll
        for (int b = 0; b < 4; ++b) acc[a][b] = (f32x4){0.f, 0.f, 0.f, 0.f};
    gemm_kloop<4, 4>(acc, W + (size_t)n0 * 256, 256, X + (size_t)m0 * 256, 256, 256, smem, tid);
    const int fb = n0 + wn * 64 + 16 * g;
    const int head = fb >> 7, o = fb & 127;
    int key0, Lk;
    if (m0 < 4096) { key0 = m0 & ~255; Lk = 256; } else { const int j = (m0 - 4096) / 2304; key0 = 4096 + j * 2304; Lk = 2304; }
#pragma unroll
    for (int mt = 0; mt < 4; ++mt) {
        const int m = m0 + wt * 64 + 16 * mt + fr;
        float v[16];
#pragma unroll
        for (int a = 0; a < 4; ++a)
#pragma unroll
            for (int r = 0; r < 4; ++r) v[4 * a + r] = acc[a][mt][r];
        if (o < 64) {
            bf16_t* d = KN + (size_t)m * 512 + head * 64 + o;
            st_wt16(d, pack8(v)); st_wt16(d + 8, pack8(v + 8));
        } else {
            bf16_t* d = VMT + (size_t)key0 * 512 + (size_t)(head * 64 + (o - 64)) * Lk + (m - key0);
#pragma unroll
            for (int i = 0; i < 16; ++i) st_wt2(d + (size_t)i * Lk, f2bf(v[i]));
        }
    }
}

DI void merge_tile(const Ctx& p, int l, int mt0, int nt0, char* smem, int tid) {
    {
        const int m0 = mt0 * 128, n0 = nt0 * 128;
        u32x2 mgp[4][4];
#pragma unroll
        for (int a = 0; a < 4; ++a)
#pragma unroll
            for (int b = 0; b < 4; ++b) mgp[a][b] = (u32x2){0u, 0u};
#pragma unroll 1
        for (int br = 0; br < 4; ++br) {
            u32x2 gpk[4][4];
            {
                f32x4 ga[4][4];
#pragma unroll
                for (int a = 0; a < 4; ++a)
#pragma unroll
                    for (int b = 0; b < 4; ++b) ga[a][b] = (f32x4){0.f, 0.f, 0.f, 0.f};
                f32x4 bvv[4];
                {
                    const int t4 = launder(tid);
                    const float* bm0 = p.in(36) + (size_t)l * 4096 + br * 1024 + n0 + (t4 >> 7) * 64 + 16 * ((t4 & 63) >> 4);
#pragma unroll
                    for (int a = 0; a < 4; ++a) bvv[a] = *(const f32x4*)(bm0 + 4 * a);
                }
                gemm_kloop<4, 4, false>(ga, (const bf16_t*)(p.ws() + OFF_WM) + (size_t)l * SZ_WM + (size_t)(br * 1024 + n0) * 1024, 1024,
                                       (const bf16_t*)(p.ws() + OFF_H) + (size_t)m0 * 1024, 1024, 1024, smem, tid);
#pragma unroll
                for (int a = 0; a < 4; ++a) {
                    const f32x4 bv = bvv[a];
#pragma unroll
                    for (int mt = 0; mt < 4; ++mt) {
                        gpk[a][mt][0] = pk2(sigmoidf(ga[a][mt][0] + bv[0]), sigmoidf(ga[a][mt][1] + bv[1]));
                        gpk[a][mt][1] = pk2(sigmoidf(ga[a][mt][2] + bv[2]), sigmoidf(ga[a][mt][3] + bv[3]));
                    }
                }
            }
            f32x4 pa[4][4];
#pragma unroll
            for (int a = 0; a < 4; ++a)
#pragma unroll
                for (int b = 0; b < 4; ++b) pa[a][b] = (f32x4){0.f, 0.f, 0.f, 0.f};
            const bf16_t* xb; size_t ldb;
            const bf16_t* PROJ = (const bf16_t*)(p.ws() + OFF_PROJ);
            if (br == 0) { xb = PROJ + (size_t)m0 * INWP + C_Z; ldb = INWP; }
            else if (br == 1) { xb = PROJ + (size_t)m0 * INWP + C_RG; ldb = INWP; }
            else if (br == 2) { xb = (const bf16_t*)(p.ws() + OFF_OA) + (size_t)m0 * 512; ldb = 512; }
            else { xb = (const bf16_t*)(p.ws() + OFF_OM) + (size_t)m0 * 512; ldb = 512; }
            gemm_kloop<4, 4, false>(pa, (const bf16_t*)(p.ws() + OFF_WBR) + (size_t)l * SZ_WBR + (size_t)br * 1024 * 512 + (size_t)n0 * 512, 512, xb, ldb, 512, smem, tid);
#pragma unroll
            for (int a = 0; a < 4; ++a)
#pragma unroll
                for (int mt = 0; mt < 4; ++mt) {
                    const float m0 = __uint_as_float(mgp[a][mt][0] << 16) + __uint_as_float(gpk[a][mt][0] << 16) * pa[a][mt][0];
                    const float m1 = __uint_as_float(mgp[a][mt][0] & 0xffff0000u) + __uint_as_float(gpk[a][mt][0] & 0xffff0000u) * pa[a][mt][1];
                    const float m2 = __uint_as_float(mgp[a][mt][1] << 16) + __uint_as_float(gpk[a][mt][1] << 16) * pa[a][mt][2];
                    const float m3 = __uint_as_float(mgp[a][mt][1] & 0xffff0000u) + __uint_as_float(gpk[a][mt][1] & 0xffff0000u) * pa[a][mt][3];
                    mgp[a][mt][0] = pk2(m0, m1); mgp[a][mt][1] = pk2(m2, m3);
                }
        }
        const int t3 = launder(tid);
        const int fr = t3 & 15, g = (t3 & 63) >> 4, wn = t3 >> 7, wt = (t3 >> 6) & 1;
        const int fb = n0 + wn * 64 + 16 * g;
        bf16_t* MG = (bf16_t*)(p.ws() + OFF_MERGED);
#pragma unroll
        for (int mt = 0; mt < 4; ++mt) {
            const int m = m0 + wt * 64 + 16 * mt + fr;
            bf16_t* d = MG + (size_t)m * 1024 + fb;
            *(u32x4*)d = (u32x4){mgp[0][mt][0], mgp[0][mt][1], mgp[1][mt][0], mgp[1][mt][1]};
            *(u32x4*)(d + 8) = (u32x4){mgp[2][mt][0], mgp[2][mt][1], mgp[3][mt][0], mgp[3][mt][1]};
        }
    }
}

struct PrepIn { u32x4 in_ak, in_mcq, in_ckv; float dtr, dtb; f32x4 wak0, wak1, c16a, c16b, s16a, s16b, wq0, wq1, wc0, wc1, c8a, c8b, s8a, s8b; };
DI void prep_token_load(const Ctx& p, int l, int ps, int m, int lane, PrepIn& pin) {
    char* ws = p.ws();
    bf16_t* PROJ = (bf16_t*)(ws + OFF_PROJ);
    const float* t16 = (const float*)(ws + OFF_T16);
    const float* t8 = (const float*)(ws + OFF_T8);
    const Tok k = tok_info(m, ps);
    bf16_t* pr = PROJ + (size_t)m * INWP;
    const u32x4 zero4 = {0u, 0u, 0u, 0u};
    u32x4 in_ak = zero4, in_mcq = zero4, in_ckv = zero4;
    if (lane < 32) in_ak = gld16(pr + C_AK + lane * 8);
    if (lane < 48) in_mcq = gld16(pr + C_MCQ + lane * 8);
    if (lane < 36) in_ckv = gld16(pr + C_MCKV + lane * 8);
    const f32x4 zf = {0.f, 0.f, 0.f, 0.f};
    float dtr = 0.f, dtb = 0.f;
    if (lane < 16) { dtr = ((const float*)(ws + OFF_DTRAW))[(size_t)m * 16 + lane]; dtb = p.in(19)[l * 16 + lane]; }
    const int u_ak = lane & 7, pos_ak = (u_ak >> 2) ? (k.t & 63) : (k.t >> 6);
    const float* wakp = p.in(26) + l * 64 + u_ak * 8;
    const float* t16p = t16 + pos_ak * 16 + (u_ak & 1) * 8;
    const f32x4 wak0 = *(const f32x4*)wakp, wak1 = *(const f32x4*)(wakp + 4);
    const f32x4 c16a = *(const f32x4*)t16p, c16b = *(const f32x4*)(t16p + 4), s16a = *(const f32x4*)(t16p + 1024), s16b = *(const f32x4*)(t16p + 1028);
    f32x4 wq0 = zf, wq1 = zf, wc0 = zf, wc1 = zf;
    if (lane < 48) { const float* w = p.in(27) + l * 384 + lane * 8; wq0 = *(const f32x4*)w; wq1 = *(const f32x4*)(w + 4); }
    if (lane < 32) { const float* w = p.in(29) + l * 256 + lane * 8; wc0 = *(const f32x4*)w; wc1 = *(const f32x4*)(w + 4); }
    const int u_kr = (lane - 32) & 3, pos_kr = (u_kr >> 1) ? (k.t & 63) : (k.t >> 6);
    const float* t8p = t8 + pos_kr * 8;
    const f32x4 c8a = *(const f32x4*)t8p, c8b = *(const f32x4*)(t8p + 4), s8a = *(const f32x4*)(t8p + 512), s8b = *(const f32x4*)(t8p + 516);
    pin.in_ak = in_ak;
    pin.in_mcq = in_mcq;
    pin.in_ckv = in_ckv;
    pin.dtr = dtr;
    pin.dtb = dtb;
    pin.wak0 = wak0;
    pin.wak1 = wak1;
    pin.c16a = c16a;
    pin.c16b = c16b;
    pin.s16a = s16a;
    pin.s16b = s16b;
    pin.wq0 = wq0;
    pin.wq1 = wq1;
    pin.wc0 = wc0;
    pin.wc1 = wc1;
    pin.c8a = c8a;
    pin.c8b = c8b;
    pin.s8a = s8a;
    pin.s8b = s8b;
}
DI void prep_token_finish(const Ctx& p, int l, int ps, int m, int lane, const PrepIn& pin) {
    char* ws = p.ws();
    bf16_t* PROJ = (bf16_t*)(ws + OFF_PROJ);
    const Tok k = tok_info(m, ps);
    bf16_t* pr = PROJ + (size_t)m * INWP;
    const int u_ak = lane & 7, u_kr = (lane - 32) & 3;
    const auto in_ak = pin.in_ak;
    const auto in_mcq = pin.in_mcq;
    const auto in_ckv = pin.in_ckv;
    const auto dtr = pin.dtr;
    const auto dtb = pin.dtb;
    const auto wak0 = pin.wak0;
    const auto wak1 = pin.wak1;
    const auto c16a = pin.c16a;
    const auto c16b = pin.c16b;
    const auto s16a = pin.s16a;
    const auto s16b = pin.s16b;
    const auto wq0 = pin.wq0;
    const auto wq1 = pin.wq1;
    const auto wc0 = pin.wc0;
    const auto wc1 = pin.wc1;
    const auto c8a = pin.c8a;
    const auto c8b = pin.c8b;
    const auto s8a = pin.s8a;
    const auto s8b = pin.s8b;
    if (lane < 16) {
        const float v = dtr + dtb;
        const float sp = v > 20.f ? v : log1pe(__expf(v));
        ((float*)(ws + OFF_DT))[(size_t)m * 16 + lane] = sp;
    }
    {
        const int seqkey0 = k.lat ? (k.krow - 256 - k.t) : (k.krow - k.t);
        const int Lk = k.lat ? 2304 : 256;
        const int keyidx = k.krow - seqkey0;
        float v[8];
        unpack8(in_ak, v);
        float ss = 0.f;
#pragma unroll
        for (int j = 0; j < 8; ++j) ss += v[j] * v[j];
        ss += shx(ss, 1); ss += shx(ss, 2); ss += shx(ss, 4);
        const float rstd = rsqrtf(ss * (1.f / 64.f) + EPS);
        const int u = u_ak;
        float kv[8];
#pragma unroll
        for (int j = 0; j < 8; ++j) kv[j] = (v[j] * rstd) * (j < 4 ? wak0[j & 3] : wak1[j & 3]);
        float kr[8];
#pragma unroll
        for (int j = 0; j < 8; ++j) {
            const float other = shx(kv[j], 2);
            const float c = j < 4 ? c16a[j & 3] : c16b[j & 3], s = j < 4 ? s16a[j & 3] : s16b[j & 3];
            kr[j] = (u & 2) ? (kv[j] * c + other * s) : (kv[j] * c - other * s);
        }
        if (lane < 16) {
            if (!k.lat) {
                float* o = p.out() + O_CK + ((size_t)(k.b * 2 + l) * 256 + k.t) * 128 + lane * 8;
                *(f32x4*)o = (f32x4){kv[0], kv[1], kv[2], kv[3]}; *(f32x4*)(o + 4) = (f32x4){kv[4], kv[5], kv[6], kv[7]};
            }
            bf16_t* ka = (bf16_t*)(ws + OFF_KA) + (size_t)k.krow * 128 + lane * 8;
            *(u32x4*)ka = k.lat ? pack8(kr) : pack8(kv);
        } else if (lane < 32) {
            const int d0 = (lane - 16) * 8;
            if (!k.lat) {
                float* o = p.out() + O_CV + ((size_t)(k.b * 2 + l) * 256 + k.t) * 128 + d0;
                *(f32x4*)o = (f32x4){v[0], v[1], v[2], v[3]}; *(f32x4*)(o + 4) = (f32x4){v[4], v[5], v[6], v[7]};
            }
            bf16_t* vt = (bf16_t*)(ws + OFF_VAT) + (size_t)seqkey0 * 128 + (size_t)d0 * Lk + keyidx;
#pragma unroll
            for (int j = 0; j < 8; ++j) vt[(size_t)j * Lk] = f2bf(v[j]);
        }
    }
    {
        float v[8];
        unpack8(in_mcq, v);
        float ss = 0.f;
#pragma unroll
        for (int j = 0; j < 8; ++j) ss += v[j] * v[j];
        ss = wsum(ss);
        const float rstd = rsqrtf(ss * (1.f / 384.f) + EPS);
        if (lane < 48) {
#pragma unroll
            for (int j = 0; j < 8; ++j) v[j] = (v[j] * rstd) * (j < 4 ? wq0[j & 3] : wq1[j & 3]);
            *(u32x4*)(pr + C_MCQ + lane * 8) = pack8(v);
        }
    }
    {
        float v[8];
        unpack8(in_ckv, v);
        float ss = 0.f;
        if (lane < 32) {
#pragma unroll
            for (int j = 0; j < 8; ++j) ss += v[j] * v[j];
        }
        ss = wsum(ss);
        const float rstd = rsqrtf(ss * (1.f / 256.f) + EPS);
        const int u = u_kr;
        float kr[8];
#pragma unroll
        for (int j = 0; j < 8; ++j) {
            const float other = shx(v[j], 1);
            const float c = j < 4 ? c8a[j & 3] : c8b[j & 3], s = j < 4 ? s8a[j & 3] : s8b[j & 3];
            kr[j] = (u & 1) ? (v[j] * c + other * s) : (v[j] * c - other * s);
        }
        if (lane < 32) {
            float c[8];
#pragma unroll
            for (int j = 0; j < 8; ++j) c[j] = (v[j] * rstd) * (j < 4 ? wc0[j & 3] : wc1[j & 3]);
            if (!k.lat) {
                float* o = p.out() + O_CC + ((size_t)(k.b * 2 + l) * 256 + k.t) * 256 + lane * 8;
                *(f32x4*)o = (f32x4){c[0], c[1], c[2], c[3]}; *(f32x4*)(o + 4) = (f32x4){c[4], c[5], c[6], c[7]};
            }
            *(u32x4*)((bf16_t*)(ws + OFF_CKV) + (size_t)k.krow * 256 + lane * 8) = pack8(c);
        } else if (lane < 36) {
            const int d0 = (lane - 32) * 8;
            if (!k.lat) {
                float* o = p.out() + O_CR + ((size_t)(k.b * 2 + l) * 256 + k.t) * 32 + d0;
                *(f32x4*)o = (f32x4){v[0], v[1], v[2], v[3]}; *(f32x4*)(o + 4) = (f32x4){v[4], v[5], v[6], v[7]};
            }
            *(u32x4*)((bf16_t*)(ws + OFF_KRP) + (size_t)k.krow * 32 + d0) = k.lat ? pack8(kr) : pack8(v);
        }
    }
}
DI void prep_token(const Ctx& p, int l, int ps, int m, int lane) {
    PrepIn pin; prep_token_load(p, l, ps, m, lane, pin);
    __builtin_amdgcn_sched_barrier(0);
    prep_token_finish(p, l, ps, m, lane, pin);
}
DI void prep_conv_item(const Ctx& p, int l, int ps, int item, int lane) {
    const int run = item >> 1, cbk = item & 1;
    const int c0 = cbk * 512 + lane * 8;
    if (c0 >= 768) return;
    const int m0 = run * 16;
    const Tok k = tok_info(m0, ps);
    const float* cw = p.in(17) + (size_t)l * 3 * 768; const float* cb = p.in(18) + (size_t)l * 768;
    float w[4][8];
#pragma unroll
    for (int tp = 0; tp < 4; ++tp) {
        const float* src = (tp < 3) ? cw + tp * 768 + c0 : cb + c0;
        const f32x4 a0 = *(const f32x4*)src, a1 = *(const f32x4*)(src + 4);
#pragma unroll
        for (int e = 0; e < 4; ++e) { w[tp][e] = a0[e]; w[tp][4 + e] = a1[e]; }
    }
    const bf16_t* xb = (const bf16_t*)(p.ws() + OFF_PROJ) + (size_t)m0 * INWP + C_XBC + c0;
    bf16_t* xo = (bf16_t*)(p.ws() + OFF_XBCA) + (size_t)m0 * 768 + c0;
    const u32x4 zero = {0u, 0u, 0u, 0u};

    const bf16_t* xe = (const bf16_t*)(p.ws() + OFF_XEDGE) + c0;
    u32x4 rw[18];
    rw[0] = zero; rw[17] = zero;
    if (k.t > 0) rw[0] = (m0 & 127) ? gld16(xb - INWP) : gld16(xe + ((size_t)((m0 >> 7) - 1) * 2 + 1) * 768);
#pragma unroll
    for (int i = 0; i < 16; ++i) rw[1 + i] = gld16(xb + (size_t)i * INWP);
    if (k.t + 16 < k.L) rw[17] = ((m0 + 16) & 127) ? gld16(xb + (size_t)16 * INWP) : gld16(xe + ((size_t)((m0 >> 7) + 1) * 2 + 0) * 768);
#pragma unroll
    for (int i = 0; i < 16; ++i) {
        float a[8], b[8], c[8], o[8];
        unpack8(rw[i], a); unpack8(rw[i + 1], b); unpack8(rw[i + 2], c);
#pragma unroll
        for (int e = 0; e < 8; ++e) o[e] = siluf(w[3][e] + w[0][e] * a[e] + w[1][e] * b[e] + w[2][e] * c[e]);
        *(u32x4*)(xo + (size_t)i * 768) = pack8(o);
    }
}
DI void prep_cache_row(const Ctx& p, int l, int ps, int r, int lane) {
    char* ws = p.ws();
    const int j = r >> 8, c = r & 255, b = ps * 2 + j;
    const int key0 = 4096 + j * 2304, krow = key0 + c, Lk = 2304;
    const size_t src = (size_t)(b * 2 + l) * 256 + c;
    if (lane < 16) {
        const float* s = p.in(4) + src * 128 + lane * 8; float v[8];
#pragma unroll
        for (int i = 0; i < 8; ++i) v[i] = s[i];
        *(u32x4*)((bf16_t*)(ws + OFF_KA) + (size_t)krow * 128 + lane * 8) = pack8(v);
    } else if (lane < 32) {
        const int d0 = (lane - 16) * 8;
        const float* s = p.in(5) + src * 128 + d0;
        bf16_t* vt = (bf16_t*)(ws + OFF_VAT) + (size_t)key0 * 128 + (size_t)d0 * Lk + c;
#pragma unroll
        for (int i = 0; i < 8; ++i) vt[(size_t)i * Lk] = f2bf(s[i]);
    } else if (lane < 36) {
        const int d0 = (lane - 32) * 8;
        const float* s = p.in(7) + src * 32 + d0; float v[8];
#pragma unroll
        for (int i = 0; i < 8; ++i) v[i] = s[i];
        *(u32x4*)((bf16_t*)(ws + OFF_KRP) + (size_t)krow * 32 + d0) = pack8(v);
    }
    if (lane < 32) {
        const float* s = p.in(6) + src * 256 + lane * 8; float v[8];
#pragma unroll
        for (int i = 0; i < 8; ++i) v[i] = s[i];
        *(u32x4*)((bf16_t*)(ws + OFF_CKV) + (size_t)krow * 256 + lane * 8) = pack8(v);
    }
}

#ifndef TEAM_MAP
#define TEAM_MAP 1
#endif
struct Team { int panel, j, size; };
DI Team team_info(volatile LAS unsigned* xw) {
    const int nloc = __builtin_amdgcn_readfirstlane((int)xw[0]), nx = __builtin_amdgcn_readfirstlane((int)xw[1]);
    const int r = __builtin_amdgcn_readfirstlane((int)xw[6]);
    int vloc = __builtin_amdgcn_readfirstlane((int)xw[7]);
    const int p0 = (64 * r) / nx, np = (64 * (r + 1)) / nx - p0;
    Team t;
#if TEAM_MAP > 0
    if (__builtin_amdgcn_readfirstlane((int)xw[5]) == 0) {
        vloc = (int)(blockIdx.x >> 3);
#if TEAM_MAP == 2
        if (nloc % np == 0) { const int sz = nloc / np; t.panel = p0 + vloc / sz; t.j = vloc % sz; t.size = sz; return t; }
#endif
    }
#endif
    const int ti = vloc % np;
    t.panel = p0 + ti; t.j = vloc / np; t.size = nloc / np + (ti < nloc % np ? 1 : 0);
    return t;
}
DI unsigned ctr_ld(unsigned* c) { return __hip_atomic_load(c, __ATOMIC_RELAXED, __HIP_MEMORY_SCOPE_AGENT); }
DI void team_sync(unsigned* cnt, unsigned need, unsigned* upself, unsigned nup, unsigned* nb0, unsigned* nb1, unsigned nbneed, int tid) {
    asm volatile("s_waitcnt vmcnt(0)" ::: "memory");
    __syncthreads();
    if (tid == 0) {
        if (upself) __hip_atomic_fetch_add(upself, nup, __ATOMIC_RELAXED, __HIP_MEMORY_SCOPE_AGENT);
        __hip_atomic_fetch_add(cnt, 1u, __ATOMIC_RELAXED, __HIP_MEMORY_SCOPE_AGENT);
        unsigned sp = 0;
        while (ctr_ld(cnt) < need || (nb0 && ctr_ld(nb0) < nbneed) || (nb1 && ctr_ld(nb1) < nbneed)) { __builtin_amdgcn_s_sleep(4); if (++sp > (1u << 24)) break; }
        __builtin_amdgcn_fence(__ATOMIC_ACQUIRE, "agent");
        asm volatile("s_waitcnt vmcnt(0)" ::: "memory");
    }
    __syncthreads();
}
DI void phase_chain(const Ctx& p, int ci, bool head, int bl, int bps, int tl, int tps, unsigned* wq, volatile LAS unsigned* xw, char* smem, int tid) {
    const Team tm = team_info(xw);
    unsigned* tcnt = (unsigned*)(p.ws() + OFF_CTR) + CTR_TEAM + (ci * 64 + tm.panel) * 256;
    unsigned* upc = tcnt + 64; unsigned* xbc = tcnt + 128;
    const unsigned sz = (unsigned)tm.size;
    unsigned ep = 0u;
    const Tok k0 = tok_info(tm.panel * 128, 0);
    const bool hasp = k0.t > 0, hasn = k0.t + 128 < k0.L;
    if (head) {
        const int t2 = launder(tid);
        const float* mod = (const float*)(p.ws() + OFF_MOD);
        bf16_t* H = (bf16_t*)(p.ws() + OFF_H);
        for (int i = tm.j * 4 + (t2 >> 6); i < 128; i += tm.size * 4) {
            const int m = tm.panel * 128 + i;
            const Tok k = tok_info(m, 0);
            f32x4 x[4]; row_load(x_in_row(p, m, 0), t2 & 63, x);
            const float* md = mod + (size_t)(0 * 5 + k.cond) * 6144;
            row_modnorm_store(x, p.in(12), md + 0, md + 1024, H + (size_t)m * 1024, t2 & 63);
        }
    }
    if (bl >= 0) {
        const int l = bl, ps = bps;
        for (int nt = tm.j; nt < 8; nt += tm.size) merge_tile(p, l, tm.panel, nt, smem, tid);
        ep += sz; team_sync(tcnt, ep, nullptr, 0u, nullptr, nullptr, 0u, tid);
        for (int nt = tm.j; nt < 8; nt += tm.size) out_tile(p, l, tm.panel, nt, smem, tid);
        ep += sz; team_sync(tcnt, ep, nullptr, 0u, nullptr, nullptr, 0u, tid);
        res_rows(p, ps, l, 0, (const float*)(p.ws() + OFF_PROJ + (size_t)tm.panel * PPB), tm.panel, tm.j, tm.size, launder(tid));
        ep += sz; team_sync(tcnt, ep, nullptr, 0u, nullptr, nullptr, 0u, tid);
        unsigned nup = 0u;
        for (int nt = tm.j; nt < 44; nt += tm.size) { up_tile(p, l, tm.panel, nt, smem, tid); ++nup; }
        ep += sz; team_sync(tcnt, ep, upc, nup, hasp ? upc - 256 : nullptr, hasn ? upc + 256 : nullptr, 44u, tid);
        for (int nt = tm.j; nt < 8; nt += tm.size) down_tile(p, l, tm.panel, nt, smem, tid);
        ep += sz; team_sync(tcnt, ep, nullptr, 0u, nullptr, nullptr, 0u, tid);
        res_rows(p, ps, l, 1, (const float*)(p.ws() + OFF_FO) + (size_t)tm.panel * 128 * 1024, tm.panel, tm.j, tm.size, launder(tid));
    }
    if (tl >= 0) {
        const int l = tl, ps = tps;
        ep += sz; team_sync(tcnt, ep, nullptr, 0u, nullptr, nullptr, 0u, tid);
        unsigned nxb = 0u;
        for (int nt = tm.j; nt < 32; nt += tm.size) { gemm_in_tile(p, l, tm.panel, nt, smem, tid); if (nt >= 4 && nt < 10) ++nxb; }
        for (int q = tm.j; q < 6; q += tm.size) gemm_in_qtile(p, l, tm.panel, q, smem, tid);
        if (launder_s(ps) == 0) {
            const int lo = l * T_LAYER + T_IN, hi = l * T_LAYER + T_MIDEND;
            for (;;) {
                const int k = next_item(wq, xw + 2, tid);
                const int w0 = lo + 4 * k;
                if (w0 >= hi) break;
                wtile_run(p, w0, min(w0 + 4, hi), 1, smem, tid);
            }
        }
        ep += sz; team_sync(tcnt, ep, xbc, nxb, hasp ? xbc - 256 : nullptr, hasn ? xbc + 256 : nullptr, 6u, tid);
        const int t2 = launder(tid);
        const int pstep = tm.size * 4;
        for (int i = tm.j * 4 + (t2 >> 6); i < 128 + 16 + 8; i += 2 * pstep) {
            const int i1 = i + pstep;
            if (i1 < 128) {
                PrepIn pa, pb;
                prep_token_load(p, l, ps, tm.panel * 128 + i, t2 & 63, pa);
                prep_token_load(p, l, ps, tm.panel * 128 + i1, t2 & 63, pb);
                __builtin_amdgcn_sched_barrier(0);
                prep_token_finish(p, l, ps, tm.panel * 128 + i, t2 & 63, pa);
                prep_token_finish(p, l, ps, tm.panel * 128 + i1, t2 & 63, pb);
            } else {
#pragma unroll
                for (int u = 0; u < 2; ++u) {
                    const int iu = i + u * pstep;
                    if (iu < 128) prep_token(p, l, ps, tm.panel * 128 + iu, t2 & 63);
                    else if (iu < 144) prep_conv_item(p, l, ps, tm.panel * 16 + (iu - 128), t2 & 63);
                    else if (iu < 152) prep_cache_row(p, l, ps, tm.panel * 8 + (iu - 144), t2 & 63);
                }
            }
        }
    }
}
template <int KC, int NQT>
DI void attn_tile(const bf16_t* __restrict__ Q, size_t ldq, const bf16_t* __restrict__ K1, size_t ldk1, const bf16_t* __restrict__ K2, size_t ldk2,
                  const bf16_t* __restrict__ VT, size_t ldvt, int nkt, float c2, bf16_t* __restrict__ O, size_t ldo,
                  const float* __restrict__ qnw  , const float* __restrict__ rope, int t0  , char* smem, int tid) {
    constexpr int KB = KC * 4096, STG = KB + 8192;
    tid = launder(tid);
    const int lane = tid & 63, w = tid >> 6, fr = lane & 15, g = lane >> 4;
    bf16x8 qf[NQT][KC];
#pragma unroll
    for (int qt = 0; qt < NQT; ++qt)
#pragma unroll
        for (int ks = 0; ks < KC; ++ks) { const u32x4 t4 = gld16(Q + (size_t)(16 * NQT * w + 16 * qt + fr) * ldq + ks * 32 + 8 * g); qf[qt][ks] = __builtin_bit_cast(bf16x8, t4); }
    if (KC == 2 && qnw) {
#pragma unroll
        for (int qt = 0; qt < NQT; ++qt) {
            float v[2][8]; float ss = 0.f;
#pragma unroll
            for (int ks = 0; ks < 2; ++ks) {
                const u32x4 t4 = __builtin_bit_cast(u32x4, qf[qt][ks]); unpack8(t4, v[ks]);
#pragma unroll
                for (int j = 0; j < 8; ++j) ss += v[ks][j] * v[ks][j];
            }
            ss += shx(ss, 16); ss += shx(ss, 32);
            const float rstd = rsqrtf(ss * (1.f / 64.f) + EPS);
            const int t = t0 + 16 * NQT * w + 16 * qt + fr;
#pragma unroll
            for (int ks = 0; ks < 2; ++ks) {
                const int pos = ks ? (t & 63) : (t >> 6);
#pragma unroll
                for (int j = 0; j < 8; ++j) {
                    float x = (v[ks][j] * rstd) * qnw[32 * ks + 8 * g + j];
                    if (rope) {
                        const float other = shx(x, 32);
                        const int fi = (g & 1) * 8 + j;
                        const float c = rope[pos * 16 + fi], sn = rope[1024 + pos * 16 + fi];
                        x = (g & 2) ? (x * c + other * sn) : (x * c - other * sn);
                    }
                    v[ks][j] = x;
                }
                const u32x4 t4 = pack8(v[ks]); qf[qt][ks] = __builtin_bit_cast(bf16x8, t4);
            }
        }
    }
    constexpr int NPK = KC * 4, PPW = (NPK + 8) / 4;
    static_assert((NPK + 8) % 4 == 0, "pieces must divide over 4 waves");
    const int wvu = __builtin_amdgcn_readfirstlane(w);
    unsigned poff[PPW];
#pragma unroll
    for (int j = 0; j < PPW; ++j) {
        const int pc = wvu * PPW + j;
        const bool isk = pc < NPK;
        const int pp = isk ? pc : pc - NPK;
        const int ks = pp >> 2, rb = pp & 3;
        const int rl = lane >> 2, row = rb * 16 + rl;
        const int q = isk ? ((row >> 3) & 3) : ((rl >> 2) & 3);
        const int gl = (lane & 3) ^ FQ(q);
        const unsigned ld = isk ? ((KC == 2 || ks < 2) ? (unsigned)ldk1 : (unsigned)ldk2) : (unsigned)ldvt;
        poff[j] = (unsigned)rl * ld + (unsigned)(gl * 8);
    }
    auto issue = [&](int kt, char* stage) {
#pragma unroll
        for (int j = 0; j < PPW; ++j) {
            const int pc = wvu * PPW + j;
            const bool isk = pc < NPK;
            const int pp = isk ? pc : pc - NPK;
            const int ks = pp >> 2, rb = pp & 3;
            const bf16_t* base;
            if (isk) { if (KC == 2 || ks < 2) base = K1 + ks * 32 + (size_t)(kt * 64 + rb * 16) * ldk1; else base = K2 + (size_t)(kt * 64 + rb * 16) * ldk2; }
            else base = VT + ks * 32 + (size_t)kt * 64 + (size_t)(rb * 16) * ldvt;
            __builtin_amdgcn_global_load_lds((const unsigned*)(base + poff[j]), (unsigned*)(stage + (isk ? 0 : KB) + (ks * 64 + rb * 16) * 64), 16, 0, 0);
        }
    };
    const int koff = tile_off(64, 0, 8 * (fr >> 2) + (fr & 3), g, fr >> 2);
    const int voff = KB + tile_off(64, 0, fr, g, (fr >> 2) & 3);
    f32x4 o[4][NQT];
#pragma unroll
    for (int a = 0; a < 4; ++a)
#pragma unroll
        for (int qt = 0; qt < NQT; ++qt) o[a][qt] = (f32x4){0.f, 0.f, 0.f, 0.f};
    float mrun[NQT], lrun[NQT];
#pragma unroll
    for (int qt = 0; qt < NQT; ++qt) { mrun[qt] = -1e30f; lrun[qt] = 0.f; }
    __syncthreads();
    issue(0, smem);
    if (nkt > 1) {
        issue(1, smem + STG);
        if (PPW == 4) asm volatile("s_waitcnt vmcnt(4)" ::: "memory"); else asm volatile("s_waitcnt vmcnt(5)" ::: "memory");
    } else asm volatile("s_waitcnt vmcnt(0)" ::: "memory");
    __syncthreads();
    int so_cur = 0, so_nn = 2 * STG;
    for (int kt = 0; kt < nkt; ++kt) {
        if (kt + 2 < nkt) issue(kt + 2, smem + so_nn);
        __builtin_amdgcn_sched_barrier(0);
        const char* sb = smem + so_cur;
        f32x4 s[4][NQT];
#pragma unroll
        for (int a = 0; a < 4; ++a)
#pragma unroll
            for (int qt = 0; qt < NQT; ++qt) s[a][qt] = (f32x4){0.f, 0.f, 0.f, 0.f};
        bf16x8 kf[KC][4];
#pragma unroll
        for (int ks = 0; ks < KC; ++ks)
#pragma unroll
            for (int a = 0; a < 4; ++a) kf[ks][a] = *(const bf16x8*)(sb + koff + ((a >> 1) * 32 + (a & 1) * 4) * 64 + ks * 4096);
        __builtin_amdgcn_sched_barrier(0);
#pragma unroll
        for (int ks = 0; ks < KC; ++ks)
#pragma unroll
            for (int a = 0; a < 4; ++a) {
#pragma unroll
                for (int qt = 0; qt < NQT; ++qt) s[a][qt] = __builtin_amdgcn_mfma_f32_16x16x32_bf16(kf[ks][a], qf[qt][ks], s[a][qt], 0, 0, 0);
            }
        bf16x8 vfr[2][4];
#pragma unroll
        for (int s2 = 0; s2 < 2; ++s2)
#pragma unroll
            for (int dt = 0; dt < 4; ++dt) vfr[s2][dt] = *(const bf16x8*)(sb + voff + dt * 1024 + s2 * 4096);
        __builtin_amdgcn_sched_barrier(0);
        bf16x8 pf[NQT][2];
#pragma unroll
        for (int qt = 0; qt < NQT; ++qt) {
            float mx = s[0][qt][0];
#pragma unroll
            for (int a = 0; a < 4; ++a)
#pragma unroll
                for (int r = 0; r < 4; ++r) mx = fmaxf(mx, s[a][qt][r]);
            mx = gmax4(mx);
            if (__builtin_amdgcn_ballot_w64((mx - mrun[qt]) * c2 > 8.f) != 0ull) {
                const float mnew = fmaxf(mrun[qt], mx);
                const float alpha = __builtin_amdgcn_exp2f((mrun[qt] - mnew) * c2);
                mrun[qt] = mnew;
                lrun[qt] = lrun[qt] * alpha;
#pragma unroll
                for (int a = 0; a < 4; ++a) o[a][qt] = o[a][qt] * alpha;
            }
            const float mc = mrun[qt] * c2;
            const f32x2 c2v = {c2, c2}, mcv = {mc, mc};
            f32x2 lsv = {0.f, 0.f}; float pv[16];
#pragma unroll
            for (int a = 0; a < 4; ++a)
#pragma unroll
                for (int rp = 0; rp < 2; ++rp) {
                    const f32x2 x = (f32x2){s[a][qt][2 * rp], s[a][qt][2 * rp + 1]} * c2v - mcv;
                    const f32x2 e = {__builtin_amdgcn_exp2f(x[0]), __builtin_amdgcn_exp2f(x[1])};
                    pv[4 * a + 2 * rp] = e[0]; pv[4 * a + 2 * rp + 1] = e[1]; lsv += e;
                }
            lrun[qt] += lsv[0] + lsv[1];
            u32x4 w0 = pack8(pv), w1 = pack8(pv + 8);
            pf[qt][0] = __builtin_bit_cast(bf16x8, w0); pf[qt][1] = __builtin_bit_cast(bf16x8, w1);
        }
        __builtin_amdgcn_sched_barrier(0);
#pragma unroll
        for (int s2 = 0; s2 < 2; ++s2)
#pragma unroll
            for (int dt = 0; dt < 4; ++dt) {
#pragma unroll
                for (int qt = 0; qt < NQT; ++qt) o[dt][qt] = __builtin_amdgcn_mfma_f32_16x16x32_bf16(vfr[s2][dt], pf[qt][s2], o[dt][qt], 0, 0, 0);
            }
        __builtin_amdgcn_sched_barrier(0);
        if (kt + 2 < nkt) { if (PPW == 4) asm volatile("s_waitcnt vmcnt(4)" ::: "memory"); else asm volatile("s_waitcnt vmcnt(5)" ::: "memory"); }
        else asm volatile("s_waitcnt vmcnt(0)" ::: "memory");
        asm volatile("s_waitcnt lgkmcnt(0)" ::: "memory");
        __builtin_amdgcn_s_barrier();
        so_cur = (so_cur == 2 * STG) ? 0 : so_cur + STG;
        so_nn = (so_nn == 2 * STG) ? 0 : so_nn + STG;
    }
#pragma unroll
    for (int qt = 0; qt < NQT; ++qt) {
        float l = gsum4(lrun[qt]);
        const float inv = 1.f / l;
        bf16_t* orow = O + (size_t)(16 * NQT * w + 16 * qt + fr) * ldo + 4 * g;
#pragma unroll
        for (int dt = 0; dt < 4; ++dt) {
            u32x2 wv2; wv2[0] = pk2(o[dt][qt][0] * inv, o[dt][qt][1] * inv); wv2[1] = pk2(o[dt][qt][2] * inv, o[dt][qt][3] * inv);
            *(u32x2*)(orow + 16 * dt) = wv2;
        }
    }
}

struct Seq { int lat, tok0, L, key0, Lk, b; };
DI Seq seq_info(int s, int ps) {
    Seq q;
    if (s < 16) { q.lat = 0; q.tok0 = s * 256; q.L = 256; q.key0 = s * 256; q.Lk = 256; q.b = ps * 16 + s; }
    else { const int j = s - 16; q.lat = 1; q.tok0 = 4096 + j * 2048; q.L = 2048; q.key0 = 4096 + j * 2304; q.Lk = 2304; q.b = ps * 2 + j; }
    return q;
}
DI void attn_gqa_item(const Ctx& p, int l, int s, int head, int qb, int ps, char* smem, int tid) {
    const Seq q = seq_info(s, ps);
    const int rows = 128;
    const bf16_t* PROJ = (const bf16_t*)(p.ws() + OFF_PROJ);
    const bf16_t* Q = PROJ + (size_t)(q.tok0 + qb * rows) * INWP + C_AQ + head * 64;
    const int kh = head >> 2;
    const bf16_t* K = (const bf16_t*)(p.ws() + OFF_KA) + (size_t)q.key0 * 128 + kh * 64;
    const bf16_t* VT = (const bf16_t*)(p.ws() + OFF_VAT) + (size_t)q.key0 * 128 + (size_t)kh * 64 * q.Lk;
    bf16_t* O = (bf16_t*)(p.ws() + OFF_OA) + (size_t)(q.tok0 + qb * rows) * 512 + head * 64;
    const float c2 = 0.125f * 1.4426950408889634f;
    attn_tile<2, 2>(Q, INWP, K, 128, K, 128, VT, q.Lk, q.Lk / 64, c2, O, 512, p.in(25) + l * 64, q.lat ? (const float*)(p.ws() + OFF_T16) : nullptr, qb * 128, smem, tid);
}
DI void attn_mla_item(const Ctx& p, int s, int head, int qb, int ps, char* smem, int tid) {
    const Seq q = seq_info(s, ps);
    const int rows = 128;
    const bf16_t* Q = (const bf16_t*)(p.ws() + OFF_QM) + (size_t)(q.tok0 + qb * rows) * 768 + head * 96;
    const bf16_t* K1 = (const bf16_t*)(p.ws() + OFF_KN) + (size_t)q.key0 * 512 + head * 64;
    const bf16_t* K2 = (const bf16_t*)(p.ws() + OFF_KRP) + (size_t)q.key0 * 32;
    const bf16_t* VT = (const bf16_t*)(p.ws() + OFF_VMT) + (size_t)q.key0 * 512 + (size_t)head * 64 * q.Lk;
    bf16_t* O = (bf16_t*)(p.ws() + OFF_OM) + (size_t)(q.tok0 + qb * rows) * 512 + head * 64;
    const float c2 = 0.10206207261596577f * 1.4426950408889634f;
    attn_tile<3, 2>(Q, 768, K1, 512, K2, 32, VT, q.Lk, q.Lk / 64, c2, O, 512, nullptr, nullptr, 0, smem, tid);
}

template <int ET>
DI void scan_item(const bf16_t* __restrict__ Qp, size_t ldq, const bf16_t* __restrict__ Kp, size_t ldk, const bf16_t* __restrict__ Vp, size_t ldv,
                  const float* __restrict__ dtp  , float acoef  ,
                  int L, int dir, const float* __restrict__ s0, float* __restrict__ sout, int lds_state  , bf16_t* __restrict__ Op, size_t ldo,
                  const float* __restrict__ rope  , float kmul,
                  int nbase  , int nch  , const bf16_t* __restrict__ s0b  ,
                  bf16_t* __restrict__ lout  , float* __restrict__ dout  , char* smem, int tid) {
    constexpr int DV = 16 * ET;
    const bool stateonly = (lout != nullptr);
    constexpr int QS = 0, KS = 8192, KT = 16384, VTO = 24576, STO = VTO + DV * 128, ACO = STO + DV * 128;
    constexpr int NV = DV / 32;
    tid = launder(tid);
    const int lane = tid & 63, w = tid >> 6, fr = lane & 15, g = lane >> 4;
    float* acs = (float*)(smem + ACO);
    u32x4 gq[2], gk[2], gv[NV]; float gdt = 1.f;
    auto issue = [&](int c) {
        const int n0 = nbase + c * 64;
        {
            const int row = tid >> 2, cc0 = (tid & 1) | ((tid & 2) << 1);
            const int tl = dir ? (L - 1 - (n0 + row)) : (n0 + row);
#pragma unroll
            for (int i = 0; i < 2; ++i) {
                gq[i] = gld16(Qp + (size_t)tl * ldq + (cc0 + 2 * i) * 8);
                gk[i] = gld16(Kp + (size_t)tl * ldk + (cc0 + 2 * i) * 8);
            }
        }
#pragma unroll
        for (int i = 0; i < NV; ++i) {
            const int q = tid + 256 * i, row = q / (DV / 8), cc = q % (DV / 8);
            const int tl = dir ? (L - 1 - (n0 + row)) : (n0 + row);
            gv[i] = gld16(Vp + (size_t)tl * ldv + cc * 8);
        }
        if (dtp) { const int tl = dir ? (L - 1 - (n0 + lane)) : (n0 + lane); gdt = dtp[(size_t)tl * 16]; }
    };
    issue(0);
    f32x4 sacc[ET];
#pragma unroll
    for (int et = 0; et < ET; ++et) {
        if (s0) {
#pragma unroll
            for (int r = 0; r < 4; ++r) sacc[et][r] = s0[(size_t)(16 * w + 4 * g + r) * lds_state + 16 * et + fr];
        } else if (s0b) {
#pragma unroll
            for (int r = 0; r < 4; ++r) sacc[et][r] = bf2f(s0b[(16 * w + 4 * g + r) * DV + 16 * et + fr]);
        } else sacc[et] = (f32x4){0.f, 0.f, 0.f, 0.f};
    }
    const int st_off = STO + ((w >> 1) * DV) * 64 + (g & 1) * 8;
    const int st_gg = (2 * w + (g >> 1)) & 3;
    __syncthreads();
    float* ropeL = (float*)(smem + ACO + 256);
    if (rope) {
#pragma unroll
        for (int i = 0; i < 2; ++i) *(f32x4*)(ropeL + (tid + 256 * i) * 4) = *(const f32x4*)(rope + (tid + 256 * i) * 4);
    }
#pragma unroll
    for (int et = 0; et < ET; ++et) {
        const int e = 16 * et + fr;
        u32x2 wv2; wv2[0] = pk2(sacc[et][0], sacc[et][1]); wv2[1] = pk2(sacc[et][2], sacc[et][3]);
        *(u32x2*)(smem + st_off + e * 64 + ((st_gg ^ FQ((e >> 2) & 3)) << 4)) = wv2;
    }
    __syncthreads();
    float dprod = 1.f;
    const int qoff = QS + tile_off(64, 0, 16 * w + fr, g, (fr >> 2) & 3);
    const int koff = KS + tile_off(64, 0, 8 * (fr >> 2) + (fr & 3), g, fr >> 2);
    const int ktoff = KT + tile_off(64, 0, 16 * w + fr, g, (fr >> 2) & 3);
    const int vtoff = VTO + tile_off(DV, 0, fr, g, (fr >> 2) & 3);
    const int stoff = STO + tile_off(DV, 0, fr, g, (fr >> 2) & 3);
    for (int c = 0; c < nch; ++c) {
        const int n0 = nbase + c * 64;
        const float dtv = gdt;
        const float la = dtp ? dtv * acoef : acoef;
        float ac, aend;
        if (dtp) {
            ac = la;
#pragma unroll
            for (int o = 1; o < 64; o <<= 1) { const float t = shu(ac, o); if (lane >= o) ac += t; }
            aend = shf(ac, 63);
        } else { ac = (float)(lane + 1) * la; aend = 64.f * la; }
        if (w == 0) acs[lane] = ac;
        {
            const int row = tid >> 2, cc0 = (tid & 1) | ((tid & 2) << 1);
            const float ksc = shf(dtv, row) * kmul, wend = __expf(aend - shf(ac, row));
            float qa[2][8], ka[2][8];
#pragma unroll
            for (int i = 0; i < 2; ++i) { unpack8(gq[i], qa[i]); unpack8(gk[i], ka[i]); }
            if (rope) {
                const int tlr = dir ? (L - 1 - (n0 + row)) : (n0 + row);
                const int pos = (cc0 >> 2) ? (tlr & 63) : (tlr >> 6);
                const float* rp = ropeL + pos * 16 + (cc0 & 1) * 8;
                f32x4 rc[2], rs[2];
                rc[0] = *(const f32x4*)rp; rc[1] = *(const f32x4*)(rp + 4); rs[0] = *(const f32x4*)(rp + 1024); rs[1] = *(const f32x4*)(rp + 1028);
#pragma unroll
                for (int j = 0; j < 8; ++j) {
                    const float c = rc[j >> 2][j & 3], sn = rs[j >> 2][j & 3];
                    const float q1 = qa[0][j], q2 = qa[1][j], k1 = ka[0][j], k2 = ka[1][j];
                    qa[0][j] = q1 * c - q2 * sn; qa[1][j] = q2 * c + q1 * sn;
                    ka[0][j] = k1 * c - k2 * sn; ka[1][j] = k2 * c + k1 * sn;
                }
            }
#pragma unroll
            for (int i = 0; i < 2; ++i) {
                const int cc = cc0 + 2 * i;
                if (rope) *(u32x4*)(smem + QS + tile_off(64, cc >> 2, row, cc & 3, (row >> 2) & 3)) = pack8(qa[i]);
                else *(u32x4*)(smem + QS + tile_off(64, cc >> 2, row, cc & 3, (row >> 2) & 3)) = gq[i];
#pragma unroll
                for (int j = 0; j < 8; ++j) ka[i][j] *= ksc;
                *(u32x4*)(smem + KS + tile_off(64, cc >> 2, row, cc & 3, (row >> 3) & 3)) = pack8(ka[i]);
#pragma unroll
                for (int j = 0; j < 8; ++j) {
                    const int d = cc * 8 + j;
                    *(bf16_t*)(smem + KT + tile_off(64, row >> 5, d, (row >> 3) & 3, (d >> 2) & 3) + (row & 7) * 2) = f2bf(ka[i][j] * wend);
                }
            }
        }
#pragma unroll
        for (int i = 0; i < NV; ++i) {
            const int q = tid + 256 * i, row = q / (DV / 8), cc = q % (DV / 8);
            const u32x4 vv = gv[i];
#pragma unroll
            for (int j = 0; j < 8; ++j) {
                const int e = cc * 8 + j;
                const unsigned short h = (unsigned short)(vv[j >> 1] >> (16 * (j & 1)));
                *(bf16_t*)(smem + VTO + tile_off(DV, row >> 5, e, (row >> 3) & 3, (e >> 2) & 3) + (row & 7) * 2) = h;
            }
        }
        if (c + 1 < nch) issue(c + 1);
        __builtin_amdgcn_sched_barrier(0);
        __syncthreads();
        {
            const int irow = 16 * w + fr;
            const int ns = (w >> 1) + 1;
            bf16x8 qfr[2], sf[ET][2], kfa[2][2][2], vf[2][ET], kt2[2];
            qfr[0] = *(const bf16x8*)(smem + qoff); qfr[1] = *(const bf16x8*)(smem + qoff + 4096);
#pragma unroll
            for (int et = 0; et < ET; ++et)
#pragma unroll
                for (int ks = 0; ks < 2; ++ks) sf[et][ks] = *(const bf16x8*)(smem + stoff + et * 1024 + ks * DV * 64);
#pragma unroll
            for (int aa = 0; aa < 2; ++aa)
#pragma unroll
                for (int ks = 0; ks < 2; ++ks) kfa[0][aa][ks] = *(const bf16x8*)(smem + koff + (4 * aa) * 64 + ks * 4096);
            const float ai = acs[irow];
            f32x4 ajv[2][2];
#pragma unroll
            for (int aa = 0; aa < 2; ++aa) ajv[0][aa] = *(const f32x4*)(acs + 8 * g + 4 * aa);
            const float cd = __expf(acs[63]);
            __builtin_amdgcn_sched_barrier(0);
            f32x4 o[ET];
            if (!stateonly) {
#pragma unroll
                for (int et = 0; et < ET; ++et) {
                    o[et] = (f32x4){0.f, 0.f, 0.f, 0.f};
#pragma unroll
                    for (int ks = 0; ks < 2; ++ks) o[et] = __builtin_amdgcn_mfma_f32_16x16x32_bf16(sf[et][ks], qfr[ks], o[et], 0, 0, 0);
                }
            }
#pragma unroll
            for (int aa = 0; aa < 2; ++aa)
#pragma unroll
                for (int ks = 0; ks < 2; ++ks) kfa[1][aa][ks] = *(const bf16x8*)(smem + koff + (32 + 4 * aa) * 64 + ks * 4096);
#pragma unroll
            for (int ks = 0; ks < 2; ++ks) {
#pragma unroll
                for (int et = 0; et < ET; ++et) vf[ks][et] = *(const bf16x8*)(smem + vtoff + et * 1024 + ks * DV * 64);
                kt2[ks] = *(const bf16x8*)(smem + ktoff + ks * 4096);
            }
#pragma unroll
            for (int aa = 0; aa < 2; ++aa) ajv[1][aa] = *(const f32x4*)(acs + 32 + 8 * g + 4 * aa);
            __builtin_amdgcn_sched_barrier(0);
            if (!stateonly) {
                const float ei = __expf(ai);
#pragma unroll
                for (int et = 0; et < ET; ++et) o[et] = o[et] * ei;
#pragma unroll
                for (int s2 = 0; s2 < 2; ++s2) {
                    if (s2 < ns) {
                        f32x4 pp[2];
#pragma unroll
                        for (int aa = 0; aa < 2; ++aa) {
                            pp[aa] = (f32x4){0.f, 0.f, 0.f, 0.f};
#pragma unroll
                            for (int ks = 0; ks < 2; ++ks) pp[aa] = __builtin_amdgcn_mfma_f32_16x16x32_bf16(kfa[s2][aa][ks], qfr[ks], pp[aa], 0, 0, 0);
                        }
                        float pv[8];
#pragma unroll
                        for (int aa = 0; aa < 2; ++aa) {
                            const int j0 = 32 * s2 + 8 * g + 4 * aa;
#pragma unroll
                            for (int r = 0; r < 4; ++r) {
                                const float dec = __expf(fminf(ai - ajv[s2][aa][r], 0.f));
                                pv[4 * aa + r] = (j0 + r <= irow) ? pp[aa][r] * dec : 0.f;
                            }
                        }
                        const u32x4 pw = pack8(pv);
                        const bf16x8 pf = __builtin_bit_cast(bf16x8, pw);
#pragma unroll
                        for (int et = 0; et < ET; ++et) o[et] = __builtin_amdgcn_mfma_f32_16x16x32_bf16(vf[s2][et], pf, o[et], 0, 0, 0);
                    }
                }
                const int tl = dir ? (L - 1 - (n0 + irow)) : (n0 + irow);
                bf16_t* orow = Op + (size_t)tl * ldo + 4 * g;
#pragma unroll
                for (int et = 0; et < ET; ++et) {
                    u32x2 wv2; wv2[0] = pk2(o[et][0], o[et][1]); wv2[1] = pk2(o[et][2], o[et][3]);
                    st_wt8(orow + 16 * et, wv2);
                }
            }
            dprod *= cd;
#pragma unroll
            for (int et = 0; et < ET; ++et) sacc[et] = sacc[et] * cd;
#pragma unroll
            for (int ks = 0; ks < 2; ++ks)
#pragma unroll
                for (int et = 0; et < ET; ++et) sacc[et] = __builtin_amdgcn_mfma_f32_16x16x32_bf16(kt2[ks], vf[ks][et], sacc[et], 0, 0, 0);
        }
        __syncthreads();
#pragma unroll
        for (int et = 0; et < ET; ++et) {
            const int e = 16 * et + fr;
            u32x2 wv2; wv2[0] = pk2(sacc[et][0], sacc[et][1]); wv2[1] = pk2(sacc[et][2], sacc[et][3]);
            *(u32x2*)(smem + st_off + e * 64 + ((st_gg ^ FQ((e >> 2) & 3)) << 4)) = wv2;
        }
    }
    if (sout) {
#pragma unroll
        for (int et = 0; et < ET; ++et)
#pragma unroll
            for (int r = 0; r < 4; ++r) sout[(size_t)(16 * w + 4 * g + r) * lds_state + 16 * et + fr] = sacc[et][r];
    }
    if (lout) {
#pragma unroll
        for (int et = 0; et < ET; ++et)
#pragma unroll
            for (int r = 0; r < 4; ++r) st_wt2(lout + (16 * w + 4 * g + r) * DV + 16 * et + fr, f2bf(sacc[et][r]));
        if (tid == 0) st_wt4f(dout, dprod);
    }
    __syncthreads();
}

DI void scan_any_item(const Ctx& p, int l, int ps, int isret, int s, int h, int dir, int half, int mode, int seg, int sid, char* smem, int tid) {
    const Seq q = seq_info(s, ps);
    const bf16_t *Qp, *Kp, *Vp; size_t ld; const float* dtp; float acoef, kmul; const float* rope; bf16_t* O; float* so; int lds;
    if (isret) {
        const bf16_t* PR = (const bf16_t*)(p.ws() + OFF_PROJ) + (size_t)q.tok0 * INWP;
        const float x = p.in(23)[l * 8 + dir * 4 + h];
        acoef = fminf(x, 0.f) - log1pe(__expf(-fabsf(x)));
        Qp = PR + C_RQ + h * 64; Kp = PR + C_RK + h * 64; Vp = PR + C_RV + h * 128 + half * 64; ld = INWP; dtp = nullptr; kmul = 0.125f;
        rope = q.lat ? (const float*)(p.ws() + OFF_T16) : nullptr;
        O = (bf16_t*)(p.ws() + OFF_OR) + ((size_t)dir * NPT + q.tok0) * 512 + h * 128 + half * 64;
        so = p.out() + O_RET + ((size_t)((q.b * 2 + l) * 2 + dir) * 4 + h) * 8192 + half * 64; lds = 128;
    } else {
        const bf16_t* XB = (const bf16_t*)(p.ws() + OFF_XBCA) + (size_t)q.tok0 * 768;
        const int grp = h >> 2;
        Qp = XB + 640 + grp * 64; Kp = XB + 512 + grp * 64; Vp = XB + h * 64; ld = 768; kmul = 1.f; rope = nullptr;
        dtp = (const float*)(p.ws() + OFF_DT) + (size_t)q.tok0 * 16 + dir * 8 + h;
        acoef = -__expf(p.in(20)[l * 16 + dir * 8 + h]);
        O = (bf16_t*)(p.ws() + OFF_OS) + ((size_t)dir * NPT + q.tok0) * 512 + h * 64;
        so = p.out() + O_SSD + ((size_t)((q.b * 2 + l) * 2 + dir) * 8 + h) * 4096; lds = 64;
    }
    bf16_t* segb = (bf16_t*)(p.ws() + OFF_SEG) + (size_t)(sid * NSEG + seg) * 4096;
    float* segd = (float*)(p.ws() + OFF_SEGD) + sid * NSEG + seg;
    scan_item<4>(Qp, ld, Kp, ld, Vp, ld, dtp, acoef, q.L, dir, nullptr, mode == 0 ? so : nullptr, lds, O, 512, rope, kmul,
                 mode == 0 ? 0 : seg * SEGTOK, mode == 0 ? (q.L >> 6) : (SEGTOK >> 6), mode == 3 ? segb : nullptr, mode == 1 ? segb : nullptr, mode == 1 ? segd : nullptr, smem, tid);
}
DI void scan_combine_item(const Ctx& p, int l, int ps, int sid, int tid) {
    const float* s0; int ld;
    if (sid < 32) { const int b = ps * 2 + (sid >> 4), h = (sid >> 1) & 7, dir = sid & 1; s0 = p.in(2) + ((size_t)((b * 2 + l) * 2 + dir) * 8 + h) * 4096; ld = 64; }
    else { const int k = sid - 32, b = ps * 2 + (k >> 4), h = (k >> 2) & 3, dir = (k >> 1) & 1, half = k & 1;
           s0 = p.in(3) + ((size_t)((b * 2 + l) * 2 + dir) * 4 + h) * 8192 + half * 64; ld = 128; }
    bf16_t* segb = (bf16_t*)(p.ws() + OFF_SEG) + (size_t)sid * NSEG * 4096;
    const float* segd = (const float*)(p.ws() + OFF_SEGD) + sid * NSEG;
    const int t2 = launder(tid);
    const float* sp = s0 + (size_t)(t2 >> 2) * ld + (t2 & 3) * 16;
    bf16_t* bp = segb + t2 * 16;
    float S[16];
#pragma unroll
    for (int k = 0; k < 4; ++k) { const f32x4 v = *(const f32x4*)(sp + 4 * k); S[4 * k] = v[0]; S[4 * k + 1] = v[1]; S[4 * k + 2] = v[2]; S[4 * k + 3] = v[3]; }
#pragma unroll 1
    for (int g2 = 0; g2 < NSEG; ++g2) {
        float loc[16]; float d = 0.f;
        if (g2 < NSEG - 1) { d = segd[g2]; unpack8(*(const u32x4*)(bp + g2 * 4096), loc); unpack8(*(const u32x4*)(bp + g2 * 4096 + 8), loc + 8); }
        else {
#pragma unroll
            for (int k = 0; k < 16; ++k) loc[k] = 0.f;
        }
        st_wt16(bp + g2 * 4096, pack8(S)); st_wt16(bp + g2 * 4096 + 8, pack8(S + 8));
#pragma unroll
        for (int k = 0; k < 16; ++k) S[k] = S[k] * d + loc[k];
    }
}

template <int PT>
DI void postscan_tokens(const Ctx& p, int l, int m, int mstep, int lane) {
    char* ws = p.ws();
    const int c0 = lane * 8;
    const bf16_t* OS = (const bf16_t*)(ws + OFF_OS);
    const bf16_t* ORb = (const bf16_t*)(ws + OFF_OR);
    u32x4 in[PT][7];
#pragma unroll
    for (int u = 0; u < PT; ++u) {
        const int mu = m + u * mstep;
        const bf16_t* pr = (const bf16_t*)(ws + OFF_PROJ) + (size_t)mu * INWP;
        in[u][0] = gld16(OS + (size_t)mu * 512 + c0);
        in[u][1] = gld16(OS + ((size_t)NPT + mu) * 512 + c0);
        in[u][2] = gld16((const bf16_t*)(ws + OFF_XBCA) + (size_t)mu * 768 + c0);
        in[u][3] = gld16(pr + C_Z + c0);
        in[u][4] = gld16(ORb + (size_t)mu * 512 + c0);
        in[u][5] = gld16(ORb + ((size_t)NPT + mu) * 512 + c0);
        in[u][6] = gld16(pr + C_RG + c0);
    }
    const float dsk = p.in(21)[l * 8 + (c0 >> 6)];
    float w1[8], w2[8];
    {
        const float* w1p = p.in(22) + l * 512 + c0; const float* w2p = p.in(24) + l * 512 + c0;
        const f32x4 a0 = *(const f32x4*)w1p, a1 = *(const f32x4*)(w1p + 4), b0 = *(const f32x4*)w2p, b1 = *(const f32x4*)(w2p + 4);
#pragma unroll
        for (int e = 0; e < 4; ++e) { w1[e] = a0[e]; w1[4 + e] = a1[e]; w2[e] = b0[e]; w2[4 + e] = b1[e]; }
    }
    __builtin_amdgcn_sched_barrier(0);
#pragma unroll
    for (int u = 0; u < PT; ++u) {
        bf16_t* pr = (bf16_t*)(ws + OFF_PROJ) + (size_t)(m + u * mstep) * INWP;
        {
            float a[8], b[8], xs[8], z[8];
            unpack8(in[u][0], a); unpack8(in[u][1], b); unpack8(in[u][2], xs); unpack8(in[u][3], z);
            float v[8], ss = 0.f;
#pragma unroll
            for (int j = 0; j < 8; ++j) { v[j] = ((a[j] + b[j]) + dsk * xs[j]) * siluf(z[j]); ss += v[j] * v[j]; }
            ss = wsum(ss);
            const float rstd = rsqrtf(ss * (1.f / 512.f) + EPS);
#pragma unroll
            for (int j = 0; j < 8; ++j) v[j] = (v[j] * rstd) * w1[j];
            *(u32x4*)(pr + C_Z + c0) = pack8(v);
        }
        {
            float a[8], b[8], gt[8];
            unpack8(in[u][4], a); unpack8(in[u][5], b); unpack8(in[u][6], gt);
            float v[8], sm = 0.f;
#pragma unroll
            for (int j = 0; j < 8; ++j) { v[j] = a[j] + b[j]; sm += v[j]; }
            sm += shx(sm, 1); sm += shx(sm, 2); sm += shx(sm, 4); sm += shx(sm, 8);
            const float mean = sm * (1.f / 128.f);
            float sq = 0.f;
#pragma unroll
            for (int j = 0; j < 8; ++j) { v[j] -= mean; sq += v[j] * v[j]; }
            sq += shx(sq, 1); sq += shx(sq, 2); sq += shx(sq, 4); sq += shx(sq, 8);
            const float rstd = rsqrtf(sq * (1.f / 128.f) + EPS);
#pragma unroll
            for (int j = 0; j < 8; ++j) v[j] = (v[j] * rstd) * w2[j] * siluf(gt[j]);
            *(u32x4*)(pr + C_RG + c0) = pack8(v);
        }
    }
}


#ifndef ONLY2
#define ONLY2 -1
#endif
#ifndef PROBE_KIND
#define PROBE_KIND -1
#endif
DI void item_publish(unsigned* cnt, int tid) {
    asm volatile("s_waitcnt vmcnt(0)" ::: "memory");
    __syncthreads();
    if (tid == 0) __hip_atomic_fetch_add(cnt, 1u, __ATOMIC_RELAXED, __HIP_MEMORY_SCOPE_AGENT);
}
DI void item_wait(unsigned* cnt, unsigned need, int tid) {
    if (tid == 0) {
        unsigned sp = 0;
        while (__hip_atomic_load(cnt, __ATOMIC_RELAXED, __HIP_MEMORY_SCOPE_AGENT) < need) { __builtin_amdgcn_s_sleep(4); if (++sp > (1u << 24)) break; }
        __builtin_amdgcn_fence(__ATOMIC_ACQUIRE, "agent");
        asm volatile("s_waitcnt vmcnt(0)" ::: "memory");
    }
    __syncthreads();
}
DI int item_finish_next(unsigned* pubcnt, unsigned* qctr, volatile LAS unsigned* slot, int tid) {
    if (!pubcnt) return next_item(qctr, slot, tid);
    unsigned nx = 0u;
    if (tid == 0) nx = __hip_atomic_fetch_add(qctr, 1u, __ATOMIC_RELAXED, __HIP_MEMORY_SCOPE_AGENT);
    asm volatile("s_waitcnt vmcnt(0)" ::: "memory");
    __syncthreads();
    if (tid == 0) {
        __hip_atomic_fetch_add(pubcnt, 1u, __ATOMIC_RELAXED, __HIP_MEMORY_SCOPE_AGENT);
        *slot = nx;
    }
    __syncthreads();
    return (int)*slot;
}
DI void phase_mix(const Ctx& p, int l, int ps, unsigned* ctr, unsigned* c12, volatile LAS unsigned* slot, char* smem, int tid) {
    unsigned* gdone = ctr + 64; unsigned* sdone = ctr + 128;
    unsigned* c1 = c12; unsigned* c2 = c12 + 64;
    constexpr int N1 = 64 * (NSEG - 1), N3 = 64 * NSEG;
    constexpr int A0 = N1, A1 = A0 + 384, A2 = A1 + 544, A3 = A2 + 256, A4 = A3 + 64, A5 = A4 + N3, A6 = A5 + 256, A7 = A6 + 256, A8 = A7 + 256, A9 = A8 + 256, A10 = A9 + 256, A11 = A10 + 256;
    int it = next_item(ctr, slot, tid);
    for (;;) {
        tid = launder(tid);
        l = launder_s(l); ps = launder_s(ps);
        unsigned* pubp = nullptr;
        const int nwi = ps == 0 ? (l == 0 ? (T_UP + T_DN + T_IN) / 4 : (T_UP + T_DN) / 4) : 0;
        if (it >= A11 + nwi) break;
        if (it < 256) it += A2; else if (it < A3) it -= 256;
        int sc = -1, isret = 0, sq = 0, hd = 0, dr = 0, hf = 0, md = 0, sg = 0, sid = 0; unsigned* pub = sdone;
        if (it < A0) { sid = it / (NSEG - 1); sg = it % (NSEG - 1); md = 1; sc = 1; pub = c1 + sid * 128; }
        else if (it >= A4 && it < A5) { const int k = it - A4; sid = k / NSEG; sg = k % NSEG; md = 3; sc = 1; }
        else if (it >= A6 && it < A7) { const int k = it - A6; sq = k >> 4; hd = (k >> 1) & 7; dr = k & 1; sc = 0; }
        else if (it >= A7 && it < A8) { const int k = it - A7; isret = 1; sq = k >> 4; hd = (k >> 2) & 3; dr = (k >> 1) & 1; hf = k & 1; sc = 0; }
        if (sc == 1) {
            if (sid < 32) { isret = 0; sq = 16 + (sid >> 4); hd = (sid >> 1) & 7; dr = sid & 1; hf = 0; }
            else { const int k = sid - 32; isret = 1; sq = 16 + (k >> 4); hd = (k >> 2) & 3; dr = (k >> 1) & 1; hf = k & 1; }
        }
        if (sc >= 0) {
            if (md == 3) item_wait(c2 + sid * 128, 1u, tid);
            scan_any_item(p, l, ps, isret, sq, hd, dr, hf, md, sg, sid, smem, tid);
            pubp = pub;
        }
        else if (it < A1) { gemm_uq_tile(p, l, ps, it - A0, smem, tid); pubp = gdone; }
        else if (it < A2) { gemm_ukv_tile(p, l, it - A1, smem, tid); pubp = gdone; }
        else if (it < A3) { const int k = it - A2; attn_gqa_item(p, l, 16 + (k >> 7), (k >> 4) & 7, k & 15, ps, smem, tid); }
        else if (it < A4) { const int sd = it - A3; item_wait(c1 + sd * 128, (unsigned)(NSEG - 1), tid); scan_combine_item(p, l, ps, sd, tid); pubp = c2 + sd * 128; }
        else if (it < A6) { const int k = it - A5; item_wait(gdone, 928u, tid); attn_mla_item(p, 16 + (k >> 7), (k >> 4) & 7, k & 15, ps, smem, tid); }
        else if (it < A9) { const int k = it - A8; attn_gqa_item(p, l, k >> 4, (k >> 1) & 7, k & 1, ps, smem, tid); }
        else if (it < A10) { const int k = it - A9; item_wait(gdone, 928u, tid); attn_mla_item(p, k >> 4, (k >> 1) & 7, k & 1, ps, smem, tid); }
        else if (it < A10 + nwi) { const int w0 = l * T_LAYER + T_MIDEND + (it - A10) * 4; wtile_run(p, w0, w0 + 4, 1, smem, tid); }
        else { item_wait(sdone, (unsigned)(N3 + 512), tid); const int k = it - A10 - nwi; const int t5 = launder(tid); for (int i = 0; i < 8; i += 4) postscan_tokens<4>(p, l, k * 32 + i * 4 + (t5 >> 6), 4, t5 & 63); }
        it = item_finish_next(pubp, ctr, slot, tid);
    }
}

constexpr int NPHASE = 10;
DI void run_phase(const Ctx& p, int ph, volatile LAS unsigned* xw, char* smem, int tid) {
    if (ph == 0) { phase_prep_w(p, smem, tid); return; }
    const int q = ph - 1;
    unsigned* ctr = (unsigned*)(p.ws() + OFF_CTR) + ph;
    if (q & 1) {
        const int inst = q >> 1, ps = inst >> 1, l = inst & 1;
        phase_mix(p, l, ps, ctr, (unsigned*)(p.ws() + OFF_CTR) + CTR_STREAM + inst * 64 * 128, xw + 2, smem, tid);
    } else {
        const int ci = q >> 1;
        const int bi = ci - 1;
        phase_chain(p, ci, ci == 0, ci >= 1 ? (bi & 1) : -1, ci >= 1 ? (bi >> 1) : 0, ci <= 3 ? (ci & 1) : -1, ci <= 3 ? (ci >> 1) : 0, ctr, xw, smem, tid);
    }
}

__global__ void __launch_bounds__(256, 2) fwd_kernel(Params prm, int ph_lo, int ph_hi, int rep) {
    __shared__ __attribute__((aligned(16))) char smem_all[512 + 65536 + 2048];
    int tid = threadIdx.x;
    volatile LAS unsigned* xw = (volatile LAS unsigned*)(smem_all);
    volatile LAS unsigned* tbl = (volatile LAS unsigned*)(smem_all + 32);
    char* smem = smem_all + 512;
    if (tid == 0) { xw[0] = 0u; xw[1] = 0u; xw[2] = 0u; xw[3] = 0u; xw[5] = 1u; }
    if (tid == 0) {
#pragma unroll
        for (int i = 0; i < 44; ++i) {
            const unsigned long long v = (i < 42) ? (unsigned long long)prm.in[i < 42 ? i : 0] : (i == 42 ? (unsigned long long)prm.out : (unsigned long long)prm.ws);
            tbl[2 * i] = (unsigned)v; tbl[2 * i + 1] = (unsigned)(v >> 32);
        }
    }
    __syncthreads();
    Ctx p; p.tbl = tbl;
    XcdBarrier bar = xcd_barrier_post((unsigned*)(p.ws() + OFF_BAR), xw, tid);
    for (int ph = ph_lo; ph < ph_hi; ++ph) {
        tid = launder(tid);
        run_phase(p, launder_s(ph), xw, smem, tid);
        if (ph + 1 < ph_hi) xcd_barrier(bar, tid);
    }
}

extern "C" void kernel_launch(void* const* d_in, const int* in_sizes, int n_in, void* d_out, int out_size, void* d_ws, size_t ws_size, hipStream_t stream) {
    (void)in_sizes; (void)n_in; (void)out_size;
    if (ws_size < WS_NEED) { fprintf(stderr, "workspace too small: %zu < %zu\n", ws_size, (size_t)WS_NEED); return; }
    Params p{};
    for (int i = 0; i < 42; ++i) p.in[i] = (const float*)d_in[i];
    p.out = (float*)d_out; p.ws = (char*)d_ws;
    static int grid_blocks = 0;
    if (!grid_blocks) {
        int dev = 0, cus = 0, per_cu = 0;
        hipGetDevice(&dev);
        hipDeviceGetAttribute(&cus, hipDeviceAttributeMultiprocessorCount, dev);
        hipOccupancyMaxActiveBlocksPerMultiprocessor(&per_cu, fwd_kernel, 256, 0);
        if (per_cu > 2) per_cu = 2;
        if (per_cu < 1) per_cu = 1;
        grid_blocks = cus * per_cu;
    }
    hipMemsetAsync((char*)d_ws + OFF_BAR, 0, BAR_BYTES + CTR_BYTES, stream);
    {
        int lo = 0, hi = NPHASE, rep = 0;
        void* args[] = {&p, &lo, &hi, &rep};
        hipError_t e = hipLaunchCooperativeKernel((void*)fwd_kernel, dim3(grid_blocks), dim3(256), args, 0, stream);
        if (e != hipSuccess) fprintf(stderr, "cooperative launch failed: %s (grid %d)\n", hipGetErrorString(e), grid_blocks);
    }

}
```
